# Optimizing an MI355X kernel written in HIP

```python
import jax, jax.numpy as jnp
from jax import lax
import numpy as np

D_MODEL = 1024
BATCH = 4
SEQ = 4096
DEPTH = 2

GRID_W = 64
CTX_LEN = 256
MIX_WIDTH = D_MODEL // 2
HEAD_DIM = 64
GQA_HEADS = MIX_WIDTH // HEAD_DIM
GQA_KV_HEADS = GQA_HEADS // 4
NA_HEADS = MIX_WIDTH // HEAD_DIM
NA_WIN_ROWS = 8
NA_WIN_COLS = 16
FOURIER_WIDTH = MIX_WIDTH
FOURIER_GROUPS = 4
FOURIER_GROUP_DIM = FOURIER_WIDTH // FOURIER_GROUPS
CONV_WIDTH = MIX_WIDTH
CONV_KERNEL = 31
N_BRANCHES = 4
N_EXPERTS = 16
N_EXPERT_GROUPS = 4
EXPERTS_PER_GROUP = N_EXPERTS // N_EXPERT_GROUPS
TOP_K = 2
EXPERT_FF = D_MODEL // 2
Q_BLOCK = 128
ROPE_THETA = 10000.0
EPS = 1e-6
ATTN_SCALE = HEAD_DIM ** -0.5

GQA_Q_WIDTH = GQA_HEADS * HEAD_DIM
GQA_KV_WIDTH = GQA_KV_HEADS * HEAD_DIM
NA_WIDTH = NA_HEADS * HEAD_DIM
PROJ_SIZES = (GQA_Q_WIDTH, GQA_KV_WIDTH, GQA_KV_WIDTH, NA_WIDTH, NA_WIDTH, NA_WIDTH,
              FOURIER_WIDTH, 2 * CONV_WIDTH, N_BRANCHES * D_MODEL)
PROJ_SPLITS = tuple(int(v) for v in np.cumsum(PROJ_SIZES)[:-1])
IN_WIDTH = sum(PROJ_SIZES)

kernel_name = "hybrid_parallel_mixer_moe_dit"


def rms_norm(x, g):
    xf = x.astype(jnp.float32)
    y = xf * lax.rsqrt(jnp.mean(xf * xf, axis=-1, keepdims=True) + EPS)
    return (y * g.astype(jnp.float32)).astype(x.dtype)


def axial_rope(n_tokens):
    t = jnp.arange(n_tokens, dtype=jnp.int32)
    row = (t // GRID_W).astype(jnp.float32)
    col = (t % GRID_W).astype(jnp.float32)
    n_pairs = HEAD_DIM // 4
    inv_freq = ROPE_THETA ** (-jnp.arange(n_pairs, dtype=jnp.float32) / n_pairs)
    ang = jnp.concatenate([row[:, None] * inv_freq, col[:, None] * inv_freq], axis=-1)
    return jnp.cos(ang), jnp.sin(ang)


def apply_rope(x, cos, sin):
    xf = x.astype(jnp.float32).reshape(*x.shape[:-1], HEAD_DIM // 2, 2)
    x1, x2 = xf[..., 0], xf[..., 1]
    c = cos[None, :, None, :]
    s = sin[None, :, None, :]
    return jnp.stack([x1 * c - x2 * s, x1 * s + x2 * c], axis=-1).reshape(x.shape).astype(x.dtype)


def attend(qg, k, v):
    s = jnp.einsum('bqhgd,bkhd->bhgqk', qg, k, preferred_element_type=jnp.float32) * ATTN_SCALE
    p = jax.nn.softmax(s, axis=-1).astype(v.dtype)
    return jnp.einsum('bhgqk,bkhd->bqhgd', p, v)


def dense_attention(q, k, v):
    B, L, hq, _ = q.shape
    hkv = k.shape[2]
    out = attend(q.reshape(B, L, hkv, hq // hkv, HEAD_DIM), k, v)
    return out.reshape(B, L, hq * HEAD_DIM)


def gqa_latent(q, k, v, k_ctx, v_ctx):
    B, S = q.shape[:2]
    g = GQA_HEADS // GQA_KV_HEADS
    k_all = jnp.concatenate([k, k_ctx], axis=1)
    v_all = jnp.concatenate([v, v_ctx], axis=1)
    nb = S // Q_BLOCK
    qb = q.reshape(B, nb, Q_BLOCK, GQA_KV_HEADS, g, HEAD_DIM).transpose(1, 0, 2, 3, 4, 5)
    out = lax.map(lambda qblk: attend(qblk, k_all, v_all), qb)
    return out.transpose(1, 0, 2, 3, 4, 5).reshape(B, S, GQA_Q_WIDTH)


def neighbourhood_latent(q, k, v, k_ctx, v_ctx, rpb):
    B, S = q.shape[:2]
    rows = S // GRID_W
    wr = min(NA_WIN_ROWS, rows)
    qg = q.reshape(B, rows, GRID_W, NA_HEADS, HEAD_DIM)
    kg = k.reshape(B, rows, GRID_W, NA_HEADS, HEAD_DIM)
    vg = v.reshape(B, rows, GRID_W, NA_HEADS, HEAD_DIM)
    cols = np.arange(GRID_W)
    col_start = np.clip(cols - NA_WIN_COLS // 2, 0, GRID_W - NA_WIN_COLS)
    col_idx = col_start[:, None] + np.arange(NA_WIN_COLS)[None, :]
    col_bias_idx = col_idx - cols[:, None] + (NA_WIN_COLS - 1)
    row_starts = jnp.clip(jnp.arange(rows) - NA_WIN_ROWS // 2, 0, rows - wr)
    rpb_f = rpb.astype(jnp.float32)
    n_win = wr * NA_WIN_COLS

    def row_block(args):
        r, r0, q_row = args
        k_band = lax.dynamic_slice_in_dim(kg, r0, wr, axis=1)
        v_band = lax.dynamic_slice_in_dim(vg, r0, wr, axis=1)
        k_win = k_band[:, :, col_idx]
        v_win = v_band[:, :, col_idx]
        s_win = jnp.einsum('bqhd,bwqjhd->bhqwj', q_row, k_win,
                           preferred_element_type=jnp.float32) * ATTN_SCALE
        row_bias_idx = r0 + jnp.arange(wr) - r + (NA_WIN_ROWS - 1)
        bias = rpb_f[:, row_bias_idx][:, :, col_bias_idx]
        s_win = s_win + bias.transpose(0, 2, 1, 3)[None]
        s_ctx = jnp.einsum('bqhd,bkhd->bhqk', q_row, k_ctx,
                           preferred_element_type=jnp.float32) * ATTN_SCALE
        s = jnp.concatenate([s_win.reshape(B, NA_HEADS, GRID_W, n_win), s_ctx], axis=-1)
        p = jax.nn.softmax(s, axis=-1).astype(v.dtype)
        p_win = p[..., :n_win].reshape(B, NA_HEADS, GRID_W, wr, NA_WIN_COLS)
        p_ctx = p[..., n_win:]
        return (jnp.einsum('bhqwj,bwqjhd->bqhd', p_win, v_win)
                + jnp.einsum('bhqk,bkhd->bqhd', p_ctx, v_ctx))

    out = lax.map(row_block, (jnp.arange(rows), row_starts, qg.transpose(1, 0, 2, 3, 4)))
    return out.transpose(1, 0, 2, 3, 4).reshape(B, S, NA_WIDTH)


def fourier_mix(u):
    B, L = u.shape[:2]
    ug = u.astype(jnp.float32).reshape(B, L, FOURIER_GROUPS, FOURIER_GROUP_DIM)
    y = jnp.fft.fft2(ug, axes=(1, 3), norm='ortho').real
    return y.reshape(B, L, FOURIER_WIDTH).astype(u.dtype)


def conformer_conv(u, conv_w, conv_b, conv_g):
    a, b = jnp.split(u, 2, axis=-1)
    z = a * jax.nn.sigmoid(b)
    z = lax.conv_general_dilated(z, conv_w[:, None, :], window_strides=(1,),
                                 padding=[(CONV_KERNEL // 2, CONV_KERNEL // 2)],
                                 dimension_numbers=('NWC', 'WIO', 'NWC'),
                                 feature_group_count=CONV_WIDTH) + conv_b
    return jax.nn.silu(rms_norm(z, conv_g))


def merge_branches(branches, gate_logits, w_branch, w_out):
    y = jnp.stack(branches, axis=-2)
    z = jnp.einsum('blnc,ncd->blnd', y, w_branch)
    g = jax.nn.sigmoid(gate_logits.reshape(*gate_logits.shape[:-1], N_BRANCHES, D_MODEL)
                       .astype(jnp.float32)).astype(z.dtype)
    return jnp.sum(g * z, axis=-2) @ w_out


def token_mixer(h, hc, w_in, q_g, k_g, rpb, conv_w, conv_b, conv_g, w_branch, w_out, cos, sin, update_ctx):
    B, S, _ = h.shape
    C = hc.shape[1]
    gq, gk, gv, nq, nk, nv, fu, cu, gl = jnp.split(h @ w_in, PROJ_SPLITS, axis=-1)
    cgq, cgk, cgv, cnq, cnk, cnv, cfu, ccu, cgl = jnp.split(hc @ w_in, PROJ_SPLITS, axis=-1)
    q = apply_rope(rms_norm(gq.reshape(B, S, GQA_HEADS, HEAD_DIM), q_g), cos, sin)
    k = apply_rope(rms_norm(gk.reshape(B, S, GQA_KV_HEADS, HEAD_DIM), k_g), cos, sin)
    v = gv.reshape(B, S, GQA_KV_HEADS, HEAD_DIM)
    kc = rms_norm(cgk.reshape(B, C, GQA_KV_HEADS, HEAD_DIM), k_g)
    vc = cgv.reshape(B, C, GQA_KV_HEADS, HEAD_DIM)
    y_gqa = gqa_latent(q, k, v, kc, vc)
    nkc = cnk.reshape(B, C, NA_HEADS, HEAD_DIM)
    nvc = cnv.reshape(B, C, NA_HEADS, HEAD_DIM)
    y_na = neighbourhood_latent(nq.reshape(B, S, NA_HEADS, HEAD_DIM), nk.reshape(B, S, NA_HEADS, HEAD_DIM),
                                nv.reshape(B, S, NA_HEADS, HEAD_DIM), nkc, nvc, rpb)
    y_fn = fourier_mix(fu)
    y_cv = conformer_conv(cu, conv_w, conv_b, conv_g)
    out = merge_branches((y_gqa, y_na, y_fn, y_cv), gl, w_branch, w_out)
    if not update_ctx:
        return out, None
    qc = rms_norm(cgq.reshape(B, C, GQA_HEADS, HEAD_DIM), q_g)
    yc_gqa = dense_attention(qc, kc, vc)
    yc_na = dense_attention(cnq.reshape(B, C, NA_HEADS, HEAD_DIM), nkc, nvc)
    yc_fn = fourier_mix(cfu)
    yc_cv = conformer_conv(ccu, conv_w, conv_b, conv_g)
    out_c = merge_branches((yc_gqa, yc_na, yc_fn, yc_cv), cgl, w_branch, w_out)
    return out, out_c


def moe(h, w_router, router_bias, w_gu, w_down):
    lead = h.shape[:-1]
    t = h.reshape(-1, D_MODEL)
    scores = jax.nn.sigmoid((t @ w_router).astype(jnp.float32))
    sel = scores + router_bias.astype(jnp.float32)
    group_score = lax.top_k(sel.reshape(-1, N_EXPERT_GROUPS, EXPERTS_PER_GROUP), TOP_K)[0].sum(-1)
    g_idx = jnp.argmax(group_score, axis=-1)
    in_group = (jnp.arange(N_EXPERTS) // EXPERTS_PER_GROUP)[None, :] == g_idx[:, None]
    _, top_idx = lax.top_k(jnp.where(in_group, sel, -jnp.inf), TOP_K)
    w = jnp.take_along_axis(scores, top_idx, axis=-1)
    w = w / jnp.sum(w, axis=-1, keepdims=True)
    gate = jnp.sum(jax.nn.one_hot(top_idx, N_EXPERTS, dtype=jnp.float32) * w[..., None], axis=1).astype(t.dtype)
    out = jnp.zeros_like(t)
    for e in range(N_EXPERTS):
        a, b = jnp.split(t @ w_gu[e], 2, axis=-1)
        out = out + gate[:, e:e + 1] * ((jax.nn.silu(a) * b) @ w_down[e])
    return out.reshape(*lead, D_MODEL)


def setup_inputs(seed: int = 0) -> dict:
    key = jax.random.key(seed)
    ks = jax.random.split(key, 22)
    D = D_MODEL

    def nrm(k, shape, std):
        return jax.random.normal(k, shape, jnp.float32) * std

    return {
        "x": nrm(ks[0], (BATCH, SEQ, D), 1.0),
        "c": nrm(ks[1], (BATCH, D), 1.0),
        "ctx": nrm(ks[2], (BATCH, CTX_LEN, D), 1.0),
        "c_ctx": nrm(ks[3], (D,), 1.0),
        "w_mod": nrm(ks[4], (DEPTH, D, 6 * D), 0.5 * D ** -0.5),
        "b_mod": nrm(ks[5], (DEPTH, 6 * D), 0.02),
        "norm1_g": 1.0 + nrm(ks[6], (DEPTH, D), 0.02),
        "norm2_g": 1.0 + nrm(ks[7], (DEPTH, D), 0.02),
        "w_in": nrm(ks[8], (DEPTH, D, IN_WIDTH), D ** -0.5),
        "q_norm_g": 1.0 + nrm(ks[9], (DEPTH, HEAD_DIM), 0.02),
        "k_norm_g": 1.0 + nrm(ks[10], (DEPTH, HEAD_DIM), 0.02),
        "na_rpb": nrm(ks[11], (DEPTH, NA_HEADS, 2 * NA_WIN_ROWS - 1, 2 * NA_WIN_COLS - 1), 0.02),
        "conv_w": nrm(ks[12], (DEPTH, CONV_KERNEL, CONV_WIDTH), CONV_KERNEL ** -0.5),
        "conv_b": nrm(ks[13], (DEPTH, CONV_WIDTH), 0.01),
        "conv_norm_g": 1.0 + nrm(ks[14], (DEPTH, CONV_WIDTH), 0.02),
        "w_branch": nrm(ks[15], (DEPTH, N_BRANCHES, MIX_WIDTH, D), MIX_WIDTH ** -0.5),
        "w_out": nrm(ks[16], (DEPTH, D, D), D ** -0.5),
        "w_router": nrm(ks[17], (D, N_EXPERTS), D ** -0.5),
        "router_bias": nrm(ks[18], (N_EXPERTS,), 0.01),
        "w_expert_gu": nrm(ks[19], (DEPTH, N_EXPERTS, D, 2 * EXPERT_FF), D ** -0.5),
        "w_expert_down": nrm(ks[20], (DEPTH, N_EXPERTS, EXPERT_FF, D), EXPERT_FF ** -0.5),
        "final_norm_g": 1.0 + nrm(ks[21], (D,), 0.02),
    }


def reference(x, c, ctx, c_ctx, w_mod, b_mod, norm1_g, norm2_g, w_in, q_norm_g, k_norm_g, na_rpb,
              conv_w, conv_b, conv_norm_g, w_branch, w_out, w_router, router_bias,
              w_expert_gu, w_expert_down, final_norm_g):
    S = x.shape[1]
    cos, sin = axial_rope(S)
    xc = ctx
    for l in range(DEPTH):
        update_ctx = l < DEPTH - 1
        m = jax.nn.silu(c) @ w_mod[l] + b_mod[l]
        sh1, sc1, g1, sh2, sc2, g2 = [t[:, None, :] for t in jnp.split(m, 6, axis=-1)]
        mc = jax.nn.silu(c_ctx) @ w_mod[l] + b_mod[l]
        csh1, csc1, cg1, csh2, csc2, cg2 = jnp.split(mc, 6, axis=-1)
        h = rms_norm(x, norm1_g[l]) * (1.0 + sc1) + sh1
        hc = rms_norm(xc, norm1_g[l]) * (1.0 + csc1) + csh1
        y, yc = token_mixer(h, hc, w_in[l], q_norm_g[l], k_norm_g[l], na_rpb[l], conv_w[l], conv_b[l],
                            conv_norm_g[l], w_branch[l], w_out[l], cos, sin, update_ctx)
        x = x + g1 * y
        h2 = rms_norm(x, norm2_g[l]) * (1.0 + sc2) + sh2
        if update_ctx:
            xc = xc + cg1 * yc
            h2c = rms_norm(xc, norm2_g[l]) * (1.0 + csc2) + csh2
            z = moe(jnp.concatenate([h2, h2c], axis=1), w_router, router_bias, w_expert_gu[l], w_expert_down[l])
            x = x + g2 * z[:, :S]
            xc = xc + cg2 * z[:, S:]
        else:
            x = x + g2 * moe(h2, w_router, router_bias, w_expert_gu[l], w_expert_down[l])
    return rms_norm(x, final_norm_g)
```

```cpp
#include <hip/hip_runtime.h>
#include <hip/hip_bf16.h>
#include <cstdio>
#include <cstdint>
#include <cmath>

namespace pg8 {
#define PG8_LAS __attribute__((address_space(3)))
#define PG8_GAS __attribute__((address_space(1)))
typedef unsigned short bf16_t;
typedef short bf16x8 __attribute__((ext_vector_type(8)));
typedef float f32x4 __attribute__((ext_vector_type(4)));
typedef unsigned u32x4 __attribute__((ext_vector_type(4)));
constexpr int BM = 256, BK = 64, HALF = 128, HTB = HALF * BK * 2, STAGE_BYTES = 8 * HTB, NXCD = 8, WGM = 8;

__host__ __device__ __forceinline__ int lds_byte(int r, int c) { const int st = (r >> 4) * 2 + (c >> 5), rr = r & 15, cc = c & 31, ob = rr * 64 + cc * 2; return st * 1024 + (ob ^ (((ob >> 9) & 1) << 5)); }
__host__ __device__ __forceinline__ void stage_rc(int b, int& R, int& C) { const int st = b / 1024, sb = b % 1024, swz = sb ^ (((sb >> 9) & 1) << 5); R = (st >> 1) * 16 + swz / 64; C = (st & 1) * 32 + (swz % 64) / 2; }
__host__ __device__ __forceinline__ int perm32(int rho) { const int n = rho >> 4, i = rho & 15; return 8 * (i >> 2) + 4 * n + (i & 3); }

struct Unit { int pm, pn, aux; size_t aoff, boff; };

__device__ __forceinline__ void tile_map(int L, int nM, int nN, int& pm, int& pn) {
    const int nwg = nM * nN; int wgid = L;
    { const int q = nwg / NXCD, r = nwg % NXCD, xcd = wgid % NXCD, off = wgid / NXCD; wgid = (xcd < r ? xcd * (q + 1) : r * (q + 1) + (xcd - r) * q) + off; }
    const int nig = WGM * nN, gid = wgid / nig, fm = gid * WGM, gsz = (nM - fm) < WGM ? (nM - fm) : WGM;
    pm = fm + ((wgid % nig) % gsz); pn = (wgid % nig) / gsz;
}

__device__ __forceinline__ unsigned cvt_pk_bf16(float lo, float hi) { unsigned r; asm volatile("v_cvt_pk_bf16_f32 %0, %1, %2" : "=v"(r) : "v"(lo), "v"(hi)); return r; }
__device__ __forceinline__ float fast_sigmoid(float x) { return __builtin_amdgcn_rcpf(1.0f + __builtin_amdgcn_exp2f(-1.4426950408889634f * x)); }
__device__ __forceinline__ float bflo(unsigned w) { return __uint_as_float(w << 16); }
__device__ __forceinline__ float bfhi(unsigned w) { return __uint_as_float(w & 0xffff0000u); }

struct EpiP {
    static constexpr bool PERM = true, KEEP = false;
    PG8_GAS bf16_t* O; int ldc; int sig_from;
    __device__ __forceinline__ void operator()(f32x4 (&acc)[2][2][4][2], const Unit& u, int wr, int wc, int fr, int fq) const {
        const int row0 = u.pm * BM + wr * 64 + fr, col0 = u.pn * BM + wc * 32 + 8 * fq; const bool sig = u.pn >= sig_from;
#pragma unroll
        for (int ai = 0; ai < 2; ++ai)
#pragma unroll
            for (int m = 0; m < 4; ++m) { PG8_GAS bf16_t* rowp = O + (size_t)(row0 + ai * HALF + m * 16) * ldc + col0;
#pragma unroll
                for (int bj = 0; bj < 2; ++bj) { f32x4 v0 = acc[ai][bj][m][0], v1 = acc[ai][bj][m][1];
                    if (sig) {
#pragma unroll
                        for (int k = 0; k < 4; ++k) { v0[k] = __builtin_fmaxf(fast_sigmoid(v0[k]), 1e-20f); v1[k] = __builtin_fmaxf(fast_sigmoid(v1[k]), 1e-20f); } }
                    u32x4 w; w.x = cvt_pk_bf16(v0[0], v0[1]); w.y = cvt_pk_bf16(v0[2], v0[3]); w.z = cvt_pk_bf16(v1[0], v1[1]); w.w = cvt_pk_bf16(v1[2], v1[3]);
                    *(PG8_GAS u32x4*)(rowp + bj * HALF) = w; } }
    }
};
struct EpiBranch {
    static constexpr bool PERM = true, KEEP = true;
    const PG8_GAS bf16_t* G; int ldg; PG8_GAS bf16_t* O; int ldc;
    __device__ __forceinline__ void operator()(f32x4 (&acc)[2][2][4][2], const Unit& u, int wr, int wc, int fr, int fq) const {
        const int row0 = u.pm * BM + wr * 64 + fr, col0 = u.pn * BM + wc * 32 + 8 * fq; const int nb = u.aux;
#pragma unroll
        for (int ai = 0; ai < 2; ++ai)
#pragma unroll
            for (int m = 0; m < 4; ++m) { const size_t row = (size_t)(row0 + ai * HALF + m * 16);
#pragma unroll
                for (int bj = 0; bj < 2; ++bj) { const int col = col0 + bj * HALF; const PG8_GAS bf16_t* gp = G + row * ldg + nb * 1024 + col;
                    const u32x4 g0 = *(const PG8_GAS u32x4*)gp; float f[8] = {bflo(g0.x), bfhi(g0.x), bflo(g0.y), bfhi(g0.y), bflo(g0.z), bfhi(g0.z), bflo(g0.w), bfhi(g0.w)};
                    if (nb < 3) { const u32x4 g1 = *(const PG8_GAS u32x4*)(gp + 1024);
                        f[0] *= __builtin_amdgcn_rcpf(bflo(g1.x)); f[1] *= __builtin_amdgcn_rcpf(bfhi(g1.x)); f[2] *= __builtin_amdgcn_rcpf(bflo(g1.y)); f[3] *= __builtin_amdgcn_rcpf(bfhi(g1.y));
                        f[4] *= __builtin_amdgcn_rcpf(bflo(g1.z)); f[5] *= __builtin_amdgcn_rcpf(bfhi(g1.z)); f[6] *= __builtin_amdgcn_rcpf(bflo(g1.w)); f[7] *= __builtin_amdgcn_rcpf(bfhi(g1.w)); }
                    f32x4 v0 = acc[ai][bj][m][0], v1 = acc[ai][bj][m][1];
                    v0[0] *= f[0]; v0[1] *= f[1]; v0[2] *= f[2]; v0[3] *= f[3]; v1[0] *= f[4]; v1[1] *= f[5]; v1[2] *= f[6]; v1[3] *= f[7];
                    if (nb < 3) { acc[ai][bj][m][0] = v0; acc[ai][bj][m][1] = v1; }
                    else { u32x4 w; w.x = cvt_pk_bf16(v0[0], v0[1]); w.y = cvt_pk_bf16(v0[2], v0[3]); w.z = cvt_pk_bf16(v1[0], v1[1]); w.w = cvt_pk_bf16(v1[2], v1[3]);
                        *(PG8_GAS u32x4*)(O + row * ldc + col) = w; acc[ai][bj][m][0] = (f32x4){0.f, 0.f, 0.f, 0.f}; acc[ai][bj][m][1] = (f32x4){0.f, 0.f, 0.f, 0.f}; } } }
    }
};
struct EpiRes {
    static constexpr bool PERM = false, KEEP = false;
    const PG8_GAS float* base_lat; const PG8_GAS float* base_ctx; PG8_GAS float* out_lat; PG8_GAS float* out_ctx; const PG8_GAS float* gmod;
    __device__ __forceinline__ void operator()(f32x4 (&acc)[2][2][4][2], const Unit& u, int wr, int wc, int fr, int fq) const {
        const int b = u.pm / 17, j = u.pm % 17;
        const size_t ro = (j < 16) ? ((size_t)b * 4096 + (size_t)j * 256) * 1024 : (size_t)b * 256 * 1024;
        const PG8_GAS float* bp = ((j < 16) ? base_lat : base_ctx) + ro; PG8_GAS float* op = ((j < 16) ? out_lat : out_ctx) + ro; const PG8_GAS float* gv = gmod + ((j < 16) ? b : 4) * 6144;
        const int col0 = u.pn * BM + wc * 32 + 4 * fq;
#pragma unroll
        for (int bj = 0; bj < 2; ++bj)
#pragma unroll
            for (int n = 0; n < 2; ++n) { const int col = col0 + bj * HALF + n * 16; const f32x4 g = *(const PG8_GAS f32x4*)(gv + col);
#pragma unroll
                for (int ai = 0; ai < 2; ++ai)
#pragma unroll
                    for (int m = 0; m < 4; ++m) { const size_t off = (size_t)(ai * HALF + wr * 64 + m * 16 + fr) * 1024 + col;
                        const f32x4 bs = *(const PG8_GAS f32x4*)(bp + off); *(PG8_GAS f32x4*)(op + off) = bs + g * acc[ai][bj][m][n]; } }
    }
};
struct EpiGU {
    static constexpr bool PERM = true, KEEP = false;
    PG8_GAS bf16_t* O; int ldc;
    __device__ __forceinline__ void operator()(f32x4 (&acc)[2][2][4][2], const Unit& u, int wr, int wc, int fr, int fq) const {
        const int row0 = u.pm * BM + wr * 64 + fr, col0 = u.pn * HALF + wc * 32 + 8 * fq;
#pragma unroll
        for (int ai = 0; ai < 2; ++ai)
#pragma unroll
            for (int m = 0; m < 4; ++m) { float o[8];
#pragma unroll
                for (int n = 0; n < 2; ++n)
#pragma unroll
                    for (int k = 0; k < 4; ++k) { const float a = acc[ai][0][m][n][k], b = acc[ai][1][m][n][k]; o[n * 4 + k] = a * fast_sigmoid(a) * b; }
                u32x4 w; w.x = cvt_pk_bf16(o[0], o[1]); w.y = cvt_pk_bf16(o[2], o[3]); w.z = cvt_pk_bf16(o[4], o[5]); w.w = cvt_pk_bf16(o[6], o[7]);
                *(PG8_GAS u32x4*)(O + (size_t)(row0 + ai * HALF + m * 16) * ldc + col0) = w; }
    }
};

template <class Epi, class Sched, bool ALIGN_EPI>
__device__ __forceinline__ void gemm_phase(PG8_LAS unsigned char* lds, int tid, const PG8_GAS bf16_t* A, const PG8_GAS bf16_t* Bt, int lda, int ldb, int K, const Sched& S, const Epi& E) {
    const int wid = __builtin_amdgcn_readfirstlane(tid >> 6), lane = tid & 63, wr = wid >> 2, wc = wid & 3, fr = lane & 15, fq = lane >> 4;
    const int nt = K / BK;
    unsigned voffA[2], voffB[2];
#pragma unroll
    for (int i = 0; i < 2; ++i) { int R, C; stage_rc(tid * 16 + i * 8192, R, C); const int Rb = Epi::PERM ? ((R & ~31) + perm32(R & 31)) : R;
        voffA[i] = (unsigned)(R * lda + C) * 2u; voffB[i] = (unsigned)(Rb * ldb + C) * 2u; }
    const size_t kstep = (size_t)(BK * 2);
    const size_t hstepA = (size_t)HALF * lda * 2, hstepB = (size_t)HALF * ldb * 2;
    const unsigned ldsw = (unsigned)wid * 1024u;
    const int aoff = lds_byte(wr * 64 + fr, fq * 8), boff = lds_byte(wc * 32 + fr, fq * 8);
#define PG8_SA(b, h) (((b) * 2 + (h)) * HTB)
#define PG8_SB(b, h) ((4 + (b) * 2 + (h)) * HTB)
#define PG8_STAGE(bufoff, gbase, voff) do { _Pragma("unroll") for (int _i = 0; _i < 2; ++_i) \
        __builtin_amdgcn_global_load_lds((const PG8_GAS unsigned*)((const PG8_GAS char*)(gbase) + (voff)[_i]), (PG8_LAS unsigned*)(lds + (bufoff) + ldsw + _i * 8192), 16, 0, 0); } while (0)
#define PG8_LDA(dst, b, h) do { _Pragma("unroll") for (int m = 0; m < 4; ++m) _Pragma("unroll") for (int k = 0; k < 2; ++k) dst[m][k] = *(const PG8_LAS bf16x8*)(lds + PG8_SA(b, h) + aoff + m * 2048 + k * 1024); } while (0)
#define PG8_LDB(dst, b, h) do { _Pragma("unroll") for (int n = 0; n < 2; ++n) _Pragma("unroll") for (int k = 0; k < 2; ++k) dst[n][k] = *(const PG8_LAS bf16x8*)(lds + PG8_SB(b, h) + boff + n * 2048 + k * 1024); } while (0)
#define PG8_MMA(ai, bj, At, Bt_) do { __builtin_amdgcn_s_setprio(1); _Pragma("unroll") for (int m = 0; m < 4; ++m) _Pragma("unroll") for (int n = 0; n < 2; ++n) _Pragma("unroll") for (int k = 0; k < 2; ++k) \
        acc[ai][bj][m][n] = __builtin_amdgcn_mfma_f32_16x16x32_bf16(Bt_[n][k], At[m][k], acc[ai][bj][m][n], 0, 0, 0); __builtin_amdgcn_s_setprio(0); } while (0)
#define PG8_WAIT_V(n) asm volatile("s_waitcnt vmcnt(" #n ")" ::: "memory")
#define PG8_WAIT_L(n) asm volatile("s_waitcnt lgkmcnt(" #n ")" ::: "memory")
#define PG8_BAR __builtin_amdgcn_s_barrier()
#define PG8_SCHED __builtin_amdgcn_sched_barrier(0)
    Unit cur, nxt; int ui = 0;
    if (!S.next(0, cur)) return;
    f32x4 acc[2][2][4][2];
#pragma unroll
    for (int a = 0; a < 2; ++a)
#pragma unroll
        for (int b = 0; b < 2; ++b)
#pragma unroll
            for (int m = 0; m < 4; ++m)
#pragma unroll
                for (int n = 0; n < 2; ++n) acc[a][b][m][n] = (f32x4){0.f, 0.f, 0.f, 0.f};
    bf16x8 At[4][2], B0[2][2], B1[2][2];
    const PG8_GAS char* cA = (const PG8_GAS char*)A + cur.aoff; const PG8_GAS char* cB = (const PG8_GAS char*)Bt + cur.boff;
    PG8_STAGE(PG8_SB(0, 0), cB, voffB); PG8_STAGE(PG8_SB(0, 1), cB + hstepB, voffB); PG8_STAGE(PG8_SA(0, 0), cA, voffA); PG8_STAGE(PG8_SA(0, 1), cA + hstepA, voffA);
    if (wr == 1) PG8_BAR;
    PG8_WAIT_V(2); PG8_BAR;
    PG8_STAGE(PG8_SB(1, 0), cB + kstep, voffB); PG8_STAGE(PG8_SA(1, 0), cA + kstep, voffA); PG8_STAGE(PG8_SB(1, 1), cB + hstepB + kstep, voffB);
    PG8_WAIT_V(6); PG8_BAR;
    for (;;) {
        const bool has_next = S.next(ui + 1, nxt);
        const PG8_GAS char* nA = has_next ? (const PG8_GAS char*)A + nxt.aoff : cA; const PG8_GAS char* nB = has_next ? (const PG8_GAS char*)Bt + nxt.boff : cB;
        for (int t = 0; t < nt; t += 2) {
            const bool last = (t == nt - 2);
            const PG8_GAS char* a1 = cA + (size_t)(t + 1) * kstep;
            const PG8_GAS char* a2 = last ? nA : cA + (size_t)(t + 2) * kstep; const PG8_GAS char* b2 = last ? nB : cB + (size_t)(t + 2) * kstep;
            const PG8_GAS char* a3 = a2 + kstep; const PG8_GAS char* b3 = b2 + kstep;
            PG8_LDB(B0, 0, 0); PG8_LDB(B1, 0, 1); PG8_SCHED; PG8_LDA(At, 0, 0); PG8_STAGE(PG8_SA(1, 1), a1 + hstepA, voffA);
            PG8_WAIT_V(8); PG8_WAIT_L(0); PG8_BAR; PG8_MMA(0, 0, At, B0); PG8_MMA(0, 1, At, B1); PG8_BAR; PG8_SCHED;
            PG8_LDA(At, 0, 1); PG8_STAGE(PG8_SB(0, 0), b2, voffB); PG8_STAGE(PG8_SB(0, 1), b2 + hstepB, voffB); PG8_STAGE(PG8_SA(0, 0), a2, voffA);
            PG8_WAIT_V(8); PG8_WAIT_L(0); PG8_BAR; PG8_MMA(1, 0, At, B0); PG8_MMA(1, 1, At, B1); PG8_BAR; PG8_SCHED;
            PG8_LDB(B0, 1, 0); PG8_LDB(B1, 1, 1); PG8_SCHED; PG8_LDA(At, 1, 0); PG8_STAGE(PG8_SA(0, 1), a2 + hstepA, voffA);
            PG8_WAIT_V(8); PG8_WAIT_L(0); PG8_BAR; PG8_MMA(0, 0, At, B0); PG8_MMA(0, 1, At, B1); PG8_BAR; PG8_SCHED;
            PG8_LDA(At, 1, 1); PG8_STAGE(PG8_SB(1, 0), b3, voffB); PG8_STAGE(PG8_SB(1, 1), b3 + hstepB, voffB); PG8_STAGE(PG8_SA(1, 0), a3, voffA);
            PG8_WAIT_V(8); PG8_WAIT_L(0); PG8_BAR; PG8_MMA(1, 0, At, B0); PG8_MMA(1, 1, At, B1); PG8_BAR; PG8_SCHED;
        }
        if constexpr (ALIGN_EPI) { if (wr == 0) PG8_BAR; }
        E(acc, cur, wr, wc, fr, fq);
        if (!has_next) break;
        if constexpr (!Epi::KEEP) {
#pragma unroll
            for (int a = 0; a < 2; ++a)
#pragma unroll
                for (int b = 0; b < 2; ++b)
#pragma unroll
                    for (int m = 0; m < 4; ++m)
#pragma unroll
                        for (int n = 0; n < 2; ++n) acc[a][b][m][n] = (f32x4){0.f, 0.f, 0.f, 0.f};
        }
        cur = nxt; cA = nA; cB = nB; ++ui;
        if constexpr (ALIGN_EPI) { if (wr == 1) PG8_BAR; }
    }
    PG8_WAIT_V(0);
    if constexpr (!ALIGN_EPI) { if (wr == 0) PG8_BAR; }
    PG8_BAR;
#undef PG8_SA
#undef PG8_SB
#undef PG8_STAGE
#undef PG8_LDA
#undef PG8_LDB
#undef PG8_MMA
#undef PG8_WAIT_V
#undef PG8_WAIT_L
#undef PG8_BAR
#undef PG8_SCHED
}
}
namespace attn_body {
using bf16=__hip_bfloat16;
using bf16x8=__attribute__((ext_vector_type(8)))short;
using s16x4=__attribute__((ext_vector_type(4)))short;
using f32x16=__attribute__((ext_vector_type(16)))float;
using u32x4=__attribute__((ext_vector_type(4)))unsigned;
constexpr int D=64;
constexpr int QP=8448,KP=8448,VP=8448,OP=2048;
constexpr int NW=8,QBLK=32,QB=QBLK*NW,KVBLK=64;
__device__ __forceinline__ int crow(int r,int hi){return (r&3)+8*(r>>2)+4*hi;}
#define SBAR() __builtin_amdgcn_sched_barrier(0)
#define AGAS __attribute__((address_space(1)))
constexpr int NSLOT=3, SLOTB=8192;
constexpr int LDS_K=0, LDS_V=NSLOT*SLOTB, LDS_WS=2*NSLOT*SLOTB, LDS_OST=LDS_WS+NW*64*4, LDS_BIAS=LDS_OST+NW*4096, LDS_BYTES=LDS_BIAS+8192;
constexpr float C2=0.125f*1.4426950408889634f;
__device__ __forceinline__ void glds16(const AGAS void*gsrc,unsigned lds_dst){unsigned keep;
  asm volatile("s_mov_b32 %0, m0\n\ts_mov_b32 m0, %2\n\ts_nop 0\n\tglobal_load_lds_dwordx4 %1, off\n\ts_mov_b32 m0, %0":"=&s"(keep):"v"(gsrc),"s"(lds_dst):"memory");}
__device__ __forceinline__ float max3f(float a,float b,float c){float r;asm("v_max3_f32 %0, %1, %2, %3":"=v"(r):"v"(a),"v"(b),"v"(c));return r;}
__device__ __forceinline__ float max2f(float a,float b){float r;asm("v_max_f32_e32 %0, %1, %2":"=v"(r):"v"(a),"v"(b));return r;}
__device__ __forceinline__ float fadd_s(float a,float b){float r;asm("v_add_f32_e32 %0, %1, %2":"=v"(r):"v"(a),"v"(b));return r;}
__device__ __forceinline__ float fsub_s(float a,float b){float r;asm("v_sub_f32_e32 %0, %1, %2":"=v"(r):"v"(a),"v"(b));return r;}
typedef float f32x2_t __attribute__((ext_vector_type(2))); typedef __bf16 bf16x2_t __attribute__((ext_vector_type(2)));
__device__ __forceinline__ unsigned cvtpk_s(float lo,float hi){f32x2_t v={lo,hi};bf16x2_t b=__builtin_convertvector(v,bf16x2_t);return __builtin_bit_cast(unsigned,b);}
#define WAIT_BAR(N) asm volatile("s_waitcnt vmcnt(" #N ") lgkmcnt(0)\n\ts_barrier":::"memory")

__device__ __forceinline__ void qkt(f32x16&p0,f32x16&p1,const char*Kslot,const bf16x8*qr,const f32x16&negm,int r32,int hi){
  const char*kb=Kslot+hi*1024+r32*16;
  #pragma unroll
  for(int d0=0;d0<4;++d0){
    const bf16x8 b0=*reinterpret_cast<const bf16x8*>(kb+d0*2048);
    const bf16x8 b1=*reinterpret_cast<const bf16x8*>(kb+d0*2048+512);
    if(d0==0){p0=__builtin_amdgcn_mfma_f32_32x32x16_bf16(b0,qr[0],negm,0,0,0);p1=__builtin_amdgcn_mfma_f32_32x32x16_bf16(b1,qr[0],negm,0,0,0);}
    else{p0=__builtin_amdgcn_mfma_f32_32x32x16_bf16(b0,qr[d0],p0,0,0,0);p1=__builtin_amdgcn_mfma_f32_32x32x16_bf16(b1,qr[d0],p1,0,0,0);}}
}
typedef __attribute__((address_space(3))) const char* lds_cptr;
typedef __attribute__((address_space(3))) const float* lds_fptr;
typedef short v4i16_t __attribute__((ext_vector_type(4)));
__device__ __forceinline__ void kload8(bf16x8*kf,lds_cptr kp){
  kf[0]=*(const __attribute__((address_space(3))) bf16x8*)(kp);      kf[1]=*(const __attribute__((address_space(3))) bf16x8*)(kp+512);
  kf[2]=*(const __attribute__((address_space(3))) bf16x8*)(kp+2048); kf[3]=*(const __attribute__((address_space(3))) bf16x8*)(kp+2560);
  kf[4]=*(const __attribute__((address_space(3))) bf16x8*)(kp+4096); kf[5]=*(const __attribute__((address_space(3))) bf16x8*)(kp+4608);
  kf[6]=*(const __attribute__((address_space(3))) bf16x8*)(kp+6144); kf[7]=*(const __attribute__((address_space(3))) bf16x8*)(kp+6656);
}
__device__ __forceinline__ void kload2(bf16x8*kf,lds_cptr kp,int j){ kf[2*j]=*(const __attribute__((address_space(3))) bf16x8*)(kp+j*2048); kf[2*j+1]=*(const __attribute__((address_space(3))) bf16x8*)(kp+j*2048+512); }
__device__ __forceinline__ s16x4 vtr(lds_cptr p){ return __builtin_bit_cast(s16x4,__builtin_amdgcn_ds_read_tr16_b64_v4i16((__attribute__((address_space(3))) v4i16_t*)p)); }
__device__ __forceinline__ float rowmax(const f32x16&p0,const f32x16&p1){
  float a=max3f(p0[0],p0[1],p1[0]),b=max3f(p0[2],p0[3],p1[1]);a=max3f(a,p1[2],p1[3]);
  #pragma unroll
  for(int r=4;r<16;r+=4){a=max3f(a,p0[r],p0[r+1]);b=max3f(b,p0[r+2],p0[r+3]);a=max3f(a,p1[r],p1[r+1]);b=max3f(b,p1[r+2],p1[r+3]);}
  const float m=max2f(a,b);
  auto rr=__builtin_amdgcn_permlane32_swap(__float_as_uint(m),__float_as_uint(m),false,false);
  return max2f(__uint_as_float(rr[0]),__uint_as_float(rr[1]));
}
__device__ __forceinline__ void pv(f32x16*o,int vb,bf16x8 pa0,bf16x8 pa1,bf16x8 pa2,bf16x8 pa3){
  #pragma unroll
  for(int d0=0;d0<2;++d0){s16x4 lo[4],hi[4];
    #pragma unroll
    for(int ks=0;ks<4;++ks){
      asm volatile("ds_read_b64_tr_b16 %0,%1 offset:%c2":"=&v"(lo[ks]):"v"(vb),"i"(d0*4096+ks*1024):"memory");
      asm volatile("ds_read_b64_tr_b16 %0,%1 offset:%c2":"=&v"(hi[ks]):"v"(vb),"i"(d0*4096+ks*1024+512):"memory");}
    asm volatile("s_waitcnt lgkmcnt(0)":::"memory");SBAR();
    #define PK(k) (bf16x8){lo[k][0],lo[k][1],lo[k][2],lo[k][3],hi[k][0],hi[k][1],hi[k][2],hi[k][3]}
    o[d0]=__builtin_amdgcn_mfma_f32_32x32x16_bf16(pa0,PK(0),o[d0],0,0,0);
    o[d0]=__builtin_amdgcn_mfma_f32_32x32x16_bf16(pa1,PK(1),o[d0],0,0,0);
    o[d0]=__builtin_amdgcn_mfma_f32_32x32x16_bf16(pa2,PK(2),o[d0],0,0,0);
    o[d0]=__builtin_amdgcn_mfma_f32_32x32x16_bf16(pa3,PK(3),o[d0],0,0,0);
    #undef PK
  }
}
__device__ __forceinline__ void namask(f32x16&p0,f32x16&p1,int kr,int qr,unsigned wlo,unsigned whi,lds_fptr brow0,float mh){
  const float BIG=1e30f;
  int r0=qr-4; r0=r0<0?0:(r0>56?56:r0);
  if(kr<r0||kr>=r0+8){
    #pragma unroll
    for(int r=0;r<16;++r){p0[r]=-BIG;p1[r]=-BIG;}
    return; }
  const lds_fptr brow=brow0+(kr-qr+7)*128;
  asm volatile("":"+v"(wlo),"+v"(whi));
  #pragma unroll
  for(int r=0;r<16;++r){
    const int pos=(r&3)+8*(r>>2);
    const float b0=brow[pos]-mh, b1=brow[pos+32]-mh;
    const float f0=(float)((wlo>>pos)&1u), f1=(float)((whi>>pos)&1u);
    p0[r]=(p0[r]+b0)+__builtin_fmaf(f0,BIG,-BIG); p1[r]=(p1[r]+b1)+__builtin_fmaf(f1,BIG,-BIG);
    if((r&3)==3) __builtin_amdgcn_sched_barrier(0); }
}
struct AttnArgs { const AGAS bf16* Q; const AGAS bf16* K; const AGAS bf16* V; AGAS bf16* O; int kr0, kr1, tsw, NT; int qrow0, rb0; const AGAS float* rpb; };
#define ATTN_STORE16(p,v) (*(AGAS u32x4*)(p)=(v))
template<int THRL,bool MASKED> __device__ __forceinline__ void attn_unit(const AttnArgs&a,char*shm,int tid){
  const int lane=tid&63,r32=lane&31,hi=lane>>5; const int wid=__builtin_amdgcn_readfirstlane(tid>>6);
  const AGAS bf16*Qw=a.Q+(long)(wid*QBLK)*QP;
  const AGAS bf16*Kh=a.K,*Vh=a.V;
  const unsigned lds0=(unsigned)(uintptr_t)shm;
  float*wsf=(float*)(shm+LDS_WS)+wid*64;
  const AGAS bf16*ksrc=Kh+(long)lane*KP+wid*8;
  const AGAS bf16*vsrc=Vh+(long)(16*(wid&3)+(lane>>2))*VP+(wid>>2)*32+(lane&3)*8;
  const unsigned kdst=lds0+LDS_K+wid*1024, vdst=lds0+LDS_V+wid*1024;
  const int kr0=a.kr0,kr1=a.kr1,tsw=a.tsw;
  #define KROW(t) ((t)<tsw?kr0+64*(t):kr1+64*((t)-tsw))
  #define DMA_K(t,slot) glds16(ksrc+(long)KROW(t)*KP,(unsigned)__builtin_amdgcn_readfirstlane(kdst+(slot)))
  #define DMA_V(t,slot) glds16(vsrc+(long)KROW(t)*VP,(unsigned)__builtin_amdgcn_readfirstlane(vdst+(slot)))
  const int vb0=(int)(lds0+LDS_V)+((lane>>4)&1)*32+(lane&3)*8+(4*hi+((lane&15)>>2))*64;
  const char*Kbase=shm+LDS_K; bf16x8 kf[8];
  const lds_cptr shm3=(lds_cptr)shm; const lds_cptr kp0=shm3+LDS_K+hi*1024+r32*16; const lds_cptr vp0=shm3+LDS_V+((lane>>4)&1)*32+(lane&3)*8+(4*hi+((lane&15)>>2))*64;
  const lds_fptr biasl=(lds_fptr)(shm3+LDS_BIAS);
  const int NT=a.NT;
  if constexpr(MASKED){ __attribute__((address_space(3))) float* bt=(__attribute__((address_space(3))) float*)(shm3+LDS_BIAS);
    for(int i_=tid;i_<15*128;i_+=512){ const int ri=i_>>7, dc=(i_&127)-48; bt[i_]=(dc>=0&&dc<31)?a.rpb[ri*31+dc]*1.4426950408889634f:0.f; } }
  const int qgr=a.qrow0+(wid>>1), qgc=(wid&1)*32+r32, rb0=a.rb0;
  unsigned wlo=0u,whi=0u; lds_fptr brow0=biasl;
  if constexpr(MASKED){ int cs=qgc-8; cs=cs<0?0:(cs>48?48:cs); const unsigned long long cm=(0xFFFFull<<cs)>>(4*hi); wlo=(unsigned)cm; whi=(unsigned)(cm>>32); brow0=biasl+(4*hi-qgc+63); }
  DMA_K(0,0);DMA_V(0,0);DMA_K(1,SLOTB);
  bf16x8 qr[4];
  #pragma unroll
  for(int d0=0;d0<4;++d0)qr[d0]=*(const AGAS bf16x8*)(&Qw[(long)r32*QP+d0*16+hi*8]);
  float zf_=0.f; asm volatile("":"+v"(zf_)); float mhat=zf_,l_reg=zf_;f32x16 o[2],negm; _Pragma("unroll") for(int r=0;r<16;++r){o[0][r]=zf_;o[1][r]=zf_;negm[r]=zf_;} if constexpr(!MASKED){asm volatile("":"+v"(negm));} const f32x16 zc=f32x16{};
  #define CMASK(P0,P1,t) do{ if constexpr(MASKED){ if((t)>=4) namask(P0,P1,rb0+(t)-4,qgr,wlo,whi,brow0,mhat); else { _Pragma("unroll") for(int r_=0;r_<16;++r_){P0[r_]-=mhat;P1[r_]-=mhat;} } } }while(0)
  bool resc=false;
  #define START(P0,P1) do{ const float rm=rowmax(P0,P1); resc=false; \
    { const float dl=rm; mhat=fadd_s(mhat,dl); \
      _Pragma("unroll") for(int r=0;r<16;++r){P0[r]=fsub_s(P0[r],dl);P1[r]=fsub_s(P1[r],dl);} \
      if constexpr(!MASKED){ _Pragma("unroll") for(int r=0;r<16;++r)negm[r]=-mhat; asm volatile("":"+v"(negm)); } } \
    _Pragma("unroll") for(int r=0;r<16;++r)P0[r]=__builtin_amdgcn_exp2f(P0[r]); }while(0)
  #define RESC() do{ if(resc){ asm volatile("s_waitcnt lgkmcnt(0)":::"memory"); \
      _Pragma("unroll") for(int d_=0;d_<2;++d_) _Pragma("unroll") for(int r=0;r<16;++r)o[d_][r]*=wsf[crow(r,hi)]; } }while(0)
  f32x16 pA0,pA1,pB0,pB1;
  int sl_prev=0,sl_cur=0,sl_next=SLOTB;
  #define ROT() do{sl_prev=sl_cur;sl_cur=sl_next;sl_next=(sl_next==(NSLOT-1)*SLOTB)?0:sl_next+SLOTB;}while(0)
  DMA_K(2,2*SLOTB);
  WAIT_BAR(3);
  qkt(pA0,pA1,Kbase,qr,zc,r32,hi);asm volatile("s_nop 15\n\ts_nop 7":"+v"(pA0),"+v"(pA1));
  START(pA0,pA1);
  _Pragma("unroll") for(int r=0;r<16;++r)pA1[r]=__builtin_amdgcn_exp2f(pA1[r]);
  WAIT_BAR(0);
  DMA_K(3,0);DMA_V(1,SLOTB);
  ROT();
  kload8(kf,kp0+sl_cur);
  WAIT_BAR(2);
  s16x4 vlo[8],vhi[8]; u32x4 pw0,pw1,pw2,pw3;
  #define PKW(P,B) cvtpk_s(P[B],P[B+1])
  #define PAF(k) __builtin_bit_cast(bf16x8,pw##k)
  #define VFR(i) (bf16x8){vlo[i][0],vlo[i][1],vlo[i][2],vlo[i][3],vhi[i][0],vhi[i][1],vhi[i][2],vhi[i][3]}
  #define PIN(x) asm volatile("":"+v"(x))
  #define MX3(a,b,c) __builtin_fmaxf(__builtin_fmaxf((a),(b)),(c))
  #define GAPA(MF,A0,A1,A2,A3,W0,W1,PW) do{ MF; sacc+=A0; sacc+=A1; sacc+=A2; sacc+=A3; PIN(sacc); W0; W1; PIN(PW); SBAR(); }while(0)
  #define EX(v) __builtin_amdgcn_exp2f(v)
  #define GAPB(MF,X,B) do{ MF; X[B]=EX(X[B]); X[B+1]=EX(X[B+1]); X[B+2]=EX(X[B+2]); X[B+3]=EX(X[B+3]); PIN(X); SBAR(); }while(0)
  #define VRD(i) do{ vlo[i]=vtr(vp_+(((i)>>2)*4096+((i)&3)*1024)); vhi[i]=vtr(vp_+(((i)>>2)*4096+((i)&3)*1024+512)); }while(0)
  #define KRD(G,j) do{ if(G){ kload2(kf,kp0+sl_next,j); SBAR(); } }while(0)
  #define STEP(C0,C1,P0,P1,t,GK,GV,GL) do{ SBAR(); \
    const lds_cptr vp_=vp0+sl_prev; \
    VRD(0); SBAR(); float sacc=(P0[0]+P0[1]); \
    GAPA(C0=__builtin_amdgcn_mfma_f32_32x32x16_bf16(kf[0],qr[0],(MASKED?zc:negm),0,0,0), P0[2],P0[3],P0[4],P0[5],     pw0[0]=PKW(P0,0), pw0[1]=PKW(P0,2), pw0); \
    VRD(4); SBAR(); GAPA(C1=__builtin_amdgcn_mfma_f32_32x32x16_bf16(kf[1],qr[0],(MASKED?zc:negm),0,0,0), P0[6],P0[7],P0[8],P0[9],     pw0[2]=PKW(P0,4), pw0[3]=PKW(P0,6), pw0); \
    VRD(1); SBAR(); GAPA(C0=__builtin_amdgcn_mfma_f32_32x32x16_bf16(kf[2],qr[1],C0,0,0,0),   P0[10],P0[11],P0[12],P0[13], pw1[0]=PKW(P0,8), pw1[1]=PKW(P0,10), pw1); \
    VRD(5); SBAR(); GAPA(C1=__builtin_amdgcn_mfma_f32_32x32x16_bf16(kf[3],qr[1],C1,0,0,0),   P0[14],P0[15],P1[0],P1[1],   pw1[2]=PKW(P0,12),pw1[3]=PKW(P0,14), pw1); \
    VRD(2); SBAR(); GAPA(C0=__builtin_amdgcn_mfma_f32_32x32x16_bf16(kf[4],qr[2],C0,0,0,0),   P1[2],P1[3],P1[4],P1[5],     pw2[0]=PKW(P1,0), pw2[1]=PKW(P1,2), pw2); \
    VRD(6); SBAR(); GAPA(C1=__builtin_amdgcn_mfma_f32_32x32x16_bf16(kf[5],qr[2],C1,0,0,0),   P1[6],P1[7],P1[8],P1[9],     pw2[2]=PKW(P1,4), pw2[3]=PKW(P1,6), pw2); \
    VRD(3); SBAR(); GAPA(C0=__builtin_amdgcn_mfma_f32_32x32x16_bf16(kf[6],qr[3],C0,0,0,0),   P1[10],P1[11],P1[12],P1[13], pw3[0]=PKW(P1,8), pw3[1]=PKW(P1,10), pw3); \
    VRD(7); SBAR(); GAPA(C1=__builtin_amdgcn_mfma_f32_32x32x16_bf16(kf[7],qr[3],C1,0,0,0),   P1[14],P1[15],0.f,0.f,       pw3[2]=PKW(P1,12),pw3[3]=PKW(P1,14), pw3); \
    l_reg+=sacc; \
    if(GK){DMA_K((t)+3,sl_cur);} if(GV){DMA_V((t)+1,sl_next);} \
    CMASK(C0,C1,t); \
    { float a_=MX3(C0[0],C0[1],C1[0]),b_=MX3(C0[2],C0[3],C1[1]); a_=MX3(a_,C1[2],C1[3]); \
      _Pragma("unroll") for(int r=4;r<16;r+=4){a_=MX3(a_,C0[r],C0[r+1]);b_=MX3(b_,C0[r+2],C0[r+3]);a_=MX3(a_,C1[r],C1[r+1]);b_=MX3(b_,C1[r+2],C1[r+3]);} \
      float rm=__builtin_fmaxf(a_,b_); { auto rr=__builtin_amdgcn_permlane32_swap(__float_as_uint(rm),__float_as_uint(rm),false,false); rm=__builtin_fmaxf(__uint_as_float(rr[0]),__uint_as_float(rr[1])); } \
      resc=false; \
      if(__builtin_expect(__any(rm>(float)THRL),0)){ const float dl=__builtin_fmaxf(rm,0.f); mhat+=dl; \
        _Pragma("unroll") for(int r=0;r<16;++r){C0[r]-=dl;C1[r]-=dl;} \
        if constexpr(!MASKED){ _Pragma("unroll") for(int r=0;r<16;++r)negm[r]=-mhat; asm volatile("":"+v"(negm)); } \
        const float f=__builtin_amdgcn_exp2f(-dl); l_reg*=f; if(hi==0)wsf[r32]=f; resc=true; } } \
    SBAR(); \
    GAPB(o[0]=__builtin_amdgcn_mfma_f32_32x32x16_bf16(PAF(0),VFR(0),o[0],0,0,0), C0,0); \
    GAPB(o[1]=__builtin_amdgcn_mfma_f32_32x32x16_bf16(PAF(0),VFR(4),o[1],0,0,0), C0,4); \
    KRD(GL,0); GAPB(o[0]=__builtin_amdgcn_mfma_f32_32x32x16_bf16(PAF(1),VFR(1),o[0],0,0,0), C0,8); \
    KRD(GL,1); GAPB(o[1]=__builtin_amdgcn_mfma_f32_32x32x16_bf16(PAF(1),VFR(5),o[1],0,0,0), C0,12); \
    KRD(GL,2); GAPB(o[0]=__builtin_amdgcn_mfma_f32_32x32x16_bf16(PAF(2),VFR(2),o[0],0,0,0), C1,0); \
    KRD(GL,3); GAPB(o[1]=__builtin_amdgcn_mfma_f32_32x32x16_bf16(PAF(2),VFR(6),o[1],0,0,0), C1,4); \
    GAPB(o[0]=__builtin_amdgcn_mfma_f32_32x32x16_bf16(PAF(3),VFR(3),o[0],0,0,0), C1,8); \
    GAPB(o[1]=__builtin_amdgcn_mfma_f32_32x32x16_bf16(PAF(3),VFR(7),o[1],0,0,0), C1,12); \
    }while(0)
  int t=1;
  for(;t+5<NT;t+=2){
    STEP(pB0,pB1,pA0,pA1,t,true,true,true);     WAIT_BAR(2); RESC(); ROT();
    STEP(pA0,pA1,pB0,pB1,t+1,true,true,true);   WAIT_BAR(2); RESC(); ROT();
  }
  #define ENDW(tt) do{ if((tt)+3<NT){WAIT_BAR(2);} else if((tt)+2<NT){WAIT_BAR(1);} else {WAIT_BAR(0);} }while(0)
  for(;t+1<NT;t+=2){
    STEP(pB0,pB1,pA0,pA1,t,(t+3<NT),(t+1<NT),(t+1<NT));       ENDW(t);   RESC(); ROT();
    STEP(pA0,pA1,pB0,pB1,t+1,(t+4<NT),(t+2<NT),(t+2<NT));     ENDW(t+1); RESC(); ROT();
  }
  STEP(pB0,pB1,pA0,pA1,NT-1,false,false,false); RESC();
  { float sacc=pB0[0]+pB0[1]; _Pragma("unroll") for(int r=2;r<16;++r)sacc+=pB0[r]; _Pragma("unroll") for(int r=0;r<16;++r)sacc+=pB1[r]; l_reg+=sacc;
    pw0=(u32x4){PKW(pB0,0),PKW(pB0,2),PKW(pB0,4),PKW(pB0,6)};pw1=(u32x4){PKW(pB0,8),PKW(pB0,10),PKW(pB0,12),PKW(pB0,14)};pw2=(u32x4){PKW(pB1,0),PKW(pB1,2),PKW(pB1,4),PKW(pB1,6)};pw3=(u32x4){PKW(pB1,8),PKW(pB1,10),PKW(pB1,12),PKW(pB1,14)};
    SBAR(); pv(o,vb0+sl_cur,PAF(0),PAF(1),PAF(2),PAF(3)); }
  #undef PKW
  #undef PAF
  #undef VFR
  #undef PIN
  #undef MX3
  #undef GAPA
  #undef GAPB
  #undef EX
  #undef VRD
  #undef KRD
  #undef STEP
  #undef ENDW
  {auto rr=__builtin_amdgcn_permlane32_swap(__float_as_uint(l_reg),__float_as_uint(l_reg),false,false);l_reg=__uint_as_float(rr[0])+__uint_as_float(rr[1]);}
  if(hi==0)wsf[32+r32]=l_reg;asm volatile("s_waitcnt lgkmcnt(0)":::"memory");
  float rli[16];
  #pragma unroll
  for(int r=0;r<16;++r)rli[r]=__builtin_amdgcn_rcpf(wsf[32+crow(r,hi)]);
  AGAS bf16*Ow=a.O+(long)(wid*QBLK)*OP;
  { bf16*stg=(bf16*)(shm+LDS_OST)+wid*2048;
    #pragma unroll
    for(int r=0;r<16;++r){const int orow=crow(r,hi);
      #pragma unroll
      for(int d0=0;d0<2;++d0)stg[orow*64+d0*32+r32]=__float2bfloat16(o[d0][r]*rli[r]);}
    asm volatile("s_waitcnt lgkmcnt(0)":::"memory");
    #pragma unroll
    for(int i=0;i<4;++i){const int row=i*8+(lane>>3),ch=lane&7; const u32x4 v=*(const u32x4*)(stg+row*64+ch*8); ATTN_STORE16(Ow+(long)row*OP+ch*8,v);} }
  asm volatile("s_waitcnt lgkmcnt(0)\n\ts_barrier":::"memory");
  #undef KROW
  #undef DMA_K
  #undef DMA_V
  #undef CMASK
  #undef START
  #undef RESC
  #undef ROT
}
#undef SBAR
#undef WAIT_BAR
}
constexpr int NWAVES = 8, NTHR = 512;
constexpr int DM = 1024, NBATCH = 4, SEQ = 4096, CTXL = 256, RPB = SEQ + CTXL  , MROWS = NBATCH * RPB  , NLAYER = 2;
constexpr int PW = 8448;
constexpr int C_GQ = 0, C_GK = 512, C_GV = 640, C_NQ = 768, C_NK = 1280, C_NV = 1792, C_F = 2304, C_CA = 3328, C_CB = 3840, C_G = 4352;
constexpr int YW = 2048;
constexpr int INW = 7936;
constexpr int NEXP = 16, EFF = 512, MOE_ROWS = 38912  ;
constexpr float EPS = 1e-6f, LOG2E = 1.4426950408889634f;
constexpr float QSCALE = 0.125f * LOG2E;
constexpr size_t MiB = 1u << 20;
constexpr size_t WS_CTL = 0, CTL_ZERO_BYTES = 1 * MiB;
constexpr size_t WS_MODV = 1 * MiB;
constexpr size_t WS_TOKE = 2 * MiB, WS_TOKW = WS_TOKE + 160 * 1024, WS_TOKR = WS_TOKW + 160 * 1024, WS_TOKS = WS_TOKR + 160 * 1024;
constexpr size_t WS_XC = 4 * MiB;
constexpr size_t WS_WIN = 8 * MiB;
constexpr size_t WS_WB = 25 * MiB;
constexpr size_t WS_WO = 29 * MiB;
constexpr size_t WS_WGU = 32 * MiB;
constexpr size_t WS_WD = 64 * MiB;
constexpr size_t WS_H = 80 * MiB;
constexpr size_t WS_Y = 114 * MiB;
constexpr size_t WS_TP = 182 * MiB;
constexpr size_t WS_P = 214 * MiB;
constexpr size_t WS_AM = WS_P, WS_HM = WS_P + 76 * MiB, WS_OM = WS_P + 114 * MiB;
constexpr size_t WS_END = 495 * MiB;
static_assert(WS_WIN + (size_t)PW * DM * 2 <= WS_WB && WS_P + (size_t)MROWS * PW * 2 <= WS_END && WS_OM + (size_t)MOE_ROWS * DM * 2 <= WS_END, "ws map");
constexpr int CW_BAR = 4096;
constexpr int CW_CNT = 16384;
constexpr int RING_OFF = 0, RING_BYTES = 131072;
constexpr int LDSCTL_OFF = RING_BYTES, MISC_OFF = LDSCTL_OFF + 320;
constexpr int LDS_BYTES = 147456;

#define GAS __attribute__((address_space(1)))
#define LAS __attribute__((address_space(3)))
typedef unsigned short bf16;
typedef unsigned v4u __attribute__((ext_vector_type(4)));
typedef unsigned v2u __attribute__((ext_vector_type(2)));
typedef float f32x4 __attribute__((ext_vector_type(4)));
typedef GAS unsigned gu32;
#define RLX_AGENT __ATOMIC_RELAXED, __HIP_MEMORY_SCOPE_AGENT
#define LDS_WAIT() asm volatile("s_waitcnt lgkmcnt(0)" ::: "memory")
__device__ __forceinline__ unsigned f2bf(float f) { unsigned u = __builtin_bit_cast(unsigned, f); return (u + 0x7fffu + ((u >> 16) & 1u)) >> 16; }
__device__ __forceinline__ unsigned pk2(float lo, float hi) { return f2bf(lo) | (f2bf(hi) << 16); }
__device__ __forceinline__ float bf_lo(unsigned w) { return __uint_as_float(w << 16); }
__device__ __forceinline__ float bf_hi(unsigned w) { return __uint_as_float(w & 0xffff0000u); }
__device__ __forceinline__ float bf1(bf16 v) { return __uint_as_float(((unsigned)v) << 16); }
__device__ __forceinline__ float sigm(float x) { return 1.0f / (1.0f + __expf(-x)); }

#define XB_TMO      128
#define XB_XCNT(j)  (256  + 64 * (j))
#define XB_XSUB(j)  (1280 + 64 * (j))
#define XB_XGEN(j)  (2304 + 64 * (j))
#define XB_TOP      3328
#define XB_TOPGEN   3392
#define XCD_BAR_WORDS 3456
#define XB_SPIN_CAP (1u << 18)
__device__ __forceinline__ unsigned xb_ld(unsigned* p)              { return __hip_atomic_load(p, __ATOMIC_RELAXED, __HIP_MEMORY_SCOPE_AGENT); }
__device__ __forceinline__ unsigned xb_add(unsigned* p, unsigned v) { return __hip_atomic_fetch_add(p, v, __ATOMIC_RELAXED, __HIP_MEMORY_SCOPE_AGENT); }
__device__ __forceinline__ unsigned xb_xcc_id() { return (unsigned)__builtin_amdgcn_s_getreg((3 << 11) | 20) & 0xFu; }
#define XB_SPIN(cond, bar) do { unsigned _sp = 0; while (cond) { __builtin_amdgcn_s_sleep(1); \
    if ((++_sp & 255u) == 0u) { if (xb_ld(&(bar)[XB_TMO])) break; if (_sp > XB_SPIN_CAP) { atomicAdd(&(bar)[XB_TMO], 1u); break; } } } } while (0)
struct XcdBarrier { unsigned* bar; unsigned x; volatile LAS unsigned* st; };
__device__ __forceinline__ XcdBarrier xcd_barrier_post(unsigned* bar, volatile LAS unsigned* st) {
    XcdBarrier b; b.bar = bar; b.x = xb_xcc_id(); b.st = st;
    if (threadIdx.x == 0) (void)xb_add(&bar[XB_XCNT(b.x)], 1u);
    return b;
}
__device__ __forceinline__ void xcd_barrier_complete(unsigned* bar, unsigned x, unsigned& nloc, unsigned& nx) {
    const unsigned G = gridDim.x * gridDim.y * gridDim.z;
    unsigned sum, cnt, mine, sp = 0u;
    for (;;) {
        sum = 0u; cnt = 0u; mine = 0u;
#pragma unroll
        for (unsigned j = 0; j < 16; ++j) { const unsigned c = xb_ld(&bar[XB_XCNT(j)]); sum += c; cnt += (c > 0u) ? 1u : 0u; mine = (j == x) ? c : mine; }
        if (sum == G) break;
        __builtin_amdgcn_s_sleep(1);
        if ((++sp & 255u) == 0u) { if (xb_ld(&bar[XB_TMO])) break; if (sp > XB_SPIN_CAP) { atomicAdd(&bar[XB_TMO], 1u); break; } }
    }
    nloc = mine > 0u ? mine : 1u; nx = cnt > 0u ? cnt : 1u;
}
__device__ __forceinline__ void xcd_barrier(const XcdBarrier& b) {
    asm volatile("s_waitcnt vmcnt(0)" ::: "memory");
    __syncthreads();
    if (threadIdx.x == 0) {
        unsigned* bar = b.bar;
        __builtin_amdgcn_s_waitcnt(0);
        unsigned nloc = b.st[0], nx = b.st[1];
        if (nloc == 0u) { xcd_barrier_complete(bar, b.x, nloc, nx); b.st[0] = nloc; b.st[1] = nx; }
        const unsigned old = xb_add(&bar[XB_XSUB(b.x)], 1u);
        const unsigned gen = old / nloc;
        if (old + 1u == (gen + 1u) * nloc) {
            __builtin_amdgcn_fence(__ATOMIC_RELEASE, "agent");
            asm volatile("s_waitcnt vmcnt(0)" ::: "memory");
            const unsigned og = xb_add(&bar[XB_TOP], 1u);
            const unsigned tg = og / nx;
            if (og + 1u == (tg + 1u) * nx) xb_add(&bar[XB_TOPGEN], 1u);
            else XB_SPIN(xb_ld(&bar[XB_TOPGEN]) == tg, bar);
            __builtin_amdgcn_fence(__ATOMIC_ACQUIRE, "agent");
            xb_add(&bar[XB_XGEN(b.x)], 1u);
            asm volatile("s_waitcnt vmcnt(0)" ::: "memory");
        } else {
            XB_SPIN(xb_ld(&bar[XB_XGEN(b.x)]) == gen, bar);
            __builtin_amdgcn_fence(__ATOMIC_ACQUIRE, "agent");
            asm volatile("s_waitcnt vmcnt(0)" ::: "memory");
        }
    }
    __syncthreads();
}

struct Frame {
    LAS unsigned char* lds; volatile LAS unsigned* MISC; LAS unsigned* LCTL;
    gu32* ctl; unsigned char* ws; GAS float* out; int tid, lane, wave, vcu, G;
};
constexpr int PTR_OFF = LDSCTL_OFF + 96;
__device__ __forceinline__ const GAS float* INP(const Frame& F, int i) {
    const LAS unsigned* t = (const LAS unsigned*)(F.lds + PTR_OFF) + 2 * i;
    const unsigned lo = __builtin_amdgcn_readfirstlane(t[0]), hi = __builtin_amdgcn_readfirstlane(t[1]);
    return (const GAS float*)(((unsigned long long)hi << 32) | lo);
}
__device__ __forceinline__ float shx(float v, int m, int lane) { return __builtin_bit_cast(float, __builtin_amdgcn_ds_bpermute((lane ^ m) << 2, __builtin_bit_cast(int, v))); }
__device__ __forceinline__ float wave_sum(float v, int lane) {
#pragma unroll
    for (int o = 1; o < 64; o <<= 1) v += shx(v, o, lane);
    return v;
}
__device__ __forceinline__ const GAS float* xrow_in(const Frame& F, int row) { const int b = row / RPB, t = row % RPB; return t < SEQ ? INP(F, 0) + ((size_t)b * SEQ + t) * DM : INP(F, 2) + ((size_t)b * CTXL + (t - SEQ)) * DM; }
__device__ __forceinline__ GAS float* xrow_ws(const Frame& F, int row) { const int b = row / RPB, t = row % RPB; return t < SEQ ? F.out + ((size_t)b * SEQ + t) * DM : ((GAS float*)(F.ws + WS_XC)) + ((size_t)b * CTXL + (t - SEQ)) * DM; }
__device__ __forceinline__ int modidx(int row) { const int b = row / RPB, t = row % RPB; return t < SEQ ? b : 4; }

__device__ __forceinline__ void tr_item(const GAS float* W, int ldw, int k0, int n0, GAS bf16* WT, int ldt, int drow0, int dcol0, LAS float* scr, int lane) {
#pragma unroll 8
    for (int i = 0; i < 32; ++i) { const int kk = 2 * i + (lane >> 5); scr[kk * 33 + (lane & 31)] = W[(size_t)(k0 + kk) * ldw + n0 + (lane & 31)]; }
    LDS_WAIT(); asm volatile("" ::: "memory");
    const int c = lane & 7;
#pragma unroll
    for (int j = 0; j < 4; ++j) { const int n = (lane >> 3) + 8 * j; const LAS float* s = scr + (8 * c) * 33 + n;
        v4u o; o.x = pk2(s[0 * 33], s[1 * 33]); o.y = pk2(s[2 * 33], s[3 * 33]); o.z = pk2(s[4 * 33], s[5 * 33]); o.w = pk2(s[6 * 33], s[7 * 33]);
        *(GAS v4u*)(WT + (size_t)(drow0 + n) * ldt + dcol0 + 8 * c) = o; }
    LDS_WAIT(); asm volatile("" ::: "memory");
}
__device__ __forceinline__ void convert_weights(Frame& F, int l) {
    LAS float* scr = (LAS float*)(F.lds + RING_OFF + F.wave * 16384);
    const int gw = F.vcu * NWAVES + F.wave, NGW = F.G * NWAVES;
    constexpr int I_IN = 16 * (INW / 32), I_BR = 4 * 8 * 32, I_O = 16 * 32, I_GU = 16 * 16 * 32, I_D = 16 * 8 * 32;
    constexpr int NITEMS = I_IN + I_BR + I_O + I_GU + I_D;
    for (int it = gw; it < NITEMS; it += NGW) {
        int r = it;
        if (r < I_IN) { const int nblk = INW / 32, kb = r / nblk, nb = r % nblk, n0 = 32 * nb;
            if (n0 >= 2304 && n0 < 2816) continue;
            const int drow = n0 < 2304 ? n0 : n0 + 512;
            tr_item(INP(F, 8) + (size_t)l * DM * INW, INW, 64 * kb, n0, ((GAS bf16*)(F.ws + WS_WIN)), DM, drow, 64 * kb, scr, F.lane); continue; } r -= I_IN;
        if (r < I_BR) { const int nbr = r / 256, q = r % 256, kb = q / 32, nb = q % 32;
            tr_item(INP(F, 15) + ((size_t)l * 4 + nbr) * 512 * DM, DM, 64 * kb, 32 * nb, ((GAS bf16*)(F.ws + WS_WB)), 2048, 32 * nb, nbr * 512 + 64 * kb, scr, F.lane); continue; } r -= I_BR;
        if (r < I_O) { const int kb = r / 32, nb = r % 32;
            tr_item(INP(F, 16) + (size_t)l * DM * DM, DM, 64 * kb, 32 * nb, ((GAS bf16*)(F.ws + WS_WO)), DM, 32 * nb, 64 * kb, scr, F.lane); continue; } r -= I_O;
        if (r < I_GU) { const int e = r / 512, q = r % 512, kb = q / 32, nb = q % 32, n0 = 32 * nb;
            const int drow = n0 < 512 ? (n0 / 128) * 256 + (n0 % 128) : ((n0 - 512) / 128) * 256 + 128 + ((n0 - 512) % 128);
            tr_item(INP(F, 19) + ((size_t)l * NEXP + e) * DM * DM, DM, 64 * kb, n0, ((GAS bf16*)(F.ws + WS_WGU)) + (size_t)e * DM * DM, DM, drow, 64 * kb, scr, F.lane); continue; } r -= I_GU;
        { const int e = r / 256, q = r % 256, kb = q / 32, nb = q % 32;
            tr_item(INP(F, 20) + ((size_t)l * NEXP + e) * EFF * DM, DM, 64 * kb, 32 * nb, ((GAS bf16*)(F.ws + WS_WD)) + (size_t)e * DM * EFF, EFF, 32 * nb, 64 * kb, scr, F.lane); }
    }
    __syncthreads();
    LAS float* wt = (LAS float*)(F.lds + RING_OFF);
    LAS float* tab = (LAS float*)(F.lds + RING_OFF + 32768);
    if (F.tid < 128) { float s, c; sincospif((float)F.tid * (1.0f / 64.0f), &s, &c); tab[2 * F.tid] = c; tab[2 * F.tid + 1] = s; }
    for (int u = F.vcu; u < 64; u += F.G) {
        const int kt = u >> 2, g = u & 3;
        __syncthreads();
#pragma unroll
        for (int i = 0; i < 16; ++i) { const int idx = i * 512 + F.tid, kk = idx >> 7, c = idx & 127; wt[idx] = INP(F, 8)[(size_t)l * DM * INW + (size_t)(kt * 64 + kk) * INW + 2304 + g * 128 + c]; }
        __syncthreads();
        const int kc = F.tid & 127, kq = F.tid >> 7;
        float aA[16], aB[16];
#pragma unroll
        for (int i = 0; i < 16; ++i) { aA[i] = 0.f; aB[i] = 0.f; }
        for (int c = 0; c < 128; ++c) { const int ti = (c * kc) & 127; const float cs = tab[2 * ti], sn = tab[2 * ti + 1];
#pragma unroll
            for (int i = 0; i < 16; ++i) { const float w = wt[(kq * 16 + i) * 128 + c]; aA[i] += w * cs; aB[i] += w * sn; } }
        GAS bf16* ra = ((GAS bf16*)(F.ws + WS_WIN)) + (size_t)(2304 + 2 * (g * 128 + kc)) * DM + kt * 64 + kq * 16; GAS bf16* rb = ra + DM;
        v4u o; o.x = pk2(aA[0], aA[1]); o.y = pk2(aA[2], aA[3]); o.z = pk2(aA[4], aA[5]); o.w = pk2(aA[6], aA[7]); *(GAS v4u*)ra = o;
        o.x = pk2(aA[8], aA[9]); o.y = pk2(aA[10], aA[11]); o.z = pk2(aA[12], aA[13]); o.w = pk2(aA[14], aA[15]); *(GAS v4u*)(ra + 8) = o;
        o.x = pk2(aB[0], aB[1]); o.y = pk2(aB[2], aB[3]); o.z = pk2(aB[4], aB[5]); o.w = pk2(aB[6], aB[7]); *(GAS v4u*)rb = o;
        o.x = pk2(aB[8], aB[9]); o.y = pk2(aB[10], aB[11]); o.z = pk2(aB[12], aB[13]); o.w = pk2(aB[14], aB[15]); *(GAS v4u*)(rb + 8) = o;
    }
    __syncthreads();
}
__device__ __forceinline__ void mod_vectors(Frame& F) {
    LAS float* sc = (LAS float*)(F.lds + RING_OFF);
    LAS float* part = (LAS float*)(F.lds + RING_OFF + 32768);
    for (int i = F.tid; i < 5 * DM; i += NTHR) { const float v = i < 4 * DM ? INP(F, 1)[i] : INP(F, 3)[i - 4 * DM]; sc[i] = v * sigm(v); }
    __syncthreads();
    for (int u = F.vcu; u < 2 * 96; u += F.G) {
        const int l = u / 96, j = (u % 96) * 64 + F.lane;
        const GAS float* wp = INP(F, 4) + (size_t)l * DM * 6144 + (size_t)(F.wave * 128) * 6144 + j;
        float a0 = 0.f, a1 = 0.f, a2 = 0.f, a3 = 0.f, a4 = 0.f;
#pragma unroll 8
        for (int kk = 0; kk < 128; ++kk) { const float w = wp[(size_t)kk * 6144]; const int k = F.wave * 128 + kk;
            a0 += sc[k] * w; a1 += sc[DM + k] * w; a2 += sc[2 * DM + k] * w; a3 += sc[3 * DM + k] * w; a4 += sc[4 * DM + k] * w; }
        part[(F.wave * 5 + 0) * 64 + F.lane] = a0; part[(F.wave * 5 + 1) * 64 + F.lane] = a1; part[(F.wave * 5 + 2) * 64 + F.lane] = a2; part[(F.wave * 5 + 3) * 64 + F.lane] = a3; part[(F.wave * 5 + 4) * 64 + F.lane] = a4;
        __syncthreads();
        if (F.tid < 320) { const int bp = F.tid >> 6, ln = F.tid & 63; float s = 0.f;
#pragma unroll
            for (int w = 0; w < 8; ++w) s += part[(w * 5 + bp) * 64 + ln];
            const int jj = (u % 96) * 64 + ln; ((GAS float*)(F.ws + WS_MODV))[((size_t)l * 5 + bp) * 6144 + jj] = s + INP(F, 5)[(size_t)l * 6144 + jj]; }
        __syncthreads();
    }
}
__device__ __forceinline__ void norm_mod(f32x4 (&v)[4], const GAS float* g, const GAS float* sc, const GAS float* sh, int lane) {
    float ss = 0.f;
#pragma unroll
    for (int j = 0; j < 4; ++j) ss += (v[j].x * v[j].x + v[j].y * v[j].y) + (v[j].z * v[j].z + v[j].w * v[j].w);
    const float rstd = 1.0f / sqrtf(wave_sum(ss, lane) * (1.0f / DM) + EPS);
#pragma unroll
    for (int j = 0; j < 4; ++j) { const int c = 4 * lane + 256 * j; const f32x4 gg = *(const f32x4*)(g + c), s1 = *(const f32x4*)(sc + c), s0 = *(const f32x4*)(sh + c);
        v[j] = v[j] * rstd * gg * (s1 + 1.0f) + s0; }
}
__device__ __forceinline__ void store_bf16_row(GAS bf16* orow, const f32x4 (&v)[4], int lane) {
#pragma unroll
    for (int j = 0; j < 4; ++j) { v2u w; w.x = pk2(v[j].x, v[j].y); w.y = pk2(v[j].z, v[j].w); *(GAS v2u*)(orow + 4 * lane + 256 * j) = w; }
}
__device__ __forceinline__ void load_row(f32x4 (&v)[4], const GAS float* xr, int lane) {
#pragma unroll
    for (int j = 0; j < 4; ++j) v[j] = *(const GAS f32x4*)(xr + 4 * lane + 256 * j);
}
__device__ __forceinline__ void phase_norm1_first(Frame& F) {
    const int gw = F.vcu * NWAVES + F.wave, NGW = F.G * NWAVES; const GAS float* mv = ((GAS float*)(F.ws + WS_MODV));
    for (int row = gw; row < MROWS; row += NGW) { f32x4 v[4]; load_row(v, xrow_in(F, row), F.lane);
        const GAS float* m = mv + (size_t)modidx(row) * 6144; norm_mod(v, INP(F, 6), m + 1024, m, F.lane); store_bf16_row(((GAS bf16*)(F.ws + WS_H)) + (size_t)row * DM, v, F.lane); }
}
__device__ __forceinline__ void phase_qkrope(Frame& F, int l) {
    const int gw = F.vcu * NWAVES + F.wave, NGW = F.G * NWAVES; const int lane = F.lane, i = lane & 31;
    const float invf = exp2f(-(float)(i & 15) * (13.287712379549449f / 16.0f));
    for (int row = gw; row < MROWS; row += NGW) {
        const int t = row % RPB; const bool lat = t < SEQ; GAS bf16* pr = ((GAS bf16*)(F.ws + WS_P)) + (size_t)row * PW;
        float cs = 1.f, sn = 0.f;
        if (lat) { const float pos = (float)((i < 16) ? (t >> 6) : (t & 63)); sincosf(pos * invf, &sn, &cs); }
#pragma unroll
        for (int it = 0; it < 5; ++it) { const int hh = 2 * it + (lane >> 5); const int col = (hh < 8 ? hh * 64 : C_GK + (hh - 8) * 64) + 2 * i;
            const unsigned w = *(const GAS unsigned*)(pr + col); float x1 = bf_lo(w), x2 = bf_hi(w);
            float ss = x1 * x1 + x2 * x2;
            ss += shx(ss, 1, lane); ss += shx(ss, 2, lane); ss += shx(ss, 4, lane); ss += shx(ss, 8, lane); ss += shx(ss, 16, lane);
            const float rstd = 1.0f / sqrtf(ss * (1.0f / 64.0f) + EPS); const GAS float* gp = (hh < 8 ? INP(F, 9) : INP(F, 10)) + l * 64 + 2 * i;
            x1 = x1 * rstd * gp[0]; x2 = x2 * rstd * gp[1];
            float y1 = x1 * cs - x2 * sn, y2 = x1 * sn + x2 * cs;
            if (hh < 8) { y1 *= QSCALE; y2 *= QSCALE; }
            *(GAS unsigned*)(pr + col) = pk2(y1, y2); }
        { const v4u w = *(const GAS v4u*)(pr + C_NQ + 8 * lane); v4u o;
          o.x = pk2(bf_lo(w.x) * QSCALE, bf_hi(w.x) * QSCALE); o.y = pk2(bf_lo(w.y) * QSCALE, bf_hi(w.y) * QSCALE); o.z = pk2(bf_lo(w.z) * QSCALE, bf_hi(w.z) * QSCALE); o.w = pk2(bf_lo(w.w) * QSCALE, bf_hi(w.w) * QSCALE);
          *(GAS v4u*)(pr + C_NQ + 8 * lane) = o; }
    }
}
__device__ __forceinline__ void phase_conv(Frame& F, int l) {
    LAS float* red = (LAS float*)(F.lds + RING_OFF);
    const int ch = F.tid; const int nchunk = (l == 0) ? 136 : 128;
    float w[31];
#pragma unroll
    for (int j = 0; j < 31; ++j) w[j] = INP(F, 12)[((size_t)l * 31 + j) * 512 + ch];
    const float cb = INP(F, 13)[l * 512 + ch], cg = INP(F, 14)[l * 512 + ch];
    for (int u = F.vcu; u < NBATCH * nchunk; u += F.G) {
        const int b = u / nchunk, c = u % nchunk; const bool lat = c < 128;
        const int seq0 = b * RPB + (lat ? 0 : SEQ), slen = lat ? SEQ : CTXL, t0 = 32 * (lat ? c : c - 128);
        float z[62];
#pragma unroll
        for (int i = 0; i < 62; ++i) { const int t = t0 - 15 + i; float zz = 0.f;
            if (t >= 0 && t < slen) { const GAS bf16* pr = ((GAS bf16*)(F.ws + WS_P)) + (size_t)(seq0 + t) * PW; const float a = bf1(pr[C_CA + ch]), g = bf1(pr[C_CB + ch]); zz = a * sigm(g); }
            z[i] = zz; }
        float o[32];
#pragma unroll
        for (int q = 0; q < 32; ++q) { float s = cb;
#pragma unroll
            for (int j = 0; j < 31; ++j) s += z[q + j] * w[j];
            o[q] = s; }
        __syncthreads();
#pragma unroll
        for (int q = 0; q < 32; ++q) { const float s = wave_sum(o[q] * o[q], F.lane); if (F.lane == 0) red[F.wave * 32 + q] = s; }
        __syncthreads();
#pragma unroll
        for (int q = 0; q < 32; ++q) { float s = 0.f;
#pragma unroll
            for (int wv = 0; wv < 8; ++wv) s += red[wv * 32 + q];
            const float y = o[q] * (1.0f / sqrtf(s * (1.0f / 512.0f) + EPS)) * cg;
            ((GAS bf16*)(F.ws + WS_Y))[(size_t)(seq0 + t0 + q) * YW + 1536 + ch] = (bf16)f2bf(y * sigm(y)); }
    }
    __syncthreads();
}
__device__ __forceinline__ void phase_fourier1(Frame& F) {
    LAS float* tab = (LAS float*)(F.lds + RING_OFF + 4096);
    __syncthreads();
    if (F.tid < 64) { float s, c; sincospif((float)F.tid * (1.0f / 32.0f), &s, &c); tab[2 * F.tid] = c; tab[2 * F.tid + 1] = s; }
    __syncthreads();
    for (int u = F.vcu; u < NBATCH * 64; u += F.G) {
        const int b = u >> 6, n2 = u & 63;
        float tr[64], ti[64];
#pragma unroll
        for (int k = 0; k < 64; ++k) { tr[k] = 0.f; ti[k] = 0.f; }
        const GAS bf16* pcol = ((GAS bf16*)(F.ws + WS_P)) + (size_t)(b * RPB + n2) * PW + C_F + 2 * F.tid;
        for (int n1 = 0; n1 < 64; ++n1) {
            const unsigned w = *(const GAS unsigned*)(pcol + (size_t)(64 * n1) * PW); const float zr = bf_lo(w), zi = -bf_hi(w);
#pragma unroll
            for (int k = 0; k < 64; ++k) { const int ix = (n1 * k) & 63; const float C = tab[2 * ix], S = tab[2 * ix + 1];
                tr[k] += zr * C + zi * S; ti[k] += zi * C - zr * S; }
        }
        GAS unsigned* tp = ((GAS unsigned*)(F.ws + WS_TP)) + ((size_t)(b * 64) * 64 + n2) * 512 + F.tid;
#pragma unroll
        for (int k = 0; k < 64; ++k) { float s, c; sincospif((float)(n2 * k) * (1.0f / 2048.0f), &s, &c);
            tp[(size_t)k * 64 * 512] = pk2(tr[k] * c + ti[k] * s, ti[k] * c - tr[k] * s); }
    }
}
__device__ __forceinline__ void phase_fourier2(Frame& F) {
    LAS float* tab = (LAS float*)(F.lds + RING_OFF + 4096);
    __syncthreads();
    if (F.tid < 64) { float s, c; sincospif((float)F.tid * (1.0f / 32.0f), &s, &c); tab[2 * F.tid] = c; tab[2 * F.tid + 1] = s; }
    __syncthreads();
    const float scale = 1.0f / sqrtf(4096.0f * 128.0f);
    for (int u = F.vcu; u < NBATCH * 64; u += F.G) {
        const int b = u >> 6, k1 = u & 63;
        float acc[64];
#pragma unroll
        for (int k = 0; k < 64; ++k) acc[k] = 0.f;
        const GAS unsigned* tp = ((GAS unsigned*)(F.ws + WS_TP)) + ((size_t)(b * 64 + k1) * 64) * 512 + F.tid;
        for (int n2 = 0; n2 < 64; ++n2) { const unsigned w = tp[(size_t)n2 * 512]; const float re = bf_lo(w), im = bf_hi(w);
#pragma unroll
            for (int k = 0; k < 64; ++k) { const int ix = (n2 * k) & 63; acc[k] += re * tab[2 * ix] + im * tab[2 * ix + 1]; } }
        GAS bf16* yo = ((GAS bf16*)(F.ws + WS_Y)) + (size_t)(b * RPB + k1) * YW + 1024 + F.tid;
#pragma unroll
        for (int k = 0; k < 64; ++k) yo[(size_t)(64 * k) * YW] = (bf16)f2bf(acc[k] * scale);
    }
}
__device__ __forceinline__ void phase_fourier_ctx(Frame& F) {
    LAS float* tab = (LAS float*)(F.lds + RING_OFF + 8192);
    __syncthreads();
    if (F.tid < 256) { float s, c; sincospif((float)F.tid * (1.0f / 128.0f), &s, &c); tab[2 * F.tid] = c; tab[2 * F.tid + 1] = s; }
    __syncthreads();
    const float scale = 1.0f / sqrtf(256.0f * 128.0f);
    for (int u = F.vcu; u < NBATCH * 8; u += F.G) {
        const int b = u >> 3, kb = (u & 7) * 32;
        float acc[32];
#pragma unroll
        for (int k = 0; k < 32; ++k) acc[k] = 0.f;
        const GAS bf16* pcol = ((GAS bf16*)(F.ws + WS_P)) + (size_t)(b * RPB + SEQ) * PW + C_F + 2 * F.tid;
        for (int n = 0; n < 256; ++n) { const unsigned w = *(const GAS unsigned*)(pcol + (size_t)n * PW); const float A = bf_lo(w), B = bf_hi(w);
#pragma unroll
            for (int k = 0; k < 32; ++k) { const int ix = (n * (kb + k)) & 255; acc[k] += A * tab[2 * ix] - B * tab[2 * ix + 1]; } }
        GAS bf16* yo = ((GAS bf16*)(F.ws + WS_Y)) + (size_t)(b * RPB + SEQ + kb) * YW + 1024 + F.tid;
#pragma unroll
        for (int k = 0; k < 32; ++k) yo[(size_t)k * YW] = (bf16)f2bf(acc[k] * scale);
    }
}
__device__ __forceinline__ void phase_norm2_router(Frame& F, int l) {
    LAS float* wr = (LAS float*)(F.lds + RING_OFF);
    LAS int* sel = (LAS int*)(F.lds + RING_OFF + 65536);
    const int nact = (l == 0) ? MROWS : NBATCH * SEQ; const int chunk = (nact + F.G - 1) / F.G; const int a0 = F.vcu * chunk, a1 = (a0 + chunk < nact) ? a0 + chunk : nact;
    __syncthreads();
    for (int i = F.tid; i < DM * 16 / 4; i += NTHR) ((LAS f32x4*)wr)[i] = ((const GAS f32x4*)INP(F, 17))[i];
    __syncthreads();
    const GAS float* mv = ((GAS float*)(F.ws + WS_MODV)) + (size_t)l * 5 * 6144;
    float rb[16];
#pragma unroll
    for (int e = 0; e < 16; ++e) rb[e] = INP(F, 18)[e];
    for (int a = a0 + F.wave; a < a1; a += NWAVES) {
        const int row = (l == 0) ? a : (a / SEQ) * RPB + (a % SEQ);
        f32x4 v[4]; load_row(v, xrow_ws(F, row), F.lane);
        const GAS float* m = mv + (size_t)modidx(row) * 6144; norm_mod(v, INP(F, 7) + l * DM, m + 4 * 1024, m + 3 * 1024, F.lane);
        store_bf16_row(((GAS bf16*)(F.ws + WS_H)) + (size_t)row * DM, v, F.lane);
        float lg[16];
#pragma unroll
        for (int e = 0; e < 16; ++e) lg[e] = 0.f;
#pragma unroll
        for (int j = 0; j < 4; ++j)
#pragma unroll
            for (int q = 0; q < 4; ++q) { const float hv = v[j][q]; const LAS f32x4* wp = (const LAS f32x4*)(wr + (4 * F.lane + 256 * j + q) * 16);
#pragma unroll
                for (int e4 = 0; e4 < 4; ++e4) { const f32x4 ww = wp[e4]; lg[4 * e4] += hv * ww.x; lg[4 * e4 + 1] += hv * ww.y; lg[4 * e4 + 2] += hv * ww.z; lg[4 * e4 + 3] += hv * ww.w; } }
        float sc[16], sl[16];
#pragma unroll
        for (int e = 0; e < 16; ++e) { sc[e] = sigm(wave_sum(lg[e], F.lane)); sl[e] = sc[e] + rb[e]; }
        float best = -INFINITY; int bi1 = 0, bi2 = 1; float bs1 = 0.f, bs2 = 0.f;
#pragma unroll
        for (int g = 0; g < 4; ++g) {
            int i1 = 4 * g; float m1 = sl[4 * g];
#pragma unroll
            for (int q = 1; q < 4; ++q) if (sl[4 * g + q] > m1) { m1 = sl[4 * g + q]; i1 = 4 * g + q; }
            int i2 = -1; float m2 = -INFINITY;
#pragma unroll
            for (int q = 0; q < 4; ++q) if (4 * g + q != i1 && sl[4 * g + q] > m2) { m2 = sl[4 * g + q]; i2 = 4 * g + q; }
            float s1 = 0.f, s2 = 0.f;
#pragma unroll
            for (int q = 0; q < 4; ++q) { if (4 * g + q == i1) s1 = sc[4 * g + q]; if (4 * g + q == i2) s2 = sc[4 * g + q]; }
            const float gs = m1 + m2;
            if (gs > best) { best = gs; bi1 = i1; bi2 = i2; bs1 = s1; bs2 = s2; }
        }
        if (F.lane == 0) { const float inv = 1.0f / (bs1 + bs2);
            ((GAS int*)(F.ws + WS_TOKE))[2 * row] = bi1; ((GAS int*)(F.ws + WS_TOKE))[2 * row + 1] = bi2; ((GAS float*)(F.ws + WS_TOKW))[2 * row] = bs1 * inv; ((GAS float*)(F.ws + WS_TOKW))[2 * row + 1] = bs2 * inv;
            sel[2 * (a - a0)] = bi1; sel[2 * (a - a0) + 1] = bi2; }
    }
    __syncthreads();
    if (F.tid < 16) { const int e = F.tid; int n = 0; const int ns = 2 * (a1 - a0);
        for (int i = 0; i < ns; ++i) n += (sel[i] == e) ? 1 : 0;
        unsigned base = 0u; if (n > 0) base = __hip_atomic_fetch_add((unsigned*)(F.ctl + CW_CNT + (l * 16 + e) * 64), (unsigned)n, RLX_AGENT);
        for (int i = 0; i < ns; ++i) if (sel[i] == e) { const int a = a0 + (i >> 1); const int row = (l == 0) ? a : (a / SEQ) * RPB + (a % SEQ); ((GAS int*)(F.ws + WS_TOKR))[2 * row + (i & 1)] = (int)base; ++base; } }
    __syncthreads();
}
__device__ __forceinline__ void moe_offsets(Frame& F, int l) {
    __syncthreads();
    if (F.tid == 0) { unsigned off = 0u;
        for (int e = 0; e < 16; ++e) { F.LCTL[e] = off; const unsigned c = __hip_atomic_load((unsigned*)(F.ctl + CW_CNT + (l * 16 + e) * 64), RLX_AGENT); off += (c + 255u) & ~255u; }
        F.LCTL[16] = off; F.LCTL[17] = off >> 8; }
    __syncthreads();
}
__device__ __forceinline__ void phase_scatter(Frame& F, int l) {
    moe_offsets(F, l);
    const int nact = (l == 0) ? MROWS : NBATCH * SEQ; const int chunk = (nact + F.G - 1) / F.G; const int a0 = F.vcu * chunk, a1 = (a0 + chunk < nact) ? a0 + chunk : nact;
    for (int a = a0 + F.wave; a < a1; a += NWAVES) {
        const int row = (l == 0) ? a : (a / SEQ) * RPB + (a % SEQ);
        const int e1 = ((GAS int*)(F.ws + WS_TOKE))[2 * row], e2 = ((GAS int*)(F.ws + WS_TOKE))[2 * row + 1];
        const int s1 = (int)F.LCTL[e1] + ((GAS int*)(F.ws + WS_TOKR))[2 * row], s2 = (int)F.LCTL[e2] + ((GAS int*)(F.ws + WS_TOKR))[2 * row + 1];
        if (F.lane == 0) { ((GAS int*)(F.ws + WS_TOKS))[2 * row] = s1; ((GAS int*)(F.ws + WS_TOKS))[2 * row + 1] = s2; }
        const GAS v4u* src = (const GAS v4u*)(((GAS bf16*)(F.ws + WS_H)) + (size_t)row * DM) + F.lane; const v4u x0 = src[0], x1 = src[64];
        GAS v4u* d1 = (GAS v4u*)(((GAS bf16*)(F.ws + WS_AM)) + (size_t)s1 * DM) + F.lane; GAS v4u* d2 = (GAS v4u*)(((GAS bf16*)(F.ws + WS_AM)) + (size_t)s2 * DM) + F.lane;
        d1[0] = x0; d1[64] = x1; d2[0] = x0; d2[64] = x1;
    }
}
__device__ __forceinline__ void phase_combine(Frame& F, int l) {
    const int gw = F.vcu * NWAVES + F.wave, NGW = F.G * NWAVES; const GAS float* mv = ((GAS float*)(F.ws + WS_MODV)) + (size_t)l * 5 * 6144;
    const int nact = (l == 0) ? MROWS : NBATCH * SEQ;
    for (int a = gw; a < nact; a += NGW) {
        const int row = (l == 0) ? a : (a / SEQ) * RPB + (a % SEQ);
        GAS float* xr = xrow_ws(F, row); f32x4 v[4]; load_row(v, xr, F.lane);
        const int s1 = ((GAS int*)(F.ws + WS_TOKS))[2 * row], s2 = ((GAS int*)(F.ws + WS_TOKS))[2 * row + 1]; const float w1 = ((GAS float*)(F.ws + WS_TOKW))[2 * row], w2 = ((GAS float*)(F.ws + WS_TOKW))[2 * row + 1];
        const GAS float* g2 = mv + (size_t)modidx(row) * 6144 + 5 * 1024;
        const GAS bf16* o1 = ((GAS bf16*)(F.ws + WS_OM)) + (size_t)s1 * DM; const GAS bf16* o2 = ((GAS bf16*)(F.ws + WS_OM)) + (size_t)s2 * DM;
#pragma unroll
        for (int j = 0; j < 4; ++j) { const int c = 4 * F.lane + 256 * j; const v2u p = *(const GAS v2u*)(o1 + c), q = *(const GAS v2u*)(o2 + c); const f32x4 gg = *(const f32x4*)(g2 + c);
            f32x4 z; z.x = w1 * bf_lo(p.x) + w2 * bf_lo(q.x); z.y = w1 * bf_hi(p.x) + w2 * bf_hi(q.x); z.z = w1 * bf_lo(p.y) + w2 * bf_lo(q.y); z.w = w1 * bf_hi(p.y) + w2 * bf_hi(q.y);
            v[j] = v[j] + gg * z; }
        if (l == 0) {
#pragma unroll
            for (int j = 0; j < 4; ++j) *(GAS f32x4*)(xr + 4 * F.lane + 256 * j) = v[j];
            const GAS float* m1 = ((GAS float*)(F.ws + WS_MODV)) + (size_t)5 * 6144 + (size_t)modidx(row) * 6144;
            norm_mod(v, INP(F, 6) + DM, m1 + 1024, m1, F.lane); store_bf16_row(((GAS bf16*)(F.ws + WS_H)) + (size_t)row * DM, v, F.lane);
        } else {
            float ss = 0.f;
#pragma unroll
            for (int j = 0; j < 4; ++j) ss += (v[j].x * v[j].x + v[j].y * v[j].y) + (v[j].z * v[j].z + v[j].w * v[j].w);
            const float rstd = 1.0f / sqrtf(wave_sum(ss, F.lane) * (1.0f / DM) + EPS);
#pragma unroll
            for (int j = 0; j < 4; ++j) { const int c = 4 * F.lane + 256 * j; *(GAS f32x4*)(xr + c) = v[j] * rstd * *(const f32x4*)(INP(F, 21) + c); }
        }
    }
}
struct SchedIn {
    int G, c;
    __device__ __forceinline__ bool next(int i, pg8::Unit& u) const { const long L = (long)i * G + c; if (L >= 68 * 33) return false; int pm, pn; pg8::tile_map((int)L, 68, 33, pm, pn);
        u.pm = pm; u.pn = pn; u.aux = 0; u.aoff = (size_t)pm * 256 * DM * 2; u.boff = (size_t)pn * 256 * DM * 2; return true; }
};
struct SchedBr {
    int G, c, nMt; bool skipctx;
    __device__ __forceinline__ bool next(int i, pg8::Unit& u) const { const long L = (long)(i >> 2) * G + c; if (L >= nMt * 4) return false; int pm, pn; pg8::tile_map((int)L, nMt, 4, pm, pn);
        if (skipctx) pm = (pm / 16) * 17 + (pm % 16);
        const int n = i & 3; u.pm = pm; u.pn = pn; u.aux = n; u.aoff = ((size_t)pm * 256 * YW + n * 512) * 2; u.boff = ((size_t)pn * 256 * 2048 + n * 512) * 2; return true; }
};
struct SchedOut {
    int G, c, nMt; bool skipctx;
    __device__ __forceinline__ bool next(int i, pg8::Unit& u) const { const long L = (long)i * G + c; if (L >= nMt * 4) return false; int pm, pn; pg8::tile_map((int)L, nMt, 4, pm, pn);
        if (skipctx) pm = (pm / 16) * 17 + (pm % 16);
        u.pm = pm; u.pn = pn; u.aux = 0; u.aoff = (size_t)pm * 256 * DM * 2; u.boff = (size_t)pn * 256 * DM * 2; return true; }
};
struct SchedMoe {
    int G, c; LAS unsigned* lctl; size_t astride, bstride_e, bstride_n;
    __device__ __forceinline__ bool next(int i, pg8::Unit& u) const { const long L = (long)i * G + c; const unsigned nt = lctl[17]; if (L >= (long)nt * 4) return false;
        const int tile = (int)(L >> 2), pn = (int)(L & 3); const unsigned row0 = (unsigned)tile * 256u; int e = 0;
#pragma unroll
        for (int k = 1; k < 16; ++k) e += (row0 >= lctl[k]) ? 1 : 0;
        u.pm = tile; u.pn = pn; u.aux = e; u.aoff = (size_t)tile * astride; u.boff = (size_t)e * bstride_e + (size_t)pn * bstride_n; return true; }
};

__device__ __forceinline__ void attn_plain_args(const Frame& F, int U, attn_body::AttnArgs& a) {
    typedef AGAS attn_body::bf16 abf;
    a.qrow0 = 0; a.rb0 = 0; a.rpb = nullptr; a.kr1 = 0;
    if (U < 512) { const int b = U >> 7, kvh = (U >> 6) & 1, hq = (U >> 4) & 3, qb = U & 15, h = kvh * 4 + hq; const size_t r0 = (size_t)b * RPB;
        a.Q = (const abf*)(((GAS bf16*)(F.ws + WS_P)) + (r0 + 256 * qb) * PW + C_GQ + h * 64); a.K = (const abf*)(((GAS bf16*)(F.ws + WS_P)) + r0 * PW + C_GK + kvh * 64); a.V = (const abf*)(((GAS bf16*)(F.ws + WS_P)) + r0 * PW + C_GV + kvh * 64);
        a.O = (abf*)(((GAS bf16*)(F.ws + WS_Y)) + (r0 + 256 * qb) * YW + h * 64); a.kr0 = 0; a.tsw = 1 << 20; a.NT = RPB / 64; }
    else if (U < 544) { const int b = (U - 512) >> 3, h = (U - 512) & 7, kvh = h >> 2; const size_t r0 = (size_t)b * RPB;
        a.Q = (const abf*)(((GAS bf16*)(F.ws + WS_P)) + (r0 + SEQ) * PW + C_GQ + h * 64); a.K = (const abf*)(((GAS bf16*)(F.ws + WS_P)) + r0 * PW + C_GK + kvh * 64); a.V = (const abf*)(((GAS bf16*)(F.ws + WS_P)) + r0 * PW + C_GV + kvh * 64);
        a.O = (abf*)(((GAS bf16*)(F.ws + WS_Y)) + (r0 + SEQ) * YW + h * 64); a.kr0 = SEQ; a.tsw = 1 << 20; a.NT = 4; }
    else { const int b = (U - 544) >> 3, h = (U - 544) & 7; const size_t r0 = (size_t)b * RPB;
        a.Q = (const abf*)(((GAS bf16*)(F.ws + WS_P)) + (r0 + SEQ) * PW + C_NQ + h * 64); a.K = (const abf*)(((GAS bf16*)(F.ws + WS_P)) + r0 * PW + C_NK + h * 64); a.V = (const abf*)(((GAS bf16*)(F.ws + WS_P)) + r0 * PW + C_NV + h * 64);
        a.O = (abf*)(((GAS bf16*)(F.ws + WS_Y)) + (r0 + SEQ) * YW + 512 + h * 64); a.kr0 = SEQ; a.tsw = 1 << 20; a.NT = 4; }
}
__device__ __forceinline__ void attn_na_args(const Frame& F, int U, int l, attn_body::AttnArgs& a) {
    typedef AGAS attn_body::bf16 abf;
    const int b = U >> 7, h = (U >> 4) & 7, j = U & 15; const size_t r0 = (size_t)b * RPB;
    int rb0 = 4 * j - 4; rb0 = rb0 < 0 ? 0 : (rb0 > 52 ? 52 : rb0);
    a.Q = (const abf*)(((GAS bf16*)(F.ws + WS_P)) + (r0 + 256 * j) * PW + C_NQ + h * 64); a.K = (const abf*)(((GAS bf16*)(F.ws + WS_P)) + r0 * PW + C_NK + h * 64); a.V = (const abf*)(((GAS bf16*)(F.ws + WS_P)) + r0 * PW + C_NV + h * 64);
    a.O = (abf*)(((GAS bf16*)(F.ws + WS_Y)) + (r0 + 256 * j) * YW + 512 + h * 64); a.kr0 = SEQ; a.kr1 = 64 * rb0; a.tsw = 4; a.NT = 16; a.qrow0 = 4 * j; a.rb0 = rb0; a.rpb = INP(F, 11) + ((size_t)l * 8 + h) * 465;
}

constexpr int N_PHASES = 2 + 11 * NLAYER;
struct Args { const GAS float* in[22]; GAS float* out; unsigned char* ws; int ph_lo, ph_hi; };
__global__ void __launch_bounds__(NTHR, 2) fwd_kernel(Args args) {
    extern __shared__ __attribute__((aligned(16))) unsigned char lds[];
    Frame F;
    F.lds = (LAS unsigned char*)lds; F.MISC = (volatile LAS unsigned*)(F.lds + MISC_OFF); F.LCTL = (LAS unsigned*)(F.lds + LDSCTL_OFF);
    F.tid = threadIdx.x; F.lane = F.tid & 63; F.wave = __builtin_amdgcn_readfirstlane(F.tid >> 6);
    F.G = gridDim.x; { const int bx = blockIdx.x; F.vcu = (F.G % 8 == 0) ? (bx % 8) * (F.G / 8) + bx / 8 : bx; }
    unsigned char* ws = args.ws;
    F.ctl = (gu32*)(ws + WS_CTL);
    F.out = args.out; F.ws = ws;
    for (int u = F.tid; u < (LDS_BYTES - LDSCTL_OFF) / 4; u += NTHR) ((LAS unsigned*)(F.lds + LDSCTL_OFF))[u] = 0u;
    __syncthreads();
    if (F.tid < 22) { unsigned long long p = 0ull;
#pragma unroll
        for (int i = 0; i < 22; ++i) if (F.tid == i) p = (unsigned long long)args.in[i];
        LAS unsigned* t = (LAS unsigned*)(F.lds + PTR_OFF) + 2 * F.tid; t[0] = (unsigned)p; t[1] = (unsigned)(p >> 32); }
    __syncthreads();
    XcdBarrier bar = xcd_barrier_post((unsigned*)(F.ctl + CW_BAR), F.MISC + 8);
    const int lo = args.ph_lo, hi = args.ph_hi;
#define LAUNDER() do { int t_ = threadIdx.x; asm volatile("" : "+v"(t_)); F.tid = t_; F.lane = t_ & 63; F.wave = __builtin_amdgcn_readfirstlane(t_ >> 6); \
        int g_ = gridDim.x, b_ = blockIdx.x; unsigned char* w_ = args.ws; GAS float* o_ = args.out; unsigned l_ = (unsigned)(uintptr_t)lds; \
        asm volatile("" : "+s"(g_), "+s"(b_), "+s"(w_), "+s"(o_), "+s"(l_)); \
        F.G = g_; bx = b_; F.vcu = (g_ % 8 == 0) ? (b_ % 8) * (g_ / 8) + b_ / 8 : b_; F.ws = w_; F.out = o_; F.ctl = (gu32*)(w_ + WS_CTL); \
        F.lds = (LAS unsigned char*)l_; F.MISC = (volatile LAS unsigned*)(F.lds + MISC_OFF); F.LCTL = (LAS unsigned*)(F.lds + LDSCTL_OFF); } while (0)
#define RUN(k) ((k) >= lo && (k) < hi)
#define SEAM(k) do { if ((k) >= lo && (k) + 1 < hi) xcd_barrier(bar); } while (0)
    int bx = (int)blockIdx.x;

    if (RUN(0)) { LAUNDER(); convert_weights(F, 0); LAUNDER(); mod_vectors(F); } SEAM(0);
    if (RUN(1)) { LAUNDER(); phase_norm1_first(F); } SEAM(1);

    for (int l = 0; l < NLAYER; ++l) {
        const int p0 = 2 + 11 * l;
        if (RUN(p0 + 0)) { LAUNDER(); SchedIn S{F.G, bx}; pg8::EpiP E{((GAS bf16*)(F.ws + WS_P)), PW, C_G / 256};
            pg8::gemm_phase<pg8::EpiP, SchedIn, true>(F.lds + RING_OFF, F.tid, ((GAS bf16*)(F.ws + WS_H)), ((GAS bf16*)(F.ws + WS_WIN)), DM, DM, DM, S, E); } SEAM(p0 + 0);
        if (RUN(p0 + 1)) { LAUNDER(); phase_qkrope(F, l); } SEAM(p0 + 1);
        if (RUN(p0 + 2)) { LAUNDER();
            phase_fourier1(F); __syncthreads(); LAUNDER();
            phase_conv(F, l); __syncthreads(); LAUNDER();
            const int nU = (l == 0) ? 576 : 512;
            for (int U = F.vcu; U < nU; U += F.G) { attn_body::AttnArgs a; attn_plain_args(F, U, a); int t_ = threadIdx.x; asm volatile("" : "+v"(t_)); attn_body::attn_unit<8, false>(a, (char*)F.lds + RING_OFF, t_); }
            __syncthreads();
        } SEAM(p0 + 2);
        if (RUN(p0 + 3)) { LAUNDER();
            phase_fourier2(F); __syncthreads(); LAUNDER();
            for (int U = F.vcu; U < 512; U += F.G) { attn_body::AttnArgs a; attn_na_args(F, U, l, a); int t_ = threadIdx.x; asm volatile("" : "+v"(t_)); attn_body::attn_unit<8, true>(a, (char*)F.lds + RING_OFF, t_); }
            __syncthreads();
            if (l == 0) { LAUNDER(); phase_fourier_ctx(F); __syncthreads(); }
        } SEAM(p0 + 3);
        if (RUN(p0 + 4)) { LAUNDER(); SchedBr S{F.G, bx, (l == 0) ? 68 : 64, l != 0}; pg8::EpiBranch E{((GAS bf16*)(F.ws + WS_P)) + C_G, PW, ((GAS bf16*)(F.ws + WS_H)), DM};
            pg8::gemm_phase<pg8::EpiBranch, SchedBr, true>(F.lds + RING_OFF, F.tid, ((GAS bf16*)(F.ws + WS_Y)), ((GAS bf16*)(F.ws + WS_WB)), YW, 2048, 512, S, E); } SEAM(p0 + 4);
        if (RUN(p0 + 5)) { LAUNDER(); SchedOut S{F.G, bx, (l == 0) ? 68 : 64, l != 0};
            pg8::EpiRes E{(l == 0) ? INP(F, 0) : F.out, (l == 0) ? INP(F, 2) : ((GAS float*)(F.ws + WS_XC)), F.out, ((GAS float*)(F.ws + WS_XC)), ((GAS float*)(F.ws + WS_MODV)) + (size_t)l * 5 * 6144 + 2 * 1024};
            pg8::gemm_phase<pg8::EpiRes, SchedOut, true>(F.lds + RING_OFF, F.tid, ((GAS bf16*)(F.ws + WS_H)), ((GAS bf16*)(F.ws + WS_WO)), DM, DM, DM, S, E); } SEAM(p0 + 5);
        if (RUN(p0 + 6)) { LAUNDER(); phase_norm2_router(F, l); } SEAM(p0 + 6);
        if (RUN(p0 + 7)) { LAUNDER(); phase_scatter(F, l); } SEAM(p0 + 7);
        if (RUN(p0 + 8)) { LAUNDER(); moe_offsets(F, l); SchedMoe S{F.G, bx, F.LCTL, (size_t)256 * DM * 2, (size_t)DM * DM * 2, (size_t)256 * DM * 2}; pg8::EpiGU E{((GAS bf16*)(F.ws + WS_HM)), EFF};
            pg8::gemm_phase<pg8::EpiGU, SchedMoe, true>(F.lds + RING_OFF, F.tid, ((GAS bf16*)(F.ws + WS_AM)), ((GAS bf16*)(F.ws + WS_WGU)), DM, DM, DM, S, E); } SEAM(p0 + 8);
        if (RUN(p0 + 9)) { LAUNDER(); moe_offsets(F, l); SchedMoe S{F.G, bx, F.LCTL, (size_t)256 * EFF * 2, (size_t)DM * EFF * 2, (size_t)256 * EFF * 2}; pg8::EpiP E{((GAS bf16*)(F.ws + WS_OM)), DM, 1 << 20};
            pg8::gemm_phase<pg8::EpiP, SchedMoe, true>(F.lds + RING_OFF, F.tid, ((GAS bf16*)(F.ws + WS_HM)), ((GAS bf16*)(F.ws + WS_WD)), EFF, EFF, EFF, S, E); } SEAM(p0 + 9);
        if (RUN(p0 + 10)) { LAUNDER(); phase_combine(F, l); if (l + 1 < NLAYER) { __syncthreads(); LAUNDER(); convert_weights(F, l + 1); } } SEAM(p0 + 10);
    }
#undef RUN
#undef SEAM
}

#ifndef MK_PER_PHASE
#define MK_PER_PHASE 0
#endif
extern "C" void kernel_launch(void* const* d_in, const GAS int* in_sizes, int n_in, void* d_out, int out_size, void* d_ws, size_t ws_size, hipStream_t stream) {
    static int grid = 0;
    if (grid == 0) {
        if (n_in != 22 || out_size != NBATCH * SEQ * DM || ws_size < WS_END) { fprintf(stderr, "kernel_launch: unexpected shapes (n_in %d, out %d, ws %zu); nothing launched\n", n_in, out_size, ws_size); grid = -1; return; }
        int dev = 0, cus = 0, per_cu = 0;
        if (hipGetDevice(&dev) != hipSuccess || hipDeviceGetAttribute(&cus, hipDeviceAttributeMultiprocessorCount, dev) != hipSuccess) { grid = -1; return; }
        if (hipFuncSetAttribute((const void*)fwd_kernel, hipFuncAttributeMaxDynamicSharedMemorySize, LDS_BYTES) != hipSuccess) { fprintf(stderr, "kernel_launch: hipFuncSetAttribute failed\n"); grid = -1; return; }
        if (hipOccupancyMaxActiveBlocksPerMultiprocessor(&per_cu, (const void*)fwd_kernel, NTHR, LDS_BYTES) != hipSuccess || per_cu < 1) { fprintf(stderr, "kernel_launch: occupancy query reports %d\n", per_cu); (void)hipGetLastError(); grid = -1; return; }
        grid = cus;
    }
    if (grid < 0) return;
    (void)hipMemsetAsync((char*)d_ws + WS_CTL, 0, CTL_ZERO_BYTES, stream);
    Args a{};
    for (int i = 0; i < 22; ++i) a.in[i] = (const GAS float*)d_in[i];
    a.out = (GAS float*)d_out; a.ws = (unsigned char*)d_ws;
#if MK_PER_PHASE
    for (int p = 0; p < N_PHASES; ++p) { a.ph_lo = p; a.ph_hi = p + 1; hipLaunchKernelGGL(fwd_kernel, dim3(grid), dim3(NTHR), LDS_BYTES, stream, a); }
#else
    a.ph_lo = 0; a.ph_hi = N_PHASES;
    hipLaunchKernelGGL(fwd_kernel, dim3(grid), dim3(NTHR), LDS_BYTES, stream, a);
#endif
}
```

```cpp
#include <hip/hip_runtime.h>
#include <hip/hip_bf16.h>
#include <cstdio>
#include <cstdint>
#include <cmath>

namespace pg8 {
#define PG8_LAS __attribute__((address_space(3)))
#define PG8_GAS __attribute__((address_space(1)))
typedef unsigned short bf16_t;
typedef short bf16x8 __attribute__((ext_vector_type(8)));
typedef float f32x4 __attribute__((ext_vector_type(4)));
typedef unsigned u32x4 __attribute__((ext_vector_type(4)));
constexpr int BM = 256, BK = 64, HALF = 128, HTB = HALF * BK * 2, STAGE_BYTES = 8 * HTB, NXCD = 8, WGM = 8;

__host__ __device__ __forceinline__ int lds_byte(int r, int c) { const int st = (r >> 4) * 2 + (c >> 5), rr = r & 15, cc = c & 31, ob = rr * 64 + cc * 2; return st * 1024 + (ob ^ (((ob >> 9) & 1) << 5)); }
__host__ __device__ __forceinline__ void stage_rc(int b, int& R, int& C) { const int st = b / 1024, sb = b % 1024, swz = sb ^ (((sb >> 9) & 1) << 5); R = (st >> 1) * 16 + swz / 64; C = (st & 1) * 32 + (swz % 64) / 2; }
__host__ __device__ __forceinline__ int perm32(int rho) { const int n = rho >> 4, i = rho & 15; return 8 * (i >> 2) + 4 * n + (i & 3); }

struct Unit { int pm, pn, aux; size_t aoff, boff; };

__device__ __forceinline__ void tile_map(int L, int nM, int nN, int& pm, int& pn) {
    const int nwg = nM * nN; int wgid = L;
    { const int q = nwg / NXCD, r = nwg % NXCD, xcd = wgid % NXCD, off = wgid / NXCD; wgid = (xcd < r ? xcd * (q + 1) : r * (q + 1) + (xcd - r) * q) + off; }
    const int nig = WGM * nN, gid = wgid / nig, fm = gid * WGM, gsz = (nM - fm) < WGM ? (nM - fm) : WGM;
    pm = fm + ((wgid % nig) % gsz); pn = (wgid % nig) / gsz;
}

__device__ __forceinline__ unsigned cvt_pk_bf16(float lo, float hi) { unsigned r; asm volatile("v_cvt_pk_bf16_f32 %0, %1, %2" : "=v"(r) : "v"(lo), "v"(hi)); return r; }
__device__ __forceinline__ float fast_sigmoid(float x) { return __builtin_amdgcn_rcpf(1.0f + __builtin_amdgcn_exp2f(-1.4426950408889634f * x)); }
__device__ __forceinline__ float bflo(unsigned w) { return __uint_as_float(w << 16); }
__device__ __forceinline__ float bfhi(unsigned w) { return __uint_as_float(w & 0xffff0000u); }

struct EpiP {
    static constexpr bool PERM = true, KEEP = false;
    PG8_GAS bf16_t* O; int ldc; int sig_from;
    __device__ __forceinline__ void operator()(f32x4 (&acc)[2][2][4][2], const Unit& u, int wr, int wc, int fr, int fq) const {
        const int row0 = u.pm * BM + wr * 64 + fr, col0 = u.pn * BM + wc * 32 + 8 * fq; const bool sig = u.pn >= sig_from;
#pragma unroll
        for (int ai = 0; ai < 2; ++ai)
#pragma unroll
            for (int m = 0; m < 4; ++m) { PG8_GAS bf16_t* rowp = O + (size_t)(row0 + ai * HALF + m * 16) * ldc + col0;
#pragma unroll
                for (int bj = 0; bj < 2; ++bj) { f32x4 v0 = acc[ai][bj][m][0], v1 = acc[ai][bj][m][1];
                    if (sig) {
#pragma unroll
                        for (int k = 0; k < 4; ++k) { v0[k] = __builtin_fmaxf(fast_sigmoid(v0[k]), 1e-20f); v1[k] = __builtin_fmaxf(fast_sigmoid(v1[k]), 1e-20f); } }
                    u32x4 w; w.x = cvt_pk_bf16(v0[0], v0[1]); w.y = cvt_pk_bf16(v0[2], v0[3]); w.z = cvt_pk_bf16(v1[0], v1[1]); w.w = cvt_pk_bf16(v1[2], v1[3]);
                    *(PG8_GAS u32x4*)(rowp + bj * HALF) = w; } }
    }
};
struct EpiBranch {
    static constexpr bool PERM = true, KEEP = true;
    const PG8_GAS bf16_t* G; int ldg; PG8_GAS bf16_t* O; int ldc;
    __device__ __forceinline__ void operator()(f32x4 (&acc)[2][2][4][2], const Unit& u, int wr, int wc, int fr, int fq) const {
        const int row0 = u.pm * BM + wr * 64 + fr, col0 = u.pn * BM + wc * 32 + 8 * fq; const int nb = u.aux;
#pragma unroll
        for (int ai = 0; ai < 2; ++ai)
#pragma unroll
            for (int m = 0; m < 4; ++m) { const size_t row = (size_t)(row0 + ai * HALF + m * 16);
#pragma unroll
                for (int bj = 0; bj < 2; ++bj) { const int col = col0 + bj * HALF; const PG8_GAS bf16_t* gp = G + row * ldg + nb * 1024 + col;
                    const u32x4 g0 = *(const PG8_GAS u32x4*)gp; float f[8] = {bflo(g0.x), bfhi(g0.x), bflo(g0.y), bfhi(g0.y), bflo(g0.z), bfhi(g0.z), bflo(g0.w), bfhi(g0.w)};
                    if (nb < 3) { const u32x4 g1 = *(const PG8_GAS u32x4*)(gp + 1024);
                        f[0] *= __builtin_amdgcn_rcpf(bflo(g1.x)); f[1] *= __builtin_amdgcn_rcpf(bfhi(g1.x)); f[2] *= __builtin_amdgcn_rcpf(bflo(g1.y)); f[3] *= __builtin_amdgcn_rcpf(bfhi(g1.y));
                        f[4] *= __builtin_amdgcn_rcpf(bflo(g1.z)); f[5] *= __builtin_amdgcn_rcpf(bfhi(g1.z)); f[6] *= __builtin_amdgcn_rcpf(bflo(g1.w)); f[7] *= __builtin_amdgcn_rcpf(bfhi(g1.w)); }
                    f32x4 v0 = acc[ai][bj][m][0], v1 = acc[ai][bj][m][1];
                    v0[0] *= f[0]; v0[1] *= f[1]; v0[2] *= f[2]; v0[3] *= f[3]; v1[0] *= f[4]; v1[1] *= f[5]; v1[2] *= f[6]; v1[3] *= f[7];
                    if (nb < 3) { acc[ai][bj][m][0] = v0; acc[ai][bj][m][1] = v1; }
                    else { u32x4 w; w.x = cvt_pk_bf16(v0[0], v0[1]); w.y = cvt_pk_bf16(v0[2], v0[3]); w.z = cvt_pk_bf16(v1[0], v1[1]); w.w = cvt_pk_bf16(v1[2], v1[3]);
                        *(PG8_GAS u32x4*)(O + row * ldc + col) = w; acc[ai][bj][m][0] = (f32x4){0.f, 0.f, 0.f, 0.f}; acc[ai][bj][m][1] = (f32x4){0.f, 0.f, 0.f, 0.f}; } } }
    }
};
struct EpiRes {
    static constexpr bool PERM = false, KEEP = false;
    const PG8_GAS float* base_lat; const PG8_GAS float* base_ctx; PG8_GAS float* out_lat; PG8_GAS float* out_ctx; const PG8_GAS float* gmod;
    __device__ __forceinline__ void operator()(f32x4 (&acc)[2][2][4][2], const Unit& u, int wr, int wc, int fr, int fq) const {
        const int b = u.pm / 17, j = u.pm % 17;
        const size_t ro = (j < 16) ? ((size_t)b * 4096 + (size_t)j * 256) * 1024 : (size_t)b * 256 * 1024;
        const PG8_GAS float* bp = ((j < 16) ? base_lat : base_ctx) + ro; PG8_GAS float* op = ((j < 16) ? out_lat : out_ctx) + ro; const PG8_GAS float* gv = gmod + ((j < 16) ? b : 4) * 6144;
        const int col0 = u.pn * BM + wc * 32 + 4 * fq;
#pragma unroll
        for (int bj = 0; bj < 2; ++bj)
#pragma unroll
            for (int n = 0; n < 2; ++n) { const int col = col0 + bj * HALF + n * 16; const f32x4 g = *(const PG8_GAS f32x4*)(gv + col);
#pragma unroll
                for (int ai = 0; ai < 2; ++ai)
#pragma unroll
                    for (int m = 0; m < 4; ++m) { const size_t off = (size_t)(ai * HALF + wr * 64 + m * 16 + fr) * 1024 + col;
                        const f32x4 bs = *(const PG8_GAS f32x4*)(bp + off); *(PG8_GAS f32x4*)(op + off) = bs + g * acc[ai][bj][m][n]; } }
    }
};
struct EpiGU {
    static constexpr bool PERM = true, KEEP = false;
    PG8_GAS bf16_t* O; int ldc;
    __device__ __forceinline__ void operator()(f32x4 (&acc)[2][2][4][2], const Unit& u, int wr, int wc, int fr, int fq) const {
        const int row0 = u.pm * BM + wr * 64 + fr, col0 = u.pn * HALF + wc * 32 + 8 * fq;
#pragma unroll
        for (int ai = 0; ai < 2; ++ai)
#pragma unroll
            for (int m = 0; m < 4; ++m) { float o[8];
#pragma unroll
                for (int n = 0; n < 2; ++n)
#pragma unroll
                    for (int k = 0; k < 4; ++k) { const float a = acc[ai][0][m][n][k], b = acc[ai][1][m][n][k]; o[n * 4 + k] = a * fast_sigmoid(a) * b; }
                u32x4 w; w.x = cvt_pk_bf16(o[0], o[1]); w.y = cvt_pk_bf16(o[2], o[3]); w.z = cvt_pk_bf16(o[4], o[5]); w.w = cvt_pk_bf16(o[6], o[7]);
                *(PG8_GAS u32x4*)(O + (size_t)(row0 + ai * HALF + m * 16) * ldc + col0) = w; }
    }
};

template <class Epi, class Sched, bool ALIGN_EPI>
__device__ __forceinline__ void gemm_phase(PG8_LAS unsigned char* lds, int tid, const PG8_GAS bf16_t* A, const PG8_GAS bf16_t* Bt, int lda, int ldb, int K, const Sched& S, const Epi& E) {
    const int wid = __builtin_amdgcn_readfirstlane(tid >> 6), lane = tid & 63, wr = wid >> 2, wc = wid & 3, fr = lane & 15, fq = lane >> 4;
    const int nt = K / BK;
    unsigned voffA[2], voffB[2];
#pragma unroll
    for (int i = 0; i < 2; ++i) { int R, C; stage_rc(tid * 16 + i * 8192, R, C); const int Rb = Epi::PERM ? ((R & ~31) + perm32(R & 31)) : R;
        voffA[i] = (unsigned)(R * lda + C) * 2u; voffB[i] = (unsigned)(Rb * ldb + C) * 2u; }
    const size_t kstep = (size_t)(BK * 2);
    const size_t hstepA = (size_t)HALF * lda * 2, hstepB = (size_t)HALF * ldb * 2;
    const unsigned ldsw = (unsigned)wid * 1024u;
    const int aoff = lds_byte(wr * 64 + fr, fq * 8), boff = lds_byte(wc * 32 + fr, fq * 8);
#define PG8_SA(b, h) (((b) * 2 + (h)) * HTB)
#define PG8_SB(b, h) ((4 + (b) * 2 + (h)) * HTB)
#define PG8_STAGE(bufoff, gbase, voff) do { _Pragma("unroll") for (int _i = 0; _i < 2; ++_i) \
        __builtin_amdgcn_global_load_lds((const PG8_GAS unsigned*)((const PG8_GAS char*)(gbase) + (voff)[_i]), (PG8_LAS unsigned*)(lds + (bufoff) + ldsw + _i * 8192), 16, 0, 0); } while (0)
#define PG8_LDA(dst, b, h) do { _Pragma("unroll") for (int m = 0; m < 4; ++m) _Pragma("unroll") for (int k = 0; k < 2; ++k) dst[m][k] = *(const PG8_LAS bf16x8*)(lds + PG8_SA(b, h) + aoff + m * 2048 + k * 1024); } while (0)
#define PG8_LDB(dst, b, h) do { _Pragma("unroll") for (int n = 0; n < 2; ++n) _Pragma("unroll") for (int k = 0; k < 2; ++k) dst[n][k] = *(const PG8_LAS bf16x8*)(lds + PG8_SB(b, h) + boff + n * 2048 + k * 1024); } while (0)
#define PG8_MMA(ai, bj, At, Bt_) do { __builtin_amdgcn_s_setprio(1); _Pragma("unroll") for (int m = 0; m < 4; ++m) _Pragma("unroll") for (int n = 0; n < 2; ++n) _Pragma("unroll") for (int k = 0; k < 2; ++k) \
        acc[ai][bj][m][n] = __builtin_amdgcn_mfma_f32_16x16x32_bf16(Bt_[n][k], At[m][k], acc[ai][bj][m][n], 0, 0, 0); __builtin_amdgcn_s_setprio(0); } while (0)
#define PG8_WAIT_V(n) asm volatile("s_waitcnt vmcnt(" #n ")" ::: "memory")
#define PG8_WAIT_L(n) asm volatile("s_waitcnt lgkmcnt(" #n ")" ::: "memory")
#define PG8_BAR __builtin_amdgcn_s_barrier()
#define PG8_SCHED __builtin_amdgcn_sched_barrier(0)
    Unit cur, nxt; int ui = 0;
    if (!S.next(0, cur)) return;
    f32x4 acc[2][2][4][2];
#pragma unroll
    for (int a = 0; a < 2; ++a)
#pragma unroll
        for (int b = 0; b < 2; ++b)
#pragma unroll
            for (int m = 0; m < 4; ++m)
#pragma unroll
                for (int n = 0; n < 2; ++n) acc[a][b][m][n] = (f32x4){0.f, 0.f, 0.f, 0.f};
    bf16x8 At[4][2], B0[2][2], B1[2][2];
    const PG8_GAS char* cA = (const PG8_GAS char*)A + cur.aoff; const PG8_GAS char* cB = (const PG8_GAS char*)Bt + cur.boff;
    PG8_STAGE(PG8_SB(0, 0), cB, voffB); PG8_STAGE(PG8_SB(0, 1), cB + hstepB, voffB); PG8_STAGE(PG8_SA(0, 0), cA, voffA); PG8_STAGE(PG8_SA(0, 1), cA + hstepA, voffA);
    if (wr == 1) PG8_BAR;
    PG8_WAIT_V(2); PG8_BAR;
    PG8_STAGE(PG8_SB(1, 0), cB + kstep, voffB); PG8_STAGE(PG8_SA(1, 0), cA + kstep, voffA); PG8_STAGE(PG8_SB(1, 1), cB + hstepB + kstep, voffB);
    PG8_WAIT_V(6); PG8_BAR;
    for (;;) {
        const bool has_next = S.next(ui + 1, nxt);
        const PG8_GAS char* nA = has_next ? (const PG8_GAS char*)A + nxt.aoff : cA; const PG8_GAS char* nB = has_next ? (const PG8_GAS char*)Bt + nxt.boff : cB;
        for (int t = 0; t < nt; t += 2) {
            const bool last = (t == nt - 2);
            const PG8_GAS char* a1 = cA + (size_t)(t + 1) * kstep;
            const PG8_GAS char* a2 = last ? nA : cA + (size_t)(t + 2) * kstep; const PG8_GAS char* b2 = last ? nB : cB + (size_t)(t + 2) * kstep;
            const PG8_GAS char* a3 = a2 + kstep; const PG8_GAS char* b3 = b2 + kstep;
            PG8_LDB(B0, 0, 0); PG8_LDB(B1, 0, 1); PG8_SCHED; PG8_LDA(At, 0, 0); PG8_STAGE(PG8_SA(1, 1), a1 + hstepA, voffA);
            PG8_WAIT_V(8); PG8_WAIT_L(0); PG8_BAR; PG8_MMA(0, 0, At, B0); PG8_MMA(0, 1, At, B1); PG8_BAR; PG8_SCHED;
            PG8_LDA(At, 0, 1); PG8_STAGE(PG8_SB(0, 0), b2, voffB); PG8_STAGE(PG8_SB(0, 1), b2 + hstepB, voffB); PG8_STAGE(PG8_SA(0, 0), a2, voffA);
            PG8_WAIT_V(8); PG8_WAIT_L(0); PG8_BAR; PG8_MMA(1, 0, At, B0); PG8_MMA(1, 1, At, B1); PG8_BAR; PG8_SCHED;
            PG8_LDB(B0, 1, 0); PG8_LDB(B1, 1, 1); PG8_SCHED; PG8_LDA(At, 1, 0); PG8_STAGE(PG8_SA(0, 1), a2 + hstepA, voffA);
            PG8_WAIT_V(8); PG8_WAIT_L(0); PG8_BAR; PG8_MMA(0, 0, At, B0); PG8_MMA(0, 1, At, B1); PG8_BAR; PG8_SCHED;
            PG8_LDA(At, 1, 1); PG8_STAGE(PG8_SB(1, 0), b3, voffB); PG8_STAGE(PG8_SB(1, 1), b3 + hstepB, voffB); PG8_STAGE(PG8_SA(1, 0), a3, voffA);
            PG8_WAIT_V(8); PG8_WAIT_L(0); PG8_BAR; PG8_MMA(1, 0, At, B0); PG8_MMA(1, 1, At, B1); PG8_BAR; PG8_SCHED;
        }
        if constexpr (ALIGN_EPI) { if (wr == 0) PG8_BAR; }
        E(acc, cur, wr, wc, fr, fq);
        if (!has_next) break;
        if constexpr (!Epi::KEEP) {
#pragma unroll
            for (int a = 0; a < 2; ++a)
#pragma unroll
                for (int b = 0; b < 2; ++b)
#pragma unroll
                    for (int m = 0; m < 4; ++m)
#pragma unroll
                        for (int n = 0; n < 2; ++n) acc[a][b][m][n] = (f32x4){0.f, 0.f, 0.f, 0.f};
        }
        cur = nxt; cA = nA; cB = nB; ++ui;
        if constexpr (ALIGN_EPI) { if (wr == 1) PG8_BAR; }
    }
    PG8_WAIT_V(0);
    if constexpr (!ALIGN_EPI) { if (wr == 0) PG8_BAR; }
    PG8_BAR;
#undef PG8_SA
#undef PG8_SB
#undef PG8_STAGE
#undef PG8_LDA
#undef PG8_LDB
#undef PG8_MMA
#undef PG8_WAIT_V
#undef PG8_WAIT_L
#undef PG8_BAR
#undef PG8_SCHED
}
}
namespace attn_body {
using bf16=__hip_bfloat16;
using bf16x8=__attribute__((ext_vector_type(8)))short;
using s16x4=__attribute__((ext_vector_type(4)))short;
using f32x16=__attribute__((ext_vector_type(16)))float;
using u32x4=__attribute__((ext_vector_type(4)))unsigned;
constexpr int D=64;
constexpr int QP=8448,KP=8448,VP=8448,OP=2048;
constexpr int NW=8,QBLK=32,QB=QBLK*NW,KVBLK=64;
__device__ __forceinline__ int crow(int r,int hi){return (r&3)+8*(r>>2)+4*hi;}
#define SBAR() __builtin_amdgcn_sched_barrier(0)
#define AGAS __attribute__((address_space(1)))
constexpr int NSLOT=3, SLOTB=8192;
constexpr int LDS_K=0, LDS_V=NSLOT*SLOTB, LDS_WS=2*NSLOT*SLOTB, LDS_OST=LDS_WS+NW*64*4, LDS_BIAS=LDS_OST+NW*4096, LDS_BYTES=LDS_BIAS+8192;
constexpr float C2=0.125f*1.4426950408889634f;
__device__ __forceinline__ void glds16(const AGAS void*gsrc,unsigned lds_dst){unsigned keep;
  asm volatile("s_mov_b32 %0, m0\n\ts_mov_b32 m0, %2\n\ts_nop 0\n\tglobal_load_lds_dwordx4 %1, off\n\ts_mov_b32 m0, %0":"=&s"(keep):"v"(gsrc),"s"(lds_dst):"memory");}
__device__ __forceinline__ float max3f(float a,float b,float c){float r;asm("v_max3_f32 %0, %1, %2, %3":"=v"(r):"v"(a),"v"(b),"v"(c));return r;}
__device__ __forceinline__ float max2f(float a,float b){float r;asm("v_max_f32_e32 %0, %1, %2":"=v"(r):"v"(a),"v"(b));return r;}
__device__ __forceinline__ float fadd_s(float a,float b){float r;asm("v_add_f32_e32 %0, %1, %2":"=v"(r):"v"(a),"v"(b));return r;}
__device__ __forceinline__ float fsub_s(float a,float b){float r;asm("v_sub_f32_e32 %0, %1, %2":"=v"(r):"v"(a),"v"(b));return r;}
typedef float f32x2_t __attribute__((ext_vector_type(2))); typedef __bf16 bf16x2_t __attribute__((ext_vector_type(2)));
__device__ __forceinline__ unsigned cvtpk_s(float lo,float hi){f32x2_t v={lo,hi};bf16x2_t b=__builtin_convertvector(v,bf16x2_t);return __builtin_bit_cast(unsigned,b);}
#define WAIT_BAR(N) asm volatile("s_waitcnt vmcnt(" #N ") lgkmcnt(0)\n\ts_barrier":::"memory")

__device__ __forceinline__ void qkt(f32x16&p0,f32x16&p1,const char*Kslot,const bf16x8*qr,const f32x16&negm,int r32,int hi){
  const char*kb=Kslot+hi*1024+r32*16;
  #pragma unroll
  for(int d0=0;d0<4;++d0){
    const bf16x8 b0=*reinterpret_cast<const bf16x8*>(kb+d0*2048);
    const bf16x8 b1=*reinterpret_cast<const bf16x8*>(kb+d0*2048+512);
    if(d0==0){p0=__builtin_amdgcn_mfma_f32_32x32x16_bf16(b0,qr[0],negm,0,0,0);p1=__builtin_amdgcn_mfma_f32_32x32x16_bf16(b1,qr[0],negm,0,0,0);}
    else{p0=__builtin_amdgcn_mfma_f32_32x32x16_bf16(b0,qr[d0],p0,0,0,0);p1=__builtin_amdgcn_mfma_f32_32x32x16_bf16(b1,qr[d0],p1,0,0,0);}}
}
typedef __attribute__((address_space(3))) const char* lds_cptr;
typedef __attribute__((address_space(3))) const float* lds_fptr;
typedef short v4i16_t __attribute__((ext_vector_type(4)));
__device__ __forceinline__ void kload8(bf16x8*kf,lds_cptr kp){
  kf[0]=*(const __attribute__((address_space(3))) bf16x8*)(kp);      kf[1]=*(const __attribute__((address_space(3))) bf16x8*)(kp+512);
  kf[2]=*(const __attribute__((address_space(3))) bf16x8*)(kp+2048); kf[3]=*(const __attribute__((address_space(3))) bf16x8*)(kp+2560);
  kf[4]=*(const __attribute__((address_space(3))) bf16x8*)(kp+4096); kf[5]=*(const __attribute__((address_space(3))) bf16x8*)(kp+4608);
  kf[6]=*(const __attribute__((address_space(3))) bf16x8*)(kp+6144); kf[7]=*(const __attribute__((address_space(3))) bf16x8*)(kp+6656);
}
__device__ __forceinline__ void kload2(bf16x8*kf,lds_cptr kp,int j){ kf[2*j]=*(const __attribute__((address_space(3))) bf16x8*)(kp+j*2048); kf[2*j+1]=*(const __attribute__((address_space(3))) bf16x8*)(kp+j*2048+512); }
__device__ __forceinline__ s16x4 vtr(lds_cptr p){ return __builtin_bit_cast(s16x4,__builtin_amdgcn_ds_read_tr16_b64_v4i16((__attribute__((address_space(3))) v4i16_t*)p)); }
__device__ __forceinline__ float rowmax(const f32x16&p0,const f32x16&p1){
  float a=max3f(p0[0],p0[1],p1[0]),b=max3f(p0[2],p0[3],p1[1]);a=max3f(a,p1[2],p1[3]);
  #pragma unroll
  for(int r=4;r<16;r+=4){a=max3f(a,p0[r],p0[r+1]);b=max3f(b,p0[r+2],p0[r+3]);a=max3f(a,p1[r],p1[r+1]);b=max3f(b,p1[r+2],p1[r+3]);}
  const float m=max2f(a,b);
  auto rr=__builtin_amdgcn_permlane32_swap(__float_as_uint(m),__float_as_uint(m),false,false);
  return max2f(__uint_as_float(rr[0]),__uint_as_float(rr[1]));
}
__device__ __forceinline__ void pv(f32x16*o,int vb,bf16x8 pa0,bf16x8 pa1,bf16x8 pa2,bf16x8 pa3){
  #pragma unroll
  for(int d0=0;d0<2;++d0){s16x4 lo[4],hi[4];
    #pragma unroll
    for(int ks=0;ks<4;++ks){
      asm volatile("ds_read_b64_tr_b16 %0,%1 offset:%c2":"=&v"(lo[ks]):"v"(vb),"i"(d0*4096+ks*1024):"memory");
      asm volatile("ds_read_b64_tr_b16 %0,%1 offset:%c2":"=&v"(hi[ks]):"v"(vb),"i"(d0*4096+ks*1024+512):"memory");}
    asm volatile("s_waitcnt lgkmcnt(0)":::"memory");SBAR();
    #define PK(k) (bf16x8){lo[k][0],lo[k][1],lo[k][2],lo[k][3],hi[k][0],hi[k][1],hi[k][2],hi[k][3]}
    o[d0]=__builtin_amdgcn_mfma_f32_32x32x16_bf16(pa0,PK(0),o[d0],0,0,0);
    o[d0]=__builtin_amdgcn_mfma_f32_32x32x16_bf16(pa1,PK(1),o[d0],0,0,0);
    o[d0]=__builtin_amdgcn_mfma_f32_32x32x16_bf16(pa2,PK(2),o[d0],0,0,0);
    o[d0]=__builtin_amdgcn_mfma_f32_32x32x16_bf16(pa3,PK(3),o[d0],0,0,0);
    #undef PK
  }
}
__device__ __forceinline__ void namask(f32x16&p0,f32x16&p1,int kr,int qr,unsigned wlo,unsigned whi,lds_fptr brow0,float mh){
  const float BIG=1e30f;
  int r0=qr-4; r0=r0<0?0:(r0>56?56:r0);
  if(kr<r0||kr>=r0+8){
    #pragma unroll
    for(int r=0;r<16;++r){p0[r]=-BIG;p1[r]=-BIG;}
    return; }
  const lds_fptr brow=brow0+(kr-qr+7)*128;
  asm volatile("":"+v"(wlo),"+v"(whi));
  #pragma unroll
  for(int r=0;r<16;++r){
    const int pos=(r&3)+8*(r>>2);
    const float b0=brow[pos]-mh, b1=brow[pos+32]-mh;
    const float f0=(float)((wlo>>pos)&1u), f1=(float)((whi>>pos)&1u);
    p0[r]=(p0[r]+b0)+__builtin_fmaf(f0,BIG,-BIG); p1[r]=(p1[r]+b1)+__builtin_fmaf(f1,BIG,-BIG);
    if((r&3)==3) __builtin_amdgcn_sched_barrier(0); }
}
struct AttnArgs { const AGAS bf16* Q; const AGAS bf16* K; const AGAS bf16* V; AGAS bf16* O; int kr0, kr1, tsw, NT; int qrow0, rb0; const AGAS float* rpb; };
#define ATTN_STORE16(p,v) (*(AGAS u32x4*)(p)=(v))
template<int THRL,bool MASKED> __device__ __forceinline__ void attn_unit(const AttnArgs&a,char*shm,int tid){
  const int lane=tid&63,r32=lane&31,hi=lane>>5; const int wid=__builtin_amdgcn_readfirstlane(tid>>6);
  const AGAS bf16*Qw=a.Q+(long)(wid*QBLK)*QP;
  const AGAS bf16*Kh=a.K,*Vh=a.V;
  const unsigned lds0=(unsigned)(uintptr_t)shm;
  float*wsf=(float*)(shm+LDS_WS)+wid*64;
  const AGAS bf16*ksrc=Kh+(long)lane*KP+wid*8;
  const AGAS bf16*vsrc=Vh+(long)(16*(wid&3)+(lane>>2))*VP+(wid>>2)*32+(lane&3)*8;
  const unsigned kdst=lds0+LDS_K+wid*1024, vdst=lds0+LDS_V+wid*1024;
  const int kr0=a.kr0,kr1=a.kr1,tsw=a.tsw;
  #define KROW(t) ((t)<tsw?kr0+64*(t):kr1+64*((t)-tsw))
  #define DMA_K(t,slot) glds16(ksrc+(long)KROW(t)*KP,(unsigned)__builtin_amdgcn_readfirstlane(kdst+(slot)))
  #define DMA_V(t,slot) glds16(vsrc+(long)KROW(t)*VP,(unsigned)__builtin_amdgcn_readfirstlane(vdst+(slot)))
  const int vb0=(int)(lds0+LDS_V)+((lane>>4)&1)*32+(lane&3)*8+(4*hi+((lane&15)>>2))*64;
  const char*Kbase=shm+LDS_K; bf16x8 kf[8];
  const lds_cptr shm3=(lds_cptr)shm; const lds_cptr kp0=shm3+LDS_K+hi*1024+r32*16; const lds_cptr vp0=shm3+LDS_V+((lane>>4)&1)*32+(lane&3)*8+(4*hi+((lane&15)>>2))*64;
  const lds_fptr biasl=(lds_fptr)(shm3+LDS_BIAS);
  const int NT=a.NT;
  if constexpr(MASKED){ __attribute__((address_space(3))) float* bt=(__attribute__((address_space(3))) float*)(shm3+LDS_BIAS);
    for(int i_=tid;i_<15*128;i_+=512){ const int ri=i_>>7, dc=(i_&127)-48; bt[i_]=(dc>=0&&dc<31)?a.rpb[ri*31+dc]*1.4426950408889634f:0.f; } }
  const int qgr=a.qrow0+(wid>>1), qgc=(wid&1)*32+r32, rb0=a.rb0;
  unsigned wlo=0u,whi=0u; lds_fptr brow0=biasl;
  if constexpr(MASKED){ int cs=qgc-8; cs=cs<0?0:(cs>48?48:cs); const unsigned long long cm=(0xFFFFull<<cs)>>(4*hi); wlo=(unsigned)cm; whi=(unsigned)(cm>>32); brow0=biasl+(4*hi-qgc+63); }
  DMA_K(0,0);DMA_V(0,0);DMA_K(1,SLOTB);
  bf16x8 qr[4];
  #pragma unroll
  for(int d0=0;d0<4;++d0)qr[d0]=*(const AGAS bf16x8*)(&Qw[(long)r32*QP+d0*16+hi*8]);
  float zf_=0.f; asm volatile("":"+v"(zf_)); float mhat=zf_,l_reg=zf_;f32x16 o[2],negm; _Pragma("unroll") for(int r=0;r<16;++r){o[0][r]=zf_;o[1][r]=zf_;negm[r]=zf_;} if constexpr(!MASKED){asm volatile("":"+v"(negm));} const f32x16 zc=f32x16{};
  #define CMASK(P0,P1,t) do{ if constexpr(MASKED){ if((t)>=4) namask(P0,P1,rb0+(t)-4,qgr,wlo,whi,brow0,mhat); else { _Pragma("unroll") for(int r_=0;r_<16;++r_){P0[r_]-=mhat;P1[r_]-=mhat;} } } }while(0)
  bool resc=false;
  #define START(P0,P1) do{ const float rm=rowmax(P0,P1); resc=false; \
    { const float dl=rm; mhat=fadd_s(mhat,dl); \
      _Pragma("unroll") for(int r=0;r<16;++r){P0[r]=fsub_s(P0[r],dl);P1[r]=fsub_s(P1[r],dl);} \
      if constexpr(!MASKED){ _Pragma("unroll") for(int r=0;r<16;++r)negm[r]=-mhat; asm volatile("":"+v"(negm)); } } \
    _Pragma("unroll") for(int r=0;r<16;++r)P0[r]=__builtin_amdgcn_exp2f(P0[r]); }while(0)
  #define RESC() do{ if(resc){ asm volatile("s_waitcnt lgkmcnt(0)":::"memory"); \
      _Pragma("unroll") for(int d_=0;d_<2;++d_) _Pragma("unroll") for(int r=0;r<16;++r)o[d_][r]*=wsf[crow(r,hi)]; } }while(0)
  f32x16 pA0,pA1,pB0,pB1;
  int sl_prev=0,sl_cur=0,sl_next=SLOTB;
  #define ROT() do{sl_prev=sl_cur;sl_cur=sl_next;sl_next=(sl_next==(NSLOT-1)*SLOTB)?0:sl_next+SLOTB;}while(0)
  DMA_K(2,2*SLOTB);
  WAIT_BAR(3);
  qkt(pA0,pA1,Kbase,qr,zc,r32,hi);asm volatile("s_nop 15\n\ts_nop 7":"+v"(pA0),"+v"(pA1));
  START(pA0,pA1);
  _Pragma("unroll") for(int r=0;r<16;++r)pA1[r]=__builtin_amdgcn_exp2f(pA1[r]);
  WAIT_BAR(0);
  DMA_K(3,0);DMA_V(1,SLOTB);
  ROT();
  kload8(kf,kp0+sl_cur);
  WAIT_BAR(2);
  s16x4 vlo[8],vhi[8]; u32x4 pw0,pw1,pw2,pw3;
  #define PKW(P,B) cvtpk_s(P[B],P[B+1])
  #define PAF(k) __builtin_bit_cast(bf16x8,pw##k)
  #define VFR(i) (bf16x8){vlo[i][0],vlo[i][1],vlo[i][2],vlo[i][3],vhi[i][0],vhi[i][1],vhi[i][2],vhi[i][3]}
  #define PIN(x) asm volatile("":"+v"(x))
  #define MX3(a,b,c) __builtin_fmaxf(__builtin_fmaxf((a),(b)),(c))
  #define GAPA(MF,A0,A1,A2,A3,W0,W1,PW) do{ MF; sacc+=A0; sacc+=A1; sacc+=A2; sacc+=A3; PIN(sacc); W0; W1; PIN(PW); SBAR(); }while(0)
  #define EX(v) __builtin_amdgcn_exp2f(v)
  #define GAPB(MF,X,B) do{ MF; X[B]=EX(X[B]); X[B+1]=EX(X[B+1]); X[B+2]=EX(X[B+2]); X[B+3]=EX(X[B+3]); PIN(X); SBAR(); }while(0)
  #define VRD(i) do{ vlo[i]=vtr(vp_+(((i)>>2)*4096+((i)&3)*1024)); vhi[i]=vtr(vp_+(((i)>>2)*4096+((i)&3)*1024+512)); }while(0)
  #define KRD(G,j) do{ if(G){ kload2(kf,kp0+sl_next,j); SBAR(); } }while(0)
  #define STEP(C0,C1,P0,P1,t,GK,GV,GL) do{ SBAR(); \
    const lds_cptr vp_=vp0+sl_prev; \
    VRD(0); SBAR(); float sacc=(P0[0]+P0[1]); \
    GAPA(C0=__builtin_amdgcn_mfma_f32_32x32x16_bf16(kf[0],qr[0],(MASKED?zc:negm),0,0,0), P0[2],P0[3],P0[4],P0[5],     pw0[0]=PKW(P0,0), pw0[1]=PKW(P0,2), pw0); \
    VRD(4); SBAR(); GAPA(C1=__builtin_amdgcn_mfma_f32_32x32x16_bf16(kf[1],qr[0],(MASKED?zc:negm),0,0,0), P0[6],P0[7],P0[8],P0[9],     pw0[2]=PKW(P0,4), pw0[3]=PKW(P0,6), pw0); \
    VRD(1); SBAR(); GAPA(C0=__builtin_amdgcn_mfma_f32_32x32x16_bf16(kf[2],qr[1],C0,0,0,0),   P0[10],P0[11],P0[12],P0[13], pw1[0]=PKW(P0,8), pw1[1]=PKW(P0,10), pw1); \
    VRD(5); SBAR(); GAPA(C1=__builtin_amdgcn_mfma_f32_32x32x16_bf16(kf[3],qr[1],C1,0,0,0),   P0[14],P0[15],P1[0],P1[1],   pw1[2]=PKW(P0,12),pw1[3]=PKW(P0,14), pw1); \
    VRD(2); SBAR(); GAPA(C0=__builtin_amdgcn_mfma_f32_32x32x16_bf16(kf[4],qr[2],C0,0,0,0),   P1[2],P1[3],P1[4],P1[5],     pw2[0]=PKW(P1,0), pw2[1]=PKW(P1,2), pw2); \
    VRD(6); SBAR(); GAPA(C1=__builtin_amdgcn_mfma_f32_32x32x16_bf16(kf[5],qr[2],C1,0,0,0),   P1[6],P1[7],P1[8],P1[9],     pw2[2]=PKW(P1,4), pw2[3]=PKW(P1,6), pw2); \
    VRD(3); SBAR(); GAPA(C0=__builtin_amdgcn_mfma_f32_32x32x16_bf16(kf[6],qr[3],C0,0,0,0),   P1[10],P1[11],P1[12],P1[13], pw3[0]=PKW(P1,8), pw3[1]=PKW(P1,10), pw3); \
    VRD(7); SBAR(); GAPA(C1=__builtin_amdgcn_mfma_f32_32x32x16_bf16(kf[7],qr[3],C1,0,0,0),   P1[14],P1[15],0.f,0.f,       pw3[2]=PKW(P1,12),pw3[3]=PKW(P1,14), pw3); \
    l_reg+=sacc; \
    if(GK){DMA_K((t)+3,sl_cur);} if(GV){DMA_V((t)+1,sl_next);} \
    CMASK(C0,C1,t); \
    { float a_=MX3(C0[0],C0[1],C1[0]),b_=MX3(C0[2],C0[3],C1[1]); a_=MX3(a_,C1[2],C1[3]); \
      _Pragma("unroll") for(int r=4;r<16;r+=4){a_=MX3(a_,C0[r],C0[r+1]);b_=MX3(b_,C0[r+2],C0[r+3]);a_=MX3(a_,C1[r],C1[r+1]);b_=MX3(b_,C1[r+2],C1[r+3]);} \
      float rm=__builtin_fmaxf(a_,b_); { auto rr=__builtin_amdgcn_permlane32_swap(__float_as_uint(rm),__float_as_uint(rm),false,false); rm=__builtin_fmaxf(__uint_as_float(rr[0]),__uint_as_float(rr[1])); } \
      resc=false; \
      if(__builtin_expect(__any(rm>(float)THRL),0)){ const float dl=__builtin_fmaxf(rm,0.f); mhat+=dl; \
        _Pragma("unroll") for(int r=0;r<16;++r){C0[r]-=dl;C1[r]-=dl;} \
        if constexpr(!MASKED){ _Pragma("unroll") for(int r=0;r<16;++r)negm[r]=-mhat; asm volatile("":"+v"(negm)); } \
        const float f=__builtin_amdgcn_exp2f(-dl); l_reg*=f; if(hi==0)wsf[r32]=f; resc=true; } } \
    SBAR(); \
    GAPB(o[0]=__builtin_amdgcn_mfma_f32_32x32x16_bf16(PAF(0),VFR(0),o[0],0,0,0), C0,0); \
    GAPB(o[1]=__builtin_amdgcn_mfma_f32_32x32x16_bf16(PAF(0),VFR(4),o[1],0,0,0), C0,4); \
    KRD(GL,0); GAPB(o[0]=__builtin_amdgcn_mfma_f32_32x32x16_bf16(PAF(1),VFR(1),o[0],0,0,0), C0,8); \
    KRD(GL,1); GAPB(o[1]=__builtin_amdgcn_mfma_f32_32x32x16_bf16(PAF(1),VFR(5),o[1],0,0,0), C0,12); \
    KRD(GL,2); GAPB(o[0]=__builtin_amdgcn_mfma_f32_32x32x16_bf16(PAF(2),VFR(2),o[0],0,0,0), C1,0); \
    KRD(GL,3); GAPB(o[1]=__builtin_amdgcn_mfma_f32_32x32x16_bf16(PAF(2),VFR(6),o[1],0,0,0), C1,4); \
    GAPB(o[0]=__builtin_amdgcn_mfma_f32_32x32x16_bf16(PAF(3),VFR(3),o[0],0,0,0), C1,8); \
    GAPB(o[1]=__builtin_amdgcn_mfma_f32_32x32x16_bf16(PAF(3),VFR(7),o[1],0,0,0), C1,12); \
    }while(0)
  int t=1;
  for(;t+5<NT;t+=2){
    STEP(pB0,pB1,pA0,pA1,t,true,true,true);     WAIT_BAR(2); RESC(); ROT();
    STEP(pA0,pA1,pB0,pB1,t+1,true,true,true);   WAIT_BAR(2); RESC(); ROT();
  }
  #define ENDW(tt) do{ if((tt)+3<NT){WAIT_BAR(2);} else if((tt)+2<NT){WAIT_BAR(1);} else {WAIT_BAR(0);} }while(0)
  for(;t+1<NT;t+=2){
    STEP(pB0,pB1,pA0,pA1,t,(t+3<NT),(t+1<NT),(t+1<NT));       ENDW(t);   RESC(); ROT();
    STEP(pA0,pA1,pB0,pB1,t+1,(t+4<NT),(t+2<NT),(t+2<NT));     ENDW(t+1); RESC(); ROT();
  }
  STEP(pB0,pB1,pA0,pA1,NT-1,false,false,false); RESC();
  { float sacc=pB0[0]+pB0[1]; _Pragma("unroll") for(int r=2;r<16;++r)sacc+=pB0[r]; _Pragma("unroll") for(int r=0;r<16;++r)sacc+=pB1[r]; l_reg+=sacc;
    pw0=(u32x4){PKW(pB0,0),PKW(pB0,2),PKW(pB0,4),PKW(pB0,6)};pw1=(u32x4){PKW(pB0,8),PKW(pB0,10),PKW(pB0,12),PKW(pB0,14)};pw2=(u32x4){PKW(pB1,0),PKW(pB1,2),PKW(pB1,4),PKW(pB1,6)};pw3=(u32x4){PKW(pB1,8),PKW(pB1,10),PKW(pB1,12),PKW(pB1,14)};
    SBAR(); pv(o,vb0+sl_cur,PAF(0),PAF(1),PAF(2),PAF(3)); }
  #undef PKW
  #undef PAF
  #undef VFR
  #undef PIN
  #undef MX3
  #undef GAPA
  #undef GAPB
  #undef EX
  #undef VRD
  #undef KRD
  #undef STEP
  #undef ENDW
  {auto rr=__builtin_amdgcn_permlane32_swap(__float_as_uint(l_reg),__float_as_uint(l_reg),false,false);l_reg=__uint_as_float(rr[0])+__uint_as_float(rr[1]);}
  if(hi==0)wsf[32+r32]=l_reg;asm volatile("s_waitcnt lgkmcnt(0)":::"memory");
  float rli[16];
  #pragma unroll
  for(int r=0;r<16;++r)rli[r]=__builtin_amdgcn_rcpf(wsf[32+crow(r,hi)]);
  AGAS bf16*Ow=a.O+(long)(wid*QBLK)*OP;
  { bf16*stg=(bf16*)(shm+LDS_OST)+wid*2048;
    #pragma unroll
    for(int r=0;r<16;++r){const int orow=crow(r,hi);
      #pragma unroll
      for(int d0=0;d0<2;++d0)stg[orow*64+d0*32+r32]=__float2bfloat16(o[d0][r]*rli[r]);}
    asm volatile("s_waitcnt lgkmcnt(0)":::"memory");
    #pragma unroll
    for(int i=0;i<4;++i){const int row=i*8+(lane>>3),ch=lane&7; const u32x4 v=*(const u32x4*)(stg+row*64+ch*8); ATTN_STORE16(Ow+(long)row*OP+ch*8,v);} }
  asm volatile("s_waitcnt lgkmcnt(0)\n\ts_barrier":::"memory");
  #undef KROW
  #undef DMA_K
  #undef DMA_V
  #undef CMASK
  #undef START
  #undef RESC
  #undef ROT
}
#undef SBAR
#undef WAIT_BAR
}
constexpr int NWAVES = 8, NTHR = 512;
constexpr int DM = 1024, NBATCH = 4, SEQ = 4096, CTXL = 256, RPB = SEQ + CTXL  , MROWS = NBATCH * RPB  , NLAYER = 2;
constexpr int PW = 8448;
constexpr int C_GQ = 0, C_GK = 512, C_GV = 640, C_NQ = 768, C_NK = 1280, C_NV = 1792, C_F = 2304, C_CA = 3328, C_CB = 3840, C_G = 4352;
constexpr int YW = 2048;
constexpr int INW = 7936;
constexpr int NEXP = 16, EFF = 512, MOE_ROWS = 38912  ;
constexpr float EPS = 1e-6f, LOG2E = 1.4426950408889634f;
constexpr float QSCALE = 0.125f * LOG2E;
constexpr size_t MiB = 1u << 20;
constexpr size_t WS_CTL = 0, CTL_ZERO_BYTES = 1 * MiB;
constexpr size_t WS_MODV = 1 * MiB;
constexpr size_t WS_TOKE = 2 * MiB, WS_TOKW = WS_TOKE + 160 * 1024, WS_TOKR = WS_TOKW + 160 * 1024, WS_TOKS = WS_TOKR + 160 * 1024;
constexpr size_t WS_XC = 4 * MiB;
constexpr size_t WS_WIN = 8 * MiB;
constexpr size_t WS_WB = 25 * MiB;
constexpr size_t WS_WO = 29 * MiB;
constexpr size_t WS_WGU = 32 * MiB;
constexpr size_t WS_WD = 64 * MiB;
constexpr size_t WS_H = 80 * MiB;
constexpr size_t WS_Y = 114 * MiB;
constexpr size_t WS_TP = 182 * MiB;
constexpr size_t WS_P = 214 * MiB;
constexpr size_t WS_AM = WS_P, WS_HM = WS_P + 76 * MiB, WS_OM = WS_P + 114 * MiB;
constexpr size_t WS_END = 495 * MiB;
static_assert(WS_WIN + (size_t)PW * DM * 2 <= WS_WB && WS_P + (size_t)MROWS * PW * 2 <= WS_END && WS_OM + (size_t)MOE_ROWS * DM * 2 <= WS_END, "ws map");
constexpr int CW_BAR = 4096;
constexpr int CW_CNT = 16384;
constexpr int RING_OFF = 0, RING_BYTES = 131072;
constexpr int LDSCTL_OFF = RING_BYTES, MISC_OFF = LDSCTL_OFF + 320;
constexpr int LDS_BYTES = 147456;

#define GAS __attribute__((address_space(1)))
#define LAS __attribute__((address_space(3)))
typedef unsigned short bf16;
typedef unsigned v4u __attribute__((ext_vector_type(4)));
typedef unsigned v2u __attribute__((ext_vector_type(2)));
typedef float f32x4 __attribute__((ext_vector_type(4)));
typedef GAS unsigned gu32;
#define RLX_AGENT __ATOMIC_RELAXED, __HIP_MEMORY_SCOPE_AGENT
#define LDS_WAIT() asm volatile("s_waitcnt lgkmcnt(0)" ::: "memory")
__device__ __forceinline__ unsigned f2bf(float f) { unsigned u = __builtin_bit_cast(unsigned, f); return (u + 0x7fffu + ((u >> 16) & 1u)) >> 16; }
__device__ __forceinline__ unsigned pk2(float lo, float hi) { return f2bf(lo) | (f2bf(hi) << 16); }
__device__ __forceinline__ float bf_lo(unsigned w) { return __uint_as_float(w << 16); }
__device__ __forceinline__ float bf_hi(unsigned w) { return __uint_as_float(w & 0xffff0000u); }
__device__ __forceinline__ float bf1(bf16 v) { return __uint_as_float(((unsigned)v) << 16); }
__device__ __forceinline__ float sigm(float x) { return 1.0f / (1.0f + __expf(-x)); }

#define XB_TMO      128
#define XB_XCNT(j)  (256  + 64 * (j))
#define XB_XSUB(j)  (1280 + 64 * (j))
#define XB_XGEN(j)  (2304 + 64 * (j))
#define XB_TOP      3328
#define XB_TOPGEN   3392
#define XCD_BAR_WORDS 3456
#define XB_SPIN_CAP (1u << 18)
__device__ __forceinline__ unsigned xb_ld(unsigned* p)              { return __hip_atomic_load(p, __ATOMIC_RELAXED, __HIP_MEMORY_SCOPE_AGENT); }
__device__ __forceinline__ unsigned xb_add(unsigned* p, unsigned v) { return __hip_atomic_fetch_add(p, v, __ATOMIC_RELAXED, __HIP_MEMORY_SCOPE_AGENT); }
__device__ __forceinline__ unsigned xb_xcc_id() { return (unsigned)__builtin_amdgcn_s_getreg((3 << 11) | 20) & 0xFu; }
#define XB_SPIN(cond, bar) do { unsigned _sp = 0; while (cond) { __builtin_amdgcn_s_sleep(1); \
    if ((++_sp & 255u) == 0u) { if (xb_ld(&(bar)[XB_TMO])) break; if (_sp > XB_SPIN_CAP) { atomicAdd(&(bar)[XB_TMO], 1u); break; } } } } while (0)
struct XcdBarrier { unsigned* bar; unsigned x; volatile LAS unsigned* st; };
__device__ __forceinline__ XcdBarrier xcd_barrier_post(unsigned* bar, volatile LAS unsigned* st) {
    XcdBarrier b; b.bar = bar; b.x = xb_xcc_id(); b.st = st;
    if (threadIdx.x == 0) (void)xb_add(&bar[XB_XCNT(b.x)], 1u);
    return b;
}
__device__ __forceinline__ void xcd_barrier_complete(unsigned* bar, unsigned x, unsigned& nloc, unsigned& nx) {
    const unsigned G = gridDim.x * gridDim.y * gridDim.z;
    unsigned sum, cnt, mine, sp = 0u;
    for (;;) {
        sum = 0u; cnt = 0u; mine = 0u;
#pragma unroll
        for (unsigned j = 0; j < 16; ++j) { const unsigned c = xb_ld(&bar[XB_XCNT(j)]); sum += c; cnt += (c > 0u) ? 1u : 0u; mine = (j == x) ? c : mine; }
        if (sum == G) break;
        __builtin_amdgcn_s_sleep(1);
        if ((++sp & 255u) == 0u) { if (xb_ld(&bar[XB_TMO])) break; if (sp > XB_SPIN_CAP) { atomicAdd(&bar[XB_TMO], 1u); break; } }
    }
    nloc = mine > 0u ? mine : 1u; nx = cnt > 0u ? cnt : 1u;
}
__device__ __forceinline__ void xcd_barrier(const XcdBarrier& b) {
    asm volatile("s_waitcnt vmcnt(0)" ::: "memory");
    __syncthreads();
    if (threadIdx.x == 0) {
        unsigned* bar = b.bar;
        __builtin_amdgcn_s_waitcnt(0);
        unsigned nloc = b.st[0], nx = b.st[1];
        if (nloc == 0u) { xcd_barrier_complete(bar, b.x, nloc, nx); b.st[0] = nloc; b.st[1] = nx; }
        const unsigned old = xb_add(&bar[XB_XSUB(b.x)], 1u);
        const unsigned gen = old / nloc;
        if (old + 1u == (gen + 1u) * nloc) {
            __builtin_amdgcn_fence(__ATOMIC_RELEASE, "agent");
            asm volatile("s_waitcnt vmcnt(0)" ::: "memory");
            const unsigned og = xb_add(&bar[XB_TOP], 1u);
            const unsigned tg = og / nx;
            if (og + 1u == (tg + 1u) * nx) xb_add(&bar[XB_TOPGEN], 1u);
            else XB_SPIN(xb_ld(&bar[XB_TOPGEN]) == tg, bar);
            __builtin_amdgcn_fence(__ATOMIC_ACQUIRE, "agent");
            xb_add(&bar[XB_XGEN(b.x)], 1u);
            asm volatile("s_waitcnt vmcnt(0)" ::: "memory");
        } else {
            XB_SPIN(xb_ld(&bar[XB_XGEN(b.x)]) == gen, bar);
            __builtin_amdgcn_fence(__ATOMIC_ACQUIRE, "agent");
            asm volatile("s_waitcnt vmcnt(0)" ::: "memory");
        }
    }
    __syncthreads();
}

struct Frame {
    LAS unsigned char* lds; volatile LAS unsigned* MISC; LAS unsigned* LCTL;
    gu32* ctl; unsigned char* ws; GAS float* out; int tid, lane, wave, vcu, G;
};
constexpr int PTR_OFF = LDSCTL_OFF + 96;
__device__ __forceinline__ const GAS float* INP(const Frame& F, int i) {
    const LAS unsigned* t = (const LAS unsigned*)(F.lds + PTR_OFF) + 2 * i;
    const unsigned lo = __builtin_amdgcn_readfirstlane(t[0]), hi = __builtin_amdgcn_readfirstlane(t[1]);
    return (const GAS float*)(((unsigned long long)hi << 32) | lo);
}
__device__ __forceinline__ float shx(float v, int m, int lane) { return __builtin_bit_cast(float, __builtin_amdgcn_ds_bpermute((lane ^ m) << 2, __builtin_bit_cast(int, v))); }
__device__ __forceinline__ float wave_sum(float v, int lane) {
#pragma unroll
    for (int o = 1; o < 64; o <<= 1) v += shx(v, o, lane);
    return v;
}
__device__ __forceinline__ const GAS float* xrow_in(const Frame& F, int row) { const int b = row / RPB, t = row % RPB; return t < SEQ ? INP(F, 0) + ((size_t)b * SEQ + t) * DM : INP(F, 2) + ((size_t)b * CTXL + (t - SEQ)) * DM; }
__device__ __forceinline__ GAS float* xrow_ws(const Frame& F, int row) { const int b = row / RPB, t = row % RPB; return t < SEQ ? F.out + ((size_t)b * SEQ + t) * DM : ((GAS float*)(F.ws + WS_XC)) + ((size_t)b * CTXL + (t - SEQ)) * DM; }
__device__ __forceinline__ int modidx(int row) { const int b = row / RPB, t = row % RPB; return t < SEQ ? b : 4; }

__device__ __forceinline__ void tr_item(const GAS float* W, int ldw, int k0, int n0, GAS bf16* WT, int ldt, int drow0, int dcol0, LAS float* scr, int lane) {
#pragma unroll 8
    for (int i = 0; i < 32; ++i) { const int kk = 2 * i + (lane >> 5); scr[kk * 33 + (lane & 31)] = W[(size_t)(k0 + kk) * ldw + n0 + (lane & 31)]; }
    LDS_WAIT(); asm volatile("" ::: "memory");
    const int c = lane & 7;
#pragma unroll
    for (int j = 0; j < 4; ++j) { const int n = (lane >> 3) + 8 * j; const LAS float* s = scr + (8 * c) * 33 + n;
        v4u o; o.x = pk2(s[0 * 33], s[1 * 33]); o.y = pk2(s[2 * 33], s[3 * 33]); o.z = pk2(s[4 * 33], s[5 * 33]); o.w = pk2(s[6 * 33], s[7 * 33]);
        *(GAS v4u*)(WT + (size_t)(drow0 + n) * ldt + dcol0 + 8 * c) = o; }
    LDS_WAIT(); asm volatile("" ::: "memory");
}
__device__ __forceinline__ void convert_weights(Frame& F, int l) {
    LAS float* scr = (LAS float*)(F.lds + RING_OFF + F.wave * 16384);
    const int gw = F.vcu * NWAVES + F.wave, NGW = F.G * NWAVES;
    constexpr int I_IN = 16 * (INW / 32), I_BR = 4 * 8 * 32, I_O = 16 * 32, I_GU = 16 * 16 * 32, I_D = 16 * 8 * 32;
    constexpr int NITEMS = I_IN + I_BR + I_O + I_GU + I_D;
    for (int it = gw; it < NITEMS; it += NGW) {
        int r = it;
        if (r < I_IN) { const int nblk = INW / 32, kb = r / nblk, nb = r % nblk, n0 = 32 * nb;
            if (n0 >= 2304 && n0 < 2816) continue;
            const int drow = n0 < 2304 ? n0 : n0 + 512;
            tr_item(INP(F, 8) + (size_t)l * DM * INW, INW, 64 * kb, n0, ((GAS bf16*)(F.ws + WS_WIN)), DM, drow, 64 * kb, scr, F.lane); continue; } r -= I_IN;
        if (r < I_BR) { const int nbr = r / 256, q = r % 256, kb = q / 32, nb = q % 32;
            tr_item(INP(F, 15) + ((size_t)l * 4 + nbr) * 512 * DM, DM, 64 * kb, 32 * nb, ((GAS bf16*)(F.ws + WS_WB)), 2048, 32 * nb, nbr * 512 + 64 * kb, scr, F.lane); continue; } r -= I_BR;
        if (r < I_O) { const int kb = r / 32, nb = r % 32;
            tr_item(INP(F, 16) + (size_t)l * DM * DM, DM, 64 * kb, 32 * nb, ((GAS bf16*)(F.ws + WS_WO)), DM, 32 * nb, 64 * kb, scr, F.lane); continue; } r -= I_O;
        if (r < I_GU) { const int e = r / 512, q = r % 512, kb = q / 32, nb = q % 32, n0 = 32 * nb;
            const int drow = n0 < 512 ? (n0 / 128) * 256 + (n0 % 128) : ((n0 - 512) / 128) * 256 + 128 + ((n0 - 512) % 128);
            tr_item(INP(F, 19) + ((size_t)l * NEXP + e) * DM * DM, DM, 64 * kb, n0, ((GAS bf16*)(F.ws + WS_WGU)) + (size_t)e * DM * DM, DM, drow, 64 * kb, scr, F.lane); continue; } r -= I_GU;
        { const int e = r / 256, q = r % 256, kb = q / 32, nb = q % 32;
            tr_item(INP(F, 20) + ((size_t)l * NEXP + e) * EFF * DM, DM, 64 * kb, 32 * nb, ((GAS bf16*)(F.ws + WS_WD)) + (size_t)e * DM * EFF, EFF, 32 * nb, 64 * kb, scr, F.lane); }
    }
    __syncthreads();
    LAS float* wt = (LAS float*)(F.lds + RING_OFF);
    LAS float* tab = (LAS float*)(F.lds + RING_OFF + 32768);
    if (F.tid < 128) { float s, c; sincospif((float)F.tid * (1.0f / 64.0f), &s, &c); tab[2 * F.tid] = c; tab[2 * F.tid + 1] = s; }
    for (int u = F.vcu; u < 64; u += F.G) {
        const int kt = u >> 2, g = u & 3;
        __syncthreads();
#pragma unroll
        for (int i = 0; i < 16; ++i) { const int idx = i * 512 + F.tid, kk = idx >> 7, c = idx & 127; wt[idx] = INP(F, 8)[(size_t)l * DM * INW + (size_t)(kt * 64 + kk) * INW + 2304 + g * 128 + c]; }
        __syncthreads();
        const int kc = F.tid & 127, kq = F.tid >> 7;
        float aA[16], aB[16];
#pragma unroll
        for (int i = 0; i < 16; ++i) { aA[i] = 0.f; aB[i] = 0.f; }
        for (int c = 0; c < 128; ++c) { const int ti = (c * kc) & 127; const float cs = tab[2 * ti], sn = tab[2 * ti + 1];
#pragma unroll
            for (int i = 0; i < 16; ++i) { const float w = wt[(kq * 16 + i) * 128 + c]; aA[i] += w * cs; aB[i] += w * sn; } }
        GAS bf16* ra = ((GAS bf16*)(F.ws + WS_WIN)) + (size_t)(2304 + g * 128 + kc) * DM + kt * 64 + kq * 16; GAS bf16* rb = ra + (size_t)512 * DM;
        v4u o; o.x = pk2(aA[0], aA[1]); o.y = pk2(aA[2], aA[3]); o.z = pk2(aA[4], aA[5]); o.w = pk2(aA[6], aA[7]); *(GAS v4u*)ra = o;
        o.x = pk2(aA[8], aA[9]); o.y = pk2(aA[10], aA[11]); o.z = pk2(aA[12], aA[13]); o.w = pk2(aA[14], aA[15]); *(GAS v4u*)(ra + 8) = o;
        o.x = pk2(aB[0], aB[1]); o.y = pk2(aB[2], aB[3]); o.z = pk2(aB[4], aB[5]); o.w = pk2(aB[6], aB[7]); *(GAS v4u*)rb = o;
        o.x = pk2(aB[8], aB[9]); o.y = pk2(aB[10], aB[11]); o.z = pk2(aB[12], aB[13]); o.w = pk2(aB[14], aB[15]); *(GAS v4u*)(rb + 8) = o;
    }
    __syncthreads();
}
__device__ __forceinline__ void mod_vectors(Frame& F) {
    LAS float* sc = (LAS float*)(F.lds + RING_OFF);
    LAS float* part = (LAS float*)(F.lds + RING_OFF + 32768);
    for (int i = F.tid; i < 5 * DM; i += NTHR) { const float v = i < 4 * DM ? INP(F, 1)[i] : INP(F, 3)[i - 4 * DM]; sc[i] = v * sigm(v); }
    __syncthreads();
    for (int u = F.vcu; u < 2 * 96; u += F.G) {
        const int l = u / 96, j = (u % 96) * 64 + F.lane;
        const GAS float* wp = INP(F, 4) + (size_t)l * DM * 6144 + (size_t)(F.wave * 128) * 6144 + j;
        float a0 = 0.f, a1 = 0.f, a2 = 0.f, a3 = 0.f, a4 = 0.f;
#pragma unroll 8
        for (int kk = 0; kk < 128; ++kk) { const float w = wp[(size_t)kk * 6144]; const int k = F.wave * 128 + kk;
            a0 += sc[k] * w; a1 += sc[DM + k] * w; a2 += sc[2 * DM + k] * w; a3 += sc[3 * DM + k] * w; a4 += sc[4 * DM + k] * w; }
        part[(F.wave * 5 + 0) * 64 + F.lane] = a0; part[(F.wave * 5 + 1) * 64 + F.lane] = a1; part[(F.wave * 5 + 2) * 64 + F.lane] = a2; part[(F.wave * 5 + 3) * 64 + F.lane] = a3; part[(F.wave * 5 + 4) * 64 + F.lane] = a4;
        __syncthreads();
        if (F.tid < 320) { const int bp = F.tid >> 6, ln = F.tid & 63; float s = 0.f;
#pragma unroll
            for (int w = 0; w < 8; ++w) s += part[(w * 5 + bp) * 64 + ln];
            const int jj = (u % 96) * 64 + ln; ((GAS float*)(F.ws + WS_MODV))[((size_t)l * 5 + bp) * 6144 + jj] = s + INP(F, 5)[(size_t)l * 6144 + jj]; }
        __syncthreads();
    }
}
__device__ __forceinline__ void norm_mod(f32x4 (&v)[4], const GAS float* g, const GAS float* sc, const GAS float* sh, int lane) {
    float ss = 0.f;
#pragma unroll
    for (int j = 0; j < 4; ++j) ss += (v[j].x * v[j].x + v[j].y * v[j].y) + (v[j].z * v[j].z + v[j].w * v[j].w);
    const float rstd = 1.0f / sqrtf(wave_sum(ss, lane) * (1.0f / DM) + EPS);
#pragma unroll
    for (int j = 0; j < 4; ++j) { const int c = 4 * lane + 256 * j; const f32x4 gg = *(const f32x4*)(g + c), s1 = *(const f32x4*)(sc + c), s0 = *(const f32x4*)(sh + c);
        v[j] = v[j] * rstd * gg * (s1 + 1.0f) + s0; }
}
__device__ __forceinline__ void store_bf16_row(GAS bf16* orow, const f32x4 (&v)[4], int lane) {
#pragma unroll
    for (int j = 0; j < 4; ++j) { v2u w; w.x = pk2(v[j].x, v[j].y); w.y = pk2(v[j].z, v[j].w); *(GAS v2u*)(orow + 4 * lane + 256 * j) = w; }
}
__device__ __forceinline__ void load_row(f32x4 (&v)[4], const GAS float* xr, int lane) {
#pragma unroll
    for (int j = 0; j < 4; ++j) v[j] = *(const GAS f32x4*)(xr + 4 * lane + 256 * j);
}
__device__ __forceinline__ void phase_norm1_first(Frame& F) {
    const int gw = F.vcu * NWAVES + F.wave, NGW = F.G * NWAVES; const GAS float* mv = ((GAS float*)(F.ws + WS_MODV));
    for (int row = gw; row < MROWS; row += NGW) { f32x4 v[4]; load_row(v, xrow_in(F, row), F.lane);
        const GAS float* m = mv + (size_t)modidx(row) * 6144; norm_mod(v, INP(F, 6), m + 1024, m, F.lane); store_bf16_row(((GAS bf16*)(F.ws + WS_H)) + (size_t)row * DM, v, F.lane); }
}
__device__ __forceinline__ void phase_qkrope(Frame& F, int l) {
    const int gw = F.vcu * NWAVES + F.wave, NGW = F.G * NWAVES; const int lane = F.lane, i = lane & 31;
    const float invf = exp2f(-(float)(i & 15) * (13.287712379549449f / 16.0f));
    for (int row = gw; row < MROWS; row += NGW) {
        const int t = row % RPB; const bool lat = t < SEQ; GAS bf16* pr = ((GAS bf16*)(F.ws + WS_P)) + (size_t)row * PW;
        float cs = 1.f, sn = 0.f;
        if (lat) { const float pos = (float)((i < 16) ? (t >> 6) : (t & 63)); sincosf(pos * invf, &sn, &cs); }
#pragma unroll
        for (int it = 0; it < 5; ++it) { const int hh = 2 * it + (lane >> 5); const int col = (hh < 8 ? hh * 64 : C_GK + (hh - 8) * 64) + 2 * i;
            const unsigned w = *(const GAS unsigned*)(pr + col); float x1 = bf_lo(w), x2 = bf_hi(w);
            float ss = x1 * x1 + x2 * x2;
            ss += shx(ss, 1, lane); ss += shx(ss, 2, lane); ss += shx(ss, 4, lane); ss += shx(ss, 8, lane); ss += shx(ss, 16, lane);
            const float rstd = 1.0f / sqrtf(ss * (1.0f / 64.0f) + EPS); const GAS float* gp = (hh < 8 ? INP(F, 9) : INP(F, 10)) + l * 64 + 2 * i;
            x1 = x1 * rstd * gp[0]; x2 = x2 * rstd * gp[1];
            float y1 = x1 * cs - x2 * sn, y2 = x1 * sn + x2 * cs;
            if (hh < 8) { y1 *= QSCALE; y2 *= QSCALE; }
            *(GAS unsigned*)(pr + col) = pk2(y1, y2); }
        { const v4u w = *(const GAS v4u*)(pr + C_NQ + 8 * lane); v4u o;
          o.x = pk2(bf_lo(w.x) * QSCALE, bf_hi(w.x) * QSCALE); o.y = pk2(bf_lo(w.y) * QSCALE, bf_hi(w.y) * QSCALE); o.z = pk2(bf_lo(w.z) * QSCALE, bf_hi(w.z) * QSCALE); o.w = pk2(bf_lo(w.w) * QSCALE, bf_hi(w.w) * QSCALE);
          *(GAS v4u*)(pr + C_NQ + 8 * lane) = o; }
    }
}
__device__ __forceinline__ void phase_conv(Frame& F, int l) {
    LAS float* zl = (LAS float*)(F.lds + RING_OFF);
    LAS float* red = (LAS float*)(F.lds + RING_OFF + 62 * 512 * 4);
    const int ch = F.tid; const int nchunk = (l == 0) ? 136 : 128;
    float w[31];
#pragma unroll
    for (int j = 0; j < 31; ++j) w[j] = INP(F, 12)[((size_t)l * 31 + j) * 512 + ch];
    const float cb = INP(F, 13)[l * 512 + ch], cg = INP(F, 14)[l * 512 + ch];
    const GAS bf16* P = ((GAS bf16*)(F.ws + WS_P)); GAS bf16* Y = ((GAS bf16*)(F.ws + WS_Y));
    for (int u = F.vcu; u < NBATCH * nchunk; u += F.G) {
        const int b = u / nchunk, c = u % nchunk; const bool lat = c < 128;
        const int seq0 = b * RPB + (lat ? 0 : SEQ), slen = lat ? SEQ : CTXL, t0 = 32 * (lat ? c : c - 128);
        __syncthreads();
#pragma unroll
        for (int it = 0; it < 8; ++it) { const int item = it * 512 + F.tid;
            if (item < 62 * 64) { const int i = item >> 6, cgp = item & 63; const int t = t0 - 15 + i; f32x4 z0 = {0.f, 0.f, 0.f, 0.f}, z1 = {0.f, 0.f, 0.f, 0.f};
                if (t >= 0 && t < slen) { const GAS bf16* pr = P + (size_t)(seq0 + t) * PW; const v4u a = *(const GAS v4u*)(pr + C_CA + 8 * cgp), g = *(const GAS v4u*)(pr + C_CB + 8 * cgp);
                    z0.x = bf_lo(a.x) * sigm(bf_lo(g.x)); z0.y = bf_hi(a.x) * sigm(bf_hi(g.x)); z0.z = bf_lo(a.y) * sigm(bf_lo(g.y)); z0.w = bf_hi(a.y) * sigm(bf_hi(g.y));
                    z1.x = bf_lo(a.z) * sigm(bf_lo(g.z)); z1.y = bf_hi(a.z) * sigm(bf_hi(g.z)); z1.z = bf_lo(a.w) * sigm(bf_lo(g.w)); z1.w = bf_hi(a.w) * sigm(bf_hi(g.w)); }
                *(LAS f32x4*)(zl + i * 512 + 8 * cgp) = z0; *(LAS f32x4*)(zl + i * 512 + 8 * cgp + 4) = z1; } }
        __syncthreads();
        float z[62];
#pragma unroll
        for (int i = 0; i < 62; ++i) z[i] = zl[i * 512 + ch];
        float o[32];
#pragma unroll
        for (int q = 0; q < 32; ++q) { float s = cb;
#pragma unroll
            for (int j = 0; j < 31; ++j) s += z[q + j] * w[j];
            o[q] = s; }
#pragma unroll
        for (int q = 0; q < 32; ++q) { const float s = wave_sum(o[q] * o[q], F.lane); if (F.lane == 0) red[F.wave * 32 + q] = s; }
        __syncthreads();
#pragma unroll
        for (int q = 0; q < 32; ++q) { float s = 0.f;
#pragma unroll
            for (int wv = 0; wv < 8; ++wv) s += red[wv * 32 + q];
            const float y = o[q] * (1.0f / sqrtf(s * (1.0f / 512.0f) + EPS)) * cg;
            Y[(size_t)(seq0 + t0 + q) * YW + 1536 + ch] = (bf16)f2bf(y * sigm(y)); }
    }
    __syncthreads();
}
typedef short fbf16x8 __attribute__((ext_vector_type(8)));
typedef short fs16x4 __attribute__((ext_vector_type(4)));
typedef float ff32x16 __attribute__((ext_vector_type(16)));
typedef __attribute__((address_space(3))) const char* flds_cptr;
__device__ __forceinline__ fs16x4 f_vtr(flds_cptr p) { return __builtin_bit_cast(fs16x4, __builtin_amdgcn_ds_read_tr16_b64_v4i16((__attribute__((address_space(3))) attn_body::v4i16_t*)p)); }
__device__ __forceinline__ void fourier_frags(Frame& F, fbf16x8 (&fr)[4][4]) {
    LAS float* tab = (LAS float*)(F.lds + RING_OFF);
    __syncthreads();
    if (F.tid < 64) { float s, c; sincospif((float)F.tid * (1.0f / 32.0f), &s, &c); tab[2 * F.tid] = c; tab[2 * F.tid + 1] = s; }
    __syncthreads();
    const int m = F.lane & 31, hi = F.lane >> 5;
#pragma unroll
    for (int mt = 0; mt < 4; ++mt)
#pragma unroll
        for (int g = 0; g < 4; ++g) { unsigned wv[4];
#pragma unroll
            for (int jp = 0; jp < 4; ++jp) { float v[2];
#pragma unroll
                for (int q = 0; q < 2; ++q) { const int j = 2 * jp + q; const int n = 16 * g + (j & 3) + 8 * (j >> 2) + 4 * hi; const int k = 32 * (mt & 1) + m; const int ix = (k * n) & 63; v[q] = tab[2 * ix + (mt >> 1)]; }
                wv[jp] = pk2(v[0], v[1]); }
            v4u t; t.x = wv[0]; t.y = wv[1]; t.z = wv[2]; t.w = wv[3]; fr[mt][g] = __builtin_bit_cast(fbf16x8, t); __builtin_amdgcn_sched_barrier(0); }
    __syncthreads();
}
#define F_BFRAG(dst, vp, dh) do { _Pragma("unroll") for (int g_ = 0; g_ < 4; ++g_) { const fs16x4 lo_ = f_vtr((vp) + (dh) * 4096 + g_ * 1024), hi_ = f_vtr((vp) + (dh) * 4096 + g_ * 1024 + 512); \
        dst[g_] = (fbf16x8){lo_[0], lo_[1], lo_[2], lo_[3], hi_[0], hi_[1], hi_[2], hi_[3]}; } } while (0)
__device__ __forceinline__ void glds16_so(const GAS void* sbase, unsigned voff, unsigned lds_dst) { unsigned keep;
    asm volatile("s_mov_b32 %0, m0\n\ts_mov_b32 m0, %3\n\ts_nop 0\n\tglobal_load_lds_dwordx4 %1, %2\n\ts_mov_b32 m0, %0" : "=&s"(keep) : "v"(voff), "s"(sbase), "s"(lds_dst) : "memory"); }
__device__ __forceinline__ fbf16x8 f_neg(fbf16x8 v) { v4u t = __builtin_bit_cast(v4u, v); t.x ^= 0x80008000u; t.y ^= 0x80008000u; t.z ^= 0x80008000u; t.w ^= 0x80008000u; return __builtin_bit_cast(fbf16x8, t); }
__device__ __forceinline__ void phase_fourier1(Frame& F) {
    fbf16x8 fr[4][4]; fourier_frags(F, fr);
    const int lane = F.lane, w = F.wave, r32 = lane & 31, hi = lane >> 5;
    const unsigned lds0 = (unsigned)(uintptr_t)(F.lds + RING_OFF);
    const flds_cptr vbase = (flds_cptr)(F.lds + RING_OFF) + ((lane >> 4) & 1) * 32 + (lane & 3) * 8 + (4 * hi + ((lane & 15) >> 2)) * 64;
    const GAS bf16* P = ((GAS bf16*)(F.ws + WS_P)); GAS bf16* TPb = (GAS bf16*)(F.ws + WS_TP);
    const unsigned voff0 = (unsigned)((64 * (lane >> 2)) * PW + (lane & 3) * 8) * 2u;
    for (int u = F.vcu; u < NBATCH * 64; u += F.G) {
        const int b = u >> 6, n2 = u & 63;
        const GAS bf16* base = P + (size_t)(b * RPB + n2) * PW + C_F + 64 * w;
        asm volatile("s_waitcnt lgkmcnt(0)" ::: "memory");
#pragma unroll
        for (int rg = 0; rg < 4; ++rg) { const unsigned vo = voff0 + (unsigned)rg * (unsigned)(64 * 16 * PW * 2);
            const unsigned dA = (unsigned)__builtin_amdgcn_readfirstlane(lds0 + w * 8192 + rg * 1024), dB = dA + 8 * 8192;
            glds16_so(base, vo, dA); glds16_so(base + 32, vo, dA + 4096); glds16_so(base + 512, vo, dB); glds16_so(base + 544, vo, dB + 4096); }
        asm volatile("s_waitcnt vmcnt(0)" ::: "memory");
#pragma unroll 1
        for (int dh = 0; dh < 2; ++dh) {
            fbf16x8 bA[4], nA[4], nB[4];
            F_BFRAG(bA, vbase + w * 8192, dh); F_BFRAG(nB, vbase + (8 + w) * 8192, dh);
#pragma unroll
            for (int g = 0; g < 4; ++g) { nA[g] = f_neg(bA[g]); nB[g] = f_neg(nB[g]); }
#pragma unroll
            for (int kb = 0; kb < 2; ++kb) {
                ff32x16 tr = {}, ti = {};
#pragma unroll
                for (int g = 0; g < 4; ++g) { tr = __builtin_amdgcn_mfma_f32_32x32x16_bf16(fr[kb][g], bA[g], tr, 0, 0, 0); ti = __builtin_amdgcn_mfma_f32_32x32x16_bf16(fr[kb][g], nB[g], ti, 0, 0, 0);
                    tr = __builtin_amdgcn_mfma_f32_32x32x16_bf16(fr[2 + kb][g], nB[g], tr, 0, 0, 0); ti = __builtin_amdgcn_mfma_f32_32x32x16_bf16(fr[2 + kb][g], nA[g], ti, 0, 0, 0); }
                const unsigned o0 = (unsigned)(((b * 64 + 32 * kb + 4 * hi) * 2) * 64 + n2) * 512u + 64 * w + 32 * dh + r32;
#pragma unroll
                for (int r = 0; r < 16; ++r) { const int kk = (r & 3) + 8 * (r >> 2); const int k1 = 32 * kb + kk + 4 * hi;
                    const float rev = (float)(n2 * k1) * (1.0f / 4096.0f); const float c = __builtin_amdgcn_cosf(rev), s = __builtin_amdgcn_sinf(rev);
                    const unsigned oi = o0 + (unsigned)kk * (2u * 64u * 512u);
                    TPb[oi] = (bf16)f2bf(tr[r] * c + ti[r] * s); TPb[oi + 64u * 512u] = (bf16)f2bf(ti[r] * c - tr[r] * s);
                    if ((r & 3) == 3) __builtin_amdgcn_sched_barrier(0); }
                __builtin_amdgcn_sched_barrier(0);
            }
        }
    }
}
__device__ __forceinline__ void phase_fourier2(Frame& F) {
    fbf16x8 fr[4][4]; fourier_frags(F, fr);
    const int lane = F.lane, w = F.wave, r32 = lane & 31, hi = lane >> 5;
    const unsigned lds0 = (unsigned)(uintptr_t)(F.lds + RING_OFF);
    const flds_cptr vbase = (flds_cptr)(F.lds + RING_OFF) + ((lane >> 4) & 1) * 32 + (lane & 3) * 8 + (4 * hi + ((lane & 15) >> 2)) * 64;
    const GAS bf16* TPb = (const GAS bf16*)(F.ws + WS_TP); GAS bf16* Y = ((GAS bf16*)(F.ws + WS_Y));
    const float scale = 1.0f / sqrtf(4096.0f * 128.0f);
    const unsigned voff0 = (unsigned)((lane >> 2) * 512 + (lane & 3) * 8) * 2u;
    for (int u = F.vcu; u < NBATCH * 64; u += F.G) {
        const int b = u >> 6, k1 = u & 63;
        const GAS bf16* base0 = TPb + (size_t)((b * 64 + k1) * 2) * 64 * 512 + 64 * w; const GAS bf16* base1 = base0 + 64 * 512;
        asm volatile("s_waitcnt lgkmcnt(0)" ::: "memory");
#pragma unroll
        for (int rg = 0; rg < 4; ++rg) { const unsigned vo = voff0 + (unsigned)rg * (unsigned)(16 * 512 * 2);
            const unsigned d0 = (unsigned)__builtin_amdgcn_readfirstlane(lds0 + w * 8192 + rg * 1024), d1 = d0 + 8 * 8192;
            glds16_so(base0, vo, d0); glds16_so(base0 + 32, vo, d0 + 4096); glds16_so(base1, vo, d1); glds16_so(base1 + 32, vo, d1 + 4096); }
        asm volatile("s_waitcnt vmcnt(0)" ::: "memory");
#pragma unroll
        for (int dh = 0; dh < 2; ++dh) {
            fbf16x8 b0[4], b1[4];
            F_BFRAG(b0, vbase + w * 8192, dh); F_BFRAG(b1, vbase + (8 + w) * 8192, dh);
#pragma unroll
            for (int mt = 0; mt < 2; ++mt) {
                ff32x16 acc = {};
#pragma unroll
                for (int g = 0; g < 4; ++g) { acc = __builtin_amdgcn_mfma_f32_32x32x16_bf16(fr[mt][g], b0[g], acc, 0, 0, 0); acc = __builtin_amdgcn_mfma_f32_32x32x16_bf16(fr[2 + mt][g], b1[g], acc, 0, 0, 0); }
                const unsigned y0 = (unsigned)(b * RPB + k1 + 64 * (32 * mt + 4 * hi)) * (unsigned)YW + 1024u + 64 * w + 32 * dh + r32;
#pragma unroll
                for (int r = 0; r < 16; ++r) { const int kk = (r & 3) + 8 * (r >> 2);
                    Y[y0 + (unsigned)kk * (64u * (unsigned)YW)] = (bf16)f2bf(acc[r] * scale); }
                __builtin_amdgcn_sched_barrier(0);
            }
        }
    }
}
__device__ __forceinline__ void phase_fourier_ctx(Frame& F) {
    LAS float* tab = (LAS float*)(F.lds + RING_OFF + 8192);
    __syncthreads();
    if (F.tid < 256) { float s, c; sincospif((float)F.tid * (1.0f / 128.0f), &s, &c); tab[2 * F.tid] = c; tab[2 * F.tid + 1] = s; }
    __syncthreads();
    const float scale = 1.0f / sqrtf(256.0f * 128.0f);
    for (int u = F.vcu; u < NBATCH * 32; u += F.G) {
        const int b = u >> 5, kb = (u & 31) * 8;
        float acc[8];
#pragma unroll
        for (int k = 0; k < 8; ++k) acc[k] = 0.f;
        const GAS bf16* pcol = ((GAS bf16*)(F.ws + WS_P)) + (size_t)(b * RPB + SEQ) * PW + C_F + F.tid;
        for (int n0 = 0; n0 < 256; n0 += 16) { float A[16], B[16];
#pragma unroll
            for (int i = 0; i < 16; ++i) { A[i] = bf1(pcol[(size_t)(n0 + i) * PW]); B[i] = bf1(pcol[(size_t)(n0 + i) * PW + 512]); }
#pragma unroll
            for (int i = 0; i < 16; ++i)
#pragma unroll
                for (int k = 0; k < 8; ++k) { const int ix = ((n0 + i) * (kb + k)) & 255; acc[k] += A[i] * tab[2 * ix] - B[i] * tab[2 * ix + 1]; } }
        GAS bf16* yo = ((GAS bf16*)(F.ws + WS_Y)) + (size_t)(b * RPB + SEQ + kb) * YW + 1024 + F.tid;
#pragma unroll
        for (int k = 0; k < 8; ++k) yo[(size_t)k * YW] = (bf16)f2bf(acc[k] * scale);
    }
}
__device__ __forceinline__ void phase_norm2_router(Frame& F, int l) {
    LAS float* wr = (LAS float*)(F.lds + RING_OFF);
    LAS int* sel = (LAS int*)(F.lds + RING_OFF + 65536);
    const int nact = (l == 0) ? MROWS : NBATCH * SEQ; const int chunk = (nact + F.G - 1) / F.G; const int a0 = F.vcu * chunk, a1 = (a0 + chunk < nact) ? a0 + chunk : nact;
    __syncthreads();
    for (int i = F.tid; i < DM * 16 / 4; i += NTHR) ((LAS f32x4*)wr)[i] = ((const GAS f32x4*)INP(F, 17))[i];
    __syncthreads();
    const GAS float* mv = ((GAS float*)(F.ws + WS_MODV)) + (size_t)l * 5 * 6144;
    float rb[16];
#pragma unroll
    for (int e = 0; e < 16; ++e) rb[e] = INP(F, 18)[e];
    for (int a = a0 + F.wave; a < a1; a += NWAVES) {
        const int row = (l == 0) ? a : (a / SEQ) * RPB + (a % SEQ);
        f32x4 v[4]; load_row(v, xrow_ws(F, row), F.lane);
        const GAS float* m = mv + (size_t)modidx(row) * 6144; norm_mod(v, INP(F, 7) + l * DM, m + 4 * 1024, m + 3 * 1024, F.lane);
        store_bf16_row(((GAS bf16*)(F.ws + WS_H)) + (size_t)row * DM, v, F.lane);
        float lg[16];
#pragma unroll
        for (int e = 0; e < 16; ++e) lg[e] = 0.f;
#pragma unroll
        for (int j = 0; j < 4; ++j)
#pragma unroll
            for (int q = 0; q < 4; ++q) { const float hv = v[j][q]; const LAS f32x4* wp = (const LAS f32x4*)(wr + (4 * F.lane + 256 * j + q) * 16);
#pragma unroll
                for (int e4 = 0; e4 < 4; ++e4) { const f32x4 ww = wp[e4]; lg[4 * e4] += hv * ww.x; lg[4 * e4 + 1] += hv * ww.y; lg[4 * e4 + 2] += hv * ww.z; lg[4 * e4 + 3] += hv * ww.w; } }
        float sc[16], sl[16];
#pragma unroll
        for (int e = 0; e < 16; ++e) { sc[e] = sigm(wave_sum(lg[e], F.lane)); sl[e] = sc[e] + rb[e]; }
        float best = -INFINITY; int bi1 = 0, bi2 = 1; float bs1 = 0.f, bs2 = 0.f;
#pragma unroll
        for (int g = 0; g < 4; ++g) {
            int i1 = 4 * g; float m1 = sl[4 * g];
#pragma unroll
            for (int q = 1; q < 4; ++q) if (sl[4 * g + q] > m1) { m1 = sl[4 * g + q]; i1 = 4 * g + q; }
            int i2 = -1; float m2 = -INFINITY;
#pragma unroll
            for (int q = 0; q < 4; ++q) if (4 * g + q != i1 && sl[4 * g + q] > m2) { m2 = sl[4 * g + q]; i2 = 4 * g + q; }
            float s1 = 0.f, s2 = 0.f;
#pragma unroll
            for (int q = 0; q < 4; ++q) { if (4 * g + q == i1) s1 = sc[4 * g + q]; if (4 * g + q == i2) s2 = sc[4 * g + q]; }
            const float gs = m1 + m2;
            if (gs > best) { best = gs; bi1 = i1; bi2 = i2; bs1 = s1; bs2 = s2; }
        }
        if (F.lane == 0) { const float inv = 1.0f / (bs1 + bs2);
            ((GAS int*)(F.ws + WS_TOKE))[2 * row] = bi1; ((GAS int*)(F.ws + WS_TOKE))[2 * row + 1] = bi2; ((GAS float*)(F.ws + WS_TOKW))[2 * row] = bs1 * inv; ((GAS float*)(F.ws + WS_TOKW))[2 * row + 1] = bs2 * inv;
            sel[2 * (a - a0)] = bi1; sel[2 * (a - a0) + 1] = bi2; }
    }
    __syncthreads();
    if (F.tid < 16) { const int e = F.tid; int n = 0; const int ns = 2 * (a1 - a0);
        for (int i = 0; i < ns; ++i) n += (sel[i] == e) ? 1 : 0;
        unsigned base = 0u; if (n > 0) base = __hip_atomic_fetch_add((unsigned*)(F.ctl + CW_CNT + (l * 16 + e) * 64), (unsigned)n, RLX_AGENT);
        for (int i = 0; i < ns; ++i) if (sel[i] == e) { const int a = a0 + (i >> 1); const int row = (l == 0) ? a : (a / SEQ) * RPB + (a % SEQ); ((GAS int*)(F.ws + WS_TOKR))[2 * row + (i & 1)] = (int)base; ++base; } }
    __syncthreads();
}
__device__ __forceinline__ void moe_offsets(Frame& F, int l) {
    __syncthreads();
    if (F.tid == 0) { unsigned off = 0u;
        for (int e = 0; e < 16; ++e) { F.LCTL[e] = off; const unsigned c = __hip_atomic_load((unsigned*)(F.ctl + CW_CNT + (l * 16 + e) * 64), RLX_AGENT); off += (c + 255u) & ~255u; }
        F.LCTL[16] = off; F.LCTL[17] = off >> 8; }
    __syncthreads();
}
__device__ __forceinline__ void phase_scatter(Frame& F, int l) {
    moe_offsets(F, l);
    const int nact = (l == 0) ? MROWS : NBATCH * SEQ; const int chunk = (nact + F.G - 1) / F.G; const int a0 = F.vcu * chunk, a1 = (a0 + chunk < nact) ? a0 + chunk : nact;
    for (int a = a0 + F.wave; a < a1; a += NWAVES) {
        const int row = (l == 0) ? a : (a / SEQ) * RPB + (a % SEQ);
        const int e1 = ((GAS int*)(F.ws + WS_TOKE))[2 * row], e2 = ((GAS int*)(F.ws + WS_TOKE))[2 * row + 1];
        const int s1 = (int)F.LCTL[e1] + ((GAS int*)(F.ws + WS_TOKR))[2 * row], s2 = (int)F.LCTL[e2] + ((GAS int*)(F.ws + WS_TOKR))[2 * row + 1];
        if (F.lane == 0) { ((GAS int*)(F.ws + WS_TOKS))[2 * row] = s1; ((GAS int*)(F.ws + WS_TOKS))[2 * row + 1] = s2; }
        const GAS v4u* src = (const GAS v4u*)(((GAS bf16*)(F.ws + WS_H)) + (size_t)row * DM) + F.lane; const v4u x0 = src[0], x1 = src[64];
        GAS v4u* d1 = (GAS v4u*)(((GAS bf16*)(F.ws + WS_AM)) + (size_t)s1 * DM) + F.lane; GAS v4u* d2 = (GAS v4u*)(((GAS bf16*)(F.ws + WS_AM)) + (size_t)s2 * DM) + F.lane;
        d1[0] = x0; d1[64] = x1; d2[0] = x0; d2[64] = x1;
    }
}
__device__ __forceinline__ void phase_combine(Frame& F, int l) {
    const int gw = F.vcu * NWAVES + F.wave, NGW = F.G * NWAVES; const GAS float* mv = ((GAS float*)(F.ws + WS_MODV)) + (size_t)l * 5 * 6144;
    const int nact = (l == 0) ? MROWS : NBATCH * SEQ;
    for (int a = gw; a < nact; a += NGW) {
        const int row = (l == 0) ? a : (a / SEQ) * RPB + (a % SEQ);
        GAS float* xr = xrow_ws(F, row); f32x4 v[4]; load_row(v, xr, F.lane);
        const int s1 = ((GAS int*)(F.ws + WS_TOKS))[2 * row], s2 = ((GAS int*)(F.ws + WS_TOKS))[2 * row + 1]; const float w1 = ((GAS float*)(F.ws + WS_TOKW))[2 * row], w2 = ((GAS float*)(F.ws + WS_TOKW))[2 * row + 1];
        const GAS float* g2 = mv + (size_t)modidx(row) * 6144 + 5 * 1024;
        const GAS bf16* o1 = ((GAS bf16*)(F.ws + WS_OM)) + (size_t)s1 * DM; const GAS bf16* o2 = ((GAS bf16*)(F.ws + WS_OM)) + (size_t)s2 * DM;
#pragma unroll
        for (int j = 0; j < 4; ++j) { const int c = 4 * F.lane + 256 * j; const v2u p = *(const GAS v2u*)(o1 + c), q = *(const GAS v2u*)(o2 + c); const f32x4 gg = *(const f32x4*)(g2 + c);
            f32x4 z; z.x = w1 * bf_lo(p.x) + w2 * bf_lo(q.x); z.y = w1 * bf_hi(p.x) + w2 * bf_hi(q.x); z.z = w1 * bf_lo(p.y) + w2 * bf_lo(q.y); z.w = w1 * bf_hi(p.y) + w2 * bf_hi(q.y);
            v[j] = v[j] + gg * z; }
        if (l == 0) {
#pragma unroll
            for (int j = 0; j < 4; ++j) *(GAS f32x4*)(xr + 4 * F.lane + 256 * j) = v[j];
            const GAS float* m1 = ((GAS float*)(F.ws + WS_MODV)) + (size_t)5 * 6144 + (size_t)modidx(row) * 6144;
            norm_mod(v, INP(F, 6) + DM, m1 + 1024, m1, F.lane); store_bf16_row(((GAS bf16*)(F.ws + WS_H)) + (size_t)row * DM, v, F.lane);
        } else {
            float ss = 0.f;
#pragma unroll
            for (int j = 0; j < 4; ++j) ss += (v[j].x * v[j].x + v[j].y * v[j].y) + (v[j].z * v[j].z + v[j].w * v[j].w);
            const float rstd = 1.0f / sqrtf(wave_sum(ss, F.lane) * (1.0f / DM) + EPS);
#pragma unroll
            for (int j = 0; j < 4; ++j) { const int c = 4 * F.lane + 256 * j; *(GAS f32x4*)(xr + c) = v[j] * rstd * *(const f32x4*)(INP(F, 21) + c); }
        }
    }
}
struct SchedIn {
    int G, c;
    __device__ __forceinline__ bool next(int i, pg8::Unit& u) const { const long L = (long)i * G + c; if (L >= 68 * 33) return false; int pm, pn; pg8::tile_map((int)L, 68, 33, pm, pn);
        u.pm = pm; u.pn = pn; u.aux = 0; u.aoff = (size_t)pm * 256 * DM * 2; u.boff = (size_t)pn * 256 * DM * 2; return true; }
};
struct SchedBr {
    int G, c, nMt; bool skipctx;
    __device__ __forceinline__ bool next(int i, pg8::Unit& u) const { const long L = (long)(i >> 2) * G + c; if (L >= nMt * 4) return false; int pm, pn; pg8::tile_map((int)L, nMt, 4, pm, pn);
        if (skipctx) pm = (pm / 16) * 17 + (pm % 16);
        const int n = i & 3; u.pm = pm; u.pn = pn; u.aux = n; u.aoff = ((size_t)pm * 256 * YW + n * 512) * 2; u.boff = ((size_t)pn * 256 * 2048 + n * 512) * 2; return true; }
};
struct SchedOut {
    int G, c, nMt; bool skipctx;
    __device__ __forceinline__ bool next(int i, pg8::Unit& u) const { const long L = (long)i * G + c; if (L >= nMt * 4) return false; int pm, pn; pg8::tile_map((int)L, nMt, 4, pm, pn);
        if (skipctx) pm = (pm / 16) * 17 + (pm % 16);
        u.pm = pm; u.pn = pn; u.aux = 0; u.aoff = (size_t)pm * 256 * DM * 2; u.boff = (size_t)pn * 256 * DM * 2; return true; }
};
struct SchedMoe {
    int G, c; LAS unsigned* lctl; size_t astride, bstride_e, bstride_n;
    __device__ __forceinline__ bool next(int i, pg8::Unit& u) const { const long L = (long)i * G + c; const unsigned nt = lctl[17]; if (L >= (long)nt * 4) return false;
        const int tile = (int)(L >> 2), pn = (int)(L & 3); const unsigned row0 = (unsigned)tile * 256u; int e = 0;
#pragma unroll
        for (int k = 1; k < 16; ++k) e += (row0 >= lctl[k]) ? 1 : 0;
        u.pm = tile; u.pn = pn; u.aux = e; u.aoff = (size_t)tile * astride; u.boff = (size_t)e * bstride_e + (size_t)pn * bstride_n; return true; }
};

__device__ __forceinline__ void attn_plain_args(const Frame& F, int U, attn_body::AttnArgs& a) {
    typedef AGAS attn_body::bf16 abf;
    a.qrow0 = 0; a.rb0 = 0; a.rpb = nullptr; a.kr1 = 0;
    if (U < 512) { const int b = U >> 7, kvh = (U >> 6) & 1, hq = (U >> 4) & 3, qb = U & 15, h = kvh * 4 + hq; const size_t r0 = (size_t)b * RPB;
        a.Q = (const abf*)(((GAS bf16*)(F.ws + WS_P)) + (r0 + 256 * qb) * PW + C_GQ + h * 64); a.K = (const abf*)(((GAS bf16*)(F.ws + WS_P)) + r0 * PW + C_GK + kvh * 64); a.V = (const abf*)(((GAS bf16*)(F.ws + WS_P)) + r0 * PW + C_GV + kvh * 64);
        a.O = (abf*)(((GAS bf16*)(F.ws + WS_Y)) + (r0 + 256 * qb) * YW + h * 64); a.kr0 = 0; a.tsw = 1 << 20; a.NT = RPB / 64; }
    else if (U < 544) { const int b = (U - 512) >> 3, h = (U - 512) & 7, kvh = h >> 2; const size_t r0 = (size_t)b * RPB;
        a.Q = (const abf*)(((GAS bf16*)(F.ws + WS_P)) + (r0 + SEQ) * PW + C_GQ + h * 64); a.K = (const abf*)(((GAS bf16*)(F.ws + WS_P)) + r0 * PW + C_GK + kvh * 64); a.V = (const abf*)(((GAS bf16*)(F.ws + WS_P)) + r0 * PW + C_GV + kvh * 64);
        a.O = (abf*)(((GAS bf16*)(F.ws + WS_Y)) + (r0 + SEQ) * YW + h * 64); a.kr0 = SEQ; a.tsw = 1 << 20; a.NT = 4; }
    else { const int b = (U - 544) >> 3, h = (U - 544) & 7; const size_t r0 = (size_t)b * RPB;
        a.Q = (const abf*)(((GAS bf16*)(F.ws + WS_P)) + (r0 + SEQ) * PW + C_NQ + h * 64); a.K = (const abf*)(((GAS bf16*)(F.ws + WS_P)) + r0 * PW + C_NK + h * 64); a.V = (const abf*)(((GAS bf16*)(F.ws + WS_P)) + r0 * PW + C_NV + h * 64);
        a.O = (abf*)(((GAS bf16*)(F.ws + WS_Y)) + (r0 + SEQ) * YW + 512 + h * 64); a.kr0 = SEQ; a.tsw = 1 << 20; a.NT = 4; }
}
__device__ __forceinline__ void attn_na_args(const Frame& F, int U, int l, attn_body::AttnArgs& a) {
    typedef AGAS attn_body::bf16 abf;
    const int b = U >> 7, h = (U >> 4) & 7, j = U & 15; const size_t r0 = (size_t)b * RPB;
    int rb0 = 4 * j - 4; rb0 = rb0 < 0 ? 0 : (rb0 > 52 ? 52 : rb0);
    a.Q = (const abf*)(((GAS bf16*)(F.ws + WS_P)) + (r0 + 256 * j) * PW + C_NQ + h * 64); a.K = (const abf*)(((GAS bf16*)(F.ws + WS_P)) + r0 * PW + C_NK + h * 64); a.V = (const abf*)(((GAS bf16*)(F.ws + WS_P)) + r0 * PW + C_NV + h * 64);
    a.O = (abf*)(((GAS bf16*)(F.ws + WS_Y)) + (r0 + 256 * j) * YW + 512 + h * 64); a.kr0 = SEQ; a.kr1 = 64 * rb0; a.tsw = 4; a.NT = 16; a.qrow0 = 4 * j; a.rb0 = rb0; a.rpb = INP(F, 11) + ((size_t)l * 8 + h) * 465;
}

constexpr int N_PHASES = 2 + 11 * NLAYER;
struct Args { const GAS float* in[22]; GAS float* out; unsigned char* ws; int ph_lo, ph_hi; };
__global__ void __launch_bounds__(NTHR, 2) fwd_kernel(Args args) {
    extern __shared__ __attribute__((aligned(16))) unsigned char lds[];
    Frame F;
    F.lds = (LAS unsigned char*)lds; F.MISC = (volatile LAS unsigned*)(F.lds + MISC_OFF); F.LCTL = (LAS unsigned*)(F.lds + LDSCTL_OFF);
    F.tid = threadIdx.x; F.lane = F.tid & 63; F.wave = __builtin_amdgcn_readfirstlane(F.tid >> 6);
    F.G = gridDim.x; { const int bx = blockIdx.x; F.vcu = (F.G % 8 == 0) ? (bx % 8) * (F.G / 8) + bx / 8 : bx; }
    unsigned char* ws = args.ws;
    F.ctl = (gu32*)(ws + WS_CTL);
    F.out = args.out; F.ws = ws;
    for (int u = F.tid; u < (LDS_BYTES - LDSCTL_OFF) / 4; u += NTHR) ((LAS unsigned*)(F.lds + LDSCTL_OFF))[u] = 0u;
    __syncthreads();
    if (F.tid < 22) { unsigned long long p = 0ull;
#pragma unroll
        for (int i = 0; i < 22; ++i) if (F.tid == i) p = (unsigned long long)args.in[i];
        LAS unsigned* t = (LAS unsigned*)(F.lds + PTR_OFF) + 2 * F.tid; t[0] = (unsigned)p; t[1] = (unsigned)(p >> 32); }
    __syncthreads();
    XcdBarrier bar = xcd_barrier_post((unsigned*)(F.ctl + CW_BAR), F.MISC + 8);
    const int lo = args.ph_lo, hi = args.ph_hi;
#define LAUNDER() do { int t_ = threadIdx.x; asm volatile("" : "+v"(t_)); F.tid = t_; F.lane = t_ & 63; F.wave = __builtin_amdgcn_readfirstlane(t_ >> 6); \
        int g_ = gridDim.x, b_ = blockIdx.x; unsigned char* w_ = args.ws; GAS float* o_ = args.out; unsigned l_ = (unsigned)(uintptr_t)lds; \
        asm volatile("" : "+s"(g_), "+s"(b_), "+s"(w_), "+s"(o_), "+s"(l_)); \
        F.G = g_; bx = b_; F.vcu = (g_ % 8 == 0) ? (b_ % 8) * (g_ / 8) + b_ / 8 : b_; F.ws = w_; F.out = o_; F.ctl = (gu32*)(w_ + WS_CTL); \
        F.lds = (LAS unsigned char*)l_; F.MISC = (volatile LAS unsigned*)(F.lds + MISC_OFF); F.LCTL = (LAS unsigned*)(F.lds + LDSCTL_OFF); } while (0)
#ifndef PROBE
#define PROBE 0
#endif
#ifndef PROBE_MASK
#define PROBE_MASK 0x7ffffffeull
#define PROBE_SCALE 0.1f
#endif
#define STAMP(i) do { if (PROBE && blockIdx.x == 0 && threadIdx.x == 0) ((GAS unsigned long long*)(args.ws + WS_CTL + 512 * 1024))[i] = __builtin_amdgcn_s_memrealtime(); } while (0)
#define RUN(k) ((k) >= lo && (k) < hi)
#define SEAM(k) do { if ((k) >= lo && (k) + 1 < hi) xcd_barrier(bar); } while (0)
    int bx = (int)blockIdx.x;

    STAMP(0);
    if (RUN(0)) { LAUNDER(); convert_weights(F, 0); LAUNDER(); mod_vectors(F); } SEAM(0); STAMP(1);
    if (RUN(1)) { LAUNDER(); phase_norm1_first(F); } SEAM(1); STAMP(2);

    for (int l = 0; l < NLAYER; ++l) {
        const int p0 = 2 + 11 * l;
        if (RUN(p0 + 0)) { LAUNDER(); SchedIn S{F.G, bx}; pg8::EpiP E{((GAS bf16*)(F.ws + WS_P)), PW, C_G / 256};
            pg8::gemm_phase<pg8::EpiP, SchedIn, true>(F.lds + RING_OFF, F.tid, ((GAS bf16*)(F.ws + WS_H)), ((GAS bf16*)(F.ws + WS_WIN)), DM, DM, DM, S, E); } SEAM(p0 + 0); STAMP(3 + 14 * l + 0);
        if (RUN(p0 + 1)) { LAUNDER(); phase_qkrope(F, l); } SEAM(p0 + 1); STAMP(3 + 14 * l + 1);
        if (RUN(p0 + 2)) { LAUNDER();
            phase_fourier1(F); __syncthreads(); LAUNDER(); STAMP(3 + 14 * l + 2);
            phase_conv(F, l); __syncthreads(); LAUNDER(); STAMP(3 + 14 * l + 3);
            const int nU = (l == 0) ? 576 : 512;
            for (int U = F.vcu; U < nU; U += F.G) { attn_body::AttnArgs a; attn_plain_args(F, U, a); int t_ = threadIdx.x; asm volatile("" : "+v"(t_)); attn_body::attn_unit<8, false>(a, (char*)F.lds + RING_OFF, t_); }
            __syncthreads();
        } SEAM(p0 + 2); STAMP(3 + 14 * l + 4);
        if (RUN(p0 + 3)) { LAUNDER();
            phase_fourier2(F); __syncthreads(); LAUNDER(); STAMP(3 + 14 * l + 5);
            for (int U = F.vcu; U < 512; U += F.G) { attn_body::AttnArgs a; attn_na_args(F, U, l, a); int t_ = threadIdx.x; asm volatile("" : "+v"(t_)); attn_body::attn_unit<8, true>(a, (char*)F.lds + RING_OFF, t_); }
            __syncthreads();
            if (l == 0) { LAUNDER(); phase_fourier_ctx(F); __syncthreads(); }
        } SEAM(p0 + 3); STAMP(3 + 14 * l + 6);
        if (RUN(p0 + 4)) { LAUNDER(); SchedBr S{F.G, bx, (l == 0) ? 68 : 64, l != 0}; pg8::EpiBranch E{((GAS bf16*)(F.ws + WS_P)) + C_G, PW, ((GAS bf16*)(F.ws + WS_H)), DM};
            pg8::gemm_phase<pg8::EpiBranch, SchedBr, true>(F.lds + RING_OFF, F.tid, ((GAS bf16*)(F.ws + WS_Y)), ((GAS bf16*)(F.ws + WS_WB)), YW, 2048, 512, S, E); } SEAM(p0 + 4); STAMP(3 + 14 * l + 7);
        if (RUN(p0 + 5)) { LAUNDER(); SchedOut S{F.G, bx, (l == 0) ? 68 : 64, l != 0};
            pg8::EpiRes E{(l == 0) ? INP(F, 0) : F.out, (l == 0) ? INP(F, 2) : ((GAS float*)(F.ws + WS_XC)), F.out, ((GAS float*)(F.ws + WS_XC)), ((GAS float*)(F.ws + WS_MODV)) + (size_t)l * 5 * 6144 + 2 * 1024};
            pg8::gemm_phase<pg8::EpiRes, SchedOut, true>(F.lds + RING_OFF, F.tid, ((GAS bf16*)(F.ws + WS_H)), ((GAS bf16*)(F.ws + WS_WO)), DM, DM, DM, S, E); } SEAM(p0 + 5); STAMP(3 + 14 * l + 8);
        if (RUN(p0 + 6)) { LAUNDER(); phase_norm2_router(F, l); } SEAM(p0 + 6); STAMP(3 + 14 * l + 9);
        if (RUN(p0 + 7)) { LAUNDER(); phase_scatter(F, l); } SEAM(p0 + 7); STAMP(3 + 14 * l + 10);
        if (RUN(p0 + 8)) { LAUNDER(); moe_offsets(F, l); SchedMoe S{F.G, bx, F.LCTL, (size_t)256 * DM * 2, (size_t)DM * DM * 2, (size_t)256 * DM * 2}; pg8::EpiGU E{((GAS bf16*)(F.ws + WS_HM)), EFF};
            pg8::gemm_phase<pg8::EpiGU, SchedMoe, true>(F.lds + RING_OFF, F.tid, ((GAS bf16*)(F.ws + WS_AM)), ((GAS bf16*)(F.ws + WS_WGU)), DM, DM, DM, S, E); } SEAM(p0 + 8); STAMP(3 + 14 * l + 11);
        if (RUN(p0 + 9)) { LAUNDER(); moe_offsets(F, l); SchedMoe S{F.G, bx, F.LCTL, (size_t)256 * EFF * 2, (size_t)DM * EFF * 2, (size_t)256 * EFF * 2}; pg8::EpiP E{((GAS bf16*)(F.ws + WS_OM)), DM, 1 << 20};
            pg8::gemm_phase<pg8::EpiP, SchedMoe, true>(F.lds + RING_OFF, F.tid, ((GAS bf16*)(F.ws + WS_HM)), ((GAS bf16*)(F.ws + WS_WD)), EFF, EFF, EFF, S, E); } SEAM(p0 + 9); STAMP(3 + 14 * l + 12);
        if (RUN(p0 + 10)) { LAUNDER(); phase_combine(F, l); if (l + 1 < NLAYER) { __syncthreads(); LAUNDER(); convert_weights(F, l + 1); } } SEAM(p0 + 10); STAMP(3 + 14 * l + 13);
    }
#if PROBE
    xcd_barrier(bar);
    { const GAS unsigned long long* st = (const GAS unsigned long long*)(args.ws + WS_CTL + 512 * 1024);
      float db = 0.f;
      for (int i = 1; i <= 30; ++i) if ((PROBE_MASK >> i) & 1ull) db += (float)(st[i] - st[i - 1]) * 0.01f;
      db *= PROBE_SCALE;
      for (size_t i = (size_t)blockIdx.x * NTHR + threadIdx.x; i < (size_t)NBATCH * SEQ * DM; i += (size_t)gridDim.x * NTHR) args.out[i] = (i == 0) ? db : 8.0f; }
#endif
#undef RUN
#undef SEAM
}

#ifndef MK_PER_PHASE
#define MK_PER_PHASE 0
#endif
extern "C" void kernel_launch(void* const* d_in, const GAS int* in_sizes, int n_in, void* d_out, int out_size, void* d_ws, size_t ws_size, hipStream_t stream) {
    static int grid = 0;
    if (grid == 0) {
        if (n_in != 22 || out_size != NBATCH * SEQ * DM || ws_size < WS_END) { fprintf(stderr, "kernel_launch: unexpected shapes (n_in %d, out %d, ws %zu); nothing launched\n", n_in, out_size, ws_size); grid = -1; return; }
        int dev = 0, cus = 0, per_cu = 0;
        if (hipGetDevice(&dev) != hipSuccess || hipDeviceGetAttribute(&cus, hipDeviceAttributeMultiprocessorCount, dev) != hipSuccess) { grid = -1; return; }
        if (hipFuncSetAttribute((const void*)fwd_kernel, hipFuncAttributeMaxDynamicSharedMemorySize, LDS_BYTES) != hipSuccess) { fprintf(stderr, "kernel_launch: hipFuncSetAttribute failed\n"); grid = -1; return; }
        if (hipOccupancyMaxActiveBlocksPerMultiprocessor(&per_cu, (const void*)fwd_kernel, NTHR, LDS_BYTES) != hipSuccess || per_cu < 1) { fprintf(stderr, "kernel_launch: occupancy query reports %d\n", per_cu); (void)hipGetLastError(); grid = -1; return; }
        grid = cus;
    }
    if (grid < 0) return;
    (void)hipMemsetAsync((char*)d_ws + WS_CTL, 0, CTL_ZERO_BYTES, stream);
    Args a{};
    for (int i = 0; i < 22; ++i) a.in[i] = (const GAS float*)d_in[i];
    a.out = (GAS float*)d_out; a.ws = (unsigned char*)d_ws;
#if MK_PER_PHASE
    for (int p = 0; p < N_PHASES; ++p) { a.ph_lo = p; a.ph_hi = p + 1; hipLaunchKernelGGL(fwd_kernel, dim3(grid), dim3(NTHR), LDS_BYTES, stream, a); }
#else
    a.ph_lo = 0; a.ph_hi = N_PHASES;
    hipLaunchKernelGGL(fwd_kernel, dim3(grid), dim3(NTHR), LDS_BYTES, stream, a);
#endif
}
```

```cpp
#include <hip/hip_runtime.h>
#include <hip/hip_bf16.h>
#include <cstdio>
#include <cstdint>
#include <cmath>

namespace pg8 {
#define PG8_LAS __attribute__((address_space(3)))
#define PG8_GAS __attribute__((address_space(1)))
typedef unsigned short bf16_t;
typedef short bf16x8 __attribute__((ext_vector_type(8)));
typedef float f32x4 __attribute__((ext_vector_type(4)));
typedef unsigned u32x4 __attribute__((ext_vector_type(4)));
constexpr int BM = 256, BK = 64, HALF = 128, HTB = HALF * BK * 2, STAGE_BYTES = 8 * HTB, NXCD = 8, WGM = 8;

__host__ __device__ __forceinline__ int lds_byte(int r, int c) { const int st = (r >> 4) * 2 + (c >> 5), rr = r & 15, cc = c & 31, ob = rr * 64 + cc * 2; return st * 1024 + (ob ^ (((ob >> 9) & 1) << 5)); }
__host__ __device__ __forceinline__ void stage_rc(int b, int& R, int& C) { const int st = b / 1024, sb = b % 1024, swz = sb ^ (((sb >> 9) & 1) << 5); R = (st >> 1) * 16 + swz / 64; C = (st & 1) * 32 + (swz % 64) / 2; }
__host__ __device__ __forceinline__ int perm32(int rho) { const int n = rho >> 4, i = rho & 15; return 8 * (i >> 2) + 4 * n + (i & 3); }

struct Unit { int pm, pn, aux; size_t aoff, boff; };

__device__ __forceinline__ void tile_map(int L, int nM, int nN, int& pm, int& pn) {
    const int nwg = nM * nN; int wgid = L;
    { const int q = nwg / NXCD, r = nwg % NXCD, xcd = wgid % NXCD, off = wgid / NXCD; wgid = (xcd < r ? xcd * (q + 1) : r * (q + 1) + (xcd - r) * q) + off; }
    const int nig = WGM * nN, gid = wgid / nig, fm = gid * WGM, gsz = (nM - fm) < WGM ? (nM - fm) : WGM;
    pm = fm + ((wgid % nig) % gsz); pn = (wgid % nig) / gsz;
}

__device__ __forceinline__ unsigned cvt_pk_bf16(float lo, float hi) { unsigned r; asm volatile("v_cvt_pk_bf16_f32 %0, %1, %2" : "=v"(r) : "v"(lo), "v"(hi)); return r; }
__device__ __forceinline__ float fast_sigmoid(float x) { return __builtin_amdgcn_rcpf(1.0f + __builtin_amdgcn_exp2f(-1.4426950408889634f * x)); }
__device__ __forceinline__ float bflo(unsigned w) { return __uint_as_float(w << 16); }
__device__ __forceinline__ float bfhi(unsigned w) { return __uint_as_float(w & 0xffff0000u); }

struct EpiP {
    static constexpr bool PERM = true, KEEP = false;
    PG8_GAS bf16_t* O; int ldc; int sig_from;
    __device__ __forceinline__ void operator()(f32x4 (&acc)[2][2][4][2], const Unit& u, int wr, int wc, int fr, int fq) const {
        const int row0 = u.pm * BM + wr * 64 + fr, col0 = u.pn * BM + wc * 32 + 8 * fq; const bool sig = u.pn >= sig_from;
#pragma unroll
        for (int ai = 0; ai < 2; ++ai)
#pragma unroll
            for (int m = 0; m < 4; ++m) { PG8_GAS bf16_t* rowp = O + (size_t)(row0 + ai * HALF + m * 16) * ldc + col0;
#pragma unroll
                for (int bj = 0; bj < 2; ++bj) { f32x4 v0 = acc[ai][bj][m][0], v1 = acc[ai][bj][m][1];
                    if (sig) {
#pragma unroll
                        for (int k = 0; k < 4; ++k) { v0[k] = __builtin_fmaxf(fast_sigmoid(v0[k]), 1e-20f); v1[k] = __builtin_fmaxf(fast_sigmoid(v1[k]), 1e-20f); } }
                    u32x4 w; w.x = cvt_pk_bf16(v0[0], v0[1]); w.y = cvt_pk_bf16(v0[2], v0[3]); w.z = cvt_pk_bf16(v1[0], v1[1]); w.w = cvt_pk_bf16(v1[2], v1[3]);
                    *(PG8_GAS u32x4*)(rowp + bj * HALF) = w; } }
    }
};
struct EpiBranch {
    static constexpr bool PERM = true, KEEP = true;
    const PG8_GAS bf16_t* G; int ldg; PG8_GAS bf16_t* O; int ldc;
    __device__ __forceinline__ void operator()(f32x4 (&acc)[2][2][4][2], const Unit& u, int wr, int wc, int fr, int fq) const {
        const int row0 = u.pm * BM + wr * 64 + fr, col0 = u.pn * BM + wc * 32 + 8 * fq; const int nb = u.aux;
#pragma unroll
        for (int ai = 0; ai < 2; ++ai)
#pragma unroll
            for (int m = 0; m < 4; ++m) { const size_t row = (size_t)(row0 + ai * HALF + m * 16);
#pragma unroll
                for (int bj = 0; bj < 2; ++bj) { const int col = col0 + bj * HALF; const PG8_GAS bf16_t* gp = G + row * ldg + nb * 1024 + col;
                    const u32x4 g0 = *(const PG8_GAS u32x4*)gp; float f[8] = {bflo(g0.x), bfhi(g0.x), bflo(g0.y), bfhi(g0.y), bflo(g0.z), bfhi(g0.z), bflo(g0.w), bfhi(g0.w)};
                    if (nb < 3) { const u32x4 g1 = *(const PG8_GAS u32x4*)(gp + 1024);
                        f[0] *= __builtin_amdgcn_rcpf(bflo(g1.x)); f[1] *= __builtin_amdgcn_rcpf(bfhi(g1.x)); f[2] *= __builtin_amdgcn_rcpf(bflo(g1.y)); f[3] *= __builtin_amdgcn_rcpf(bfhi(g1.y));
                        f[4] *= __builtin_amdgcn_rcpf(bflo(g1.z)); f[5] *= __builtin_amdgcn_rcpf(bfhi(g1.z)); f[6] *= __builtin_amdgcn_rcpf(bflo(g1.w)); f[7] *= __builtin_amdgcn_rcpf(bfhi(g1.w)); }
                    f32x4 v0 = acc[ai][bj][m][0], v1 = acc[ai][bj][m][1];
                    v0[0] *= f[0]; v0[1] *= f[1]; v0[2] *= f[2]; v0[3] *= f[3]; v1[0] *= f[4]; v1[1] *= f[5]; v1[2] *= f[6]; v1[3] *= f[7];
                    if (nb < 3) { acc[ai][bj][m][0] = v0; acc[ai][bj][m][1] = v1; }
                    else { u32x4 w; w.x = cvt_pk_bf16(v0[0], v0[1]); w.y = cvt_pk_bf16(v0[2], v0[3]); w.z = cvt_pk_bf16(v1[0], v1[1]); w.w = cvt_pk_bf16(v1[2], v1[3]);
                        *(PG8_GAS u32x4*)(O + row * ldc + col) = w; acc[ai][bj][m][0] = (f32x4){0.f, 0.f, 0.f, 0.f}; acc[ai][bj][m][1] = (f32x4){0.f, 0.f, 0.f, 0.f}; } } }
    }
};
struct EpiRes {
    static constexpr bool PERM = false, KEEP = false;
    const PG8_GAS float* base_lat; const PG8_GAS float* base_ctx; PG8_GAS float* out_lat; PG8_GAS float* out_ctx; const PG8_GAS float* gmod;
    __device__ __forceinline__ void operator()(f32x4 (&acc)[2][2][4][2], const Unit& u, int wr, int wc, int fr, int fq) const {
        const int b = u.pm / 17, j = u.pm % 17;
        const size_t ro = (j < 16) ? ((size_t)b * 4096 + (size_t)j * 256) * 1024 : (size_t)b * 256 * 1024;
        const PG8_GAS float* bp = ((j < 16) ? base_lat : base_ctx) + ro; PG8_GAS float* op = ((j < 16) ? out_lat : out_ctx) + ro; const PG8_GAS float* gv = gmod + ((j < 16) ? b : 4) * 6144;
        const int col0 = u.pn * BM + wc * 32 + 4 * fq;
#pragma unroll
        for (int bj = 0; bj < 2; ++bj)
#pragma unroll
            for (int n = 0; n < 2; ++n) { const int col = col0 + bj * HALF + n * 16; const f32x4 g = *(const PG8_GAS f32x4*)(gv + col);
#pragma unroll
                for (int ai = 0; ai < 2; ++ai)
#pragma unroll
                    for (int m = 0; m < 4; ++m) { const size_t off = (size_t)(ai * HALF + wr * 64 + m * 16 + fr) * 1024 + col;
                        const f32x4 bs = *(const PG8_GAS f32x4*)(bp + off); *(PG8_GAS f32x4*)(op + off) = bs + g * acc[ai][bj][m][n]; } }
    }
};
struct EpiGU {
    static constexpr bool PERM = true, KEEP = false;
    PG8_GAS bf16_t* O; int ldc;
    __device__ __forceinline__ void operator()(f32x4 (&acc)[2][2][4][2], const Unit& u, int wr, int wc, int fr, int fq) const {
        const int row0 = u.pm * BM + wr * 64 + fr, col0 = u.pn * HALF + wc * 32 + 8 * fq;
#pragma unroll
        for (int ai = 0; ai < 2; ++ai)
#pragma unroll
            for (int m = 0; m < 4; ++m) { float o[8];
#pragma unroll
                for (int n = 0; n < 2; ++n)
#pragma unroll
                    for (int k = 0; k < 4; ++k) { const float a = acc[ai][0][m][n][k], b = acc[ai][1][m][n][k]; o[n * 4 + k] = a * fast_sigmoid(a) * b; }
                u32x4 w; w.x = cvt_pk_bf16(o[0], o[1]); w.y = cvt_pk_bf16(o[2], o[3]); w.z = cvt_pk_bf16(o[4], o[5]); w.w = cvt_pk_bf16(o[6], o[7]);
                *(PG8_GAS u32x4*)(O + (size_t)(row0 + ai * HALF + m * 16) * ldc + col0) = w; }
    }
};

template <class Epi, class Sched, bool ALIGN_EPI>
__device__ __forceinline__ void gemm_phase(PG8_LAS unsigned char* lds, int tid, const PG8_GAS bf16_t* A, const PG8_GAS bf16_t* Bt, int lda, int ldb, int K, const Sched& S, const Epi& E) {
    const int wid = __builtin_amdgcn_readfirstlane(tid >> 6), lane = tid & 63, wr = wid >> 2, wc = wid & 3, fr = lane & 15, fq = lane >> 4;
    const int nt = K / BK;
    unsigned voffA[2], voffB[2];
#pragma unroll
    for (int i = 0; i < 2; ++i) { int R, C; stage_rc(tid * 16 + i * 8192, R, C); const int Rb = Epi::PERM ? ((R & ~31) + perm32(R & 31)) : R;
        voffA[i] = (unsigned)(R * lda + C) * 2u; voffB[i] = (unsigned)(Rb * ldb + C) * 2u; }
    const size_t kstep = (size_t)(BK * 2);
    const size_t hstepA = (size_t)HALF * lda * 2, hstepB = (size_t)HALF * ldb * 2;
    const unsigned ldsw = (unsigned)wid * 1024u;
    const int aoff = lds_byte(wr * 64 + fr, fq * 8), boff = lds_byte(wc * 32 + fr, fq * 8);
#define PG8_SA(b, h) (((b) * 2 + (h)) * HTB)
#define PG8_SB(b, h) ((4 + (b) * 2 + (h)) * HTB)
#define PG8_STAGE(bufoff, gbase, voff) do { _Pragma("unroll") for (int _i = 0; _i < 2; ++_i) \
        __builtin_amdgcn_global_load_lds((const PG8_GAS unsigned*)((const PG8_GAS char*)(gbase) + (voff)[_i]), (PG8_LAS unsigned*)(lds + (bufoff) + ldsw + _i * 8192), 16, 0, 0); } while (0)
#define PG8_LDA(dst, b, h) do { _Pragma("unroll") for (int m = 0; m < 4; ++m) _Pragma("unroll") for (int k = 0; k < 2; ++k) dst[m][k] = *(const PG8_LAS bf16x8*)(lds + PG8_SA(b, h) + aoff + m * 2048 + k * 1024); } while (0)
#define PG8_LDB(dst, b, h) do { _Pragma("unroll") for (int n = 0; n < 2; ++n) _Pragma("unroll") for (int k = 0; k < 2; ++k) dst[n][k] = *(const PG8_LAS bf16x8*)(lds + PG8_SB(b, h) + boff + n * 2048 + k * 1024); } while (0)
#define PG8_MMA(ai, bj, At, Bt_) do { __builtin_amdgcn_s_setprio(1); _Pragma("unroll") for (int m = 0; m < 4; ++m) _Pragma("unroll") for (int n = 0; n < 2; ++n) _Pragma("unroll") for (int k = 0; k < 2; ++k) \
        acc[ai][bj][m][n] = __builtin_amdgcn_mfma_f32_16x16x32_bf16(Bt_[n][k], At[m][k], acc[ai][bj][m][n], 0, 0, 0); __builtin_amdgcn_s_setprio(0); } while (0)
#define PG8_WAIT_V(n) asm volatile("s_waitcnt vmcnt(" #n ")" ::: "memory")
#define PG8_WAIT_L(n) asm volatile("s_waitcnt lgkmcnt(" #n ")" ::: "memory")
#define PG8_BAR __builtin_amdgcn_s_barrier()
#define PG8_SCHED __builtin_amdgcn_sched_barrier(0)
    Unit cur, nxt; int ui = 0;
    if (!S.next(0, cur)) return;
    f32x4 acc[2][2][4][2];
#pragma unroll
    for (int a = 0; a < 2; ++a)
#pragma unroll
        for (int b = 0; b < 2; ++b)
#pragma unroll
            for (int m = 0; m < 4; ++m)
#pragma unroll
                for (int n = 0; n < 2; ++n) acc[a][b][m][n] = (f32x4){0.f, 0.f, 0.f, 0.f};
    bf16x8 At[4][2], B0[2][2], B1[2][2];
    const PG8_GAS char* cA = (const PG8_GAS char*)A + cur.aoff; const PG8_GAS char* cB = (const PG8_GAS char*)Bt + cur.boff;
    PG8_STAGE(PG8_SB(0, 0), cB, voffB); PG8_STAGE(PG8_SB(0, 1), cB + hstepB, voffB); PG8_STAGE(PG8_SA(0, 0), cA, voffA); PG8_STAGE(PG8_SA(0, 1), cA + hstepA, voffA);
    if (wr == 1) PG8_BAR;
    PG8_WAIT_V(2); PG8_BAR;
    PG8_STAGE(PG8_SB(1, 0), cB + kstep, voffB); PG8_STAGE(PG8_SA(1, 0), cA + kstep, voffA); PG8_STAGE(PG8_SB(1, 1), cB + hstepB + kstep, voffB);
    PG8_WAIT_V(6); PG8_BAR;
    for (;;) {
        const bool has_next = S.next(ui + 1, nxt);
        const PG8_GAS char* nA = has_next ? (const PG8_GAS char*)A + nxt.aoff : cA; const PG8_GAS char* nB = has_next ? (const PG8_GAS char*)Bt + nxt.boff : cB;
        for (int t = 0; t < nt; t += 2) {
            const bool last = (t == nt - 2);
            const PG8_GAS char* a1 = cA + (size_t)(t + 1) * kstep;
            const PG8_GAS char* a2 = last ? nA : cA + (size_t)(t + 2) * kstep; const PG8_GAS char* b2 = last ? nB : cB + (size_t)(t + 2) * kstep;
            const PG8_GAS char* a3 = a2 + kstep; const PG8_GAS char* b3 = b2 + kstep;
            PG8_LDB(B0, 0, 0); PG8_LDB(B1, 0, 1); PG8_SCHED; PG8_LDA(At, 0, 0); PG8_STAGE(PG8_SA(1, 1), a1 + hstepA, voffA);
            PG8_WAIT_V(8); PG8_WAIT_L(0); PG8_BAR; PG8_MMA(0, 0, At, B0); PG8_MMA(0, 1, At, B1); PG8_BAR; PG8_SCHED;
            PG8_LDA(At, 0, 1); PG8_STAGE(PG8_SB(0, 0), b2, voffB); PG8_STAGE(PG8_SB(0, 1), b2 + hstepB, voffB); PG8_STAGE(PG8_SA(0, 0), a2, voffA);
            PG8_WAIT_V(8); PG8_WAIT_L(0); PG8_BAR; PG8_MMA(1, 0, At, B0); PG8_MMA(1, 1, At, B1); PG8_BAR; PG8_SCHED;
            PG8_LDB(B0, 1, 0); PG8_LDB(B1, 1, 1); PG8_SCHED; PG8_LDA(At, 1, 0); PG8_STAGE(PG8_SA(0, 1), a2 + hstepA, voffA);
            PG8_WAIT_V(8); PG8_WAIT_L(0); PG8_BAR; PG8_MMA(0, 0, At, B0); PG8_MMA(0, 1, At, B1); PG8_BAR; PG8_SCHED;
            PG8_LDA(At, 1, 1); PG8_STAGE(PG8_SB(1, 0), b3, voffB); PG8_STAGE(PG8_SB(1, 1), b3 + hstepB, voffB); PG8_STAGE(PG8_SA(1, 0), a3, voffA);
            PG8_WAIT_V(8); PG8_WAIT_L(0); PG8_BAR; PG8_MMA(1, 0, At, B0); PG8_MMA(1, 1, At, B1); PG8_BAR; PG8_SCHED;
        }
        if constexpr (ALIGN_EPI) { if (wr == 0) PG8_BAR; }
        E(acc, cur, wr, wc, fr, fq);
        if (!has_next) break;
        if constexpr (!Epi::KEEP) {
#pragma unroll
            for (int a = 0; a < 2; ++a)
#pragma unroll
                for (int b = 0; b < 2; ++b)
#pragma unroll
                    for (int m = 0; m < 4; ++m)
#pragma unroll
                        for (int n = 0; n < 2; ++n) acc[a][b][m][n] = (f32x4){0.f, 0.f, 0.f, 0.f};
        }
        cur = nxt; cA = nA; cB = nB; ++ui;
        if constexpr (ALIGN_EPI) { if (wr == 1) PG8_BAR; }
    }
    PG8_WAIT_V(0);
    if constexpr (!ALIGN_EPI) { if (wr == 0) PG8_BAR; }
    PG8_BAR;
#undef PG8_SA
#undef PG8_SB
#undef PG8_STAGE
#undef PG8_LDA
#undef PG8_LDB
#undef PG8_MMA
#undef PG8_WAIT_V
#undef PG8_WAIT_L
#undef PG8_BAR
#undef PG8_SCHED
}
}
namespace attn_body {
using bf16=__hip_bfloat16;
using bf16x8=__attribute__((ext_vector_type(8)))short;
using s16x4=__attribute__((ext_vector_type(4)))short;
using f32x16=__attribute__((ext_vector_type(16)))float;
using u32x4=__attribute__((ext_vector_type(4)))unsigned;
constexpr int D=64;
constexpr int QP=8448,KP=8448,VP=8448,OP=2048;
constexpr int NW=8,QBLK=32,QB=QBLK*NW,KVBLK=64;
__device__ __forceinline__ int crow(int r,int hi){return (r&3)+8*(r>>2)+4*hi;}
#define SBAR() __builtin_amdgcn_sched_barrier(0)
#define AGAS __attribute__((address_space(1)))
constexpr int NSLOT=3, SLOTB=8192;
constexpr int LDS_K=0, LDS_V=NSLOT*SLOTB, LDS_WS=2*NSLOT*SLOTB, LDS_OST=LDS_WS+NW*64*4, LDS_BIAS=LDS_OST+NW*4096, LDS_BYTES=LDS_BIAS+8192;
constexpr float C2=0.125f*1.4426950408889634f;
__device__ __forceinline__ void glds16(const AGAS void*gsrc,unsigned lds_dst){unsigned keep;
  asm volatile("s_mov_b32 %0, m0\n\ts_mov_b32 m0, %2\n\ts_nop 0\n\tglobal_load_lds_dwordx4 %1, off\n\ts_mov_b32 m0, %0":"=&s"(keep):"v"(gsrc),"s"(lds_dst):"memory");}
__device__ __forceinline__ float max3f(float a,float b,float c){float r;asm("v_max3_f32 %0, %1, %2, %3":"=v"(r):"v"(a),"v"(b),"v"(c));return r;}
__device__ __forceinline__ float max2f(float a,float b){float r;asm("v_max_f32_e32 %0, %1, %2":"=v"(r):"v"(a),"v"(b));return r;}
__device__ __forceinline__ float fadd_s(float a,float b){float r;asm("v_add_f32_e32 %0, %1, %2":"=v"(r):"v"(a),"v"(b));return r;}
__device__ __forceinline__ float fsub_s(float a,float b){float r;asm("v_sub_f32_e32 %0, %1, %2":"=v"(r):"v"(a),"v"(b));return r;}
typedef float f32x2_t __attribute__((ext_vector_type(2))); typedef __bf16 bf16x2_t __attribute__((ext_vector_type(2)));
__device__ __forceinline__ unsigned cvtpk_s(float lo,float hi){f32x2_t v={lo,hi};bf16x2_t b=__builtin_convertvector(v,bf16x2_t);return __builtin_bit_cast(unsigned,b);}
#define WAIT_BAR(N) asm volatile("s_waitcnt vmcnt(" #N ") lgkmcnt(0)\n\ts_barrier":::"memory")

__device__ __forceinline__ void qkt(f32x16&p0,f32x16&p1,const char*Kslot,const bf16x8*qr,const f32x16&negm,int r32,int hi){
  const char*kb=Kslot+hi*1024+r32*16;
  #pragma unroll
  for(int d0=0;d0<4;++d0){
    const bf16x8 b0=*reinterpret_cast<const bf16x8*>(kb+d0*2048);
    const bf16x8 b1=*reinterpret_cast<const bf16x8*>(kb+d0*2048+512);
    if(d0==0){p0=__builtin_amdgcn_mfma_f32_32x32x16_bf16(b0,qr[0],negm,0,0,0);p1=__builtin_amdgcn_mfma_f32_32x32x16_bf16(b1,qr[0],negm,0,0,0);}
    else{p0=__builtin_amdgcn_mfma_f32_32x32x16_bf16(b0,qr[d0],p0,0,0,0);p1=__builtin_amdgcn_mfma_f32_32x32x16_bf16(b1,qr[d0],p1,0,0,0);}}
}
typedef __attribute__((address_space(3))) const char* lds_cptr;
typedef __attribute__((address_space(3))) const float* lds_fptr;
typedef short v4i16_t __attribute__((ext_vector_type(4)));
__device__ __forceinline__ void kload8(bf16x8*kf,lds_cptr kp){
  kf[0]=*(const __attribute__((address_space(3))) bf16x8*)(kp);      kf[1]=*(const __attribute__((address_space(3))) bf16x8*)(kp+512);
  kf[2]=*(const __attribute__((address_space(3))) bf16x8*)(kp+2048); kf[3]=*(const __attribute__((address_space(3))) bf16x8*)(kp+2560);
  kf[4]=*(const __attribute__((address_space(3))) bf16x8*)(kp+4096); kf[5]=*(const __attribute__((address_space(3))) bf16x8*)(kp+4608);
  kf[6]=*(const __attribute__((address_space(3))) bf16x8*)(kp+6144); kf[7]=*(const __attribute__((address_space(3))) bf16x8*)(kp+6656);
}
__device__ __forceinline__ void kload2(bf16x8*kf,lds_cptr kp,int j){ kf[2*j]=*(const __attribute__((address_space(3))) bf16x8*)(kp+j*2048); kf[2*j+1]=*(const __attribute__((address_space(3))) bf16x8*)(kp+j*2048+512); }
__device__ __forceinline__ s16x4 vtr(lds_cptr p){ return __builtin_bit_cast(s16x4,__builtin_amdgcn_ds_read_tr16_b64_v4i16((__attribute__((address_space(3))) v4i16_t*)p)); }
__device__ __forceinline__ float rowmax(const f32x16&p0,const f32x16&p1){
  float a=max3f(p0[0],p0[1],p1[0]),b=max3f(p0[2],p0[3],p1[1]);a=max3f(a,p1[2],p1[3]);
  #pragma unroll
  for(int r=4;r<16;r+=4){a=max3f(a,p0[r],p0[r+1]);b=max3f(b,p0[r+2],p0[r+3]);a=max3f(a,p1[r],p1[r+1]);b=max3f(b,p1[r+2],p1[r+3]);}
  const float m=max2f(a,b);
  auto rr=__builtin_amdgcn_permlane32_swap(__float_as_uint(m),__float_as_uint(m),false,false);
  return max2f(__uint_as_float(rr[0]),__uint_as_float(rr[1]));
}
__device__ __forceinline__ void pv(f32x16*o,int vb,bf16x8 pa0,bf16x8 pa1,bf16x8 pa2,bf16x8 pa3){
  #pragma unroll
  for(int d0=0;d0<2;++d0){s16x4 lo[4],hi[4];
    #pragma unroll
    for(int ks=0;ks<4;++ks){
      asm volatile("ds_read_b64_tr_b16 %0,%1 offset:%c2":"=&v"(lo[ks]):"v"(vb),"i"(d0*4096+ks*1024):"memory");
      asm volatile("ds_read_b64_tr_b16 %0,%1 offset:%c2":"=&v"(hi[ks]):"v"(vb),"i"(d0*4096+ks*1024+512):"memory");}
    asm volatile("s_waitcnt lgkmcnt(0)":::"memory");SBAR();
    #define PK(k) (bf16x8){lo[k][0],lo[k][1],lo[k][2],lo[k][3],hi[k][0],hi[k][1],hi[k][2],hi[k][3]}
    o[d0]=__builtin_amdgcn_mfma_f32_32x32x16_bf16(pa0,PK(0),o[d0],0,0,0);
    o[d0]=__builtin_amdgcn_mfma_f32_32x32x16_bf16(pa1,PK(1),o[d0],0,0,0);
    o[d0]=__builtin_amdgcn_mfma_f32_32x32x16_bf16(pa2,PK(2),o[d0],0,0,0);
    o[d0]=__builtin_amdgcn_mfma_f32_32x32x16_bf16(pa3,PK(3),o[d0],0,0,0);
    #undef PK
  }
}
__device__ __forceinline__ void namask(f32x16&p0,f32x16&p1,int kr,int qr,unsigned wlo,unsigned whi,lds_fptr brow0,float mh){
  const float BIG=1e30f;
  int r0=qr-4; r0=r0<0?0:(r0>56?56:r0);
  if(kr<r0||kr>=r0+8){
    #pragma unroll
    for(int r=0;r<16;++r){p0[r]=-BIG;p1[r]=-BIG;}
    return; }
  const lds_fptr brow=brow0+(kr-qr+7)*128;
  asm volatile("":"+v"(wlo),"+v"(whi));
  #pragma unroll
  for(int r=0;r<16;++r){
    const int pos=(r&3)+8*(r>>2);
    const float b0=brow[pos]-mh, b1=brow[pos+32]-mh;
    const float f0=(float)((wlo>>pos)&1u), f1=(float)((whi>>pos)&1u);
    p0[r]=(p0[r]+b0)+__builtin_fmaf(f0,BIG,-BIG); p1[r]=(p1[r]+b1)+__builtin_fmaf(f1,BIG,-BIG);
    if((r&3)==3) __builtin_amdgcn_sched_barrier(0); }
}
struct AttnArgs { const AGAS bf16* Q; const AGAS bf16* K; const AGAS bf16* V; AGAS bf16* O; int kr0, kr1, tsw, NT; int qrow0, rb0; const AGAS float* rpb; };
#define ATTN_STORE16(p,v) (*(AGAS u32x4*)(p)=(v))
template<int THRL,bool MASKED> __device__ __forceinline__ void attn_unit(const AttnArgs&a,char*shm,int tid){
  const int lane=tid&63,r32=lane&31,hi=lane>>5; const int wid=__builtin_amdgcn_readfirstlane(tid>>6);
  const AGAS bf16*Qw=a.Q+(long)(wid*QBLK)*QP;
  const AGAS bf16*Kh=a.K,*Vh=a.V;
  const unsigned lds0=(unsigned)(uintptr_t)shm;
  float*wsf=(float*)(shm+LDS_WS)+wid*64;
  const AGAS bf16*ksrc=Kh+(long)lane*KP+wid*8;
  const AGAS bf16*vsrc=Vh+(long)(16*(wid&3)+(lane>>2))*VP+(wid>>2)*32+(lane&3)*8;
  const unsigned kdst=lds0+LDS_K+wid*1024, vdst=lds0+LDS_V+wid*1024;
  const int kr0=a.kr0,kr1=a.kr1,tsw=a.tsw;
  #define KROW(t) ((t)<tsw?kr0+64*(t):kr1+64*((t)-tsw))
  #define DMA_K(t,slot) glds16(ksrc+(long)KROW(t)*KP,(unsigned)__builtin_amdgcn_readfirstlane(kdst+(slot)))
  #define DMA_V(t,slot) glds16(vsrc+(long)KROW(t)*VP,(unsigned)__builtin_amdgcn_readfirstlane(vdst+(slot)))
  const int vb0=(int)(lds0+LDS_V)+((lane>>4)&1)*32+(lane&3)*8+(4*hi+((lane&15)>>2))*64;
  const char*Kbase=shm+LDS_K; bf16x8 kf[8];
  const lds_cptr shm3=(lds_cptr)shm; const lds_cptr kp0=shm3+LDS_K+hi*1024+r32*16; const lds_cptr vp0=shm3+LDS_V+((lane>>4)&1)*32+(lane&3)*8+(4*hi+((lane&15)>>2))*64;
  const lds_fptr biasl=(lds_fptr)(shm3+LDS_BIAS);
  const int NT=a.NT;
  if constexpr(MASKED){ __attribute__((address_space(3))) float* bt=(__attribute__((address_space(3))) float*)(shm3+LDS_BIAS);
    for(int i_=tid;i_<15*128;i_+=512){ const int ri=i_>>7, dc=(i_&127)-48; bt[i_]=(dc>=0&&dc<31)?a.rpb[ri*31+dc]*1.4426950408889634f:0.f; } }
  const int qgr=a.qrow0+(wid>>1), qgc=(wid&1)*32+r32, rb0=a.rb0;
  unsigned wlo=0u,whi=0u; lds_fptr brow0=biasl;
  if constexpr(MASKED){ int cs=qgc-8; cs=cs<0?0:(cs>48?48:cs); const unsigned long long cm=(0xFFFFull<<cs)>>(4*hi); wlo=(unsigned)cm; whi=(unsigned)(cm>>32); brow0=biasl+(4*hi-qgc+63); }
  DMA_K(0,0);DMA_V(0,0);DMA_K(1,SLOTB);
  bf16x8 qr[4];
  #pragma unroll
  for(int d0=0;d0<4;++d0)qr[d0]=*(const AGAS bf16x8*)(&Qw[(long)r32*QP+d0*16+hi*8]);
  float zf_=0.f; asm volatile("":"+v"(zf_)); float mhat=zf_,l_reg=zf_;f32x16 o[2],negm; _Pragma("unroll") for(int r=0;r<16;++r){o[0][r]=zf_;o[1][r]=zf_;negm[r]=zf_;} if constexpr(!MASKED){asm volatile("":"+v"(negm));} const f32x16 zc=f32x16{};
  #define CMASK(P0,P1,t) do{ if constexpr(MASKED){ if((t)>=4) namask(P0,P1,rb0+(t)-4,qgr,wlo,whi,brow0,mhat); else { _Pragma("unroll") for(int r_=0;r_<16;++r_){P0[r_]-=mhat;P1[r_]-=mhat;} } } }while(0)
  bool resc=false;
  #define START(P0,P1) do{ const float rm=rowmax(P0,P1); resc=false; \
    { const float dl=rm; mhat=fadd_s(mhat,dl); \
      _Pragma("unroll") for(int r=0;r<16;++r){P0[r]=fsub_s(P0[r],dl);P1[r]=fsub_s(P1[r],dl);} \
      if constexpr(!MASKED){ _Pragma("unroll") for(int r=0;r<16;++r)negm[r]=-mhat; asm volatile("":"+v"(negm)); } } \
    _Pragma("unroll") for(int r=0;r<16;++r)P0[r]=__builtin_amdgcn_exp2f(P0[r]); }while(0)
  #define RESC() do{ if(resc){ asm volatile("s_waitcnt lgkmcnt(0)":::"memory"); \
      _Pragma("unroll") for(int d_=0;d_<2;++d_) _Pragma("unroll") for(int r=0;r<16;++r)o[d_][r]*=wsf[crow(r,hi)]; } }while(0)
  f32x16 pA0,pA1,pB0,pB1;
  int sl_prev=0,sl_cur=0,sl_next=SLOTB;
  #define ROT() do{sl_prev=sl_cur;sl_cur=sl_next;sl_next=(sl_next==(NSLOT-1)*SLOTB)?0:sl_next+SLOTB;}while(0)
  DMA_K(2,2*SLOTB);
  WAIT_BAR(3);
  qkt(pA0,pA1,Kbase,qr,zc,r32,hi);asm volatile("s_nop 15\n\ts_nop 7":"+v"(pA0),"+v"(pA1));
  START(pA0,pA1);
  _Pragma("unroll") for(int r=0;r<16;++r)pA1[r]=__builtin_amdgcn_exp2f(pA1[r]);
  WAIT_BAR(0);
  DMA_K(3,0);DMA_V(1,SLOTB);
  ROT();
  kload8(kf,kp0+sl_cur);
  WAIT_BAR(2);
  s16x4 vlo[8],vhi[8]; u32x4 pw0,pw1,pw2,pw3;
  #define PKW(P,B) cvtpk_s(P[B],P[B+1])
  #define PAF(k) __builtin_bit_cast(bf16x8,pw##k)
  #define VFR(i) (bf16x8){vlo[i][0],vlo[i][1],vlo[i][2],vlo[i][3],vhi[i][0],vhi[i][1],vhi[i][2],vhi[i][3]}
  #define PIN(x) asm volatile("":"+v"(x))
  #define MX3(a,b,c) __builtin_fmaxf(__builtin_fmaxf((a),(b)),(c))
  #define GAPA(MF,A0,A1,A2,A3,W0,W1,PW) do{ MF; sacc+=A0; sacc+=A1; sacc+=A2; sacc+=A3; PIN(sacc); W0; W1; PIN(PW); SBAR(); }while(0)
  #define EX(v) __builtin_amdgcn_exp2f(v)
  #define GAPB(MF,X,B) do{ MF; X[B]=EX(X[B]); X[B+1]=EX(X[B+1]); X[B+2]=EX(X[B+2]); X[B+3]=EX(X[B+3]); PIN(X); SBAR(); }while(0)
  #define VRD(i) do{ vlo[i]=vtr(vp_+(((i)>>2)*4096+((i)&3)*1024)); vhi[i]=vtr(vp_+(((i)>>2)*4096+((i)&3)*1024+512)); }while(0)
  #define KRD(G,j) do{ if(G){ kload2(kf,kp0+sl_next,j); SBAR(); } }while(0)
  #define STEP(C0,C1,P0,P1,t,GK,GV,GL) do{ SBAR(); \
    const lds_cptr vp_=vp0+sl_prev; \
    VRD(0); SBAR(); float sacc=(P0[0]+P0[1]); \
    GAPA(C0=__builtin_amdgcn_mfma_f32_32x32x16_bf16(kf[0],qr[0],(MASKED?zc:negm),0,0,0), P0[2],P0[3],P0[4],P0[5],     pw0[0]=PKW(P0,0), pw0[1]=PKW(P0,2), pw0); \
    VRD(4); SBAR(); GAPA(C1=__builtin_amdgcn_mfma_f32_32x32x16_bf16(kf[1],qr[0],(MASKED?zc:negm),0,0,0), P0[6],P0[7],P0[8],P0[9],     pw0[2]=PKW(P0,4), pw0[3]=PKW(P0,6), pw0); \
    VRD(1); SBAR(); GAPA(C0=__builtin_amdgcn_mfma_f32_32x32x16_bf16(kf[2],qr[1],C0,0,0,0),   P0[10],P0[11],P0[12],P0[13], pw1[0]=PKW(P0,8), pw1[1]=PKW(P0,10), pw1); \
    VRD(5); SBAR(); GAPA(C1=__builtin_amdgcn_mfma_f32_32x32x16_bf16(kf[3],qr[1],C1,0,0,0),   P0[14],P0[15],P1[0],P1[1],   pw1[2]=PKW(P0,12),pw1[3]=PKW(P0,14), pw1); \
    VRD(2); SBAR(); GAPA(C0=__builtin_amdgcn_mfma_f32_32x32x16_bf16(kf[4],qr[2],C0,0,0,0),   P1[2],P1[3],P1[4],P1[5],     pw2[0]=PKW(P1,0), pw2[1]=PKW(P1,2), pw2); \
    VRD(6); SBAR(); GAPA(C1=__builtin_amdgcn_mfma_f32_32x32x16_bf16(kf[5],qr[2],C1,0,0,0),   P1[6],P1[7],P1[8],P1[9],     pw2[2]=PKW(P1,4), pw2[3]=PKW(P1,6), pw2); \
    VRD(3); SBAR(); GAPA(C0=__builtin_amdgcn_mfma_f32_32x32x16_bf16(kf[6],qr[3],C0,0,0,0),   P1[10],P1[11],P1[12],P1[13], pw3[0]=PKW(P1,8), pw3[1]=PKW(P1,10), pw3); \
    VRD(7); SBAR(); GAPA(C1=__builtin_amdgcn_mfma_f32_32x32x16_bf16(kf[7],qr[3],C1,0,0,0),   P1[14],P1[15],0.f,0.f,       pw3[2]=PKW(P1,12),pw3[3]=PKW(P1,14), pw3); \
    l_reg+=sacc; \
    if(GK){DMA_K((t)+3,sl_cur);} if(GV){DMA_V((t)+1,sl_next);} \
    CMASK(C0,C1,t); \
    { float a_=MX3(C0[0],C0[1],C1[0]),b_=MX3(C0[2],C0[3],C1[1]); a_=MX3(a_,C1[2],C1[3]); \
      _Pragma("unroll") for(int r=4;r<16;r+=4){a_=MX3(a_,C0[r],C0[r+1]);b_=MX3(b_,C0[r+2],C0[r+3]);a_=MX3(a_,C1[r],C1[r+1]);b_=MX3(b_,C1[r+2],C1[r+3]);} \
      float rm=__builtin_fmaxf(a_,b_); { auto rr=__builtin_amdgcn_permlane32_swap(__float_as_uint(rm),__float_as_uint(rm),false,false); rm=__builtin_fmaxf(__uint_as_float(rr[0]),__uint_as_float(rr[1])); } \
      resc=false; \
      if(__builtin_expect(__any(rm>(float)THRL),0)){ const float dl=__builtin_fmaxf(rm,0.f); mhat+=dl; \
        _Pragma("unroll") for(int r=0;r<16;++r){C0[r]-=dl;C1[r]-=dl;} \
        if constexpr(!MASKED){ _Pragma("unroll") for(int r=0;r<16;++r)negm[r]=-mhat; asm volatile("":"+v"(negm)); } \
        const float f=__builtin_amdgcn_exp2f(-dl); l_reg*=f; if(hi==0)wsf[r32]=f; resc=true; } } \
    SBAR(); \
    GAPB(o[0]=__builtin_amdgcn_mfma_f32_32x32x16_bf16(PAF(0),VFR(0),o[0],0,0,0), C0,0); \
    GAPB(o[1]=__builtin_amdgcn_mfma_f32_32x32x16_bf16(PAF(0),VFR(4),o[1],0,0,0), C0,4); \
    KRD(GL,0); GAPB(o[0]=__builtin_amdgcn_mfma_f32_32x32x16_bf16(PAF(1),VFR(1),o[0],0,0,0), C0,8); \
    KRD(GL,1); GAPB(o[1]=__builtin_amdgcn_mfma_f32_32x32x16_bf16(PAF(1),VFR(5),o[1],0,0,0), C0,12); \
    KRD(GL,2); GAPB(o[0]=__builtin_amdgcn_mfma_f32_32x32x16_bf16(PAF(2),VFR(2),o[0],0,0,0), C1,0); \
    KRD(GL,3); GAPB(o[1]=__builtin_amdgcn_mfma_f32_32x32x16_bf16(PAF(2),VFR(6),o[1],0,0,0), C1,4); \
    GAPB(o[0]=__builtin_amdgcn_mfma_f32_32x32x16_bf16(PAF(3),VFR(3),o[0],0,0,0), C1,8); \
    GAPB(o[1]=__builtin_amdgcn_mfma_f32_32x32x16_bf16(PAF(3),VFR(7),o[1],0,0,0), C1,12); \
    }while(0)
  int t=1;
  for(;t+5<NT;t+=2){
    STEP(pB0,pB1,pA0,pA1,t,true,true,true);     WAIT_BAR(2); RESC(); ROT();
    STEP(pA0,pA1,pB0,pB1,t+1,true,true,true);   WAIT_BAR(2); RESC(); ROT();
  }
  #define ENDW(tt) do{ if((tt)+3<NT){WAIT_BAR(2);} else if((tt)+2<NT){WAIT_BAR(1);} else {WAIT_BAR(0);} }while(0)
  for(;t+1<NT;t+=2){
    STEP(pB0,pB1,pA0,pA1,t,(t+3<NT),(t+1<NT),(t+1<NT));       ENDW(t);   RESC(); ROT();
    STEP(pA0,pA1,pB0,pB1,t+1,(t+4<NT),(t+2<NT),(t+2<NT));     ENDW(t+1); RESC(); ROT();
  }
  STEP(pB0,pB1,pA0,pA1,NT-1,false,false,false); RESC();
  { float sacc=pB0[0]+pB0[1]; _Pragma("unroll") for(int r=2;r<16;++r)sacc+=pB0[r]; _Pragma("unroll") for(int r=0;r<16;++r)sacc+=pB1[r]; l_reg+=sacc;
    pw0=(u32x4){PKW(pB0,0),PKW(pB0,2),PKW(pB0,4),PKW(pB0,6)};pw1=(u32x4){PKW(pB0,8),PKW(pB0,10),PKW(pB0,12),PKW(pB0,14)};pw2=(u32x4){PKW(pB1,0),PKW(pB1,2),PKW(pB1,4),PKW(pB1,6)};pw3=(u32x4){PKW(pB1,8),PKW(pB1,10),PKW(pB1,12),PKW(pB1,14)};
    SBAR(); pv(o,vb0+sl_cur,PAF(0),PAF(1),PAF(2),PAF(3)); }
  #undef PKW
  #undef PAF
  #undef VFR
  #undef PIN
  #undef MX3
  #undef GAPA
  #undef GAPB
  #undef EX
  #undef VRD
  #undef KRD
  #undef STEP
  #undef ENDW
  {auto rr=__builtin_amdgcn_permlane32_swap(__float_as_uint(l_reg),__float_as_uint(l_reg),false,false);l_reg=__uint_as_float(rr[0])+__uint_as_float(rr[1]);}
  if(hi==0)wsf[32+r32]=l_reg;asm volatile("s_waitcnt lgkmcnt(0)":::"memory");
  float rli[16];
  #pragma unroll
  for(int r=0;r<16;++r)rli[r]=__builtin_amdgcn_rcpf(wsf[32+crow(r,hi)]);
  AGAS bf16*Ow=a.O+(long)(wid*QBLK)*OP;
  { bf16*stg=(bf16*)(shm+LDS_OST)+wid*2048;
    #pragma unroll
    for(int r=0;r<16;++r){const int orow=crow(r,hi);
      #pragma unroll
      for(int d0=0;d0<2;++d0)stg[orow*64+d0*32+r32]=__float2bfloat16(o[d0][r]*rli[r]);}
    asm volatile("s_waitcnt lgkmcnt(0)":::"memory");
    #pragma unroll
    for(int i=0;i<4;++i){const int row=i*8+(lane>>3),ch=lane&7; const u32x4 v=*(const u32x4*)(stg+row*64+ch*8); ATTN_STORE16(Ow+(long)row*OP+ch*8,v);} }
  asm volatile("s_waitcnt lgkmcnt(0)\n\ts_barrier":::"memory");
  #undef KROW
  #undef DMA_K
  #undef DMA_V
  #undef CMASK
  #undef START
  #undef RESC
  #undef ROT
}
#undef SBAR
#undef WAIT_BAR
}
constexpr int NWAVES = 8, NTHR = 512;
constexpr int DM = 1024, NBATCH = 4, SEQ = 4096, CTXL = 256, RPB = SEQ + CTXL  , MROWS = NBATCH * RPB  , NLAYER = 2;
constexpr int PW = 8448;
constexpr int C_GQ = 0, C_GK = 512, C_GV = 640, C_NQ = 768, C_NK = 1280, C_NV = 1792, C_F = 2304, C_CA = 3328, C_CB = 3840, C_G = 4352;
constexpr int YW = 2048;
constexpr int INW = 7936;
constexpr int NEXP = 16, EFF = 512, MOE_ROWS = 38912  ;
constexpr float EPS = 1e-6f, LOG2E = 1.4426950408889634f;
constexpr float QSCALE = 0.125f * LOG2E;
constexpr size_t MiB = 1u << 20;
constexpr size_t WS_CTL = 0, CTL_ZERO_BYTES = 1 * MiB;
constexpr size_t WS_MODV = 1 * MiB;
constexpr size_t WS_TOKE = 2 * MiB, WS_TOKW = WS_TOKE + 160 * 1024, WS_TOKR = WS_TOKW + 160 * 1024, WS_TOKS = WS_TOKR + 160 * 1024;
constexpr size_t WS_XC = 4 * MiB;
constexpr size_t WS_WIN = 8 * MiB;
constexpr size_t WS_WB = 25 * MiB;
constexpr size_t WS_WO = 29 * MiB;
constexpr size_t WS_WGU = 32 * MiB;
constexpr size_t WS_WD = 64 * MiB;
constexpr size_t WS_H = 80 * MiB;
constexpr size_t WS_Y = 114 * MiB;
constexpr size_t WS_TP = 182 * MiB;
constexpr size_t WS_P = 214 * MiB;
constexpr size_t WS_AM = WS_P, WS_HM = WS_P + 76 * MiB, WS_OM = WS_P + 114 * MiB;
constexpr size_t WS_END = 495 * MiB;
static_assert(WS_WIN + (size_t)PW * DM * 2 <= WS_WB && WS_P + (size_t)MROWS * PW * 2 <= WS_END && WS_OM + (size_t)MOE_ROWS * DM * 2 <= WS_END, "ws map");
constexpr int CW_BAR = 4096;
constexpr int CW_CNT = 16384;
constexpr int RING_OFF = 0, RING_BYTES = 131072;
constexpr int LDSCTL_OFF = RING_BYTES, MISC_OFF = LDSCTL_OFF + 320;
constexpr int LDS_BYTES = 147456;

#define GAS __attribute__((address_space(1)))
#define LAS __attribute__((address_space(3)))
typedef unsigned short bf16;
typedef unsigned v4u __attribute__((ext_vector_type(4)));
typedef unsigned v2u __attribute__((ext_vector_type(2)));
typedef float f32x4 __attribute__((ext_vector_type(4)));
typedef GAS unsigned gu32;
#define RLX_AGENT __ATOMIC_RELAXED, __HIP_MEMORY_SCOPE_AGENT
#define LDS_WAIT() asm volatile("s_waitcnt lgkmcnt(0)" ::: "memory")
__device__ __forceinline__ unsigned f2bf(float f) { unsigned u = __builtin_bit_cast(unsigned, f); return (u + 0x7fffu + ((u >> 16) & 1u)) >> 16; }
__device__ __forceinline__ unsigned pk2(float lo, float hi) { return f2bf(lo) | (f2bf(hi) << 16); }
__device__ __forceinline__ float bf_lo(unsigned w) { return __uint_as_float(w << 16); }
__device__ __forceinline__ float bf_hi(unsigned w) { return __uint_as_float(w & 0xffff0000u); }
__device__ __forceinline__ float bf1(bf16 v) { return __uint_as_float(((unsigned)v) << 16); }
__device__ __forceinline__ float sigm(float x) { return 1.0f / (1.0f + __expf(-x)); }

#define XB_TMO      128
#define XB_XCNT(j)  (256  + 64 * (j))
#define XB_XSUB(j)  (1280 + 64 * (j))
#define XB_XGEN(j)  (2304 + 64 * (j))
#define XB_TOP      3328
#define XB_TOPGEN   3392
#define XCD_BAR_WORDS 3456
#define XB_SPIN_CAP (1u << 18)
__device__ __forceinline__ unsigned xb_ld(unsigned* p)              { return __hip_atomic_load(p, __ATOMIC_RELAXED, __HIP_MEMORY_SCOPE_AGENT); }
__device__ __forceinline__ unsigned xb_add(unsigned* p, unsigned v) { return __hip_atomic_fetch_add(p, v, __ATOMIC_RELAXED, __HIP_MEMORY_SCOPE_AGENT); }
__device__ __forceinline__ unsigned xb_xcc_id() { return (unsigned)__builtin_amdgcn_s_getreg((3 << 11) | 20) & 0xFu; }
#define XB_SPIN(cond, bar) do { unsigned _sp = 0; while (cond) { __builtin_amdgcn_s_sleep(1); \
    if ((++_sp & 255u) == 0u) { if (xb_ld(&(bar)[XB_TMO])) break; if (_sp > XB_SPIN_CAP) { atomicAdd(&(bar)[XB_TMO], 1u); break; } } } } while (0)
struct XcdBarrier { unsigned* bar; unsigned x; volatile LAS unsigned* st; };
__device__ __forceinline__ XcdBarrier xcd_barrier_post(unsigned* bar, volatile LAS unsigned* st) {
    XcdBarrier b; b.bar = bar; b.x = xb_xcc_id(); b.st = st;
    if (threadIdx.x == 0) (void)xb_add(&bar[XB_XCNT(b.x)], 1u);
    return b;
}
__device__ __forceinline__ void xcd_barrier_complete(unsigned* bar, unsigned x, unsigned& nloc, unsigned& nx) {
    const unsigned G = gridDim.x * gridDim.y * gridDim.z;
    unsigned sum, cnt, mine, sp = 0u;
    for (;;) {
        sum = 0u; cnt = 0u; mine = 0u;
#pragma unroll
        for (unsigned j = 0; j < 16; ++j) { const unsigned c = xb_ld(&bar[XB_XCNT(j)]); sum += c; cnt += (c > 0u) ? 1u : 0u; mine = (j == x) ? c : mine; }
        if (sum == G) break;
        __builtin_amdgcn_s_sleep(1);
        if ((++sp & 255u) == 0u) { if (xb_ld(&bar[XB_TMO])) break; if (sp > XB_SPIN_CAP) { atomicAdd(&bar[XB_TMO], 1u); break; } }
    }
    nloc = mine > 0u ? mine : 1u; nx = cnt > 0u ? cnt : 1u;
}
__device__ __forceinline__ void xcd_barrier(const XcdBarrier& b) {
    asm volatile("s_waitcnt vmcnt(0)" ::: "memory");
    __syncthreads();
    if (threadIdx.x == 0) {
        unsigned* bar = b.bar;
        __builtin_amdgcn_s_waitcnt(0);
        unsigned nloc = b.st[0], nx = b.st[1];
        if (nloc == 0u) { xcd_barrier_complete(bar, b.x, nloc, nx); b.st[0] = nloc; b.st[1] = nx; }
        const unsigned old = xb_add(&bar[XB_XSUB(b.x)], 1u);
        const unsigned gen = old / nloc;
        if (old + 1u == (gen + 1u) * nloc) {
            __builtin_amdgcn_fence(__ATOMIC_RELEASE, "agent");
            asm volatile("s_waitcnt vmcnt(0)" ::: "memory");
            const unsigned og = xb_add(&bar[XB_TOP], 1u);
            const unsigned tg = og / nx;
            if (og + 1u == (tg + 1u) * nx) xb_add(&bar[XB_TOPGEN], 1u);
            else XB_SPIN(xb_ld(&bar[XB_TOPGEN]) == tg, bar);
            __builtin_amdgcn_fence(__ATOMIC_ACQUIRE, "agent");
            xb_add(&bar[XB_XGEN(b.x)], 1u);
            asm volatile("s_waitcnt vmcnt(0)" ::: "memory");
        } else {
            XB_SPIN(xb_ld(&bar[XB_XGEN(b.x)]) == gen, bar);
            __builtin_amdgcn_fence(__ATOMIC_ACQUIRE, "agent");
            asm volatile("s_waitcnt vmcnt(0)" ::: "memory");
        }
    }
    __syncthreads();
}

struct Frame {
    LAS unsigned char* lds; volatile LAS unsigned* MISC; LAS unsigned* LCTL;
    gu32* ctl; unsigned char* ws; GAS float* out; int tid, lane, wave, vcu, G;
};
constexpr int PTR_OFF = LDSCTL_OFF + 96;
__device__ __forceinline__ const GAS float* INP(const Frame& F, int i) {
    const LAS unsigned* t = (const LAS unsigned*)(F.lds + PTR_OFF) + 2 * i;
    const unsigned lo = __builtin_amdgcn_readfirstlane(t[0]), hi = __builtin_amdgcn_readfirstlane(t[1]);
    return (const GAS float*)(((unsigned long long)hi << 32) | lo);
}
__device__ __forceinline__ float shx(float v, int m, int lane) { return __builtin_bit_cast(float, __builtin_amdgcn_ds_bpermute((lane ^ m) << 2, __builtin_bit_cast(int, v))); }
__device__ __forceinline__ float wave_sum(float v, int lane) {
#pragma unroll
    for (int o = 1; o < 64; o <<= 1) v += shx(v, o, lane);
    return v;
}
__device__ __forceinline__ const GAS float* xrow_in(const Frame& F, int row) { const int b = row / RPB, t = row % RPB; return t < SEQ ? INP(F, 0) + ((size_t)b * SEQ + t) * DM : INP(F, 2) + ((size_t)b * CTXL + (t - SEQ)) * DM; }
__device__ __forceinline__ GAS float* xrow_ws(const Frame& F, int row) { const int b = row / RPB, t = row % RPB; return t < SEQ ? F.out + ((size_t)b * SEQ + t) * DM : ((GAS float*)(F.ws + WS_XC)) + ((size_t)b * CTXL + (t - SEQ)) * DM; }
__device__ __forceinline__ int modidx(int row) { const int b = row / RPB, t = row % RPB; return t < SEQ ? b : 4; }

__device__ __forceinline__ void tr_item(const GAS float* W, int ldw, int k0, int n0, GAS bf16* WT, int ldt, int drow0, int dcol0, LAS float* scr, int lane) {
#pragma unroll 8
    for (int i = 0; i < 32; ++i) { const int kk = 2 * i + (lane >> 5); scr[kk * 33 + (lane & 31)] = W[(size_t)(k0 + kk) * ldw + n0 + (lane & 31)]; }
    LDS_WAIT(); asm volatile("" ::: "memory");
    const int c = lane & 7;
#pragma unroll
    for (int j = 0; j < 4; ++j) { const int n = (lane >> 3) + 8 * j; const LAS float* s = scr + (8 * c) * 33 + n;
        v4u o; o.x = pk2(s[0 * 33], s[1 * 33]); o.y = pk2(s[2 * 33], s[3 * 33]); o.z = pk2(s[4 * 33], s[5 * 33]); o.w = pk2(s[6 * 33], s[7 * 33]);
        *(GAS v4u*)(WT + (size_t)(drow0 + n) * ldt + dcol0 + 8 * c) = o; }
    LDS_WAIT(); asm volatile("" ::: "memory");
}
__device__ __forceinline__ void convert_weights(Frame& F, int l) {
    LAS float* scr = (LAS float*)(F.lds + RING_OFF + F.wave * 16384);
    const int gw = F.vcu * NWAVES + F.wave, NGW = F.G * NWAVES;
    constexpr int I_IN = 16 * (INW / 32), I_BR = 4 * 8 * 32, I_O = 16 * 32, I_GU = 16 * 16 * 32, I_D = 16 * 8 * 32;
    constexpr int NITEMS = I_IN + I_BR + I_O + I_GU + I_D;
    for (int it = gw; it < NITEMS; it += NGW) {
        int r = it;
        if (r < I_IN) { const int nblk = INW / 32, kb = r / nblk, nb = r % nblk, n0 = 32 * nb;
            if (n0 >= 2304 && n0 < 2816) continue;
            const int drow = n0 < 2304 ? n0 : n0 + 512;
            tr_item(INP(F, 8) + (size_t)l * DM * INW, INW, 64 * kb, n0, ((GAS bf16*)(F.ws + WS_WIN)), DM, drow, 64 * kb, scr, F.lane); continue; } r -= I_IN;
        if (r < I_BR) { const int nbr = r / 256, q = r % 256, kb = q / 32, nb = q % 32;
            tr_item(INP(F, 15) + ((size_t)l * 4 + nbr) * 512 * DM, DM, 64 * kb, 32 * nb, ((GAS bf16*)(F.ws + WS_WB)), 2048, 32 * nb, nbr * 512 + 64 * kb, scr, F.lane); continue; } r -= I_BR;
        if (r < I_O) { const int kb = r / 32, nb = r % 32;
            tr_item(INP(F, 16) + (size_t)l * DM * DM, DM, 64 * kb, 32 * nb, ((GAS bf16*)(F.ws + WS_WO)), DM, 32 * nb, 64 * kb, scr, F.lane); continue; } r -= I_O;
        if (r < I_GU) { const int e = r / 512, q = r % 512, kb = q / 32, nb = q % 32, n0 = 32 * nb;
            const int drow = n0 < 512 ? (n0 / 128) * 256 + (n0 % 128) : ((n0 - 512) / 128) * 256 + 128 + ((n0 - 512) % 128);
            tr_item(INP(F, 19) + ((size_t)l * NEXP + e) * DM * DM, DM, 64 * kb, n0, ((GAS bf16*)(F.ws + WS_WGU)) + (size_t)e * DM * DM, DM, drow, 64 * kb, scr, F.lane); continue; } r -= I_GU;
        { const int e = r / 256, q = r % 256, kb = q / 32, nb = q % 32;
            tr_item(INP(F, 20) + ((size_t)l * NEXP + e) * EFF * DM, DM, 64 * kb, 32 * nb, ((GAS bf16*)(F.ws + WS_WD)) + (size_t)e * DM * EFF, EFF, 32 * nb, 64 * kb, scr, F.lane); }
    }
    __syncthreads();
    LAS float* wt = (LAS float*)(F.lds + RING_OFF);
    LAS float* tab = (LAS float*)(F.lds + RING_OFF + 32768);
    if (F.tid < 128) { float s, c; sincospif((float)F.tid * (1.0f / 64.0f), &s, &c); tab[2 * F.tid] = c; tab[2 * F.tid + 1] = s; }
    for (int u = F.vcu; u < 64; u += F.G) {
        const int kt = u >> 2, g = u & 3;
        __syncthreads();
#pragma unroll
        for (int i = 0; i < 16; ++i) { const int idx = i * 512 + F.tid, kk = idx >> 7, c = idx & 127; wt[idx] = INP(F, 8)[(size_t)l * DM * INW + (size_t)(kt * 64 + kk) * INW + 2304 + g * 128 + c]; }
        __syncthreads();
        const int kc = F.tid & 127, kq = F.tid >> 7;
        float aA[16], aB[16];
#pragma unroll
        for (int i = 0; i < 16; ++i) { aA[i] = 0.f; aB[i] = 0.f; }
        for (int c = 0; c < 128; ++c) { const int ti = (c * kc) & 127; const float cs = tab[2 * ti], sn = tab[2 * ti + 1];
#pragma unroll
            for (int i = 0; i < 16; ++i) { const float w = wt[(kq * 16 + i) * 128 + c]; aA[i] += w * cs; aB[i] += w * sn; } }
        GAS bf16* ra = ((GAS bf16*)(F.ws + WS_WIN)) + (size_t)(2304 + g * 128 + kc) * DM + kt * 64 + kq * 16; GAS bf16* rb = ra + (size_t)512 * DM;
        v4u o; o.x = pk2(aA[0], aA[1]); o.y = pk2(aA[2], aA[3]); o.z = pk2(aA[4], aA[5]); o.w = pk2(aA[6], aA[7]); *(GAS v4u*)ra = o;
        o.x = pk2(aA[8], aA[9]); o.y = pk2(aA[10], aA[11]); o.z = pk2(aA[12], aA[13]); o.w = pk2(aA[14], aA[15]); *(GAS v4u*)(ra + 8) = o;
        o.x = pk2(aB[0], aB[1]); o.y = pk2(aB[2], aB[3]); o.z = pk2(aB[4], aB[5]); o.w = pk2(aB[6], aB[7]); *(GAS v4u*)rb = o;
        o.x = pk2(aB[8], aB[9]); o.y = pk2(aB[10], aB[11]); o.z = pk2(aB[12], aB[13]); o.w = pk2(aB[14], aB[15]); *(GAS v4u*)(rb + 8) = o;
    }
    __syncthreads();
}
__device__ __forceinline__ void mod_vectors(Frame& F) {
    LAS float* sc = (LAS float*)(F.lds + RING_OFF);
    LAS float* part = (LAS float*)(F.lds + RING_OFF + 32768);
    for (int i = F.tid; i < 5 * DM; i += NTHR) { const float v = i < 4 * DM ? INP(F, 1)[i] : INP(F, 3)[i - 4 * DM]; sc[i] = v * sigm(v); }
    __syncthreads();
    for (int u = F.vcu; u < 2 * 96; u += F.G) {
        const int l = u / 96, j = (u % 96) * 64 + F.lane;
        const GAS float* wp = INP(F, 4) + (size_t)l * DM * 6144 + (size_t)(F.wave * 128) * 6144 + j;
        float a0 = 0.f, a1 = 0.f, a2 = 0.f, a3 = 0.f, a4 = 0.f;
#pragma unroll 8
        for (int kk = 0; kk < 128; ++kk) { const float w = wp[(size_t)kk * 6144]; const int k = F.wave * 128 + kk;
            a0 += sc[k] * w; a1 += sc[DM + k] * w; a2 += sc[2 * DM + k] * w; a3 += sc[3 * DM + k] * w; a4 += sc[4 * DM + k] * w; }
        part[(F.wave * 5 + 0) * 64 + F.lane] = a0; part[(F.wave * 5 + 1) * 64 + F.lane] = a1; part[(F.wave * 5 + 2) * 64 + F.lane] = a2; part[(F.wave * 5 + 3) * 64 + F.lane] = a3; part[(F.wave * 5 + 4) * 64 + F.lane] = a4;
        __syncthreads();
        if (F.tid < 320) { const int bp = F.tid >> 6, ln = F.tid & 63; float s = 0.f;
#pragma unroll
            for (int w = 0; w < 8; ++w) s += part[(w * 5 + bp) * 64 + ln];
            const int jj = (u % 96) * 64 + ln; ((GAS float*)(F.ws + WS_MODV))[((size_t)l * 5 + bp) * 6144 + jj] = s + INP(F, 5)[(size_t)l * 6144 + jj]; }
        __syncthreads();
    }
}
__device__ __forceinline__ void norm_mod(f32x4 (&v)[4], const GAS float* g, const GAS float* sc, const GAS float* sh, int lane) {
    float ss = 0.f;
#pragma unroll
    for (int j = 0; j < 4; ++j) ss += (v[j].x * v[j].x + v[j].y * v[j].y) + (v[j].z * v[j].z + v[j].w * v[j].w);
    const float rstd = 1.0f / sqrtf(wave_sum(ss, lane) * (1.0f / DM) + EPS);
#pragma unroll
    for (int j = 0; j < 4; ++j) { const int c = 4 * lane + 256 * j; const f32x4 gg = *(const f32x4*)(g + c), s1 = *(const f32x4*)(sc + c), s0 = *(const f32x4*)(sh + c);
        v[j] = v[j] * rstd * gg * (s1 + 1.0f) + s0; }
}
__device__ __forceinline__ void store_bf16_row(GAS bf16* orow, const f32x4 (&v)[4], int lane) {
#pragma unroll
    for (int j = 0; j < 4; ++j) { v2u w; w.x = pk2(v[j].x, v[j].y); w.y = pk2(v[j].z, v[j].w); *(GAS v2u*)(orow + 4 * lane + 256 * j) = w; }
}
__device__ __forceinline__ void load_row(f32x4 (&v)[4], const GAS float* xr, int lane) {
#pragma unroll
    for (int j = 0; j < 4; ++j) v[j] = *(const GAS f32x4*)(xr + 4 * lane + 256 * j);
}
__device__ __forceinline__ void phase_norm1_first(Frame& F) {
    const int gw = F.vcu * NWAVES + F.wave, NGW = F.G * NWAVES; const GAS float* mv = ((GAS float*)(F.ws + WS_MODV)); const GAS float* g1 = INP(F, 6);
    for (int row = gw; row < MROWS; row += 2 * NGW) { const int row2 = row + NGW; const bool has2 = row2 < MROWS;
        f32x4 v[4], v2[4]; load_row(v, xrow_in(F, row), F.lane); if (has2) load_row(v2, xrow_in(F, row2), F.lane);
        { const GAS float* m = mv + (size_t)modidx(row) * 6144; norm_mod(v, g1, m + 1024, m, F.lane); store_bf16_row(((GAS bf16*)(F.ws + WS_H)) + (size_t)row * DM, v, F.lane); }
        if (has2) { const GAS float* m = mv + (size_t)modidx(row2) * 6144; norm_mod(v2, g1, m + 1024, m, F.lane); store_bf16_row(((GAS bf16*)(F.ws + WS_H)) + (size_t)row2 * DM, v2, F.lane); } }
}
__device__ __forceinline__ void phase_qkrope(Frame& F, int l) {
    const int gw = F.vcu * NWAVES + F.wave, NGW = F.G * NWAVES; const int lane = F.lane, i = lane & 31;
    const float invf = exp2f(-(float)(i & 15) * (13.287712379549449f / 16.0f));
    for (int row = gw; row < MROWS; row += NGW) {
        const int t = row % RPB; const bool lat = t < SEQ; GAS bf16* pr = ((GAS bf16*)(F.ws + WS_P)) + (size_t)row * PW;
        float cs = 1.f, sn = 0.f;
        if (lat) { const float pos = (float)((i < 16) ? (t >> 6) : (t & 63)); sincosf(pos * invf, &sn, &cs); }
#pragma unroll
        for (int it = 0; it < 5; ++it) { const int hh = 2 * it + (lane >> 5); const int col = (hh < 8 ? hh * 64 : C_GK + (hh - 8) * 64) + 2 * i;
            const unsigned w = *(const GAS unsigned*)(pr + col); float x1 = bf_lo(w), x2 = bf_hi(w);
            float ss = x1 * x1 + x2 * x2;
            ss += shx(ss, 1, lane); ss += shx(ss, 2, lane); ss += shx(ss, 4, lane); ss += shx(ss, 8, lane); ss += shx(ss, 16, lane);
            const float rstd = 1.0f / sqrtf(ss * (1.0f / 64.0f) + EPS); const GAS float* gp = (hh < 8 ? INP(F, 9) : INP(F, 10)) + l * 64 + 2 * i;
            x1 = x1 * rstd * gp[0]; x2 = x2 * rstd * gp[1];
            float y1 = x1 * cs - x2 * sn, y2 = x1 * sn + x2 * cs;
            if (hh < 8) { y1 *= QSCALE; y2 *= QSCALE; }
            *(GAS unsigned*)(pr + col) = pk2(y1, y2); }
        { const v4u w = *(const GAS v4u*)(pr + C_NQ + 8 * lane); v4u o;
          o.x = pk2(bf_lo(w.x) * QSCALE, bf_hi(w.x) * QSCALE); o.y = pk2(bf_lo(w.y) * QSCALE, bf_hi(w.y) * QSCALE); o.z = pk2(bf_lo(w.z) * QSCALE, bf_hi(w.z) * QSCALE); o.w = pk2(bf_lo(w.w) * QSCALE, bf_hi(w.w) * QSCALE);
          *(GAS v4u*)(pr + C_NQ + 8 * lane) = o; }
    }
}
__device__ __forceinline__ void phase_conv(Frame& F, int l) {
    LAS float* zl = (LAS float*)(F.lds + RING_OFF);
    LAS float* red = (LAS float*)(F.lds + RING_OFF + 62 * 512 * 4);
    const int ch = F.tid; const int nchunk = (l == 0) ? 136 : 128;
    float w[31];
#pragma unroll
    for (int j = 0; j < 31; ++j) w[j] = INP(F, 12)[((size_t)l * 31 + j) * 512 + ch];
    const float cb = INP(F, 13)[l * 512 + ch], cg = INP(F, 14)[l * 512 + ch];
    const GAS bf16* P = ((GAS bf16*)(F.ws + WS_P)); GAS bf16* Y = ((GAS bf16*)(F.ws + WS_Y));
    for (int u = F.vcu; u < NBATCH * nchunk; u += F.G) {
        const int b = u / nchunk, c = u % nchunk; const bool lat = c < 128;
        const int seq0 = b * RPB + (lat ? 0 : SEQ), slen = lat ? SEQ : CTXL, t0 = 32 * (lat ? c : c - 128);
        __syncthreads();
#pragma unroll
        for (int it = 0; it < 8; ++it) { const int item = it * 512 + F.tid;
            if (item < 62 * 64) { const int i = item >> 6, cgp = item & 63; const int t = t0 - 15 + i; f32x4 z0 = {0.f, 0.f, 0.f, 0.f}, z1 = {0.f, 0.f, 0.f, 0.f};
                if (t >= 0 && t < slen) { const GAS bf16* pr = P + (size_t)(seq0 + t) * PW; const v4u a = *(const GAS v4u*)(pr + C_CA + 8 * cgp), g = *(const GAS v4u*)(pr + C_CB + 8 * cgp);
                    z0.x = bf_lo(a.x) * sigm(bf_lo(g.x)); z0.y = bf_hi(a.x) * sigm(bf_hi(g.x)); z0.z = bf_lo(a.y) * sigm(bf_lo(g.y)); z0.w = bf_hi(a.y) * sigm(bf_hi(g.y));
                    z1.x = bf_lo(a.z) * sigm(bf_lo(g.z)); z1.y = bf_hi(a.z) * sigm(bf_hi(g.z)); z1.z = bf_lo(a.w) * sigm(bf_lo(g.w)); z1.w = bf_hi(a.w) * sigm(bf_hi(g.w)); }
                *(LAS f32x4*)(zl + i * 512 + 8 * cgp) = z0; *(LAS f32x4*)(zl + i * 512 + 8 * cgp + 4) = z1; } }
        __syncthreads();
        float z[62];
#pragma unroll
        for (int i = 0; i < 62; ++i) z[i] = zl[i * 512 + ch];
        float o[32];
#pragma unroll
        for (int q = 0; q < 32; ++q) { float s = cb;
#pragma unroll
            for (int j = 0; j < 31; ++j) s += z[q + j] * w[j];
            o[q] = s; }
#pragma unroll
        for (int q = 0; q < 32; ++q) { const float s = wave_sum(o[q] * o[q], F.lane); if (F.lane == 0) red[F.wave * 32 + q] = s; }
        __syncthreads();
#pragma unroll
        for (int q = 0; q < 32; ++q) { float s = 0.f;
#pragma unroll
            for (int wv = 0; wv < 8; ++wv) s += red[wv * 32 + q];
            const float y = o[q] * (1.0f / sqrtf(s * (1.0f / 512.0f) + EPS)) * cg;
            Y[(size_t)(seq0 + t0 + q) * YW + 1536 + ch] = (bf16)f2bf(y * sigm(y)); }
    }
    __syncthreads();
}
typedef short fbf16x8 __attribute__((ext_vector_type(8)));
typedef short fs16x4 __attribute__((ext_vector_type(4)));
typedef float ff32x16 __attribute__((ext_vector_type(16)));
typedef __attribute__((address_space(3))) const char* flds_cptr;
__device__ __forceinline__ fs16x4 f_vtr(flds_cptr p) { return __builtin_bit_cast(fs16x4, __builtin_amdgcn_ds_read_tr16_b64_v4i16((__attribute__((address_space(3))) attn_body::v4i16_t*)p)); }
__device__ __forceinline__ void fourier_frags(Frame& F, fbf16x8 (&fr)[4][4]) {
    LAS float* tab = (LAS float*)(F.lds + RING_OFF);
    __syncthreads();
    if (F.tid < 64) { float s, c; sincospif((float)F.tid * (1.0f / 32.0f), &s, &c); tab[2 * F.tid] = c; tab[2 * F.tid + 1] = s; }
    __syncthreads();
    const int m = F.lane & 31, hi = F.lane >> 5;
#pragma unroll
    for (int mt = 0; mt < 4; ++mt)
#pragma unroll
        for (int g = 0; g < 4; ++g) { unsigned wv[4];
#pragma unroll
            for (int jp = 0; jp < 4; ++jp) { float v[2];
#pragma unroll
                for (int q = 0; q < 2; ++q) { const int j = 2 * jp + q; const int n = 16 * g + (j & 3) + 8 * (j >> 2) + 4 * hi; const int k = 32 * (mt & 1) + m; const int ix = (k * n) & 63; v[q] = tab[2 * ix + (mt >> 1)]; }
                wv[jp] = pk2(v[0], v[1]); }
            v4u t; t.x = wv[0]; t.y = wv[1]; t.z = wv[2]; t.w = wv[3]; fr[mt][g] = __builtin_bit_cast(fbf16x8, t); __builtin_amdgcn_sched_barrier(0); }
    __syncthreads();
}
#define F_BFRAG(dst, vp, dh) do { _Pragma("unroll") for (int g_ = 0; g_ < 4; ++g_) { const fs16x4 lo_ = f_vtr((vp) + (dh) * 4096 + g_ * 1024), hi_ = f_vtr((vp) + (dh) * 4096 + g_ * 1024 + 512); \
        dst[g_] = (fbf16x8){lo_[0], lo_[1], lo_[2], lo_[3], hi_[0], hi_[1], hi_[2], hi_[3]}; } } while (0)
__device__ __forceinline__ void glds16_so(const GAS void* sbase, unsigned voff, unsigned lds_dst) { unsigned keep;
    asm volatile("s_mov_b32 %0, m0\n\ts_mov_b32 m0, %3\n\ts_nop 0\n\tglobal_load_lds_dwordx4 %1, %2\n\ts_mov_b32 m0, %0" : "=&s"(keep) : "v"(voff), "s"(sbase), "s"(lds_dst) : "memory"); }
__device__ __forceinline__ fbf16x8 f_neg(fbf16x8 v) { v4u t = __builtin_bit_cast(v4u, v); t.x ^= 0x80008000u; t.y ^= 0x80008000u; t.z ^= 0x80008000u; t.w ^= 0x80008000u; return __builtin_bit_cast(fbf16x8, t); }
__device__ __forceinline__ void phase_fourier1(Frame& F) {
    fbf16x8 fr[4][4]; fourier_frags(F, fr);
    const int lane = F.lane, w = F.wave, r32 = lane & 31, hi = lane >> 5;
    const unsigned lds0 = (unsigned)(uintptr_t)(F.lds + RING_OFF);
    const flds_cptr vbase = (flds_cptr)(F.lds + RING_OFF) + ((lane >> 4) & 1) * 32 + (lane & 3) * 8 + (4 * hi + ((lane & 15) >> 2)) * 64;
    const GAS bf16* P = ((GAS bf16*)(F.ws + WS_P)); GAS bf16* TPb = (GAS bf16*)(F.ws + WS_TP);
    const unsigned voff0 = (unsigned)((64 * (lane >> 2)) * PW + (lane & 3) * 8) * 2u;
    for (int u = F.vcu; u < NBATCH * 64; u += F.G) {
        const int b = u >> 6, n2 = u & 63;
        const GAS bf16* base = P + (size_t)(b * RPB + n2) * PW + C_F + 64 * w;
        asm volatile("s_waitcnt lgkmcnt(0)" ::: "memory");
#pragma unroll
        for (int rg = 0; rg < 4; ++rg) { const unsigned vo = voff0 + (unsigned)rg * (unsigned)(64 * 16 * PW * 2);
            const unsigned dA = (unsigned)__builtin_amdgcn_readfirstlane(lds0 + w * 8192 + rg * 1024), dB = dA + 8 * 8192;
            glds16_so(base, vo, dA); glds16_so(base + 32, vo, dA + 4096); glds16_so(base + 512, vo, dB); glds16_so(base + 544, vo, dB + 4096); }
        asm volatile("s_waitcnt vmcnt(0)" ::: "memory");
#pragma unroll 1
        for (int dh = 0; dh < 2; ++dh) {
            fbf16x8 bA[4], nA[4], nB[4];
            F_BFRAG(bA, vbase + w * 8192, dh); F_BFRAG(nB, vbase + (8 + w) * 8192, dh);
#pragma unroll
            for (int g = 0; g < 4; ++g) { nA[g] = f_neg(bA[g]); nB[g] = f_neg(nB[g]); }
#pragma unroll
            for (int kb = 0; kb < 2; ++kb) {
                ff32x16 tr = {}, ti = {};
#pragma unroll
                for (int g = 0; g < 4; ++g) { tr = __builtin_amdgcn_mfma_f32_32x32x16_bf16(fr[kb][g], bA[g], tr, 0, 0, 0); ti = __builtin_amdgcn_mfma_f32_32x32x16_bf16(fr[kb][g], nB[g], ti, 0, 0, 0);
                    tr = __builtin_amdgcn_mfma_f32_32x32x16_bf16(fr[2 + kb][g], nB[g], tr, 0, 0, 0); ti = __builtin_amdgcn_mfma_f32_32x32x16_bf16(fr[2 + kb][g], nA[g], ti, 0, 0, 0); }
                const unsigned o0 = (unsigned)(((b * 64 + 32 * kb + 4 * hi) * 2) * 64 + n2) * 512u + 64 * w + 32 * dh + r32;
#pragma unroll
                for (int r = 0; r < 16; ++r) { const int kk = (r & 3) + 8 * (r >> 2); const int k1 = 32 * kb + kk + 4 * hi;
                    const float rev = (float)(n2 * k1) * (1.0f / 4096.0f); const float c = __builtin_amdgcn_cosf(rev), s = __builtin_amdgcn_sinf(rev);
                    const unsigned oi = o0 + (unsigned)kk * (2u * 64u * 512u);
                    TPb[oi] = (bf16)f2bf(tr[r] * c + ti[r] * s); TPb[oi + 64u * 512u] = (bf16)f2bf(ti[r] * c - tr[r] * s);
                    if ((r & 3) == 3) __builtin_amdgcn_sched_barrier(0); }
                __builtin_amdgcn_sched_barrier(0);
            }
        }
    }
}
__device__ __forceinline__ void phase_fourier2(Frame& F) {
    fbf16x8 fr[4][4]; fourier_frags(F, fr);
    const int lane = F.lane, w = F.wave, r32 = lane & 31, hi = lane >> 5;
    const unsigned lds0 = (unsigned)(uintptr_t)(F.lds + RING_OFF);
    const flds_cptr vbase = (flds_cptr)(F.lds + RING_OFF) + ((lane >> 4) & 1) * 32 + (lane & 3) * 8 + (4 * hi + ((lane & 15) >> 2)) * 64;
    const GAS bf16* TPb = (const GAS bf16*)(F.ws + WS_TP); GAS bf16* Y = ((GAS bf16*)(F.ws + WS_Y));
    const float scale = 1.0f / sqrtf(4096.0f * 128.0f);
    const unsigned voff0 = (unsigned)((lane >> 2) * 512 + (lane & 3) * 8) * 2u;
    for (int u = F.vcu; u < NBATCH * 64; u += F.G) {
        const int b = u >> 6, k1 = u & 63;
        const GAS bf16* base0 = TPb + (size_t)((b * 64 + k1) * 2) * 64 * 512 + 64 * w; const GAS bf16* base1 = base0 + 64 * 512;
        asm volatile("s_waitcnt lgkmcnt(0)" ::: "memory");
#pragma unroll
        for (int rg = 0; rg < 4; ++rg) { const unsigned vo = voff0 + (unsigned)rg * (unsigned)(16 * 512 * 2);
            const unsigned d0 = (unsigned)__builtin_amdgcn_readfirstlane(lds0 + w * 8192 + rg * 1024), d1 = d0 + 8 * 8192;
            glds16_so(base0, vo, d0); glds16_so(base0 + 32, vo, d0 + 4096); glds16_so(base1, vo, d1); glds16_so(base1 + 32, vo, d1 + 4096); }
        asm volatile("s_waitcnt vmcnt(0)" ::: "memory");
#pragma unroll
        for (int dh = 0; dh < 2; ++dh) {
            fbf16x8 b0[4], b1[4];
            F_BFRAG(b0, vbase + w * 8192, dh); F_BFRAG(b1, vbase + (8 + w) * 8192, dh);
#pragma unroll
            for (int mt = 0; mt < 2; ++mt) {
                ff32x16 acc = {};
#pragma unroll
                for (int g = 0; g < 4; ++g) { acc = __builtin_amdgcn_mfma_f32_32x32x16_bf16(fr[mt][g], b0[g], acc, 0, 0, 0); acc = __builtin_amdgcn_mfma_f32_32x32x16_bf16(fr[2 + mt][g], b1[g], acc, 0, 0, 0); }
                const unsigned y0 = (unsigned)(b * RPB + k1 + 64 * (32 * mt + 4 * hi)) * (unsigned)YW + 1024u + 64 * w + 32 * dh + r32;
#pragma unroll
                for (int r = 0; r < 16; ++r) { const int kk = (r & 3) + 8 * (r >> 2);
                    Y[y0 + (unsigned)kk * (64u * (unsigned)YW)] = (bf16)f2bf(acc[r] * scale); }
                __builtin_amdgcn_sched_barrier(0);
            }
        }
    }
}
typedef float fc_f32x2 __attribute__((ext_vector_type(2)));
__device__ __forceinline__ void phase_fourier_ctx(Frame& F) {
    LAS float* tab = (LAS float*)(F.lds + RING_OFF + 8192);
    __syncthreads();
    if (F.tid < 256) { float s, c; sincospif((float)F.tid * (1.0f / 128.0f), &s, &c); tab[2 * F.tid] = c; tab[2 * F.tid + 1] = s; }
    __syncthreads();
    const float scale = 1.0f / sqrtf(256.0f * 128.0f);
#define FC_LOAD(A_, B_, n0_) do { _Pragma("unroll") for (int i_ = 0; i_ < 16; ++i_) { A_[i_] = pcol[(size_t)((n0_) + i_) * PW]; B_[i_] = pcol[(size_t)((n0_) + i_) * PW + 512]; } } while (0)
#define FC_COMP(A_, B_, n0_) do { _Pragma("unroll") for (int i_ = 0; i_ < 16; ++i_) { const float a_ = bf1(A_[i_]), b_ = bf1(B_[i_]); _Pragma("unroll") for (int k_ = 0; k_ < 4; ++k_) { \
        const int ix_ = (((n0_) + i_) * (kb + k_)) & 255; const fc_f32x2 cs_ = *(const LAS fc_f32x2*)(tab + 2 * ix_); acc[k_] += a_ * cs_.x - b_ * cs_.y; } } } while (0)
    for (int u = F.vcu; u < NBATCH * 64; u += F.G) {
        const int b = u >> 6, kb = (u & 63) * 4;
        float acc[4] = {0.f, 0.f, 0.f, 0.f};
        const GAS bf16* pcol = ((GAS bf16*)(F.ws + WS_P)) + (size_t)(b * RPB + SEQ) * PW + C_F + F.tid;
        bf16 A0[16], B0[16], A1[16], B1[16];
        FC_LOAD(A0, B0, 0);
        for (int n0 = 0; n0 < 256; n0 += 32) {
            FC_LOAD(A1, B1, n0 + 16);
            FC_COMP(A0, B0, n0);
            if (n0 + 32 < 256) FC_LOAD(A0, B0, n0 + 32);
            FC_COMP(A1, B1, n0 + 16);
        }
        GAS bf16* yo = ((GAS bf16*)(F.ws + WS_Y)) + (size_t)(b * RPB + SEQ + kb) * YW + 1024 + F.tid;
#pragma unroll
        for (int k = 0; k < 4; ++k) yo[(size_t)k * YW] = (bf16)f2bf(acc[k] * scale);
    }
#undef FC_LOAD
#undef FC_COMP
}
__device__ __forceinline__ void phase_norm2_router(Frame& F, int l) {
    LAS float* wr = (LAS float*)(F.lds + RING_OFF);
    LAS int* sel = (LAS int*)(F.lds + RING_OFF + 65536);
    const int nact = (l == 0) ? MROWS : NBATCH * SEQ; const int chunk = (nact + F.G - 1) / F.G; const int a0 = F.vcu * chunk, a1 = (a0 + chunk < nact) ? a0 + chunk : nact;
    __syncthreads();
    for (int i = F.tid; i < DM * 16 / 4; i += NTHR) { const f32x4 t = ((const GAS f32x4*)INP(F, 17))[i]; const int c = i >> 2, e0 = (i & 3) * 4;
        wr[(e0 + 0) * DM + c] = t.x; wr[(e0 + 1) * DM + c] = t.y; wr[(e0 + 2) * DM + c] = t.z; wr[(e0 + 3) * DM + c] = t.w; }
    __syncthreads();
    const GAS float* mv = ((GAS float*)(F.ws + WS_MODV)) + (size_t)l * 5 * 6144;
    float rb[16];
#pragma unroll
    for (int e = 0; e < 16; ++e) rb[e] = INP(F, 18)[e];
    for (int a = a0 + F.wave; a < a1; a += NWAVES) {
        const int row = (l == 0) ? a : (a / SEQ) * RPB + (a % SEQ);
        f32x4 v[4]; load_row(v, xrow_ws(F, row), F.lane);
        const GAS float* m = mv + (size_t)modidx(row) * 6144; norm_mod(v, INP(F, 7) + l * DM, m + 4 * 1024, m + 3 * 1024, F.lane);
        store_bf16_row(((GAS bf16*)(F.ws + WS_H)) + (size_t)row * DM, v, F.lane);
        float lg[16];
#pragma unroll
        for (int e = 0; e < 16; ++e) lg[e] = 0.f;
#pragma unroll
        for (int e = 0; e < 16; ++e)
#pragma unroll
            for (int j = 0; j < 4; ++j) { const f32x4 ww = *(const LAS f32x4*)(wr + e * DM + 4 * F.lane + 256 * j); lg[e] += (v[j].x * ww.x + v[j].y * ww.y) + (v[j].z * ww.z + v[j].w * ww.w); }
        float sc[16], sl[16];
#pragma unroll
        for (int e = 0; e < 16; ++e) { sc[e] = sigm(wave_sum(lg[e], F.lane)); sl[e] = sc[e] + rb[e]; }
        float best = -INFINITY; int bi1 = 0, bi2 = 1; float bs1 = 0.f, bs2 = 0.f;
#pragma unroll
        for (int g = 0; g < 4; ++g) {
            int i1 = 4 * g; float m1 = sl[4 * g];
#pragma unroll
            for (int q = 1; q < 4; ++q) if (sl[4 * g + q] > m1) { m1 = sl[4 * g + q]; i1 = 4 * g + q; }
            int i2 = -1; float m2 = -INFINITY;
#pragma unroll
            for (int q = 0; q < 4; ++q) if (4 * g + q != i1 && sl[4 * g + q] > m2) { m2 = sl[4 * g + q]; i2 = 4 * g + q; }
            float s1 = 0.f, s2 = 0.f;
#pragma unroll
            for (int q = 0; q < 4; ++q) { if (4 * g + q == i1) s1 = sc[4 * g + q]; if (4 * g + q == i2) s2 = sc[4 * g + q]; }
            const float gs = m1 + m2;
            if (gs > best) { best = gs; bi1 = i1; bi2 = i2; bs1 = s1; bs2 = s2; }
        }
        if (F.lane == 0) { const float inv = 1.0f / (bs1 + bs2);
            ((GAS int*)(F.ws + WS_TOKE))[2 * row] = bi1; ((GAS int*)(F.ws + WS_TOKE))[2 * row + 1] = bi2; ((GAS float*)(F.ws + WS_TOKW))[2 * row] = bs1 * inv; ((GAS float*)(F.ws + WS_TOKW))[2 * row + 1] = bs2 * inv;
            sel[2 * (a - a0)] = bi1; sel[2 * (a - a0) + 1] = bi2; }
    }
    __syncthreads();
    if (F.tid < 16) { const int e = F.tid; int n = 0; const int ns = 2 * (a1 - a0);
        for (int i = 0; i < ns; ++i) n += (sel[i] == e) ? 1 : 0;
        unsigned base = 0u; if (n > 0) base = __hip_atomic_fetch_add((unsigned*)(F.ctl + CW_CNT + (l * 16 + e) * 64), (unsigned)n, RLX_AGENT);
        for (int i = 0; i < ns; ++i) if (sel[i] == e) { const int a = a0 + (i >> 1); const int row = (l == 0) ? a : (a / SEQ) * RPB + (a % SEQ); ((GAS int*)(F.ws + WS_TOKR))[2 * row + (i & 1)] = (int)base; ++base; } }
    __syncthreads();
}
__device__ __forceinline__ void moe_offsets(Frame& F, int l) {
    __syncthreads();
    if (F.tid == 0) { unsigned off = 0u;
        for (int e = 0; e < 16; ++e) { F.LCTL[e] = off; const unsigned c = __hip_atomic_load((unsigned*)(F.ctl + CW_CNT + (l * 16 + e) * 64), RLX_AGENT); off += (c + 255u) & ~255u; }
        F.LCTL[16] = off; F.LCTL[17] = off >> 8; }
    __syncthreads();
}
__device__ __forceinline__ void phase_scatter(Frame& F, int l) {
    moe_offsets(F, l);
    const int nact = (l == 0) ? MROWS : NBATCH * SEQ; const int chunk = (nact + F.G - 1) / F.G; const int a0 = F.vcu * chunk, a1 = (a0 + chunk < nact) ? a0 + chunk : nact;
    for (int a = a0 + F.wave; a < a1; a += NWAVES) {
        const int row = (l == 0) ? a : (a / SEQ) * RPB + (a % SEQ);
        const int e1 = ((GAS int*)(F.ws + WS_TOKE))[2 * row], e2 = ((GAS int*)(F.ws + WS_TOKE))[2 * row + 1];
        const int s1 = (int)F.LCTL[e1] + ((GAS int*)(F.ws + WS_TOKR))[2 * row], s2 = (int)F.LCTL[e2] + ((GAS int*)(F.ws + WS_TOKR))[2 * row + 1];
        if (F.lane == 0) { ((GAS int*)(F.ws + WS_TOKS))[2 * row] = s1; ((GAS int*)(F.ws + WS_TOKS))[2 * row + 1] = s2; }
        const GAS v4u* src = (const GAS v4u*)(((GAS bf16*)(F.ws + WS_H)) + (size_t)row * DM) + F.lane; const v4u x0 = src[0], x1 = src[64];
        GAS v4u* d1 = (GAS v4u*)(((GAS bf16*)(F.ws + WS_AM)) + (size_t)s1 * DM) + F.lane; GAS v4u* d2 = (GAS v4u*)(((GAS bf16*)(F.ws + WS_AM)) + (size_t)s2 * DM) + F.lane;
        d1[0] = x0; d1[64] = x1; d2[0] = x0; d2[64] = x1;
    }
}
struct CombRow { f32x4 v[4]; v2u p[4], q[4]; float w1, w2; };
__device__ __forceinline__ void comb_load(Frame& F, int row, CombRow& R, GAS float* xr) {
    load_row(R.v, xr, F.lane);
    const int s1 = ((GAS int*)(F.ws + WS_TOKS))[2 * row], s2 = ((GAS int*)(F.ws + WS_TOKS))[2 * row + 1]; R.w1 = ((GAS float*)(F.ws + WS_TOKW))[2 * row]; R.w2 = ((GAS float*)(F.ws + WS_TOKW))[2 * row + 1];
    const GAS bf16* o1 = ((GAS bf16*)(F.ws + WS_OM)) + (size_t)s1 * DM; const GAS bf16* o2 = ((GAS bf16*)(F.ws + WS_OM)) + (size_t)s2 * DM;
#pragma unroll
    for (int j = 0; j < 4; ++j) { const int c = 4 * F.lane + 256 * j; R.p[j] = *(const GAS v2u*)(o1 + c); R.q[j] = *(const GAS v2u*)(o2 + c); }
}
__device__ __forceinline__ void comb_finish(Frame& F, int l, int row, CombRow& R, GAS float* xr) {
    const GAS float* g2 = ((GAS float*)(F.ws + WS_MODV)) + (size_t)l * 5 * 6144 + (size_t)modidx(row) * 6144 + 5 * 1024;
#pragma unroll
    for (int j = 0; j < 4; ++j) { const int c = 4 * F.lane + 256 * j; const v2u p = R.p[j], q = R.q[j]; const f32x4 gg = *(const GAS f32x4*)(g2 + c); const float w1 = R.w1, w2 = R.w2;
        f32x4 z; z.x = w1 * bf_lo(p.x) + w2 * bf_lo(q.x); z.y = w1 * bf_hi(p.x) + w2 * bf_hi(q.x); z.z = w1 * bf_lo(p.y) + w2 * bf_lo(q.y); z.w = w1 * bf_hi(p.y) + w2 * bf_hi(q.y);
        R.v[j] = R.v[j] + gg * z; }
    if (l == 0) {
#pragma unroll
        for (int j = 0; j < 4; ++j) *(GAS f32x4*)(xr + 4 * F.lane + 256 * j) = R.v[j];
        const GAS float* m1 = ((GAS float*)(F.ws + WS_MODV)) + (size_t)5 * 6144 + (size_t)modidx(row) * 6144;
        norm_mod(R.v, INP(F, 6) + DM, m1 + 1024, m1, F.lane); store_bf16_row(((GAS bf16*)(F.ws + WS_H)) + (size_t)row * DM, R.v, F.lane);
    } else {
        float ss = 0.f;
#pragma unroll
        for (int j = 0; j < 4; ++j) ss += (R.v[j].x * R.v[j].x + R.v[j].y * R.v[j].y) + (R.v[j].z * R.v[j].z + R.v[j].w * R.v[j].w);
        const float rstd = 1.0f / sqrtf(wave_sum(ss, F.lane) * (1.0f / DM) + EPS);
#pragma unroll
        for (int j = 0; j < 4; ++j) { const int c = 4 * F.lane + 256 * j; *(GAS f32x4*)(xr + c) = R.v[j] * rstd * *(const GAS f32x4*)(INP(F, 21) + c); }
    }
}
__device__ __forceinline__ void phase_combine(Frame& F, int l) {
    const int gw = F.vcu * NWAVES + F.wave, NGW = F.G * NWAVES;
    const int nact = (l == 0) ? MROWS : NBATCH * SEQ;
    for (int a = gw; a < nact; a += 2 * NGW) { const int a2 = a + NGW; const bool has2 = a2 < nact;
        const int row = (l == 0) ? a : (a / SEQ) * RPB + (a % SEQ); const int row2 = has2 ? ((l == 0) ? a2 : (a2 / SEQ) * RPB + (a2 % SEQ)) : row;
        GAS float* xr = xrow_ws(F, row); GAS float* xr2 = xrow_ws(F, row2);
        CombRow R1, R2; comb_load(F, row, R1, xr); if (has2) comb_load(F, row2, R2, xr2);
        comb_finish(F, l, row, R1, xr); if (has2) comb_finish(F, l, row2, R2, xr2); }
}
struct SchedIn {
    int G, c;
    __device__ __forceinline__ bool next(int i, pg8::Unit& u) const { const long L = (long)i * G + c; if (L >= 68 * 33) return false; int pm, pn; pg8::tile_map((int)L, 68, 33, pm, pn);
        u.pm = pm; u.pn = pn; u.aux = 0; u.aoff = (size_t)pm * 256 * DM * 2; u.boff = (size_t)pn * 256 * DM * 2; return true; }
};
struct SchedBr {
    int G, c, nMt; bool skipctx;
    __device__ __forceinline__ bool next(int i, pg8::Unit& u) const { const long L = (long)(i >> 2) * G + c; if (L >= nMt * 4) return false; int pm, pn; pg8::tile_map((int)L, nMt, 4, pm, pn);
        if (skipctx) pm = (pm / 16) * 17 + (pm % 16);
        const int n = i & 3; u.pm = pm; u.pn = pn; u.aux = n; u.aoff = ((size_t)pm * 256 * YW + n * 512) * 2; u.boff = ((size_t)pn * 256 * 2048 + n * 512) * 2; return true; }
};
struct SchedOut {
    int G, c, nMt; bool skipctx;
    __device__ __forceinline__ bool next(int i, pg8::Unit& u) const { const long L = (long)i * G + c; if (L >= nMt * 4) return false; int pm, pn; pg8::tile_map((int)L, nMt, 4, pm, pn);
        if (skipctx) pm = (pm / 16) * 17 + (pm % 16);
        u.pm = pm; u.pn = pn; u.aux = 0; u.aoff = (size_t)pm * 256 * DM * 2; u.boff = (size_t)pn * 256 * DM * 2; return true; }
};
struct SchedMoe {
    int G, c; LAS unsigned* lctl; size_t astride, bstride_e, bstride_n;
    __device__ __forceinline__ bool next(int i, pg8::Unit& u) const { const long L = (long)i * G + c; const unsigned nt = lctl[17]; if (L >= (long)nt * 4) return false;
        const int tile = (int)(L >> 2), pn = (int)(L & 3); const unsigned row0 = (unsigned)tile * 256u; int e = 0;
#pragma unroll
        for (int k = 1; k < 16; ++k) e += (row0 >= lctl[k]) ? 1 : 0;
        u.pm = tile; u.pn = pn; u.aux = e; u.aoff = (size_t)tile * astride; u.boff = (size_t)e * bstride_e + (size_t)pn * bstride_n; return true; }
};

__device__ __forceinline__ void attn_plain_args(const Frame& F, int U, attn_body::AttnArgs& a) {
    typedef AGAS attn_body::bf16 abf;
    a.qrow0 = 0; a.rb0 = 0; a.rpb = nullptr; a.kr1 = 0;
    if (U < 512) { const int b = U >> 7, kvh = (U >> 6) & 1, hq = (U >> 4) & 3, qb = U & 15, h = kvh * 4 + hq; const size_t r0 = (size_t)b * RPB;
        a.Q = (const abf*)(((GAS bf16*)(F.ws + WS_P)) + (r0 + 256 * qb) * PW + C_GQ + h * 64); a.K = (const abf*)(((GAS bf16*)(F.ws + WS_P)) + r0 * PW + C_GK + kvh * 64); a.V = (const abf*)(((GAS bf16*)(F.ws + WS_P)) + r0 * PW + C_GV + kvh * 64);
        a.O = (abf*)(((GAS bf16*)(F.ws + WS_Y)) + (r0 + 256 * qb) * YW + h * 64); a.kr0 = 0; a.tsw = 1 << 20; a.NT = RPB / 64; }
    else if (U < 544) { const int b = (U - 512) >> 3, h = (U - 512) & 7, kvh = h >> 2; const size_t r0 = (size_t)b * RPB;
        a.Q = (const abf*)(((GAS bf16*)(F.ws + WS_P)) + (r0 + SEQ) * PW + C_GQ + h * 64); a.K = (const abf*)(((GAS bf16*)(F.ws + WS_P)) + r0 * PW + C_GK + kvh * 64); a.V = (const abf*)(((GAS bf16*)(F.ws + WS_P)) + r0 * PW + C_GV + kvh * 64);
        a.O = (abf*)(((GAS bf16*)(F.ws + WS_Y)) + (r0 + SEQ) * YW + h * 64); a.kr0 = SEQ; a.tsw = 1 << 20; a.NT = 4; }
    else { const int b = (U - 544) >> 3, h = (U - 544) & 7; const size_t r0 = (size_t)b * RPB;
        a.Q = (const abf*)(((GAS bf16*)(F.ws + WS_P)) + (r0 + SEQ) * PW + C_NQ + h * 64); a.K = (const abf*)(((GAS bf16*)(F.ws + WS_P)) + r0 * PW + C_NK + h * 64); a.V = (const abf*)(((GAS bf16*)(F.ws + WS_P)) + r0 * PW + C_NV + h * 64);
        a.O = (abf*)(((GAS bf16*)(F.ws + WS_Y)) + (r0 + SEQ) * YW + 512 + h * 64); a.kr0 = SEQ; a.tsw = 1 << 20; a.NT = 4; }
}
__device__ __forceinline__ void attn_na_args(const Frame& F, int U, int l, attn_body::AttnArgs& a) {
    typedef AGAS attn_body::bf16 abf;
    const int b = U >> 7, h = (U >> 4) & 7, j = U & 15; const size_t r0 = (size_t)b * RPB;
    int rb0 = 4 * j - 4; rb0 = rb0 < 0 ? 0 : (rb0 > 52 ? 52 : rb0);
    a.Q = (const abf*)(((GAS bf16*)(F.ws + WS_P)) + (r0 + 256 * j) * PW + C_NQ + h * 64); a.K = (const abf*)(((GAS bf16*)(F.ws + WS_P)) + r0 * PW + C_NK + h * 64); a.V = (const abf*)(((GAS bf16*)(F.ws + WS_P)) + r0 * PW + C_NV + h * 64);
    a.O = (abf*)(((GAS bf16*)(F.ws + WS_Y)) + (r0 + 256 * j) * YW + 512 + h * 64); a.kr0 = SEQ; a.kr1 = 64 * rb0; a.tsw = 4; a.NT = 16; a.qrow0 = 4 * j; a.rb0 = rb0; a.rpb = INP(F, 11) + ((size_t)l * 8 + h) * 465;
}

constexpr int N_PHASES = 2 + 11 * NLAYER;
struct Args { const GAS float* in[22]; GAS float* out; unsigned char* ws; int ph_lo, ph_hi; };
__global__ void __launch_bounds__(NTHR, 2) fwd_kernel(Args args) {
    extern __shared__ __attribute__((aligned(16))) unsigned char lds[];
    Frame F;
    F.lds = (LAS unsigned char*)lds; F.MISC = (volatile LAS unsigned*)(F.lds + MISC_OFF); F.LCTL = (LAS unsigned*)(F.lds + LDSCTL_OFF);
    F.tid = threadIdx.x; F.lane = F.tid & 63; F.wave = __builtin_amdgcn_readfirstlane(F.tid >> 6);
    F.G = gridDim.x; { const int bx = blockIdx.x; F.vcu = (F.G % 8 == 0) ? (bx % 8) * (F.G / 8) + bx / 8 : bx; }
    unsigned char* ws = args.ws;
    F.ctl = (gu32*)(ws + WS_CTL);
    F.out = args.out; F.ws = ws;
    for (int u = F.tid; u < (LDS_BYTES - LDSCTL_OFF) / 4; u += NTHR) ((LAS unsigned*)(F.lds + LDSCTL_OFF))[u] = 0u;
    __syncthreads();
    if (F.tid < 22) { unsigned long long p = 0ull;
#pragma unroll
        for (int i = 0; i < 22; ++i) if (F.tid == i) p = (unsigned long long)args.in[i];
        LAS unsigned* t = (LAS unsigned*)(F.lds + PTR_OFF) + 2 * F.tid; t[0] = (unsigned)p; t[1] = (unsigned)(p >> 32); }
    __syncthreads();
    XcdBarrier bar = xcd_barrier_post((unsigned*)(F.ctl + CW_BAR), F.MISC + 8);
    const int lo = args.ph_lo, hi = args.ph_hi;
#define LAUNDER() do { int t_ = threadIdx.x; asm volatile("" : "+v"(t_)); F.tid = t_; F.lane = t_ & 63; F.wave = __builtin_amdgcn_readfirstlane(t_ >> 6); \
        int g_ = gridDim.x, b_ = blockIdx.x; unsigned char* w_ = args.ws; GAS float* o_ = args.out; unsigned l_ = (unsigned)(uintptr_t)lds; \
        asm volatile("" : "+s"(g_), "+s"(b_), "+s"(w_), "+s"(o_), "+s"(l_)); \
        F.G = g_; bx = b_; F.vcu = (g_ % 8 == 0) ? (b_ % 8) * (g_ / 8) + b_ / 8 : b_; F.ws = w_; F.out = o_; F.ctl = (gu32*)(w_ + WS_CTL); \
        F.lds = (LAS unsigned char*)l_; F.MISC = (volatile LAS unsigned*)(F.lds + MISC_OFF); F.LCTL = (LAS unsigned*)(F.lds + LDSCTL_OFF); } while (0)
#ifndef PROBE
#define PROBE 0
#endif
#ifndef PROBE_MASK
#define PROBE_MASK 0x7ffffffeull
#define PROBE_SCALE 0.1f
#endif
#define STAMP(i) do { if (PROBE && blockIdx.x == 0 && threadIdx.x == 0) ((GAS unsigned long long*)(args.ws + WS_CTL + 512 * 1024))[i] = __builtin_amdgcn_s_memrealtime(); } while (0)
#define RUN(k) ((k) >= lo && (k) < hi)
#define SEAM(k) do { if ((k) >= lo && (k) + 1 < hi) xcd_barrier(bar); } while (0)
    int bx = (int)blockIdx.x;

    STAMP(0);
    if (RUN(0)) { LAUNDER(); convert_weights(F, 0); LAUNDER(); mod_vectors(F); } SEAM(0); STAMP(1);
    if (RUN(1)) { LAUNDER(); phase_norm1_first(F); } SEAM(1); STAMP(2);

    for (int l = 0; l < NLAYER; ++l) {
        const int p0 = 2 + 11 * l;
        if (RUN(p0 + 0)) { LAUNDER(); SchedIn S{F.G, bx}; pg8::EpiP E{((GAS bf16*)(F.ws + WS_P)), PW, C_G / 256};
            pg8::gemm_phase<pg8::EpiP, SchedIn, true>(F.lds + RING_OFF, F.tid, ((GAS bf16*)(F.ws + WS_H)), ((GAS bf16*)(F.ws + WS_WIN)), DM, DM, DM, S, E); } SEAM(p0 + 0); STAMP(3 + 14 * l + 0);
        if (RUN(p0 + 1)) { LAUNDER(); phase_qkrope(F, l); } SEAM(p0 + 1); STAMP(3 + 14 * l + 1);
        if (RUN(p0 + 2)) { LAUNDER();
            phase_fourier1(F); __syncthreads(); LAUNDER(); STAMP(3 + 14 * l + 2);
            phase_conv(F, l); __syncthreads(); LAUNDER(); STAMP(3 + 14 * l + 3);
            const int nU = (l == 0) ? 576 : 512;
            for (int U = F.vcu; U < nU; U += F.G) { attn_body::AttnArgs a; attn_plain_args(F, U, a); int t_ = threadIdx.x; asm volatile("" : "+v"(t_)); attn_body::attn_unit<8, false>(a, (char*)F.lds + RING_OFF, t_); }
            __syncthreads();
        } SEAM(p0 + 2); STAMP(3 + 14 * l + 4);
        if (RUN(p0 + 3)) { LAUNDER();
            phase_fourier2(F); __syncthreads(); LAUNDER(); STAMP(3 + 14 * l + 5);
            for (int U = F.vcu; U < 512; U += F.G) { attn_body::AttnArgs a; attn_na_args(F, U, l, a); int t_ = threadIdx.x; asm volatile("" : "+v"(t_)); attn_body::attn_unit<8, true>(a, (char*)F.lds + RING_OFF, t_); }
            __syncthreads();
            if (l == 0) { LAUNDER(); phase_fourier_ctx(F); __syncthreads(); }
        } SEAM(p0 + 3); STAMP(3 + 14 * l + 6);
        if (RUN(p0 + 4)) { LAUNDER(); SchedBr S{F.G, bx, (l == 0) ? 68 : 64, l != 0}; pg8::EpiBranch E{((GAS bf16*)(F.ws + WS_P)) + C_G, PW, ((GAS bf16*)(F.ws + WS_H)), DM};
            pg8::gemm_phase<pg8::EpiBranch, SchedBr, true>(F.lds + RING_OFF, F.tid, ((GAS bf16*)(F.ws + WS_Y)), ((GAS bf16*)(F.ws + WS_WB)), YW, 2048, 512, S, E); } SEAM(p0 + 4); STAMP(3 + 14 * l + 7);
        if (RUN(p0 + 5)) { LAUNDER(); SchedOut S{F.G, bx, (l == 0) ? 68 : 64, l != 0};
            pg8::EpiRes E{(l == 0) ? INP(F, 0) : F.out, (l == 0) ? INP(F, 2) : ((GAS float*)(F.ws + WS_XC)), F.out, ((GAS float*)(F.ws + WS_XC)), ((GAS float*)(F.ws + WS_MODV)) + (size_t)l * 5 * 6144 + 2 * 1024};
            pg8::gemm_phase<pg8::EpiRes, SchedOut, true>(F.lds + RING_OFF, F.tid, ((GAS bf16*)(F.ws + WS_H)), ((GAS bf16*)(F.ws + WS_WO)), DM, DM, DM, S, E); } SEAM(p0 + 5); STAMP(3 + 14 * l + 8);
        if (RUN(p0 + 6)) { LAUNDER(); phase_norm2_router(F, l); } SEAM(p0 + 6); STAMP(3 + 14 * l + 9);
        if (RUN(p0 + 7)) { LAUNDER(); phase_scatter(F, l); } SEAM(p0 + 7); STAMP(3 + 14 * l + 10);
        if (RUN(p0 + 8)) { LAUNDER(); moe_offsets(F, l); SchedMoe S{F.G, bx, F.LCTL, (size_t)256 * DM * 2, (size_t)DM * DM * 2, (size_t)256 * DM * 2}; pg8::EpiGU E{((GAS bf16*)(F.ws + WS_HM)), EFF};
            pg8::gemm_phase<pg8::EpiGU, SchedMoe, true>(F.lds + RING_OFF, F.tid, ((GAS bf16*)(F.ws + WS_AM)), ((GAS bf16*)(F.ws + WS_WGU)), DM, DM, DM, S, E); } SEAM(p0 + 8); STAMP(3 + 14 * l + 11);
        if (RUN(p0 + 9)) { LAUNDER(); moe_offsets(F, l); SchedMoe S{F.G, bx, F.LCTL, (size_t)256 * EFF * 2, (size_t)DM * EFF * 2, (size_t)256 * EFF * 2}; pg8::EpiP E{((GAS bf16*)(F.ws + WS_OM)), DM, 1 << 20};
            pg8::gemm_phase<pg8::EpiP, SchedMoe, true>(F.lds + RING_OFF, F.tid, ((GAS bf16*)(F.ws + WS_HM)), ((GAS bf16*)(F.ws + WS_WD)), EFF, EFF, EFF, S, E); } SEAM(p0 + 9); STAMP(3 + 14 * l + 12);
        if (RUN(p0 + 10)) { LAUNDER(); phase_combine(F, l); if (l + 1 < NLAYER) { __syncthreads(); LAUNDER(); convert_weights(F, l + 1); } } SEAM(p0 + 10); STAMP(3 + 14 * l + 13);
    }
#if PROBE
    xcd_barrier(bar);
    { const GAS unsigned long long* st = (const GAS unsigned long long*)(args.ws + WS_CTL + 512 * 1024);
      float db = 0.f;
      for (int i = 1; i <= 30; ++i) if ((PROBE_MASK >> i) & 1ull) db += (float)(st[i] - st[i - 1]) * 0.01f;
      db *= PROBE_SCALE;
      for (size_t i = (size_t)blockIdx.x * NTHR + threadIdx.x; i < (size_t)NBATCH * SEQ * DM; i += (size_t)gridDim.x * NTHR) args.out[i] = (i == 0) ? db : 8.0f; }
#endif
#undef RUN
#undef SEAM
}

#ifndef MK_PER_PHASE
#define MK_PER_PHASE 0
#endif
extern "C" void kernel_launch(void* const* d_in, const GAS int* in_sizes, int n_in, void* d_out, int out_size, void* d_ws, size_t ws_size, hipStream_t stream) {
    static int grid = 0;
    if (grid == 0) {
        if (n_in != 22 || out_size != NBATCH * SEQ * DM || ws_size < WS_END) { fprintf(stderr, "kernel_launch: unexpected shapes (n_in %d, out %d, ws %zu); nothing launched\n", n_in, out_size, ws_size); grid = -1; return; }
        int dev = 0, cus = 0, per_cu = 0;
        if (hipGetDevice(&dev) != hipSuccess || hipDeviceGetAttribute(&cus, hipDeviceAttributeMultiprocessorCount, dev) != hipSuccess) { grid = -1; return; }
        if (hipFuncSetAttribute((const void*)fwd_kernel, hipFuncAttributeMaxDynamicSharedMemorySize, LDS_BYTES) != hipSuccess) { fprintf(stderr, "kernel_launch: hipFuncSetAttribute failed\n"); grid = -1; return; }
        if (hipOccupancyMaxActiveBlocksPerMultiprocessor(&per_cu, (const void*)fwd_kernel, NTHR, LDS_BYTES) != hipSuccess || per_cu < 1) { fprintf(stderr, "kernel_launch: occupancy query reports %d\n", per_cu); (void)hipGetLastError(); grid = -1; return; }
        grid = cus;
    }
    if (grid < 0) return;
    (void)hipMemsetAsync((char*)d_ws + WS_CTL, 0, CTL_ZERO_BYTES, stream);
    Args a{};
    for (int i = 0; i < 22; ++i) a.in[i] = (const GAS float*)d_in[i];
    a.out = (GAS float*)d_out; a.ws = (unsigned char*)d_ws;
#if MK_PER_PHASE
    for (int p = 0; p < N_PHASES; ++p) { a.ph_lo = p; a.ph_hi = p + 1; hipLaunchKernelGGL(fwd_kernel, dim3(grid), dim3(NTHR), LDS_BYTES, stream, a); }
#else
    a.ph_lo = 0; a.ph_hi = N_PHASES;
    hipLaunchKernelGGL(fwd_kernel, dim3(grid), dim3(NTHR), LDS_BYTES, stream, a);
#endif
}
```

```cpp
#include <hip/hip_runtime.h>
#include <hip/hip_bf16.h>
#include <cstdio>
#include <cstdint>
#include <cmath>

namespace pg8 {
#define PG8_LAS __attribute__((address_space(3)))
#define PG8_GAS __attribute__((address_space(1)))
typedef unsigned short bf16_t;
typedef short bf16x8 __attribute__((ext_vector_type(8)));
typedef float f32x4 __attribute__((ext_vector_type(4)));
typedef unsigned u32x4 __attribute__((ext_vector_type(4)));
constexpr int BM = 256, BK = 64, HALF = 128, HTB = HALF * BK * 2, STAGE_BYTES = 8 * HTB, NXCD = 8, WGM = 8;

__host__ __device__ __forceinline__ int lds_byte(int r, int c) { const int st = (r >> 4) * 2 + (c >> 5), rr = r & 15, cc = c & 31, ob = rr * 64 + cc * 2; return st * 1024 + (ob ^ (((ob >> 9) & 1) << 5)); }
__host__ __device__ __forceinline__ void stage_rc(int b, int& R, int& C) { const int st = b / 1024, sb = b % 1024, swz = sb ^ (((sb >> 9) & 1) << 5); R = (st >> 1) * 16 + swz / 64; C = (st & 1) * 32 + (swz % 64) / 2; }
__host__ __device__ __forceinline__ int perm32(int rho) { const int n = rho >> 4, i = rho & 15; return 8 * (i >> 2) + 4 * n + (i & 3); }

struct Unit { int pm, pn, aux; size_t aoff, boff; };

__device__ __forceinline__ void tile_map(int L, int nM, int nN, int& pm, int& pn) {
    const int nwg = nM * nN; int wgid = L;
    { const int q = nwg / NXCD, r = nwg % NXCD, xcd = wgid % NXCD, off = wgid / NXCD; wgid = (xcd < r ? xcd * (q + 1) : r * (q + 1) + (xcd - r) * q) + off; }
    const int nig = WGM * nN, gid = wgid / nig, fm = gid * WGM, gsz = (nM - fm) < WGM ? (nM - fm) : WGM;
    pm = fm + ((wgid % nig) % gsz); pn = (wgid % nig) / gsz;
}

__device__ __forceinline__ unsigned cvt_pk_bf16(float lo, float hi) { unsigned r; asm volatile("v_cvt_pk_bf16_f32 %0, %1, %2" : "=v"(r) : "v"(lo), "v"(hi)); return r; }
__device__ __forceinline__ float fast_sigmoid(float x) { return __builtin_amdgcn_rcpf(1.0f + __builtin_amdgcn_exp2f(-1.4426950408889634f * x)); }
__device__ __forceinline__ float bflo(unsigned w) { return __uint_as_float(w << 16); }
__device__ __forceinline__ float bfhi(unsigned w) { return __uint_as_float(w & 0xffff0000u); }

struct EpiP {
    static constexpr bool PERM = true, KEEP = false;
    PG8_GAS bf16_t* O; int ldc; int sig_from;
    __device__ __forceinline__ void operator()(f32x4 (&acc)[2][2][4][2], const Unit& u, int wr, int wc, int fr, int fq) const {
        const int row0 = u.pm * BM + wr * 64 + fr, col0 = u.pn * BM + wc * 32 + 8 * fq; const bool sig = u.pn >= sig_from;
#pragma unroll
        for (int ai = 0; ai < 2; ++ai)
#pragma unroll
            for (int m = 0; m < 4; ++m) { PG8_GAS bf16_t* rowp = O + (size_t)(row0 + ai * HALF + m * 16) * ldc + col0;
#pragma unroll
                for (int bj = 0; bj < 2; ++bj) { f32x4 v0 = acc[ai][bj][m][0], v1 = acc[ai][bj][m][1];
                    if (sig) {
#pragma unroll
                        for (int k = 0; k < 4; ++k) { v0[k] = __builtin_fmaxf(fast_sigmoid(v0[k]), 1e-20f); v1[k] = __builtin_fmaxf(fast_sigmoid(v1[k]), 1e-20f); } }
                    u32x4 w; w.x = cvt_pk_bf16(v0[0], v0[1]); w.y = cvt_pk_bf16(v0[2], v0[3]); w.z = cvt_pk_bf16(v1[0], v1[1]); w.w = cvt_pk_bf16(v1[2], v1[3]);
                    *(PG8_GAS u32x4*)(rowp + bj * HALF) = w; } }
    }
};
struct EpiBranch {
    static constexpr bool PERM = true, KEEP = true;
    const PG8_GAS bf16_t* G; int ldg; PG8_GAS bf16_t* O; int ldc;
    __device__ __forceinline__ void operator()(f32x4 (&acc)[2][2][4][2], const Unit& u, int wr, int wc, int fr, int fq) const {
        const int row0 = u.pm * BM + wr * 64 + fr, col0 = u.pn * BM + wc * 32 + 8 * fq; const int nb = u.aux;
#pragma unroll
        for (int ai = 0; ai < 2; ++ai) {
            u32x4 g0[4][2], g1[4][2];
#pragma unroll
            for (int m = 0; m < 4; ++m)
#pragma unroll
                for (int bj = 0; bj < 2; ++bj) { const PG8_GAS bf16_t* gp = G + (size_t)(row0 + ai * HALF + m * 16) * ldg + nb * 1024 + col0 + bj * HALF;
                    g0[m][bj] = *(const PG8_GAS u32x4*)gp; g1[m][bj] = (nb < 3) ? *(const PG8_GAS u32x4*)(gp + 1024) : g0[m][bj]; }
#pragma unroll
            for (int m = 0; m < 4; ++m)
#pragma unroll
                for (int bj = 0; bj < 2; ++bj) { const size_t row = (size_t)(row0 + ai * HALF + m * 16); const int col = col0 + bj * HALF;
                    const u32x4 a = g0[m][bj], b = g1[m][bj];
                    float f[8] = {bflo(a.x), bfhi(a.x), bflo(a.y), bfhi(a.y), bflo(a.z), bfhi(a.z), bflo(a.w), bfhi(a.w)};
                    if (nb < 3) {
                        f[0] *= __builtin_amdgcn_rcpf(bflo(b.x)); f[1] *= __builtin_amdgcn_rcpf(bfhi(b.x)); f[2] *= __builtin_amdgcn_rcpf(bflo(b.y)); f[3] *= __builtin_amdgcn_rcpf(bfhi(b.y));
                        f[4] *= __builtin_amdgcn_rcpf(bflo(b.z)); f[5] *= __builtin_amdgcn_rcpf(bfhi(b.z)); f[6] *= __builtin_amdgcn_rcpf(bflo(b.w)); f[7] *= __builtin_amdgcn_rcpf(bfhi(b.w)); }
                    f32x4 v0 = acc[ai][bj][m][0], v1 = acc[ai][bj][m][1];
                    v0[0] *= f[0]; v0[1] *= f[1]; v0[2] *= f[2]; v0[3] *= f[3]; v1[0] *= f[4]; v1[1] *= f[5]; v1[2] *= f[6]; v1[3] *= f[7];
                    if (nb < 3) { acc[ai][bj][m][0] = v0; acc[ai][bj][m][1] = v1; }
                    else { u32x4 w; w.x = cvt_pk_bf16(v0[0], v0[1]); w.y = cvt_pk_bf16(v0[2], v0[3]); w.z = cvt_pk_bf16(v1[0], v1[1]); w.w = cvt_pk_bf16(v1[2], v1[3]);
                        *(PG8_GAS u32x4*)(O + row * ldc + col) = w; acc[ai][bj][m][0] = (f32x4){0.f, 0.f, 0.f, 0.f}; acc[ai][bj][m][1] = (f32x4){0.f, 0.f, 0.f, 0.f}; } }
        }
    }
};
struct EpiRes {
    static constexpr bool PERM = false, KEEP = false;
    const PG8_GAS float* base_lat; const PG8_GAS float* base_ctx; PG8_GAS float* out_lat; PG8_GAS float* out_ctx; const PG8_GAS float* gmod;
    __device__ __forceinline__ void operator()(f32x4 (&acc)[2][2][4][2], const Unit& u, int wr, int wc, int fr, int fq) const {
        const int b = u.pm / 17, j = u.pm % 17;
        const size_t ro = (j < 16) ? ((size_t)b * 4096 + (size_t)j * 256) * 1024 : (size_t)b * 256 * 1024;
        const PG8_GAS float* bp = ((j < 16) ? base_lat : base_ctx) + ro; PG8_GAS float* op = ((j < 16) ? out_lat : out_ctx) + ro; const PG8_GAS float* gv = gmod + ((j < 16) ? b : 4) * 6144;
        const int col0 = u.pn * BM + wc * 32 + 4 * fq;
#pragma unroll
        for (int bj = 0; bj < 2; ++bj)
#pragma unroll
            for (int n = 0; n < 2; ++n) { const int col = col0 + bj * HALF + n * 16; const f32x4 g = *(const PG8_GAS f32x4*)(gv + col);
                f32x4 bs[2][4];
#pragma unroll
                for (int ai = 0; ai < 2; ++ai)
#pragma unroll
                    for (int m = 0; m < 4; ++m) bs[ai][m] = *(const PG8_GAS f32x4*)(bp + (size_t)(ai * HALF + wr * 64 + m * 16 + fr) * 1024 + col);
#pragma unroll
                for (int ai = 0; ai < 2; ++ai)
#pragma unroll
                    for (int m = 0; m < 4; ++m) *(PG8_GAS f32x4*)(op + (size_t)(ai * HALF + wr * 64 + m * 16 + fr) * 1024 + col) = bs[ai][m] + g * acc[ai][bj][m][n]; }
    }
};
struct EpiGU {
    static constexpr bool PERM = true, KEEP = false;
    PG8_GAS bf16_t* O; int ldc;
    __device__ __forceinline__ void operator()(f32x4 (&acc)[2][2][4][2], const Unit& u, int wr, int wc, int fr, int fq) const {
        const int row0 = u.pm * BM + wr * 64 + fr, col0 = u.pn * HALF + wc * 32 + 8 * fq;
#pragma unroll
        for (int ai = 0; ai < 2; ++ai)
#pragma unroll
            for (int m = 0; m < 4; ++m) { float o[8];
#pragma unroll
                for (int n = 0; n < 2; ++n)
#pragma unroll
                    for (int k = 0; k < 4; ++k) { const float a = acc[ai][0][m][n][k], b = acc[ai][1][m][n][k]; o[n * 4 + k] = a * fast_sigmoid(a) * b; }
                u32x4 w; w.x = cvt_pk_bf16(o[0], o[1]); w.y = cvt_pk_bf16(o[2], o[3]); w.z = cvt_pk_bf16(o[4], o[5]); w.w = cvt_pk_bf16(o[6], o[7]);
                *(PG8_GAS u32x4*)(O + (size_t)(row0 + ai * HALF + m * 16) * ldc + col0) = w; }
    }
};

template <class Epi, class Sched, bool ALIGN_EPI>
__device__ __forceinline__ void gemm_phase(PG8_LAS unsigned char* lds, int tid, const PG8_GAS bf16_t* A, const PG8_GAS bf16_t* Bt, int lda, int ldb, int K, const Sched& S, const Epi& E) {
    const int wid = __builtin_amdgcn_readfirstlane(tid >> 6), lane = tid & 63, wr = wid >> 2, wc = wid & 3, fr = lane & 15, fq = lane >> 4;
    const int nt = K / BK;
    unsigned voffA[2], voffB[2];
#pragma unroll
    for (int i = 0; i < 2; ++i) { int R, C; stage_rc(tid * 16 + i * 8192, R, C); const int Rb = Epi::PERM ? ((R & ~31) + perm32(R & 31)) : R;
        voffA[i] = (unsigned)(R * lda + C) * 2u; voffB[i] = (unsigned)(Rb * ldb + C) * 2u; }
    const size_t kstep = (size_t)(BK * 2);
    const size_t hstepA = (size_t)HALF * lda * 2, hstepB = (size_t)HALF * ldb * 2;
    const unsigned ldsw = (unsigned)wid * 1024u;
    const int aoff = lds_byte(wr * 64 + fr, fq * 8), boff = lds_byte(wc * 32 + fr, fq * 8);
#define PG8_SA(b, h) (((b) * 2 + (h)) * HTB)
#define PG8_SB(b, h) ((4 + (b) * 2 + (h)) * HTB)
#define PG8_STAGE(bufoff, gbase, voff) do { _Pragma("unroll") for (int _i = 0; _i < 2; ++_i) \
        __builtin_amdgcn_global_load_lds((const PG8_GAS unsigned*)((const PG8_GAS char*)(gbase) + (voff)[_i]), (PG8_LAS unsigned*)(lds + (bufoff) + ldsw + _i * 8192), 16, 0, 0); } while (0)
#define PG8_LDA(dst, b, h) do { _Pragma("unroll") for (int m = 0; m < 4; ++m) _Pragma("unroll") for (int k = 0; k < 2; ++k) dst[m][k] = *(const PG8_LAS bf16x8*)(lds + PG8_SA(b, h) + aoff + m * 2048 + k * 1024); } while (0)
#define PG8_LDB(dst, b, h) do { _Pragma("unroll") for (int n = 0; n < 2; ++n) _Pragma("unroll") for (int k = 0; k < 2; ++k) dst[n][k] = *(const PG8_LAS bf16x8*)(lds + PG8_SB(b, h) + boff + n * 2048 + k * 1024); } while (0)
#define PG8_MMA(ai, bj, At, Bt_) do { __builtin_amdgcn_s_setprio(1); _Pragma("unroll") for (int m = 0; m < 4; ++m) _Pragma("unroll") for (int n = 0; n < 2; ++n) _Pragma("unroll") for (int k = 0; k < 2; ++k) \
        acc[ai][bj][m][n] = __builtin_amdgcn_mfma_f32_16x16x32_bf16(Bt_[n][k], At[m][k], acc[ai][bj][m][n], 0, 0, 0); __builtin_amdgcn_s_setprio(0); } while (0)
#define PG8_WAIT_V(n) asm volatile("s_waitcnt vmcnt(" #n ")" ::: "memory")
#define PG8_WAIT_L(n) asm volatile("s_waitcnt lgkmcnt(" #n ")" ::: "memory")
#define PG8_BAR __builtin_amdgcn_s_barrier()
#define PG8_SCHED __builtin_amdgcn_sched_barrier(0)
    Unit cur, nxt; int ui = 0;
    if (!S.next(0, cur)) return;
    f32x4 acc[2][2][4][2];
#pragma unroll
    for (int a = 0; a < 2; ++a)
#pragma unroll
        for (int b = 0; b < 2; ++b)
#pragma unroll
            for (int m = 0; m < 4; ++m)
#pragma unroll
                for (int n = 0; n < 2; ++n) acc[a][b][m][n] = (f32x4){0.f, 0.f, 0.f, 0.f};
    bf16x8 At[4][2], B0[2][2], B1[2][2];
    const PG8_GAS char* cA = (const PG8_GAS char*)A + cur.aoff; const PG8_GAS char* cB = (const PG8_GAS char*)Bt + cur.boff;
    PG8_STAGE(PG8_SB(0, 0), cB, voffB); PG8_STAGE(PG8_SB(0, 1), cB + hstepB, voffB); PG8_STAGE(PG8_SA(0, 0), cA, voffA); PG8_STAGE(PG8_SA(0, 1), cA + hstepA, voffA);
    if (wr == 1) PG8_BAR;
    PG8_WAIT_V(2); PG8_BAR;
    PG8_STAGE(PG8_SB(1, 0), cB + kstep, voffB); PG8_STAGE(PG8_SA(1, 0), cA + kstep, voffA); PG8_STAGE(PG8_SB(1, 1), cB + hstepB + kstep, voffB);
    PG8_WAIT_V(6); PG8_BAR;
    for (;;) {
        const bool has_next = S.next(ui + 1, nxt);
        const PG8_GAS char* nA = has_next ? (const PG8_GAS char*)A + nxt.aoff : cA; const PG8_GAS char* nB = has_next ? (const PG8_GAS char*)Bt + nxt.boff : cB;
        for (int t = 0; t < nt; t += 2) {
            const bool last = (t == nt - 2);
            const PG8_GAS char* a1 = cA + (size_t)(t + 1) * kstep;
            const PG8_GAS char* a2 = last ? nA : cA + (size_t)(t + 2) * kstep; const PG8_GAS char* b2 = last ? nB : cB + (size_t)(t + 2) * kstep;
            const PG8_GAS char* a3 = a2 + kstep; const PG8_GAS char* b3 = b2 + kstep;
            PG8_LDB(B0, 0, 0); PG8_LDB(B1, 0, 1); PG8_SCHED; PG8_LDA(At, 0, 0); PG8_STAGE(PG8_SA(1, 1), a1 + hstepA, voffA);
            PG8_WAIT_V(8); PG8_WAIT_L(0); PG8_BAR; PG8_MMA(0, 0, At, B0); PG8_MMA(0, 1, At, B1); PG8_BAR; PG8_SCHED;
            PG8_LDA(At, 0, 1); PG8_STAGE(PG8_SB(0, 0), b2, voffB); PG8_STAGE(PG8_SB(0, 1), b2 + hstepB, voffB); PG8_STAGE(PG8_SA(0, 0), a2, voffA);
            PG8_WAIT_V(8); PG8_WAIT_L(0); PG8_BAR; PG8_MMA(1, 0, At, B0); PG8_MMA(1, 1, At, B1); PG8_BAR; PG8_SCHED;
            PG8_LDB(B0, 1, 0); PG8_LDB(B1, 1, 1); PG8_SCHED; PG8_LDA(At, 1, 0); PG8_STAGE(PG8_SA(0, 1), a2 + hstepA, voffA);
            PG8_WAIT_V(8); PG8_WAIT_L(0); PG8_BAR; PG8_MMA(0, 0, At, B0); PG8_MMA(0, 1, At, B1); PG8_BAR; PG8_SCHED;
            PG8_LDA(At, 1, 1); PG8_STAGE(PG8_SB(1, 0), b3, voffB); PG8_STAGE(PG8_SB(1, 1), b3 + hstepB, voffB); PG8_STAGE(PG8_SA(1, 0), a3, voffA);
            PG8_WAIT_V(8); PG8_WAIT_L(0); PG8_BAR; PG8_MMA(1, 0, At, B0); PG8_MMA(1, 1, At, B1); PG8_BAR; PG8_SCHED;
        }
        if constexpr (ALIGN_EPI) { if (wr == 0) PG8_BAR; }
        E(acc, cur, wr, wc, fr, fq);
        if (!has_next) break;
        if constexpr (!Epi::KEEP) {
#pragma unroll
            for (int a = 0; a < 2; ++a)
#pragma unroll
                for (int b = 0; b < 2; ++b)
#pragma unroll
                    for (int m = 0; m < 4; ++m)
#pragma unroll
                        for (int n = 0; n < 2; ++n) acc[a][b][m][n] = (f32x4){0.f, 0.f, 0.f, 0.f};
        }
        cur = nxt; cA = nA; cB = nB; ++ui;
        if constexpr (ALIGN_EPI) { if (wr == 1) PG8_BAR; }
    }
    PG8_WAIT_V(0);
    if constexpr (!ALIGN_EPI) { if (wr == 0) PG8_BAR; }
    PG8_BAR;
#undef PG8_SA
#undef PG8_SB
#undef PG8_STAGE
#undef PG8_LDA
#undef PG8_LDB
#undef PG8_MMA
#undef PG8_WAIT_V
#undef PG8_WAIT_L
#undef PG8_BAR
#undef PG8_SCHED
}
}
namespace attn_body {
using bf16=__hip_bfloat16;
using bf16x8=__attribute__((ext_vector_type(8)))short;
using s16x4=__attribute__((ext_vector_type(4)))short;
using f32x16=__attribute__((ext_vector_type(16)))float;
using u32x4=__attribute__((ext_vector_type(4)))unsigned;
constexpr int D=64;
constexpr int QP=8448,KP=8448,VP=8448,OP=2048;
constexpr int NW=8,QBLK=32,QB=QBLK*NW,KVBLK=64;
__device__ __forceinline__ int crow(int r,int hi){return (r&3)+8*(r>>2)+4*hi;}
#define SBAR() __builtin_amdgcn_sched_barrier(0)
#define AGAS __attribute__((address_space(1)))
constexpr int NSLOT=3, SLOTB=8192;
constexpr int LDS_K=0, LDS_V=NSLOT*SLOTB, LDS_WS=2*NSLOT*SLOTB, LDS_OST=LDS_WS+NW*64*4, LDS_BIAS=LDS_OST+NW*4096, LDS_BYTES=LDS_BIAS+8192;
constexpr float C2=0.125f*1.4426950408889634f;
__device__ __forceinline__ void glds16(const AGAS void*gsrc,unsigned lds_dst){unsigned keep;
  asm volatile("s_mov_b32 %0, m0\n\ts_mov_b32 m0, %2\n\ts_nop 0\n\tglobal_load_lds_dwordx4 %1, off\n\ts_mov_b32 m0, %0":"=&s"(keep):"v"(gsrc),"s"(lds_dst):"memory");}
__device__ __forceinline__ float max3f(float a,float b,float c){float r;asm("v_max3_f32 %0, %1, %2, %3":"=v"(r):"v"(a),"v"(b),"v"(c));return r;}
__device__ __forceinline__ float max2f(float a,float b){float r;asm("v_max_f32_e32 %0, %1, %2":"=v"(r):"v"(a),"v"(b));return r;}
__device__ __forceinline__ float fadd_s(float a,float b){float r;asm("v_add_f32_e32 %0, %1, %2":"=v"(r):"v"(a),"v"(b));return r;}
__device__ __forceinline__ float fsub_s(float a,float b){float r;asm("v_sub_f32_e32 %0, %1, %2":"=v"(r):"v"(a),"v"(b));return r;}
typedef float f32x2_t __attribute__((ext_vector_type(2))); typedef __bf16 bf16x2_t __attribute__((ext_vector_type(2)));
__device__ __forceinline__ unsigned cvtpk_s(float lo,float hi){f32x2_t v={lo,hi};bf16x2_t b=__builtin_convertvector(v,bf16x2_t);return __builtin_bit_cast(unsigned,b);}
#define WAIT_BAR(N) asm volatile("s_waitcnt vmcnt(" #N ") lgkmcnt(0)\n\ts_barrier":::"memory")

__device__ __forceinline__ void qkt(f32x16&p0,f32x16&p1,const char*Kslot,const bf16x8*qr,const f32x16&negm,int r32,int hi){
  const char*kb=Kslot+hi*1024+r32*16;
  #pragma unroll
  for(int d0=0;d0<4;++d0){
    const bf16x8 b0=*reinterpret_cast<const bf16x8*>(kb+d0*2048);
    const bf16x8 b1=*reinterpret_cast<const bf16x8*>(kb+d0*2048+512);
    if(d0==0){p0=__builtin_amdgcn_mfma_f32_32x32x16_bf16(b0,qr[0],negm,0,0,0);p1=__builtin_amdgcn_mfma_f32_32x32x16_bf16(b1,qr[0],negm,0,0,0);}
    else{p0=__builtin_amdgcn_mfma_f32_32x32x16_bf16(b0,qr[d0],p0,0,0,0);p1=__builtin_amdgcn_mfma_f32_32x32x16_bf16(b1,qr[d0],p1,0,0,0);}}
}
typedef __attribute__((address_space(3))) const char* lds_cptr;
typedef __attribute__((address_space(3))) const float* lds_fptr;
typedef short v4i16_t __attribute__((ext_vector_type(4)));
__device__ __forceinline__ void kload8(bf16x8*kf,lds_cptr kp){
  kf[0]=*(const __attribute__((address_space(3))) bf16x8*)(kp);      kf[1]=*(const __attribute__((address_space(3))) bf16x8*)(kp+512);
  kf[2]=*(const __attribute__((address_space(3))) bf16x8*)(kp+2048); kf[3]=*(const __attribute__((address_space(3))) bf16x8*)(kp+2560);
  kf[4]=*(const __attribute__((address_space(3))) bf16x8*)(kp+4096); kf[5]=*(const __attribute__((address_space(3))) bf16x8*)(kp+4608);
  kf[6]=*(const __attribute__((address_space(3))) bf16x8*)(kp+6144); kf[7]=*(const __attribute__((address_space(3))) bf16x8*)(kp+6656);
}
__device__ __forceinline__ void kload2(bf16x8*kf,lds_cptr kp,int j){ kf[2*j]=*(const __attribute__((address_space(3))) bf16x8*)(kp+j*2048); kf[2*j+1]=*(const __attribute__((address_space(3))) bf16x8*)(kp+j*2048+512); }
__device__ __forceinline__ s16x4 vtr(lds_cptr p){ return __builtin_bit_cast(s16x4,__builtin_amdgcn_ds_read_tr16_b64_v4i16((__attribute__((address_space(3))) v4i16_t*)p)); }
__device__ __forceinline__ float rowmax(const f32x16&p0,const f32x16&p1){
  float a=max3f(p0[0],p0[1],p1[0]),b=max3f(p0[2],p0[3],p1[1]);a=max3f(a,p1[2],p1[3]);
  #pragma unroll
  for(int r=4;r<16;r+=4){a=max3f(a,p0[r],p0[r+1]);b=max3f(b,p0[r+2],p0[r+3]);a=max3f(a,p1[r],p1[r+1]);b=max3f(b,p1[r+2],p1[r+3]);}
  const float m=max2f(a,b);
  auto rr=__builtin_amdgcn_permlane32_swap(__float_as_uint(m),__float_as_uint(m),false,false);
  return max2f(__uint_as_float(rr[0]),__uint_as_float(rr[1]));
}
__device__ __forceinline__ void pv(f32x16*o,int vb,bf16x8 pa0,bf16x8 pa1,bf16x8 pa2,bf16x8 pa3){
  #pragma unroll
  for(int d0=0;d0<2;++d0){s16x4 lo[4],hi[4];
    #pragma unroll
    for(int ks=0;ks<4;++ks){
      asm volatile("ds_read_b64_tr_b16 %0,%1 offset:%c2":"=&v"(lo[ks]):"v"(vb),"i"(d0*4096+ks*1024):"memory");
      asm volatile("ds_read_b64_tr_b16 %0,%1 offset:%c2":"=&v"(hi[ks]):"v"(vb),"i"(d0*4096+ks*1024+512):"memory");}
    asm volatile("s_waitcnt lgkmcnt(0)":::"memory");SBAR();
    #define PK(k) (bf16x8){lo[k][0],lo[k][1],lo[k][2],lo[k][3],hi[k][0],hi[k][1],hi[k][2],hi[k][3]}
    o[d0]=__builtin_amdgcn_mfma_f32_32x32x16_bf16(pa0,PK(0),o[d0],0,0,0);
    o[d0]=__builtin_amdgcn_mfma_f32_32x32x16_bf16(pa1,PK(1),o[d0],0,0,0);
    o[d0]=__builtin_amdgcn_mfma_f32_32x32x16_bf16(pa2,PK(2),o[d0],0,0,0);
    o[d0]=__builtin_amdgcn_mfma_f32_32x32x16_bf16(pa3,PK(3),o[d0],0,0,0);
    #undef PK
  }
}
__device__ __forceinline__ void namask(f32x16&p0,f32x16&p1,int kr,int qr,unsigned wlo,unsigned whi,lds_fptr brow0,float mh){
  const float BIG=1e30f;
  int r0=qr-4; r0=r0<0?0:(r0>56?56:r0);
  if(kr<r0||kr>=r0+8){
    #pragma unroll
    for(int r=0;r<16;++r){p0[r]=-BIG;p1[r]=-BIG;}
    return; }
  const lds_fptr brow=brow0+(kr-qr+7)*128;
  asm volatile("":"+v"(wlo),"+v"(whi));
  #pragma unroll
  for(int r=0;r<16;++r){
    const int pos=(r&3)+8*(r>>2);
    const float b0=brow[pos]-mh, b1=brow[pos+32]-mh;
    const float f0=(float)((wlo>>pos)&1u), f1=(float)((whi>>pos)&1u);
    p0[r]=(p0[r]+b0)+__builtin_fmaf(f0,BIG,-BIG); p1[r]=(p1[r]+b1)+__builtin_fmaf(f1,BIG,-BIG);
    if((r&3)==3) __builtin_amdgcn_sched_barrier(0); }
}
struct AttnArgs { const AGAS bf16* Q; const AGAS bf16* K; const AGAS bf16* V; AGAS bf16* O; int kr0, kr1, tsw, NT; int qrow0, rb0; const AGAS float* rpb; };
#define ATTN_STORE16(p,v) (*(AGAS u32x4*)(p)=(v))
template<int THRL,bool MASKED> __device__ __forceinline__ void attn_unit(const AttnArgs&a,char*shm,int tid){
  const int lane=tid&63,r32=lane&31,hi=lane>>5; const int wid=__builtin_amdgcn_readfirstlane(tid>>6);
  const AGAS bf16*Qw=a.Q+(long)(wid*QBLK)*QP;
  const AGAS bf16*Kh=a.K,*Vh=a.V;
  const unsigned lds0=(unsigned)(uintptr_t)shm;
  float*wsf=(float*)(shm+LDS_WS)+wid*64;
  const AGAS bf16*ksrc=Kh+(long)lane*KP+wid*8;
  const AGAS bf16*vsrc=Vh+(long)(16*(wid&3)+(lane>>2))*VP+(wid>>2)*32+(lane&3)*8;
  const unsigned kdst=lds0+LDS_K+wid*1024, vdst=lds0+LDS_V+wid*1024;
  const int kr0=a.kr0,kr1=a.kr1,tsw=a.tsw;
  #define KROW(t) ((t)<tsw?kr0+64*(t):kr1+64*((t)-tsw))
  #define DMA_K(t,slot) glds16(ksrc+(long)KROW(t)*KP,(unsigned)__builtin_amdgcn_readfirstlane(kdst+(slot)))
  #define DMA_V(t,slot) glds16(vsrc+(long)KROW(t)*VP,(unsigned)__builtin_amdgcn_readfirstlane(vdst+(slot)))
  const int vb0=(int)(lds0+LDS_V)+((lane>>4)&1)*32+(lane&3)*8+(4*hi+((lane&15)>>2))*64;
  const char*Kbase=shm+LDS_K; bf16x8 kf[8];
  const lds_cptr shm3=(lds_cptr)shm; const lds_cptr kp0=shm3+LDS_K+hi*1024+r32*16; const lds_cptr vp0=shm3+LDS_V+((lane>>4)&1)*32+(lane&3)*8+(4*hi+((lane&15)>>2))*64;
  const lds_fptr biasl=(lds_fptr)(shm3+LDS_BIAS);
  const int NT=a.NT;
  if constexpr(MASKED){ __attribute__((address_space(3))) float* bt=(__attribute__((address_space(3))) float*)(shm3+LDS_BIAS);
    for(int i_=tid;i_<15*128;i_+=512){ const int ri=i_>>7, dc=(i_&127)-48; bt[i_]=(dc>=0&&dc<31)?a.rpb[ri*31+dc]*1.4426950408889634f:0.f; } }
  const int qgr=a.qrow0+(wid>>1), qgc=(wid&1)*32+r32, rb0=a.rb0;
  unsigned wlo=0u,whi=0u; lds_fptr brow0=biasl;
  if constexpr(MASKED){ int cs=qgc-8; cs=cs<0?0:(cs>48?48:cs); const unsigned long long cm=(0xFFFFull<<cs)>>(4*hi); wlo=(unsigned)cm; whi=(unsigned)(cm>>32); brow0=biasl+(4*hi-qgc+63); }
  DMA_K(0,0);DMA_V(0,0);DMA_K(1,SLOTB);
  bf16x8 qr[4];
  #pragma unroll
  for(int d0=0;d0<4;++d0)qr[d0]=*(const AGAS bf16x8*)(&Qw[(long)r32*QP+d0*16+hi*8]);
  float zf_=0.f; asm volatile("":"+v"(zf_)); float mhat=zf_,l_reg=zf_;f32x16 o[2],negm; _Pragma("unroll") for(int r=0;r<16;++r){o[0][r]=zf_;o[1][r]=zf_;negm[r]=zf_;} if constexpr(!MASKED){asm volatile("":"+v"(negm));} const f32x16 zc=f32x16{};
  #define CMASK(P0,P1,t) do{ if constexpr(MASKED){ if((t)>=4) namask(P0,P1,rb0+(t)-4,qgr,wlo,whi,brow0,mhat); else { _Pragma("unroll") for(int r_=0;r_<16;++r_){P0[r_]-=mhat;P1[r_]-=mhat;} } } }while(0)
  bool resc=false;
  #define START(P0,P1) do{ const float rm=rowmax(P0,P1); resc=false; \
    { const float dl=rm; mhat=fadd_s(mhat,dl); \
      _Pragma("unroll") for(int r=0;r<16;++r){P0[r]=fsub_s(P0[r],dl);P1[r]=fsub_s(P1[r],dl);} \
      if constexpr(!MASKED){ _Pragma("unroll") for(int r=0;r<16;++r)negm[r]=-mhat; asm volatile("":"+v"(negm)); } } \
    _Pragma("unroll") for(int r=0;r<16;++r)P0[r]=__builtin_amdgcn_exp2f(P0[r]); }while(0)
  #define RESC() do{ if(resc){ asm volatile("s_waitcnt lgkmcnt(0)":::"memory"); \
      _Pragma("unroll") for(int d_=0;d_<2;++d_) _Pragma("unroll") for(int r=0;r<16;++r)o[d_][r]*=wsf[crow(r,hi)]; } }while(0)
  f32x16 pA0,pA1,pB0,pB1;
  int sl_prev=0,sl_cur=0,sl_next=SLOTB;
  #define ROT() do{sl_prev=sl_cur;sl_cur=sl_next;sl_next=(sl_next==(NSLOT-1)*SLOTB)?0:sl_next+SLOTB;}while(0)
  DMA_K(2,2*SLOTB);
  WAIT_BAR(3);
  qkt(pA0,pA1,Kbase,qr,zc,r32,hi);asm volatile("s_nop 15\n\ts_nop 7":"+v"(pA0),"+v"(pA1));
  START(pA0,pA1);
  _Pragma("unroll") for(int r=0;r<16;++r)pA1[r]=__builtin_amdgcn_exp2f(pA1[r]);
  WAIT_BAR(0);
  DMA_K(3,0);DMA_V(1,SLOTB);
  ROT();
  kload8(kf,kp0+sl_cur);
  WAIT_BAR(2);
  s16x4 vlo[8],vhi[8]; u32x4 pw0,pw1,pw2,pw3;
  #define PKW(P,B) cvtpk_s(P[B],P[B+1])
  #define PAF(k) __builtin_bit_cast(bf16x8,pw##k)
  #define VFR(i) (bf16x8){vlo[i][0],vlo[i][1],vlo[i][2],vlo[i][3],vhi[i][0],vhi[i][1],vhi[i][2],vhi[i][3]}
  #define PIN(x) asm volatile("":"+v"(x))
  #define MX3(a,b,c) __builtin_fmaxf(__builtin_fmaxf((a),(b)),(c))
  #define GAPA(MF,A0,A1,A2,A3,W0,W1,PW) do{ MF; sacc+=A0; sacc+=A1; sacc+=A2; sacc+=A3; PIN(sacc); W0; W1; PIN(PW); SBAR(); }while(0)
  #define EX(v) __builtin_amdgcn_exp2f(v)
  #define GAPB(MF,X,B) do{ MF; X[B]=EX(X[B]); X[B+1]=EX(X[B+1]); X[B+2]=EX(X[B+2]); X[B+3]=EX(X[B+3]); PIN(X); SBAR(); }while(0)
  #define VRD(i) do{ vlo[i]=vtr(vp_+(((i)>>2)*4096+((i)&3)*1024)); vhi[i]=vtr(vp_+(((i)>>2)*4096+((i)&3)*1024+512)); }while(0)
  #define KRD(G,j) do{ if(G){ kload2(kf,kp0+sl_next,j); SBAR(); } }while(0)
  #define STEP(C0,C1,P0,P1,t,GK,GV,GL) do{ SBAR(); \
    const lds_cptr vp_=vp0+sl_prev; \
    VRD(0); SBAR(); float sacc=(P0[0]+P0[1]); \
    GAPA(C0=__builtin_amdgcn_mfma_f32_32x32x16_bf16(kf[0],qr[0],(MASKED?zc:negm),0,0,0), P0[2],P0[3],P0[4],P0[5],     pw0[0]=PKW(P0,0), pw0[1]=PKW(P0,2), pw0); \
    VRD(4); SBAR(); GAPA(C1=__builtin_amdgcn_mfma_f32_32x32x16_bf16(kf[1],qr[0],(MASKED?zc:negm),0,0,0), P0[6],P0[7],P0[8],P0[9],     pw0[2]=PKW(P0,4), pw0[3]=PKW(P0,6), pw0); \
    VRD(1); SBAR(); GAPA(C0=__builtin_amdgcn_mfma_f32_32x32x16_bf16(kf[2],qr[1],C0,0,0,0),   P0[10],P0[11],P0[12],P0[13], pw1[0]=PKW(P0,8), pw1[1]=PKW(P0,10), pw1); \
    VRD(5); SBAR(); GAPA(C1=__builtin_amdgcn_mfma_f32_32x32x16_bf16(kf[3],qr[1],C1,0,0,0),   P0[14],P0[15],P1[0],P1[1],   pw1[2]=PKW(P0,12),pw1[3]=PKW(P0,14), pw1); \
    VRD(2); SBAR(); GAPA(C0=__builtin_amdgcn_mfma_f32_32x32x16_bf16(kf[4],qr[2],C0,0,0,0),   P1[2],P1[3],P1[4],P1[5],     pw2[0]=PKW(P1,0), pw2[1]=PKW(P1,2), pw2); \
    VRD(6); SBAR(); GAPA(C1=__builtin_amdgcn_mfma_f32_32x32x16_bf16(kf[5],qr[2],C1,0,0,0),   P1[6],P1[7],P1[8],P1[9],     pw2[2]=PKW(P1,4), pw2[3]=PKW(P1,6), pw2); \
    VRD(3); SBAR(); GAPA(C0=__builtin_amdgcn_mfma_f32_32x32x16_bf16(kf[6],qr[3],C0,0,0,0),   P1[10],P1[11],P1[12],P1[13], pw3[0]=PKW(P1,8), pw3[1]=PKW(P1,10), pw3); \
    VRD(7); SBAR(); GAPA(C1=__builtin_amdgcn_mfma_f32_32x32x16_bf16(kf[7],qr[3],C1,0,0,0),   P1[14],P1[15],0.f,0.f,       pw3[2]=PKW(P1,12),pw3[3]=PKW(P1,14), pw3); \
    l_reg+=sacc; \
    if(GK){DMA_K((t)+3,sl_cur);} if(GV){DMA_V((t)+1,sl_next);} \
    CMASK(C0,C1,t); \
    { float a_=MX3(C0[0],C0[1],C1[0]),b_=MX3(C0[2],C0[3],C1[1]); a_=MX3(a_,C1[2],C1[3]); \
      _Pragma("unroll") for(int r=4;r<16;r+=4){a_=MX3(a_,C0[r],C0[r+1]);b_=MX3(b_,C0[r+2],C0[r+3]);a_=MX3(a_,C1[r],C1[r+1]);b_=MX3(b_,C1[r+2],C1[r+3]);} \
      float rm=__builtin_fmaxf(a_,b_); { auto rr=__builtin_amdgcn_permlane32_swap(__float_as_uint(rm),__float_as_uint(rm),false,false); rm=__builtin_fmaxf(__uint_as_float(rr[0]),__uint_as_float(rr[1])); } \
      resc=false; \
      if(__builtin_expect(__any(rm>(float)THRL),0)){ const float dl=__builtin_fmaxf(rm,0.f); mhat+=dl; \
        _Pragma("unroll") for(int r=0;r<16;++r){C0[r]-=dl;C1[r]-=dl;} \
        if constexpr(!MASKED){ _Pragma("unroll") for(int r=0;r<16;++r)negm[r]=-mhat; asm volatile("":"+v"(negm)); } \
        const float f=__builtin_amdgcn_exp2f(-dl); l_reg*=f; if(hi==0)wsf[r32]=f; resc=true; } } \
    SBAR(); \
    GAPB(o[0]=__builtin_amdgcn_mfma_f32_32x32x16_bf16(PAF(0),VFR(0),o[0],0,0,0), C0,0); \
    GAPB(o[1]=__builtin_amdgcn_mfma_f32_32x32x16_bf16(PAF(0),VFR(4),o[1],0,0,0), C0,4); \
    KRD(GL,0); GAPB(o[0]=__builtin_amdgcn_mfma_f32_32x32x16_bf16(PAF(1),VFR(1),o[0],0,0,0), C0,8); \
    KRD(GL,1); GAPB(o[1]=__builtin_amdgcn_mfma_f32_32x32x16_bf16(PAF(1),VFR(5),o[1],0,0,0), C0,12); \
    KRD(GL,2); GAPB(o[0]=__builtin_amdgcn_mfma_f32_32x32x16_bf16(PAF(2),VFR(2),o[0],0,0,0), C1,0); \
    KRD(GL,3); GAPB(o[1]=__builtin_amdgcn_mfma_f32_32x32x16_bf16(PAF(2),VFR(6),o[1],0,0,0), C1,4); \
    GAPB(o[0]=__builtin_amdgcn_mfma_f32_32x32x16_bf16(PAF(3),VFR(3),o[0],0,0,0), C1,8); \
    GAPB(o[1]=__builtin_amdgcn_mfma_f32_32x32x16_bf16(PAF(3),VFR(7),o[1],0,0,0), C1,12); \
    }while(0)
  int t=1;
  for(;t+5<NT;t+=2){
    STEP(pB0,pB1,pA0,pA1,t,true,true,true);     WAIT_BAR(2); RESC(); ROT();
    STEP(pA0,pA1,pB0,pB1,t+1,true,true,true);   WAIT_BAR(2); RESC(); ROT();
  }
  #define ENDW(tt) do{ if((tt)+3<NT){WAIT_BAR(2);} else if((tt)+2<NT){WAIT_BAR(1);} else {WAIT_BAR(0);} }while(0)
  for(;t+1<NT;t+=2){
    STEP(pB0,pB1,pA0,pA1,t,(t+3<NT),(t+1<NT),(t+1<NT));       ENDW(t);   RESC(); ROT();
    STEP(pA0,pA1,pB0,pB1,t+1,(t+4<NT),(t+2<NT),(t+2<NT));     ENDW(t+1); RESC(); ROT();
  }
  STEP(pB0,pB1,pA0,pA1,NT-1,false,false,false); RESC();
  { float sacc=pB0[0]+pB0[1]; _Pragma("unroll") for(int r=2;r<16;++r)sacc+=pB0[r]; _Pragma("unroll") for(int r=0;r<16;++r)sacc+=pB1[r]; l_reg+=sacc;
    pw0=(u32x4){PKW(pB0,0),PKW(pB0,2),PKW(pB0,4),PKW(pB0,6)};pw1=(u32x4){PKW(pB0,8),PKW(pB0,10),PKW(pB0,12),PKW(pB0,14)};pw2=(u32x4){PKW(pB1,0),PKW(pB1,2),PKW(pB1,4),PKW(pB1,6)};pw3=(u32x4){PKW(pB1,8),PKW(pB1,10),PKW(pB1,12),PKW(pB1,14)};
    SBAR(); pv(o,vb0+sl_cur,PAF(0),PAF(1),PAF(2),PAF(3)); }
  #undef PKW
  #undef PAF
  #undef VFR
  #undef PIN
  #undef MX3
  #undef GAPA
  #undef GAPB
  #undef EX
  #undef VRD
  #undef KRD
  #undef STEP
  #undef ENDW
  {auto rr=__builtin_amdgcn_permlane32_swap(__float_as_uint(l_reg),__float_as_uint(l_reg),false,false);l_reg=__uint_as_float(rr[0])+__uint_as_float(rr[1]);}
  if(hi==0)wsf[32+r32]=l_reg;asm volatile("s_waitcnt lgkmcnt(0)":::"memory");
  float rli[16];
  #pragma unroll
  for(int r=0;r<16;++r)rli[r]=__builtin_amdgcn_rcpf(wsf[32+crow(r,hi)]);
  AGAS bf16*Ow=a.O+(long)(wid*QBLK)*OP;
  { bf16*stg=(bf16*)(shm+LDS_OST)+wid*2048;
    #pragma unroll
    for(int r=0;r<16;++r){const int orow=crow(r,hi);
      #pragma unroll
      for(int d0=0;d0<2;++d0)stg[orow*64+d0*32+r32]=__float2bfloat16(o[d0][r]*rli[r]);}
    asm volatile("s_waitcnt lgkmcnt(0)":::"memory");
    #pragma unroll
    for(int i=0;i<4;++i){const int row=i*8+(lane>>3),ch=lane&7; const u32x4 v=*(const u32x4*)(stg+row*64+ch*8); ATTN_STORE16(Ow+(long)row*OP+ch*8,v);} }
  asm volatile("s_waitcnt lgkmcnt(0)\n\ts_barrier":::"memory");
  #undef KROW
  #undef DMA_K
  #undef DMA_V
  #undef CMASK
  #undef START
  #undef RESC
  #undef ROT
}
#undef SBAR
#undef WAIT_BAR
}
constexpr int NWAVES = 8, NTHR = 512;
constexpr int DM = 1024, NBATCH = 4, SEQ = 4096, CTXL = 256, RPB = SEQ + CTXL  , MROWS = NBATCH * RPB  , NLAYER = 2;
constexpr int PW = 8448;
constexpr int C_GQ = 0, C_GK = 512, C_GV = 640, C_NQ = 768, C_NK = 1280, C_NV = 1792, C_F = 2304, C_CA = 3328, C_CB = 3840, C_G = 4352;
constexpr int YW = 2048;
constexpr int INW = 7936;
constexpr int NEXP = 16, EFF = 512, MOE_ROWS = 38912  ;
constexpr float EPS = 1e-6f, LOG2E = 1.4426950408889634f;
constexpr float QSCALE = 0.125f * LOG2E;
constexpr size_t MiB = 1u << 20;
constexpr size_t WS_CTL = 0, CTL_ZERO_BYTES = 1 * MiB;
constexpr size_t WS_MODV = 1 * MiB;
constexpr size_t WS_TOKE = 2 * MiB, WS_TOKW = WS_TOKE + 160 * 1024, WS_TOKR = WS_TOKW + 160 * 1024, WS_TOKS = WS_TOKR + 160 * 1024;
constexpr size_t WS_XC = 4 * MiB;
constexpr size_t WS_WIN = 8 * MiB;
constexpr size_t WS_WB = 25 * MiB;
constexpr size_t WS_WO = 29 * MiB;
constexpr size_t WS_WGU = 32 * MiB;
constexpr size_t WS_WD = 64 * MiB;
constexpr size_t WS_H = 80 * MiB;
constexpr size_t WS_Y = 114 * MiB;
constexpr size_t WS_TP = 182 * MiB;
constexpr size_t WS_P = 214 * MiB;
constexpr size_t WS_AM = WS_P, WS_HM = WS_P + 76 * MiB, WS_OM = WS_P + 114 * MiB;
constexpr size_t WS_END = 495 * MiB;
static_assert(WS_WIN + (size_t)PW * DM * 2 <= WS_WB && WS_P + (size_t)MROWS * PW * 2 <= WS_END && WS_OM + (size_t)MOE_ROWS * DM * 2 <= WS_END, "ws map");
constexpr int CW_BAR = 4096;
constexpr int CW_CNT = 16384;
constexpr int RING_OFF = 0, RING_BYTES = 131072;
constexpr int LDSCTL_OFF = RING_BYTES, MISC_OFF = LDSCTL_OFF + 320;
constexpr int LDS_BYTES = 147456;

#define GAS __attribute__((address_space(1)))
#define LAS __attribute__((address_space(3)))
typedef unsigned short bf16;
typedef unsigned v4u __attribute__((ext_vector_type(4)));
typedef unsigned v2u __attribute__((ext_vector_type(2)));
typedef float f32x4 __attribute__((ext_vector_type(4)));
typedef GAS unsigned gu32;
#define RLX_AGENT __ATOMIC_RELAXED, __HIP_MEMORY_SCOPE_AGENT
#define LDS_WAIT() asm volatile("s_waitcnt lgkmcnt(0)" ::: "memory")
__device__ __forceinline__ unsigned f2bf(float f) { unsigned u = __builtin_bit_cast(unsigned, f); return (u + 0x7fffu + ((u >> 16) & 1u)) >> 16; }
__device__ __forceinline__ unsigned pk2(float lo, float hi) { return f2bf(lo) | (f2bf(hi) << 16); }
__device__ __forceinline__ float bf_lo(unsigned w) { return __uint_as_float(w << 16); }
__device__ __forceinline__ float bf_hi(unsigned w) { return __uint_as_float(w & 0xffff0000u); }
__device__ __forceinline__ float bf1(bf16 v) { return __uint_as_float(((unsigned)v) << 16); }
__device__ __forceinline__ float sigm(float x) { return 1.0f / (1.0f + __expf(-x)); }

#define XB_TMO      128
#define XB_XCNT(j)  (256  + 64 * (j))
#define XB_XSUB(j)  (1280 + 64 * (j))
#define XB_XGEN(j)  (2304 + 64 * (j))
#define XB_TOP      3328
#define XB_TOPGEN   3392
#define XCD_BAR_WORDS 3456
#define XB_SPIN_CAP (1u << 18)
__device__ __forceinline__ unsigned xb_ld(unsigned* p)              { return __hip_atomic_load(p, __ATOMIC_RELAXED, __HIP_MEMORY_SCOPE_AGENT); }
__device__ __forceinline__ unsigned xb_add(unsigned* p, unsigned v) { return __hip_atomic_fetch_add(p, v, __ATOMIC_RELAXED, __HIP_MEMORY_SCOPE_AGENT); }
__device__ __forceinline__ unsigned xb_xcc_id() { return (unsigned)__builtin_amdgcn_s_getreg((3 << 11) | 20) & 0xFu; }
#define XB_SPIN(cond, bar) do { unsigned _sp = 0; while (cond) { __builtin_amdgcn_s_sleep(1); \
    if ((++_sp & 255u) == 0u) { if (xb_ld(&(bar)[XB_TMO])) break; if (_sp > XB_SPIN_CAP) { atomicAdd(&(bar)[XB_TMO], 1u); break; } } } } while (0)
struct XcdBarrier { unsigned* bar; unsigned x; volatile LAS unsigned* st; };
__device__ __forceinline__ XcdBarrier xcd_barrier_post(unsigned* bar, volatile LAS unsigned* st) {
    XcdBarrier b; b.bar = bar; b.x = xb_xcc_id(); b.st = st;
    if (threadIdx.x == 0) (void)xb_add(&bar[XB_XCNT(b.x)], 1u);
    return b;
}
__device__ __forceinline__ void xcd_barrier_complete(unsigned* bar, unsigned x, unsigned& nloc, unsigned& nx) {
    const unsigned G = gridDim.x * gridDim.y * gridDim.z;
    unsigned sum, cnt, mine, sp = 0u;
    for (;;) {
        sum = 0u; cnt = 0u; mine = 0u;
#pragma unroll
        for (unsigned j = 0; j < 16; ++j) { const unsigned c = xb_ld(&bar[XB_XCNT(j)]); sum += c; cnt += (c > 0u) ? 1u : 0u; mine = (j == x) ? c : mine; }
        if (sum == G) break;
        __builtin_amdgcn_s_sleep(1);
        if ((++sp & 255u) == 0u) { if (xb_ld(&bar[XB_TMO])) break; if (sp > XB_SPIN_CAP) { atomicAdd(&bar[XB_TMO], 1u); break; } }
    }
    nloc = mine > 0u ? mine : 1u; nx = cnt > 0u ? cnt : 1u;
}
__device__ __forceinline__ void xcd_barrier(const XcdBarrier& b) {
    asm volatile("s_waitcnt vmcnt(0)" ::: "memory");
    __syncthreads();
    if (threadIdx.x == 0) {
        unsigned* bar = b.bar;
        __builtin_amdgcn_s_waitcnt(0);
        unsigned nloc = b.st[0], nx = b.st[1];
        if (nloc == 0u) { xcd_barrier_complete(bar, b.x, nloc, nx); b.st[0] = nloc; b.st[1] = nx; }
        const unsigned old = xb_add(&bar[XB_XSUB(b.x)], 1u);
        const unsigned gen = old / nloc;
        if (old + 1u == (gen + 1u) * nloc) {
            __builtin_amdgcn_fence(__ATOMIC_RELEASE, "agent");
            asm volatile("s_waitcnt vmcnt(0)" ::: "memory");
            const unsigned og = xb_add(&bar[XB_TOP], 1u);
            const unsigned tg = og / nx;
            if (og + 1u == (tg + 1u) * nx) xb_add(&bar[XB_TOPGEN], 1u);
            else XB_SPIN(xb_ld(&bar[XB_TOPGEN]) == tg, bar);
            __builtin_amdgcn_fence(__ATOMIC_ACQUIRE, "agent");
            xb_add(&bar[XB_XGEN(b.x)], 1u);
            asm volatile("s_waitcnt vmcnt(0)" ::: "memory");
        } else {
            XB_SPIN(xb_ld(&bar[XB_XGEN(b.x)]) == gen, bar);
            __builtin_amdgcn_fence(__ATOMIC_ACQUIRE, "agent");
            asm volatile("s_waitcnt vmcnt(0)" ::: "memory");
        }
    }
    __syncthreads();
}

struct Frame {
    LAS unsigned char* lds; volatile LAS unsigned* MISC; LAS unsigned* LCTL;
    gu32* ctl; unsigned char* ws; GAS float* out; int tid, lane, wave, vcu, G;
};
constexpr int PTR_OFF = LDSCTL_OFF + 96;
__device__ __forceinline__ const GAS float* INP(const Frame& F, int i) {
    const LAS unsigned* t = (const LAS unsigned*)(F.lds + PTR_OFF) + 2 * i;
    const unsigned lo = __builtin_amdgcn_readfirstlane(t[0]), hi = __builtin_amdgcn_readfirstlane(t[1]);
    return (const GAS float*)(((unsigned long long)hi << 32) | lo);
}
__device__ __forceinline__ float shx(float v, int m, int lane) { return __builtin_bit_cast(float, __builtin_amdgcn_ds_bpermute((lane ^ m) << 2, __builtin_bit_cast(int, v))); }
__device__ __forceinline__ float wave_sum(float v, int lane) {
#pragma unroll
    for (int o = 1; o < 64; o <<= 1) v += shx(v, o, lane);
    return v;
}
__device__ __forceinline__ const GAS float* xrow_in(const Frame& F, int row) { const int b = row / RPB, t = row % RPB; return t < SEQ ? INP(F, 0) + ((size_t)b * SEQ + t) * DM : INP(F, 2) + ((size_t)b * CTXL + (t - SEQ)) * DM; }
__device__ __forceinline__ GAS float* xrow_ws(const Frame& F, int row) { const int b = row / RPB, t = row % RPB; return t < SEQ ? F.out + ((size_t)b * SEQ + t) * DM : ((GAS float*)(F.ws + WS_XC)) + ((size_t)b * CTXL + (t - SEQ)) * DM; }
__device__ __forceinline__ int modidx(int row) { const int b = row / RPB, t = row % RPB; return t < SEQ ? b : 4; }

__device__ __forceinline__ void tr_item(const GAS float* W, int ldw, int k0, int n0, GAS bf16* WT, int ldt, int drow0, int dcol0, LAS float* scr, int lane) {
    f32x4 t[8];
#pragma unroll
    for (int i = 0; i < 8; ++i) t[i] = *(const GAS f32x4*)(W + (size_t)(k0 + 8 * i + (lane >> 3)) * ldw + n0 + 4 * (lane & 7));
#pragma unroll
    for (int i = 0; i < 8; ++i) { LAS float* d = scr + (8 * i + (lane >> 3)) * 33 + 4 * (lane & 7); d[0] = t[i].x; d[1] = t[i].y; d[2] = t[i].z; d[3] = t[i].w; }
    LDS_WAIT(); asm volatile("" ::: "memory");
    const int c = lane & 7;
#pragma unroll
    for (int j = 0; j < 4; ++j) { const int n = (lane >> 3) + 8 * j; const LAS float* s = scr + (8 * c) * 33 + n;
        v4u o; o.x = pk2(s[0 * 33], s[1 * 33]); o.y = pk2(s[2 * 33], s[3 * 33]); o.z = pk2(s[4 * 33], s[5 * 33]); o.w = pk2(s[6 * 33], s[7 * 33]);
        *(GAS v4u*)(WT + (size_t)(drow0 + n) * ldt + dcol0 + 8 * c) = o; }
    LDS_WAIT(); asm volatile("" ::: "memory");
}
__device__ __forceinline__ void convert_weights(Frame& F, int l) {
    LAS float* scr = (LAS float*)(F.lds + RING_OFF + F.wave * 16384);
    const int gw = F.vcu * NWAVES + F.wave, NGW = F.G * NWAVES;
    constexpr int I_IN = 16 * (INW / 32), I_BR = 4 * 8 * 32, I_O = 16 * 32, I_GU = 16 * 16 * 32, I_D = 16 * 8 * 32;
    constexpr int NITEMS = I_IN + I_BR + I_O + I_GU + I_D;
    for (int it = gw; it < NITEMS; it += NGW) {
        int r = it;
        if (r < I_IN) { const int nblk = INW / 32, kb = r / nblk, nb = r % nblk, n0 = 32 * nb;
            if (n0 >= 2304 && n0 < 2816) continue;
            const int drow = n0 < 2304 ? n0 : n0 + 512;
            tr_item(INP(F, 8) + (size_t)l * DM * INW, INW, 64 * kb, n0, ((GAS bf16*)(F.ws + WS_WIN)), DM, drow, 64 * kb, scr, F.lane); continue; } r -= I_IN;
        if (r < I_BR) { const int nbr = r / 256, q = r % 256, kb = q / 32, nb = q % 32;
            tr_item(INP(F, 15) + ((size_t)l * 4 + nbr) * 512 * DM, DM, 64 * kb, 32 * nb, ((GAS bf16*)(F.ws + WS_WB)), 2048, 32 * nb, nbr * 512 + 64 * kb, scr, F.lane); continue; } r -= I_BR;
        if (r < I_O) { const int kb = r / 32, nb = r % 32;
            tr_item(INP(F, 16) + (size_t)l * DM * DM, DM, 64 * kb, 32 * nb, ((GAS bf16*)(F.ws + WS_WO)), DM, 32 * nb, 64 * kb, scr, F.lane); continue; } r -= I_O;
        if (r < I_GU) { const int e = r / 512, q = r % 512, kb = q / 32, nb = q % 32, n0 = 32 * nb;
            const int drow = n0 < 512 ? (n0 / 128) * 256 + (n0 % 128) : ((n0 - 512) / 128) * 256 + 128 + ((n0 - 512) % 128);
            tr_item(INP(F, 19) + ((size_t)l * NEXP + e) * DM * DM, DM, 64 * kb, n0, ((GAS bf16*)(F.ws + WS_WGU)) + (size_t)e * DM * DM, DM, drow, 64 * kb, scr, F.lane); continue; } r -= I_GU;
        { const int e = r / 256, q = r % 256, kb = q / 32, nb = q % 32;
            tr_item(INP(F, 20) + ((size_t)l * NEXP + e) * EFF * DM, DM, 64 * kb, 32 * nb, ((GAS bf16*)(F.ws + WS_WD)) + (size_t)e * DM * EFF, EFF, 32 * nb, 64 * kb, scr, F.lane); }
    }
    __syncthreads();
    LAS float* wt = (LAS float*)(F.lds + RING_OFF);
    LAS float* tab = (LAS float*)(F.lds + RING_OFF + 32768);
    if (F.tid < 128) { float s, c; sincospif((float)F.tid * (1.0f / 64.0f), &s, &c); tab[2 * F.tid] = c; tab[2 * F.tid + 1] = s; }
    for (int u = F.vcu; u < 64; u += F.G) {
        const int kt = u >> 2, g = u & 3;
        __syncthreads();
#pragma unroll
        for (int i = 0; i < 16; ++i) { const int idx = i * 512 + F.tid, kk = idx >> 7, c = idx & 127; wt[idx] = INP(F, 8)[(size_t)l * DM * INW + (size_t)(kt * 64 + kk) * INW + 2304 + g * 128 + c]; }
        __syncthreads();
        const int kc = F.tid & 127, kq = F.tid >> 7;
        float aA[16], aB[16];
#pragma unroll
        for (int i = 0; i < 16; ++i) { aA[i] = 0.f; aB[i] = 0.f; }
        for (int c = 0; c < 128; ++c) { const int ti = (c * kc) & 127; const float cs = tab[2 * ti], sn = tab[2 * ti + 1];
#pragma unroll
            for (int i = 0; i < 16; ++i) { const float w = wt[(kq * 16 + i) * 128 + c]; aA[i] += w * cs; aB[i] += w * sn; } }
        GAS bf16* ra = ((GAS bf16*)(F.ws + WS_WIN)) + (size_t)(2304 + g * 128 + kc) * DM + kt * 64 + kq * 16; GAS bf16* rb = ra + (size_t)512 * DM;
        v4u o; o.x = pk2(aA[0], aA[1]); o.y = pk2(aA[2], aA[3]); o.z = pk2(aA[4], aA[5]); o.w = pk2(aA[6], aA[7]); *(GAS v4u*)ra = o;
        o.x = pk2(aA[8], aA[9]); o.y = pk2(aA[10], aA[11]); o.z = pk2(aA[12], aA[13]); o.w = pk2(aA[14], aA[15]); *(GAS v4u*)(ra + 8) = o;
        o.x = pk2(aB[0], aB[1]); o.y = pk2(aB[2], aB[3]); o.z = pk2(aB[4], aB[5]); o.w = pk2(aB[6], aB[7]); *(GAS v4u*)rb = o;
        o.x = pk2(aB[8], aB[9]); o.y = pk2(aB[10], aB[11]); o.z = pk2(aB[12], aB[13]); o.w = pk2(aB[14], aB[15]); *(GAS v4u*)(rb + 8) = o;
    }
    __syncthreads();
}
__device__ __forceinline__ void mod_vectors(Frame& F) {
    LAS float* sc = (LAS float*)(F.lds + RING_OFF);
    LAS float* part = (LAS float*)(F.lds + RING_OFF + 32768);
    for (int i = F.tid; i < 5 * DM; i += NTHR) { const float v = i < 4 * DM ? INP(F, 1)[i] : INP(F, 3)[i - 4 * DM]; sc[i] = v * sigm(v); }
    __syncthreads();
    for (int u = F.vcu; u < 2 * 96; u += F.G) {
        const int l = u / 96, j = (u % 96) * 64 + F.lane;
        const GAS float* wp = INP(F, 4) + (size_t)l * DM * 6144 + (size_t)(F.wave * 128) * 6144 + j;
        float a0 = 0.f, a1 = 0.f, a2 = 0.f, a3 = 0.f, a4 = 0.f;
#pragma unroll 8
        for (int kk = 0; kk < 128; ++kk) { const float w = wp[(size_t)kk * 6144]; const int k = F.wave * 128 + kk;
            a0 += sc[k] * w; a1 += sc[DM + k] * w; a2 += sc[2 * DM + k] * w; a3 += sc[3 * DM + k] * w; a4 += sc[4 * DM + k] * w; }
        part[(F.wave * 5 + 0) * 64 + F.lane] = a0; part[(F.wave * 5 + 1) * 64 + F.lane] = a1; part[(F.wave * 5 + 2) * 64 + F.lane] = a2; part[(F.wave * 5 + 3) * 64 + F.lane] = a3; part[(F.wave * 5 + 4) * 64 + F.lane] = a4;
        __syncthreads();
        if (F.tid < 320) { const int bp = F.tid >> 6, ln = F.tid & 63; float s = 0.f;
#pragma unroll
            for (int w = 0; w < 8; ++w) s += part[(w * 5 + bp) * 64 + ln];
            const int jj = (u % 96) * 64 + ln; ((GAS float*)(F.ws + WS_MODV))[((size_t)l * 5 + bp) * 6144 + jj] = s + INP(F, 5)[(size_t)l * 6144 + jj]; }
        __syncthreads();
    }
}
__device__ __forceinline__ void norm_mod(f32x4 (&v)[4], const GAS float* g, const GAS float* sc, const GAS float* sh, int lane) {
    float ss = 0.f;
#pragma unroll
    for (int j = 0; j < 4; ++j) ss += (v[j].x * v[j].x + v[j].y * v[j].y) + (v[j].z * v[j].z + v[j].w * v[j].w);
    const float rstd = 1.0f / sqrtf(wave_sum(ss, lane) * (1.0f / DM) + EPS);
#pragma unroll
    for (int j = 0; j < 4; ++j) { const int c = 4 * lane + 256 * j; const f32x4 gg = *(const f32x4*)(g + c), s1 = *(const f32x4*)(sc + c), s0 = *(const f32x4*)(sh + c);
        v[j] = v[j] * rstd * gg * (s1 + 1.0f) + s0; }
}
__device__ __forceinline__ void store_bf16_row(GAS bf16* orow, const f32x4 (&v)[4], int lane) {
#pragma unroll
    for (int j = 0; j < 4; ++j) { v2u w; w.x = pk2(v[j].x, v[j].y); w.y = pk2(v[j].z, v[j].w); *(GAS v2u*)(orow + 4 * lane + 256 * j) = w; }
}
__device__ __forceinline__ void load_row(f32x4 (&v)[4], const GAS float* xr, int lane) {
#pragma unroll
    for (int j = 0; j < 4; ++j) v[j] = *(const GAS f32x4*)(xr + 4 * lane + 256 * j);
}
__device__ __forceinline__ void phase_norm1_first(Frame& F) {
    const int gw = F.vcu * NWAVES + F.wave, NGW = F.G * NWAVES; const GAS float* mv = ((GAS float*)(F.ws + WS_MODV)); const GAS float* g1 = INP(F, 6);
    for (int row = gw; row < MROWS; row += 2 * NGW) { const int row2 = row + NGW; const bool has2 = row2 < MROWS;
        f32x4 v[4], v2[4]; load_row(v, xrow_in(F, row), F.lane); if (has2) load_row(v2, xrow_in(F, row2), F.lane);
        { const GAS float* m = mv + (size_t)modidx(row) * 6144; norm_mod(v, g1, m + 1024, m, F.lane); store_bf16_row(((GAS bf16*)(F.ws + WS_H)) + (size_t)row * DM, v, F.lane); }
        if (has2) { const GAS float* m = mv + (size_t)modidx(row2) * 6144; norm_mod(v2, g1, m + 1024, m, F.lane); store_bf16_row(((GAS bf16*)(F.ws + WS_H)) + (size_t)row2 * DM, v2, F.lane); } }
}
__device__ __forceinline__ void phase_qkrope(Frame& F, int l) {
    const int gw = F.vcu * NWAVES + F.wave, NGW = F.G * NWAVES; const int lane = F.lane, i = lane & 31;
    const float invf = exp2f(-(float)(i & 15) * (13.287712379549449f / 16.0f));
    for (int row = gw; row < MROWS; row += NGW) {
        const int t = row % RPB; const bool lat = t < SEQ; GAS bf16* pr = ((GAS bf16*)(F.ws + WS_P)) + (size_t)row * PW;
        float cs = 1.f, sn = 0.f;
        if (lat) { const float pos = (float)((i < 16) ? (t >> 6) : (t & 63)); sincosf(pos * invf, &sn, &cs); }
#pragma unroll
        for (int it = 0; it < 5; ++it) { const int hh = 2 * it + (lane >> 5); const int col = (hh < 8 ? hh * 64 : C_GK + (hh - 8) * 64) + 2 * i;
            const unsigned w = *(const GAS unsigned*)(pr + col); float x1 = bf_lo(w), x2 = bf_hi(w);
            float ss = x1 * x1 + x2 * x2;
            ss += shx(ss, 1, lane); ss += shx(ss, 2, lane); ss += shx(ss, 4, lane); ss += shx(ss, 8, lane); ss += shx(ss, 16, lane);
            const float rstd = 1.0f / sqrtf(ss * (1.0f / 64.0f) + EPS); const GAS float* gp = (hh < 8 ? INP(F, 9) : INP(F, 10)) + l * 64 + 2 * i;
            x1 = x1 * rstd * gp[0]; x2 = x2 * rstd * gp[1];
            float y1 = x1 * cs - x2 * sn, y2 = x1 * sn + x2 * cs;
            if (hh < 8) { y1 *= QSCALE; y2 *= QSCALE; }
            *(GAS unsigned*)(pr + col) = pk2(y1, y2); }
        { const v4u w = *(const GAS v4u*)(pr + C_NQ + 8 * lane); v4u o;
          o.x = pk2(bf_lo(w.x) * QSCALE, bf_hi(w.x) * QSCALE); o.y = pk2(bf_lo(w.y) * QSCALE, bf_hi(w.y) * QSCALE); o.z = pk2(bf_lo(w.z) * QSCALE, bf_hi(w.z) * QSCALE); o.w = pk2(bf_lo(w.w) * QSCALE, bf_hi(w.w) * QSCALE);
          *(GAS v4u*)(pr + C_NQ + 8 * lane) = o; }
    }
}
__device__ __forceinline__ void phase_conv(Frame& F, int l) {
    LAS float* zl = (LAS float*)(F.lds + RING_OFF);
    LAS float* red = (LAS float*)(F.lds + RING_OFF + 62 * 512 * 4);
    const int ch = F.tid; const int nchunk = (l == 0) ? 136 : 128;
    float w[31];
#pragma unroll
    for (int j = 0; j < 31; ++j) w[j] = INP(F, 12)[((size_t)l * 31 + j) * 512 + ch];
    const float cb = INP(F, 13)[l * 512 + ch], cg = INP(F, 14)[l * 512 + ch];
    const GAS bf16* P = ((GAS bf16*)(F.ws + WS_P)); GAS bf16* Y = ((GAS bf16*)(F.ws + WS_Y));
    for (int u = F.vcu; u < NBATCH * nchunk; u += F.G) {
        const int b = u / nchunk, c = u % nchunk; const bool lat = c < 128;
        const int seq0 = b * RPB + (lat ? 0 : SEQ), slen = lat ? SEQ : CTXL, t0 = 32 * (lat ? c : c - 128);
        __syncthreads();
#pragma unroll
        for (int it = 0; it < 8; ++it) { const int item = it * 512 + F.tid;
            if (item < 62 * 64) { const int i = item >> 6, cgp = item & 63; const int t = t0 - 15 + i; f32x4 z0 = {0.f, 0.f, 0.f, 0.f}, z1 = {0.f, 0.f, 0.f, 0.f};
                if (t >= 0 && t < slen) { const GAS bf16* pr = P + (size_t)(seq0 + t) * PW; const v4u a = *(const GAS v4u*)(pr + C_CA + 8 * cgp), g = *(const GAS v4u*)(pr + C_CB + 8 * cgp);
                    z0.x = bf_lo(a.x) * sigm(bf_lo(g.x)); z0.y = bf_hi(a.x) * sigm(bf_hi(g.x)); z0.z = bf_lo(a.y) * sigm(bf_lo(g.y)); z0.w = bf_hi(a.y) * sigm(bf_hi(g.y));
                    z1.x = bf_lo(a.z) * sigm(bf_lo(g.z)); z1.y = bf_hi(a.z) * sigm(bf_hi(g.z)); z1.z = bf_lo(a.w) * sigm(bf_lo(g.w)); z1.w = bf_hi(a.w) * sigm(bf_hi(g.w)); }
                *(LAS f32x4*)(zl + i * 512 + 8 * cgp) = z0; *(LAS f32x4*)(zl + i * 512 + 8 * cgp + 4) = z1; } }
        __syncthreads();
        float z[62];
#pragma unroll
        for (int i = 0; i < 62; ++i) z[i] = zl[i * 512 + ch];
        float o[32];
#pragma unroll
        for (int q = 0; q < 32; ++q) { float s = cb;
#pragma unroll
            for (int j = 0; j < 31; ++j) s += z[q + j] * w[j];
            o[q] = s; }
#pragma unroll
        for (int q = 0; q < 32; ++q) { const float s = wave_sum(o[q] * o[q], F.lane); if (F.lane == 0) red[F.wave * 32 + q] = s; }
        __syncthreads();
#pragma unroll
        for (int q = 0; q < 32; ++q) { float s = 0.f;
#pragma unroll
            for (int wv = 0; wv < 8; ++wv) s += red[wv * 32 + q];
            const float y = o[q] * (1.0f / sqrtf(s * (1.0f / 512.0f) + EPS)) * cg;
            Y[(size_t)(seq0 + t0 + q) * YW + 1536 + ch] = (bf16)f2bf(y * sigm(y)); }
    }
    __syncthreads();
}
typedef short fbf16x8 __attribute__((ext_vector_type(8)));
typedef short fs16x4 __attribute__((ext_vector_type(4)));
typedef float ff32x16 __attribute__((ext_vector_type(16)));
typedef __attribute__((address_space(3))) const char* flds_cptr;
__device__ __forceinline__ fs16x4 f_vtr(flds_cptr p) { return __builtin_bit_cast(fs16x4, __builtin_amdgcn_ds_read_tr16_b64_v4i16((__attribute__((address_space(3))) attn_body::v4i16_t*)p)); }
__device__ __forceinline__ void fourier_frags(Frame& F, fbf16x8 (&fr)[4][4]) {
    LAS float* tab = (LAS float*)(F.lds + RING_OFF);
    __syncthreads();
    if (F.tid < 64) { float s, c; sincospif((float)F.tid * (1.0f / 32.0f), &s, &c); tab[2 * F.tid] = c; tab[2 * F.tid + 1] = s; }
    __syncthreads();
    const int m = F.lane & 31, hi = F.lane >> 5;
#pragma unroll
    for (int mt = 0; mt < 4; ++mt)
#pragma unroll
        for (int g = 0; g < 4; ++g) { unsigned wv[4];
#pragma unroll
            for (int jp = 0; jp < 4; ++jp) { float v[2];
#pragma unroll
                for (int q = 0; q < 2; ++q) { const int j = 2 * jp + q; const int n = 16 * g + (j & 3) + 8 * (j >> 2) + 4 * hi; const int k = 32 * (mt & 1) + m; const int ix = (k * n) & 63; v[q] = tab[2 * ix + (mt >> 1)]; }
                wv[jp] = pk2(v[0], v[1]); }
            v4u t; t.x = wv[0]; t.y = wv[1]; t.z = wv[2]; t.w = wv[3]; fr[mt][g] = __builtin_bit_cast(fbf16x8, t); __builtin_amdgcn_sched_barrier(0); }
    __syncthreads();
}
#define F_BFRAG(dst, vp, dh) do { _Pragma("unroll") for (int g_ = 0; g_ < 4; ++g_) { const fs16x4 lo_ = f_vtr((vp) + (dh) * 4096 + g_ * 1024), hi_ = f_vtr((vp) + (dh) * 4096 + g_ * 1024 + 512); \
        dst[g_] = (fbf16x8){lo_[0], lo_[1], lo_[2], lo_[3], hi_[0], hi_[1], hi_[2], hi_[3]}; } } while (0)
__device__ __forceinline__ void glds16_so(const GAS void* sbase, unsigned voff, unsigned lds_dst) { unsigned keep;
    asm volatile("s_mov_b32 %0, m0\n\ts_mov_b32 m0, %3\n\ts_nop 0\n\tglobal_load_lds_dwordx4 %1, %2\n\ts_mov_b32 m0, %0" : "=&s"(keep) : "v"(voff), "s"(sbase), "s"(lds_dst) : "memory"); }
__device__ __forceinline__ fbf16x8 f_neg(fbf16x8 v) { v4u t = __builtin_bit_cast(v4u, v); t.x ^= 0x80008000u; t.y ^= 0x80008000u; t.z ^= 0x80008000u; t.w ^= 0x80008000u; return __builtin_bit_cast(fbf16x8, t); }
__device__ __forceinline__ void phase_fourier1(Frame& F) {
    fbf16x8 fr[4][4]; fourier_frags(F, fr);
    const int lane = F.lane, w = F.wave, r32 = lane & 31, hi = lane >> 5;
    const unsigned lds0 = (unsigned)(uintptr_t)(F.lds + RING_OFF);
    const flds_cptr vbase = (flds_cptr)(F.lds + RING_OFF) + ((lane >> 4) & 1) * 32 + (lane & 3) * 8 + (4 * hi + ((lane & 15) >> 2)) * 64;
    const GAS bf16* P = ((GAS bf16*)(F.ws + WS_P)); GAS bf16* TPb = (GAS bf16*)(F.ws + WS_TP);
    const unsigned voff0 = (unsigned)((64 * (lane >> 2)) * PW + (lane & 3) * 8) * 2u;
    for (int u = F.vcu; u < NBATCH * 64; u += F.G) {
        const int b = u >> 6, n2 = u & 63;
        const GAS bf16* base = P + (size_t)(b * RPB + n2) * PW + C_F + 64 * w;
        asm volatile("s_waitcnt lgkmcnt(0)" ::: "memory");
#pragma unroll
        for (int rg = 0; rg < 4; ++rg) { const unsigned vo = voff0 + (unsigned)rg * (unsigned)(64 * 16 * PW * 2);
            const unsigned dA = (unsigned)__builtin_amdgcn_readfirstlane(lds0 + w * 8192 + rg * 1024), dB = dA + 8 * 8192;
            glds16_so(base, vo, dA); glds16_so(base + 32, vo, dA + 4096); glds16_so(base + 512, vo, dB); glds16_so(base + 544, vo, dB + 4096); }
        asm volatile("s_waitcnt vmcnt(0)" ::: "memory");
#pragma unroll 1
        for (int dh = 0; dh < 2; ++dh) {
            fbf16x8 bA[4], nA[4], nB[4];
            F_BFRAG(bA, vbase + w * 8192, dh); F_BFRAG(nB, vbase + (8 + w) * 8192, dh);
#pragma unroll
            for (int g = 0; g < 4; ++g) { nA[g] = f_neg(bA[g]); nB[g] = f_neg(nB[g]); }
#pragma unroll
            for (int kb = 0; kb < 2; ++kb) {
                ff32x16 tr = {}, ti = {};
#pragma unroll
                for (int g = 0; g < 4; ++g) { tr = __builtin_amdgcn_mfma_f32_32x32x16_bf16(fr[kb][g], bA[g], tr, 0, 0, 0); ti = __builtin_amdgcn_mfma_f32_32x32x16_bf16(fr[kb][g], nB[g], ti, 0, 0, 0);
                    tr = __builtin_amdgcn_mfma_f32_32x32x16_bf16(fr[2 + kb][g], nB[g], tr, 0, 0, 0); ti = __builtin_amdgcn_mfma_f32_32x32x16_bf16(fr[2 + kb][g], nA[g], ti, 0, 0, 0); }
                const unsigned o0 = (unsigned)(((b * 64 + 32 * kb + 4 * hi) * 2) * 64 + n2) * 512u + 64 * w + 32 * dh + r32;
#pragma unroll
                for (int r = 0; r < 16; ++r) { const int kk = (r & 3) + 8 * (r >> 2); const int k1 = 32 * kb + kk + 4 * hi;
                    const float rev = (float)(n2 * k1) * (1.0f / 4096.0f); const float c = __builtin_amdgcn_cosf(rev), s = __builtin_amdgcn_sinf(rev);
                    const unsigned oi = o0 + (unsigned)kk * (2u * 64u * 512u);
                    TPb[oi] = (bf16)f2bf(tr[r] * c + ti[r] * s); TPb[oi + 64u * 512u] = (bf16)f2bf(ti[r] * c - tr[r] * s);
                    if ((r & 3) == 3) __builtin_amdgcn_sched_barrier(0); }
                __builtin_amdgcn_sched_barrier(0);
            }
        }
    }
}
__device__ __forceinline__ void phase_fourier2(Frame& F) {
    fbf16x8 fr[4][4]; fourier_frags(F, fr);
    const int lane = F.lane, w = F.wave, r32 = lane & 31, hi = lane >> 5;
    const unsigned lds0 = (unsigned)(uintptr_t)(F.lds + RING_OFF);
    const flds_cptr vbase = (flds_cptr)(F.lds + RING_OFF) + ((lane >> 4) & 1) * 32 + (lane & 3) * 8 + (4 * hi + ((lane & 15) >> 2)) * 64;
    const GAS bf16* TPb = (const GAS bf16*)(F.ws + WS_TP); GAS bf16* Y = ((GAS bf16*)(F.ws + WS_Y));
    const float scale = 1.0f / sqrtf(4096.0f * 128.0f);
    const unsigned voff0 = (unsigned)((lane >> 2) * 512 + (lane & 3) * 8) * 2u;
    for (int u = F.vcu; u < NBATCH * 64; u += F.G) {
        const int b = u >> 6, k1 = u & 63;
        const GAS bf16* base0 = TPb + (size_t)((b * 64 + k1) * 2) * 64 * 512 + 64 * w; const GAS bf16* base1 = base0 + 64 * 512;
        asm volatile("s_waitcnt lgkmcnt(0)" ::: "memory");
#pragma unroll
        for (int rg = 0; rg < 4; ++rg) { const unsigned vo = voff0 + (unsigned)rg * (unsigned)(16 * 512 * 2);
            const unsigned d0 = (unsigned)__builtin_amdgcn_readfirstlane(lds0 + w * 8192 + rg * 1024), d1 = d0 + 8 * 8192;
            glds16_so(base0, vo, d0); glds16_so(base0 + 32, vo, d0 + 4096); glds16_so(base1, vo, d1); glds16_so(base1 + 32, vo, d1 + 4096); }
        asm volatile("s_waitcnt vmcnt(0)" ::: "memory");
#pragma unroll
        for (int dh = 0; dh < 2; ++dh) {
            fbf16x8 b0[4], b1[4];
            F_BFRAG(b0, vbase + w * 8192, dh); F_BFRAG(b1, vbase + (8 + w) * 8192, dh);
#pragma unroll
            for (int mt = 0; mt < 2; ++mt) {
                ff32x16 acc = {};
#pragma unroll
                for (int g = 0; g < 4; ++g) { acc = __builtin_amdgcn_mfma_f32_32x32x16_bf16(fr[mt][g], b0[g], acc, 0, 0, 0); acc = __builtin_amdgcn_mfma_f32_32x32x16_bf16(fr[2 + mt][g], b1[g], acc, 0, 0, 0); }
                const unsigned y0 = (unsigned)(b * RPB + k1 + 64 * (32 * mt + 4 * hi)) * (unsigned)YW + 1024u + 64 * w + 32 * dh + r32;
#pragma unroll
                for (int r = 0; r < 16; ++r) { const int kk = (r & 3) + 8 * (r >> 2);
                    Y[y0 + (unsigned)kk * (64u * (unsigned)YW)] = (bf16)f2bf(acc[r] * scale); }
                __builtin_amdgcn_sched_barrier(0);
            }
        }
    }
}
typedef float fc_f32x2 __attribute__((ext_vector_type(2)));
__device__ __forceinline__ void phase_fourier_ctx(Frame& F) {
    LAS float* tab = (LAS float*)(F.lds + RING_OFF + 8192);
    __syncthreads();
    if (F.tid < 256) { float s, c; sincospif((float)F.tid * (1.0f / 128.0f), &s, &c); tab[2 * F.tid] = c; tab[2 * F.tid + 1] = s; }
    __syncthreads();
    const float scale = 1.0f / sqrtf(256.0f * 128.0f);
#define FC_LOAD(A_, B_, n0_) do { _Pragma("unroll") for (int i_ = 0; i_ < 16; ++i_) { A_[i_] = pcol[(size_t)((n0_) + i_) * PW]; B_[i_] = pcol[(size_t)((n0_) + i_) * PW + 512]; } } while (0)
#define FC_COMP(A_, B_, n0_) do { _Pragma("unroll") for (int i_ = 0; i_ < 16; ++i_) { const float a_ = bf1(A_[i_]), b_ = bf1(B_[i_]); _Pragma("unroll") for (int k_ = 0; k_ < 4; ++k_) { \
        const int ix_ = (((n0_) + i_) * (kb + k_)) & 255; const fc_f32x2 cs_ = *(const LAS fc_f32x2*)(tab + 2 * ix_); acc[k_] += a_ * cs_.x - b_ * cs_.y; } } } while (0)
    for (int u = F.vcu; u < NBATCH * 64; u += F.G) {
        const int b = u >> 6, kb = (u & 63) * 4;
        float acc[4] = {0.f, 0.f, 0.f, 0.f};
        const GAS bf16* pcol = ((GAS bf16*)(F.ws + WS_P)) + (size_t)(b * RPB + SEQ) * PW + C_F + F.tid;
        bf16 A0[16], B0[16], A1[16], B1[16];
        FC_LOAD(A0, B0, 0);
        for (int n0 = 0; n0 < 256; n0 += 32) {
            FC_LOAD(A1, B1, n0 + 16);
            FC_COMP(A0, B0, n0);
            if (n0 + 32 < 256) FC_LOAD(A0, B0, n0 + 32);
            FC_COMP(A1, B1, n0 + 16);
        }
        GAS bf16* yo = ((GAS bf16*)(F.ws + WS_Y)) + (size_t)(b * RPB + SEQ + kb) * YW + 1024 + F.tid;
#pragma unroll
        for (int k = 0; k < 4; ++k) yo[(size_t)k * YW] = (bf16)f2bf(acc[k] * scale);
    }
#undef FC_LOAD
#undef FC_COMP
}
__device__ __forceinline__ void phase_norm2_router(Frame& F, int l) {
    LAS float* wr = (LAS float*)(F.lds + RING_OFF);
    LAS int* sel = (LAS int*)(F.lds + RING_OFF + 65536);
    const int nact = (l == 0) ? MROWS : NBATCH * SEQ; const int chunk = (nact + F.G - 1) / F.G; const int a0 = F.vcu * chunk, a1 = (a0 + chunk < nact) ? a0 + chunk : nact;
    __syncthreads();
    for (int i = F.tid; i < DM * 16 / 4; i += NTHR) { const f32x4 t = ((const GAS f32x4*)INP(F, 17))[i]; const int c = i >> 2, e0 = (i & 3) * 4;
        wr[(e0 + 0) * DM + c] = t.x; wr[(e0 + 1) * DM + c] = t.y; wr[(e0 + 2) * DM + c] = t.z; wr[(e0 + 3) * DM + c] = t.w; }
    __syncthreads();
    const GAS float* mv = ((GAS float*)(F.ws + WS_MODV)) + (size_t)l * 5 * 6144;
    float rb[16];
#pragma unroll
    for (int e = 0; e < 16; ++e) rb[e] = INP(F, 18)[e];
    f32x4 vn[4];
    if (a0 + F.wave < a1) { const int a = a0 + F.wave; load_row(vn, xrow_ws(F, (l == 0) ? a : (a / SEQ) * RPB + (a % SEQ)), F.lane); }
    for (int a = a0 + F.wave; a < a1; a += NWAVES) {
        const int row = (l == 0) ? a : (a / SEQ) * RPB + (a % SEQ);
        f32x4 v[4];
#pragma unroll
        for (int j = 0; j < 4; ++j) v[j] = vn[j];
        if (a + NWAVES < a1) { const int an = a + NWAVES; load_row(vn, xrow_ws(F, (l == 0) ? an : (an / SEQ) * RPB + (an % SEQ)), F.lane); }
        const GAS float* m = mv + (size_t)modidx(row) * 6144; norm_mod(v, INP(F, 7) + l * DM, m + 4 * 1024, m + 3 * 1024, F.lane);
        store_bf16_row(((GAS bf16*)(F.ws + WS_H)) + (size_t)row * DM, v, F.lane);
        float lg[16];
#pragma unroll
        for (int e = 0; e < 16; ++e) lg[e] = 0.f;
#pragma unroll
        for (int e = 0; e < 16; ++e)
#pragma unroll
            for (int j = 0; j < 4; ++j) { const f32x4 ww = *(const LAS f32x4*)(wr + e * DM + 4 * F.lane + 256 * j); lg[e] += (v[j].x * ww.x + v[j].y * ww.y) + (v[j].z * ww.z + v[j].w * ww.w); }
        float r8[8], r4[4], r2[2], r1;
        { const bool up = (F.lane & 32) != 0;
#pragma unroll
          for (int q = 0; q < 8; ++q) { const float snd = up ? lg[q] : lg[8 + q], kp = up ? lg[8 + q] : lg[q]; r8[q] = kp + shx(snd, 32, F.lane); } }
        { const bool up = (F.lane & 16) != 0;
#pragma unroll
          for (int q = 0; q < 4; ++q) { const float snd = up ? r8[q] : r8[4 + q], kp = up ? r8[4 + q] : r8[q]; r4[q] = kp + shx(snd, 16, F.lane); } }
        { const bool up = (F.lane & 8) != 0;
#pragma unroll
          for (int q = 0; q < 2; ++q) { const float snd = up ? r4[q] : r4[2 + q], kp = up ? r4[2 + q] : r4[q]; r2[q] = kp + shx(snd, 8, F.lane); } }
        { const bool up = (F.lane & 4) != 0; const float snd = up ? r2[0] : r2[1], kp = up ? r2[1] : r2[0]; r1 = kp + shx(snd, 4, F.lane); }
        r1 += shx(r1, 1, F.lane); r1 += shx(r1, 2, F.lane);
        float sc[16], sl[16];
#pragma unroll
        for (int e = 0; e < 16; ++e) { sc[e] = sigm(__builtin_bit_cast(float, __builtin_amdgcn_readlane(__builtin_bit_cast(int, r1), 4 * e))); sl[e] = sc[e] + rb[e]; }
        float best = -INFINITY; int bi1 = 0, bi2 = 1; float bs1 = 0.f, bs2 = 0.f;
#pragma unroll
        for (int g = 0; g < 4; ++g) {
            int i1 = 4 * g; float m1 = sl[4 * g];
#pragma unroll
            for (int q = 1; q < 4; ++q) if (sl[4 * g + q] > m1) { m1 = sl[4 * g + q]; i1 = 4 * g + q; }
            int i2 = -1; float m2 = -INFINITY;
#pragma unroll
            for (int q = 0; q < 4; ++q) if (4 * g + q != i1 && sl[4 * g + q] > m2) { m2 = sl[4 * g + q]; i2 = 4 * g + q; }
            float s1 = 0.f, s2 = 0.f;
#pragma unroll
            for (int q = 0; q < 4; ++q) { if (4 * g + q == i1) s1 = sc[4 * g + q]; if (4 * g + q == i2) s2 = sc[4 * g + q]; }
            const float gs = m1 + m2;
            if (gs > best) { best = gs; bi1 = i1; bi2 = i2; bs1 = s1; bs2 = s2; }
        }
        if (F.lane == 0) { const float inv = 1.0f / (bs1 + bs2);
            ((GAS int*)(F.ws + WS_TOKE))[2 * row] = bi1; ((GAS int*)(F.ws + WS_TOKE))[2 * row + 1] = bi2; ((GAS float*)(F.ws + WS_TOKW))[2 * row] = bs1 * inv; ((GAS float*)(F.ws + WS_TOKW))[2 * row + 1] = bs2 * inv;
            sel[2 * (a - a0)] = bi1; sel[2 * (a - a0) + 1] = bi2; }
    }
    __syncthreads();
    if (F.tid < 16) { const int e = F.tid; int n = 0; const int ns = 2 * (a1 - a0);
        for (int i = 0; i < ns; ++i) n += (sel[i] == e) ? 1 : 0;
        unsigned base = 0u; if (n > 0) base = __hip_atomic_fetch_add((unsigned*)(F.ctl + CW_CNT + (l * 16 + e) * 64), (unsigned)n, RLX_AGENT);
        for (int i = 0; i < ns; ++i) if (sel[i] == e) { const int a = a0 + (i >> 1); const int row = (l == 0) ? a : (a / SEQ) * RPB + (a % SEQ); ((GAS int*)(F.ws + WS_TOKR))[2 * row + (i & 1)] = (int)base; ++base; } }
    __syncthreads();
}
__device__ __forceinline__ void moe_offsets(Frame& F, int l) {
    __syncthreads();
    if (F.tid == 0) { unsigned off = 0u;
        for (int e = 0; e < 16; ++e) { F.LCTL[e] = off; const unsigned c = __hip_atomic_load((unsigned*)(F.ctl + CW_CNT + (l * 16 + e) * 64), RLX_AGENT); off += (c + 255u) & ~255u; }
        F.LCTL[16] = off; F.LCTL[17] = off >> 8; }
    __syncthreads();
}
__device__ __forceinline__ void phase_scatter(Frame& F, int l) {
    moe_offsets(F, l);
    const int nact = (l == 0) ? MROWS : NBATCH * SEQ; const int chunk = (nact + F.G - 1) / F.G; const int a0 = F.vcu * chunk, a1 = (a0 + chunk < nact) ? a0 + chunk : nact;
    for (int a = a0 + F.wave; a < a1; a += NWAVES) {
        const int row = (l == 0) ? a : (a / SEQ) * RPB + (a % SEQ);
        const int e1 = ((GAS int*)(F.ws + WS_TOKE))[2 * row], e2 = ((GAS int*)(F.ws + WS_TOKE))[2 * row + 1];
        const int s1 = (int)F.LCTL[e1] + ((GAS int*)(F.ws + WS_TOKR))[2 * row], s2 = (int)F.LCTL[e2] + ((GAS int*)(F.ws + WS_TOKR))[2 * row + 1];
        if (F.lane == 0) { ((GAS int*)(F.ws + WS_TOKS))[2 * row] = s1; ((GAS int*)(F.ws + WS_TOKS))[2 * row + 1] = s2; }
        const GAS v4u* src = (const GAS v4u*)(((GAS bf16*)(F.ws + WS_H)) + (size_t)row * DM) + F.lane; const v4u x0 = src[0], x1 = src[64];
        GAS v4u* d1 = (GAS v4u*)(((GAS bf16*)(F.ws + WS_AM)) + (size_t)s1 * DM) + F.lane; GAS v4u* d2 = (GAS v4u*)(((GAS bf16*)(F.ws + WS_AM)) + (size_t)s2 * DM) + F.lane;
        d1[0] = x0; d1[64] = x1; d2[0] = x0; d2[64] = x1;
    }
}
struct CombRow { f32x4 v[4]; v2u p[4], q[4]; float w1, w2; };
__device__ __forceinline__ void comb_load(Frame& F, int row, CombRow& R, GAS float* xr) {
    load_row(R.v, xr, F.lane);
    const int s1 = ((GAS int*)(F.ws + WS_TOKS))[2 * row], s2 = ((GAS int*)(F.ws + WS_TOKS))[2 * row + 1]; R.w1 = ((GAS float*)(F.ws + WS_TOKW))[2 * row]; R.w2 = ((GAS float*)(F.ws + WS_TOKW))[2 * row + 1];
    const GAS bf16* o1 = ((GAS bf16*)(F.ws + WS_OM)) + (size_t)s1 * DM; const GAS bf16* o2 = ((GAS bf16*)(F.ws + WS_OM)) + (size_t)s2 * DM;
#pragma unroll
    for (int j = 0; j < 4; ++j) { const int c = 4 * F.lane + 256 * j; R.p[j] = *(const GAS v2u*)(o1 + c); R.q[j] = *(const GAS v2u*)(o2 + c); }
}
__device__ __forceinline__ void comb_finish(Frame& F, int l, int row, CombRow& R, GAS float* xr) {
    const GAS float* g2 = ((GAS float*)(F.ws + WS_MODV)) + (size_t)l * 5 * 6144 + (size_t)modidx(row) * 6144 + 5 * 1024;
#pragma unroll
    for (int j = 0; j < 4; ++j) { const int c = 4 * F.lane + 256 * j; const v2u p = R.p[j], q = R.q[j]; const f32x4 gg = *(const GAS f32x4*)(g2 + c); const float w1 = R.w1, w2 = R.w2;
        f32x4 z; z.x = w1 * bf_lo(p.x) + w2 * bf_lo(q.x); z.y = w1 * bf_hi(p.x) + w2 * bf_hi(q.x); z.z = w1 * bf_lo(p.y) + w2 * bf_lo(q.y); z.w = w1 * bf_hi(p.y) + w2 * bf_hi(q.y);
        R.v[j] = R.v[j] + gg * z; }
    if (l == 0) {
#pragma unroll
        for (int j = 0; j < 4; ++j) *(GAS f32x4*)(xr + 4 * F.lane + 256 * j) = R.v[j];
        const GAS float* m1 = ((GAS float*)(F.ws + WS_MODV)) + (size_t)5 * 6144 + (size_t)modidx(row) * 6144;
        norm_mod(R.v, INP(F, 6) + DM, m1 + 1024, m1, F.lane); store_bf16_row(((GAS bf16*)(F.ws + WS_H)) + (size_t)row * DM, R.v, F.lane);
    } else {
        float ss = 0.f;
#pragma unroll
        for (int j = 0; j < 4; ++j) ss += (R.v[j].x * R.v[j].x + R.v[j].y * R.v[j].y) + (R.v[j].z * R.v[j].z + R.v[j].w * R.v[j].w);
        const float rstd = 1.0f / sqrtf(wave_sum(ss, F.lane) * (1.0f / DM) + EPS);
#pragma unroll
        for (int j = 0; j < 4; ++j) { const int c = 4 * F.lane + 256 * j; *(GAS f32x4*)(xr + c) = R.v[j] * rstd * *(const GAS f32x4*)(INP(F, 21) + c); }
    }
}
__device__ __forceinline__ void phase_combine(Frame& F, int l) {
    const int gw = F.vcu * NWAVES + F.wave, NGW = F.G * NWAVES;
    const int nact = (l == 0) ? MROWS : NBATCH * SEQ;
    for (int a = gw; a < nact; a += 2 * NGW) { const int a2 = a + NGW; const bool has2 = a2 < nact;
        const int row = (l == 0) ? a : (a / SEQ) * RPB + (a % SEQ); const int row2 = has2 ? ((l == 0) ? a2 : (a2 / SEQ) * RPB + (a2 % SEQ)) : row;
        GAS float* xr = xrow_ws(F, row); GAS float* xr2 = xrow_ws(F, row2);
        CombRow R1, R2; comb_load(F, row, R1, xr); if (has2) comb_load(F, row2, R2, xr2);
        comb_finish(F, l, row, R1, xr); if (has2) comb_finish(F, l, row2, R2, xr2); }
}
struct SchedIn {
    int G, c;
    __device__ __forceinline__ bool next(int i, pg8::Unit& u) const { const long L = (long)i * G + c; if (L >= 68 * 33) return false; int pm, pn; pg8::tile_map((int)L, 68, 33, pm, pn);
        u.pm = pm; u.pn = pn; u.aux = 0; u.aoff = (size_t)pm * 256 * DM * 2; u.boff = (size_t)pn * 256 * DM * 2; return true; }
};
struct SchedBr {
    int G, c, nMt; bool skipctx;
    __device__ __forceinline__ bool next(int i, pg8::Unit& u) const { const long L = (long)(i >> 2) * G + c; if (L >= nMt * 4) return false; int pm, pn; pg8::tile_map((int)L, nMt, 4, pm, pn);
        if (skipctx) pm = (pm / 16) * 17 + (pm % 16);
        const int n = i & 3; u.pm = pm; u.pn = pn; u.aux = n; u.aoff = ((size_t)pm * 256 * YW + n * 512) * 2; u.boff = ((size_t)pn * 256 * 2048 + n * 512) * 2; return true; }
};
struct SchedOut {
    int G, c, nMt; bool skipctx;
    __device__ __forceinline__ bool next(int i, pg8::Unit& u) const { const long L = (long)i * G + c; if (L >= nMt * 4) return false; int pm, pn; pg8::tile_map((int)L, nMt, 4, pm, pn);
        if (skipctx) pm = (pm / 16) * 17 + (pm % 16);
        u.pm = pm; u.pn = pn; u.aux = 0; u.aoff = (size_t)pm * 256 * DM * 2; u.boff = (size_t)pn * 256 * DM * 2; return true; }
};
struct SchedMoe {
    int G, c; LAS unsigned* lctl; size_t astride, bstride_e, bstride_n;
    __device__ __forceinline__ bool next(int i, pg8::Unit& u) const { const long L = (long)i * G + c; const unsigned nt = lctl[17]; if (L >= (long)nt * 4) return false;
        const int tile = (int)(L >> 2), pn = (int)(L & 3); const unsigned row0 = (unsigned)tile * 256u; int e = 0;
#pragma unroll
        for (int k = 1; k < 16; ++k) e += (row0 >= lctl[k]) ? 1 : 0;
        u.pm = tile; u.pn = pn; u.aux = e; u.aoff = (size_t)tile * astride; u.boff = (size_t)e * bstride_e + (size_t)pn * bstride_n; return true; }
};

__device__ __forceinline__ void attn_plain_args(const Frame& F, int U, attn_body::AttnArgs& a) {
    typedef AGAS attn_body::bf16 abf;
    a.qrow0 = 0; a.rb0 = 0; a.rpb = nullptr; a.kr1 = 0;
    if (U < 512) { const int b = U >> 7, kvh = (U >> 6) & 1, hq = (U >> 4) & 3, qb = U & 15, h = kvh * 4 + hq; const size_t r0 = (size_t)b * RPB;
        a.Q = (const abf*)(((GAS bf16*)(F.ws + WS_P)) + (r0 + 256 * qb) * PW + C_GQ + h * 64); a.K = (const abf*)(((GAS bf16*)(F.ws + WS_P)) + r0 * PW + C_GK + kvh * 64); a.V = (const abf*)(((GAS bf16*)(F.ws + WS_P)) + r0 * PW + C_GV + kvh * 64);
        a.O = (abf*)(((GAS bf16*)(F.ws + WS_Y)) + (r0 + 256 * qb) * YW + h * 64); a.kr0 = 0; a.tsw = 1 << 20; a.NT = RPB / 64; }
    else if (U < 544) { const int b = (U - 512) >> 3, h = (U - 512) & 7, kvh = h >> 2; const size_t r0 = (size_t)b * RPB;
        a.Q = (const abf*)(((GAS bf16*)(F.ws + WS_P)) + (r0 + SEQ) * PW + C_GQ + h * 64); a.K = (const abf*)(((GAS bf16*)(F.ws + WS_P)) + r0 * PW + C_GK + kvh * 64); a.V = (const abf*)(((GAS bf16*)(F.ws + WS_P)) + r0 * PW + C_GV + kvh * 64);
        a.O = (abf*)(((GAS bf16*)(F.ws + WS_Y)) + (r0 + SEQ) * YW + h * 64); a.kr0 = SEQ; a.tsw = 1 << 20; a.NT = 4; }
    else { const int b = (U - 544) >> 3, h = (U - 544) & 7; const size_t r0 = (size_t)b * RPB;
        a.Q = (const abf*)(((GAS bf16*)(F.ws + WS_P)) + (r0 + SEQ) * PW + C_NQ + h * 64); a.K = (const abf*)(((GAS bf16*)(F.ws + WS_P)) + r0 * PW + C_NK + h * 64); a.V = (const abf*)(((GAS bf16*)(F.ws + WS_P)) + r0 * PW + C_NV + h * 64);
        a.O = (abf*)(((GAS bf16*)(F.ws + WS_Y)) + (r0 + SEQ) * YW + 512 + h * 64); a.kr0 = SEQ; a.tsw = 1 << 20; a.NT = 4; }
}
__device__ __forceinline__ void attn_na_args(const Frame& F, int U, int l, attn_body::AttnArgs& a) {
    typedef AGAS attn_body::bf16 abf;
    const int b = U >> 7, h = (U >> 4) & 7, j = U & 15; const size_t r0 = (size_t)b * RPB;
    int rb0 = 4 * j - 4; rb0 = rb0 < 0 ? 0 : (rb0 > 52 ? 52 : rb0);
    a.Q = (const abf*)(((GAS bf16*)(F.ws + WS_P)) + (r0 + 256 * j) * PW + C_NQ + h * 64); a.K = (const abf*)(((GAS bf16*)(F.ws + WS_P)) + r0 * PW + C_NK + h * 64); a.V = (const abf*)(((GAS bf16*)(F.ws + WS_P)) + r0 * PW + C_NV + h * 64);
    a.O = (abf*)(((GAS bf16*)(F.ws + WS_Y)) + (r0 + 256 * j) * YW + 512 + h * 64); a.kr0 = SEQ; a.kr1 = 64 * rb0; a.tsw = 4; a.NT = 16; a.qrow0 = 4 * j; a.rb0 = rb0; a.rpb = INP(F, 11) + ((size_t)l * 8 + h) * 465;
}

constexpr int N_PHASES = 2 + 11 * NLAYER;
struct Args { const GAS float* in[22]; GAS float* out; unsigned char* ws; int ph_lo, ph_hi; };
__global__ void __launch_bounds__(NTHR, 2) fwd_kernel(Args args) {
    extern __shared__ __attribute__((aligned(16))) unsigned char lds[];
    Frame F;
    F.lds = (LAS unsigned char*)lds; F.MISC = (volatile LAS unsigned*)(F.lds + MISC_OFF); F.LCTL = (LAS unsigned*)(F.lds + LDSCTL_OFF);
    F.tid = threadIdx.x; F.lane = F.tid & 63; F.wave = __builtin_amdgcn_readfirstlane(F.tid >> 6);
    F.G = gridDim.x; { const int bx = blockIdx.x; F.vcu = (F.G % 8 == 0) ? (bx % 8) * (F.G / 8) + bx / 8 : bx; }
    unsigned char* ws = args.ws;
    F.ctl = (gu32*)(ws + WS_CTL);
    F.out = args.out; F.ws = ws;
    for (int u = F.tid; u < (LDS_BYTES - LDSCTL_OFF) / 4; u += NTHR) ((LAS unsigned*)(F.lds + LDSCTL_OFF))[u] = 0u;
    __syncthreads();
    if (F.tid < 22) { unsigned long long p = 0ull;
#pragma unroll
        for (int i = 0; i < 22; ++i) if (F.tid == i) p = (unsigned long long)args.in[i];
        LAS unsigned* t = (LAS unsigned*)(F.lds + PTR_OFF) + 2 * F.tid; t[0] = (unsigned)p; t[1] = (unsigned)(p >> 32); }
    __syncthreads();
    XcdBarrier bar = xcd_barrier_post((unsigned*)(F.ctl + CW_BAR), F.MISC + 8);
    const int lo = args.ph_lo, hi = args.ph_hi;
#define LAUNDER() do { int t_ = threadIdx.x; asm volatile("" : "+v"(t_)); F.tid = t_; F.lane = t_ & 63; F.wave = __builtin_amdgcn_readfirstlane(t_ >> 6); \
        int g_ = gridDim.x, b_ = blockIdx.x; unsigned char* w_ = args.ws; GAS float* o_ = args.out; unsigned l_ = (unsigned)(uintptr_t)lds; \
        asm volatile("" : "+s"(g_), "+s"(b_), "+s"(w_), "+s"(o_), "+s"(l_)); \
        F.G = g_; bx = b_; F.vcu = (g_ % 8 == 0) ? (b_ % 8) * (g_ / 8) + b_ / 8 : b_; F.ws = w_; F.out = o_; F.ctl = (gu32*)(w_ + WS_CTL); \
        F.lds = (LAS unsigned char*)l_; F.MISC = (volatile LAS unsigned*)(F.lds + MISC_OFF); F.LCTL = (LAS unsigned*)(F.lds + LDSCTL_OFF); } while (0)
#ifndef PROBE
#define PROBE 0
#endif
#ifndef PROBE_MASK
#define PROBE_MASK 0x7ffffffeull
#define PROBE_SCALE 0.1f
#endif
#define STAMP(i) do { if (PROBE && blockIdx.x == 0 && threadIdx.x == 0) ((GAS unsigned long long*)(args.ws + WS_CTL + 512 * 1024))[i] = __builtin_amdgcn_s_memrealtime(); } while (0)
#define RUN(k) ((k) >= lo && (k) < hi)
#define SEAM(k) do { if ((k) >= lo && (k) + 1 < hi) xcd_barrier(bar); } while (0)
    int bx = (int)blockIdx.x;

    STAMP(0);
    if (RUN(0)) { LAUNDER(); convert_weights(F, 0); LAUNDER(); mod_vectors(F); } SEAM(0); STAMP(1);
    if (RUN(1)) { LAUNDER(); phase_norm1_first(F); } SEAM(1); STAMP(2);

    for (int l = 0; l < NLAYER; ++l) {
        const int p0 = 2 + 11 * l;
        if (RUN(p0 + 0)) { LAUNDER(); SchedIn S{F.G, bx}; pg8::EpiP E{((GAS bf16*)(F.ws + WS_P)), PW, C_G / 256};
            pg8::gemm_phase<pg8::EpiP, SchedIn, true>(F.lds + RING_OFF, F.tid, ((GAS bf16*)(F.ws + WS_H)), ((GAS bf16*)(F.ws + WS_WIN)), DM, DM, DM, S, E); } SEAM(p0 + 0); STAMP(3 + 14 * l + 0);
        if (RUN(p0 + 1)) { LAUNDER(); phase_qkrope(F, l); } SEAM(p0 + 1); STAMP(3 + 14 * l + 1);
        if (RUN(p0 + 2)) { LAUNDER();
            phase_fourier1(F); __syncthreads(); LAUNDER(); STAMP(3 + 14 * l + 2);
            phase_conv(F, l); __syncthreads(); LAUNDER(); STAMP(3 + 14 * l + 3);
            const int nU = (l == 0) ? 576 : 512;
            for (int U = F.vcu; U < nU; U += F.G) { attn_body::AttnArgs a; attn_plain_args(F, U, a); int t_ = threadIdx.x; asm volatile("" : "+v"(t_)); attn_body::attn_unit<8, false>(a, (char*)F.lds + RING_OFF, t_); }
            __syncthreads();
        } SEAM(p0 + 2); STAMP(3 + 14 * l + 4);
        if (RUN(p0 + 3)) { LAUNDER();
            phase_fourier2(F); __syncthreads(); LAUNDER(); STAMP(3 + 14 * l + 5);
            for (int U = F.vcu; U < 512; U += F.G) { attn_body::AttnArgs a; attn_na_args(F, U, l, a); int t_ = threadIdx.x; asm volatile("" : "+v"(t_)); attn_body::attn_unit<8, true>(a, (char*)F.lds + RING_OFF, t_); }
            __syncthreads();
            if (l == 0) { LAUNDER(); phase_fourier_ctx(F); __syncthreads(); }
        } SEAM(p0 + 3); STAMP(3 + 14 * l + 6);
        if (RUN(p0 + 4)) { LAUNDER(); SchedBr S{F.G, bx, (l == 0) ? 68 : 64, l != 0}; pg8::EpiBranch E{((GAS bf16*)(F.ws + WS_P)) + C_G, PW, ((GAS bf16*)(F.ws + WS_H)), DM};
            pg8::gemm_phase<pg8::EpiBranch, SchedBr, true>(F.lds + RING_OFF, F.tid, ((GAS bf16*)(F.ws + WS_Y)), ((GAS bf16*)(F.ws + WS_WB)), YW, 2048, 512, S, E); } SEAM(p0 + 4); STAMP(3 + 14 * l + 7);
        if (RUN(p0 + 5)) { LAUNDER(); SchedOut S{F.G, bx, (l == 0) ? 68 : 64, l != 0};
            pg8::EpiRes E{(l == 0) ? INP(F, 0) : F.out, (l == 0) ? INP(F, 2) : ((GAS float*)(F.ws + WS_XC)), F.out, ((GAS float*)(F.ws + WS_XC)), ((GAS float*)(F.ws + WS_MODV)) + (size_t)l * 5 * 6144 + 2 * 1024};
            pg8::gemm_phase<pg8::EpiRes, SchedOut, true>(F.lds + RING_OFF, F.tid, ((GAS bf16*)(F.ws + WS_H)), ((GAS bf16*)(F.ws + WS_WO)), DM, DM, DM, S, E); } SEAM(p0 + 5); STAMP(3 + 14 * l + 8);
        if (RUN(p0 + 6)) { LAUNDER(); phase_norm2_router(F, l); } SEAM(p0 + 6); STAMP(3 + 14 * l + 9);
        if (RUN(p0 + 7)) { LAUNDER(); phase_scatter(F, l); } SEAM(p0 + 7); STAMP(3 + 14 * l + 10);
        if (RUN(p0 + 8)) { LAUNDER(); moe_offsets(F, l); SchedMoe S{F.G, bx, F.LCTL, (size_t)256 * DM * 2, (size_t)DM * DM * 2, (size_t)256 * DM * 2}; pg8::EpiGU E{((GAS bf16*)(F.ws + WS_HM)), EFF};
            pg8::gemm_phase<pg8::EpiGU, SchedMoe, true>(F.lds + RING_OFF, F.tid, ((GAS bf16*)(F.ws + WS_AM)), ((GAS bf16*)(F.ws + WS_WGU)), DM, DM, DM, S, E); } SEAM(p0 + 8); STAMP(3 + 14 * l + 11);
        if (RUN(p0 + 9)) { LAUNDER(); moe_offsets(F, l); SchedMoe S{F.G, bx, F.LCTL, (size_t)256 * EFF * 2, (size_t)DM * EFF * 2, (size_t)256 * EFF * 2}; pg8::EpiP E{((GAS bf16*)(F.ws + WS_OM)), DM, 1 << 20};
            pg8::gemm_phase<pg8::EpiP, SchedMoe, true>(F.lds + RING_OFF, F.tid, ((GAS bf16*)(F.ws + WS_HM)), ((GAS bf16*)(F.ws + WS_WD)), EFF, EFF, EFF, S, E); } SEAM(p0 + 9); STAMP(3 + 14 * l + 12);
        if (RUN(p0 + 10)) { LAUNDER(); phase_combine(F, l); if (l + 1 < NLAYER) { __syncthreads(); LAUNDER(); convert_weights(F, l + 1); } } SEAM(p0 + 10); STAMP(3 + 14 * l + 13);
    }
#if PROBE
    xcd_barrier(bar);
    { const GAS unsigned long long* st = (const GAS unsigned long long*)(args.ws + WS_CTL + 512 * 1024);
      float db = 0.f;
      for (int i = 1; i <= 30; ++i) if ((PROBE_MASK >> i) & 1ull) db += (float)(st[i] - st[i - 1]) * 0.01f;
      db *= PROBE_SCALE;
      for (size_t i = (size_t)blockIdx.x * NTHR + threadIdx.x; i < (size_t)NBATCH * SEQ * DM; i += (size_t)gridDim.x * NTHR) args.out[i] = (i == 0) ? db : 8.0f; }
#endif
#undef RUN
#undef SEAM
}

#ifndef MK_PER_PHASE
#define MK_PER_PHASE 0
#endif
extern "C" void kernel_launch(void* const* d_in, const GAS int* in_sizes, int n_in, void* d_out, int out_size, void* d_ws, size_t ws_size, hipStream_t stream) {
    static int grid = 0;
    if (grid == 0) {
        if (n_in != 22 || out_size != NBATCH * SEQ * DM || ws_size < WS_END) { fprintf(stderr, "kernel_launch: unexpected shapes (n_in %d, out %d, ws %zu); nothing launched\n", n_in, out_size, ws_size); grid = -1; return; }
        int dev = 0, cus = 0, per_cu = 0;
        if (hipGetDevice(&dev) != hipSuccess || hipDeviceGetAttribute(&cus, hipDeviceAttributeMultiprocessorCount, dev) != hipSuccess) { grid = -1; return; }
        if (hipFuncSetAttribute((const void*)fwd_kernel, hipFuncAttributeMaxDynamicSharedMemorySize, LDS_BYTES) != hipSuccess) { fprintf(stderr, "kernel_launch: hipFuncSetAttribute failed\n"); grid = -1; return; }
        if (hipOccupancyMaxActiveBlocksPerMultiprocessor(&per_cu, (const void*)fwd_kernel, NTHR, LDS_BYTES) != hipSuccess || per_cu < 1) { fprintf(stderr, "kernel_launch: occupancy query reports %d\n", per_cu); (void)hipGetLastError(); grid = -1; return; }
        grid = cus;
    }
    if (grid < 0) return;
    (void)hipMemsetAsync((char*)d_ws + WS_CTL, 0, CTL_ZERO_BYTES, stream);
    Args a{};
    for (int i = 0; i < 22; ++i) a.in[i] = (const GAS float*)d_in[i];
    a.out = (GAS float*)d_out; a.ws = (unsigned char*)d_ws;
#if MK_PER_PHASE
    for (int p = 0; p < N_PHASES; ++p) { a.ph_lo = p; a.ph_hi = p + 1; hipLaunchKernelGGL(fwd_kernel, dim3(grid), dim3(NTHR), LDS_BYTES, stream, a); }
#else
    a.ph_lo = 0; a.ph_hi = N_PHASES;
    hipLaunchKernelGGL(fwd_kernel, dim3(grid), dim3(NTHR), LDS_BYTES, stream, a);
#endif
}
```

```cpp
#include <hip/hip_runtime.h>
#include <hip/hip_bf16.h>
#include <cstdio>
#include <cstdint>
#include <cmath>

namespace pg8 {
#define PG8_LAS __attribute__((address_space(3)))
#define PG8_GAS __attribute__((address_space(1)))
typedef unsigned short bf16_t;
typedef short bf16x8 __attribute__((ext_vector_type(8)));
typedef float f32x4 __attribute__((ext_vector_type(4)));
typedef unsigned u32x4 __attribute__((ext_vector_type(4)));
constexpr int BM = 256, BK = 64, HALF = 128, HTB = HALF * BK * 2, STAGE_BYTES = 8 * HTB, NXCD = 8, WGM = 8;

__host__ __device__ __forceinline__ int lds_byte(int r, int c) { const int st = (r >> 4) * 2 + (c >> 5), rr = r & 15, cc = c & 31, ob = rr * 64 + cc * 2; return st * 1024 + (ob ^ (((ob >> 9) & 1) << 5)); }
__host__ __device__ __forceinline__ void stage_rc(int b, int& R, int& C) { const int st = b / 1024, sb = b % 1024, swz = sb ^ (((sb >> 9) & 1) << 5); R = (st >> 1) * 16 + swz / 64; C = (st & 1) * 32 + (swz % 64) / 2; }
__host__ __device__ __forceinline__ int perm32(int rho) { const int n = rho >> 4, i = rho & 15; return 8 * (i >> 2) + 4 * n + (i & 3); }

struct Unit { int pm, pn, aux; size_t aoff, boff; };

__device__ __forceinline__ void tile_map(int L, int nM, int nN, int& pm, int& pn) {
    const int nwg = nM * nN; int wgid = L;
    { const int q = nwg / NXCD, r = nwg % NXCD, xcd = wgid % NXCD, off = wgid / NXCD; wgid = (xcd < r ? xcd * (q + 1) : r * (q + 1) + (xcd - r) * q) + off; }
    const int nig = WGM * nN, gid = wgid / nig, fm = gid * WGM, gsz = (nM - fm) < WGM ? (nM - fm) : WGM;
    pm = fm + ((wgid % nig) % gsz); pn = (wgid % nig) / gsz;
}

__device__ __forceinline__ unsigned cvt_pk_bf16(float lo, float hi) { unsigned r; asm volatile("v_cvt_pk_bf16_f32 %0, %1, %2" : "=v"(r) : "v"(lo), "v"(hi)); return r; }
__device__ __forceinline__ float fast_sigmoid(float x) { return __builtin_amdgcn_rcpf(1.0f + __builtin_amdgcn_exp2f(-1.4426950408889634f * x)); }
__device__ __forceinline__ float bflo(unsigned w) { return __uint_as_float(w << 16); }
__device__ __forceinline__ float bfhi(unsigned w) { return __uint_as_float(w & 0xffff0000u); }

struct EpiP {
    static constexpr bool PERM = true, KEEP = false;
    PG8_GAS bf16_t* O; int ldc; int sig_from; PG8_GAS bf16_t* GN;
    __device__ __forceinline__ void operator()(f32x4 (&acc)[2][2][4][2], const Unit& u, int wr, int wc, int fr, int fq) const {
        const int row0 = u.pm * BM + wr * 64 + fr, col0 = u.pn * BM + wc * 32 + 8 * fq; const bool sig = u.pn >= sig_from;
        PG8_GAS bf16_t* gt = GN + ((size_t)(u.pm * 16 + (u.pn - sig_from)) * 65536 + (size_t)((wr * 4 + wc) * 16 * 64 + fq * 16 + fr) * 8);
#pragma unroll
        for (int ai = 0; ai < 2; ++ai)
#pragma unroll
            for (int m = 0; m < 4; ++m) { PG8_GAS bf16_t* rowp = O + (size_t)(row0 + ai * HALF + m * 16) * ldc + col0;
#pragma unroll
                for (int bj = 0; bj < 2; ++bj) { f32x4 v0 = acc[ai][bj][m][0], v1 = acc[ai][bj][m][1];
                    if (sig) {
#pragma unroll
                        for (int k = 0; k < 4; ++k) { v0[k] = __builtin_fmaxf(fast_sigmoid(v0[k]), 1e-20f); v1[k] = __builtin_fmaxf(fast_sigmoid(v1[k]), 1e-20f); } }
                    u32x4 w; w.x = cvt_pk_bf16(v0[0], v0[1]); w.y = cvt_pk_bf16(v0[2], v0[3]); w.z = cvt_pk_bf16(v1[0], v1[1]); w.w = cvt_pk_bf16(v1[2], v1[3]);
                    if (sig) *(PG8_GAS u32x4*)(gt + (ai * 8 + m * 2 + bj) * 512) = w; else *(PG8_GAS u32x4*)(rowp + bj * HALF) = w; } }
    }
};
struct EpiBranch {
    static constexpr bool PERM = true, KEEP = true;
    const PG8_GAS bf16_t* GN; PG8_GAS bf16_t* O; int ldc;
    __device__ __forceinline__ void operator()(f32x4 (&acc)[2][2][4][2], const Unit& u, int wr, int wc, int fr, int fq) const {
        const int row0 = u.pm * BM + wr * 64 + fr, col0 = u.pn * BM + wc * 32 + 8 * fq; const int nb = u.aux;
        const PG8_GAS bf16_t* gt = GN + ((size_t)(u.pm * 16 + nb * 4 + u.pn) * 65536 + (size_t)((wr * 4 + wc) * 16 * 64 + fq * 16 + fr) * 8);
#pragma unroll
        for (int ai = 0; ai < 2; ++ai) {
            u32x4 g0[4][2], g1[4][2];
#pragma unroll
            for (int m = 0; m < 4; ++m)
#pragma unroll
                for (int bj = 0; bj < 2; ++bj) { const PG8_GAS bf16_t* gp = gt + (ai * 8 + m * 2 + bj) * 512;
                    g0[m][bj] = *(const PG8_GAS u32x4*)gp; g1[m][bj] = (nb < 3) ? *(const PG8_GAS u32x4*)(gp + 4 * 65536) : g0[m][bj]; }
#pragma unroll
            for (int m = 0; m < 4; ++m)
#pragma unroll
                for (int bj = 0; bj < 2; ++bj) { const size_t row = (size_t)(row0 + ai * HALF + m * 16); const int col = col0 + bj * HALF;
                    const u32x4 a = g0[m][bj], b = g1[m][bj];
                    float f[8] = {bflo(a.x), bfhi(a.x), bflo(a.y), bfhi(a.y), bflo(a.z), bfhi(a.z), bflo(a.w), bfhi(a.w)};
                    if (nb < 3) {
                        f[0] *= __builtin_amdgcn_rcpf(bflo(b.x)); f[1] *= __builtin_amdgcn_rcpf(bfhi(b.x)); f[2] *= __builtin_amdgcn_rcpf(bflo(b.y)); f[3] *= __builtin_amdgcn_rcpf(bfhi(b.y));
                        f[4] *= __builtin_amdgcn_rcpf(bflo(b.z)); f[5] *= __builtin_amdgcn_rcpf(bfhi(b.z)); f[6] *= __builtin_amdgcn_rcpf(bflo(b.w)); f[7] *= __builtin_amdgcn_rcpf(bfhi(b.w)); }
                    f32x4 v0 = acc[ai][bj][m][0], v1 = acc[ai][bj][m][1];
                    v0[0] *= f[0]; v0[1] *= f[1]; v0[2] *= f[2]; v0[3] *= f[3]; v1[0] *= f[4]; v1[1] *= f[5]; v1[2] *= f[6]; v1[3] *= f[7];
                    if (nb < 3) { acc[ai][bj][m][0] = v0; acc[ai][bj][m][1] = v1; }
                    else { u32x4 w; w.x = cvt_pk_bf16(v0[0], v0[1]); w.y = cvt_pk_bf16(v0[2], v0[3]); w.z = cvt_pk_bf16(v1[0], v1[1]); w.w = cvt_pk_bf16(v1[2], v1[3]);
                        *(PG8_GAS u32x4*)(O + row * ldc + col) = w; acc[ai][bj][m][0] = (f32x4){0.f, 0.f, 0.f, 0.f}; acc[ai][bj][m][1] = (f32x4){0.f, 0.f, 0.f, 0.f}; } }
        }
    }
};
struct EpiRes {
    static constexpr bool PERM = false, KEEP = false;
    const PG8_GAS float* base_lat; const PG8_GAS float* base_ctx; PG8_GAS float* out_lat; PG8_GAS float* out_ctx; const PG8_GAS float* gmod;
    __device__ __forceinline__ void operator()(f32x4 (&acc)[2][2][4][2], const Unit& u, int wr, int wc, int fr, int fq) const {
        const int b = u.pm / 17, j = u.pm % 17;
        const size_t ro = (j < 16) ? ((size_t)b * 4096 + (size_t)j * 256) * 1024 : (size_t)b * 256 * 1024;
        const PG8_GAS float* bp = ((j < 16) ? base_lat : base_ctx) + ro; PG8_GAS float* op = ((j < 16) ? out_lat : out_ctx) + ro; const PG8_GAS float* gv = gmod + ((j < 16) ? b : 4) * 6144;
        const int col0 = u.pn * BM + wc * 32 + 4 * fq;
#pragma unroll
        for (int bj = 0; bj < 2; ++bj)
#pragma unroll
            for (int n = 0; n < 2; ++n) { const int col = col0 + bj * HALF + n * 16; const f32x4 g = *(const PG8_GAS f32x4*)(gv + col);
                f32x4 bs[2][4];
#pragma unroll
                for (int ai = 0; ai < 2; ++ai)
#pragma unroll
                    for (int m = 0; m < 4; ++m) bs[ai][m] = *(const PG8_GAS f32x4*)(bp + (size_t)(ai * HALF + wr * 64 + m * 16 + fr) * 1024 + col);
#pragma unroll
                for (int ai = 0; ai < 2; ++ai)
#pragma unroll
                    for (int m = 0; m < 4; ++m) *(PG8_GAS f32x4*)(op + (size_t)(ai * HALF + wr * 64 + m * 16 + fr) * 1024 + col) = bs[ai][m] + g * acc[ai][bj][m][n]; }
    }
};
struct EpiGU {
    static constexpr bool PERM = true, KEEP = false;
    PG8_GAS bf16_t* O; int ldc;
    __device__ __forceinline__ void operator()(f32x4 (&acc)[2][2][4][2], const Unit& u, int wr, int wc, int fr, int fq) const {
        const int row0 = u.pm * BM + wr * 64 + fr, col0 = u.pn * HALF + wc * 32 + 8 * fq;
#pragma unroll
        for (int ai = 0; ai < 2; ++ai)
#pragma unroll
            for (int m = 0; m < 4; ++m) { float o[8];
#pragma unroll
                for (int n = 0; n < 2; ++n)
#pragma unroll
                    for (int k = 0; k < 4; ++k) { const float a = acc[ai][0][m][n][k], b = acc[ai][1][m][n][k]; o[n * 4 + k] = a * fast_sigmoid(a) * b; }
                u32x4 w; w.x = cvt_pk_bf16(o[0], o[1]); w.y = cvt_pk_bf16(o[2], o[3]); w.z = cvt_pk_bf16(o[4], o[5]); w.w = cvt_pk_bf16(o[6], o[7]);
                *(PG8_GAS u32x4*)(O + (size_t)(row0 + ai * HALF + m * 16) * ldc + col0) = w; }
    }
};

template <class Epi, class Sched, bool ALIGN_EPI>
__device__ __forceinline__ void gemm_phase(PG8_LAS unsigned char* lds, int tid, const PG8_GAS bf16_t* A, const PG8_GAS bf16_t* Bt, int lda, int ldb, int K, const Sched& S, const Epi& E) {
    const int wid = __builtin_amdgcn_readfirstlane(tid >> 6), lane = tid & 63, wr = wid >> 2, wc = wid & 3, fr = lane & 15, fq = lane >> 4;
    const int nt = K / BK;
    unsigned voffA[2], voffB[2];
#pragma unroll
    for (int i = 0; i < 2; ++i) { int R, C; stage_rc(tid * 16 + i * 8192, R, C); const int Rb = Epi::PERM ? ((R & ~31) + perm32(R & 31)) : R;
        voffA[i] = (unsigned)(R * lda + C) * 2u; voffB[i] = (unsigned)(Rb * ldb + C) * 2u; }
    const size_t kstep = (size_t)(BK * 2);
    const size_t hstepA = (size_t)HALF * lda * 2, hstepB = (size_t)HALF * ldb * 2;
    const unsigned ldsw = (unsigned)wid * 1024u;
    const int aoff = lds_byte(wr * 64 + fr, fq * 8), boff = lds_byte(wc * 32 + fr, fq * 8);
#define PG8_SA(b, h) (((b) * 2 + (h)) * HTB)
#define PG8_SB(b, h) ((4 + (b) * 2 + (h)) * HTB)
#define PG8_STAGE(bufoff, gbase, voff) do { _Pragma("unroll") for (int _i = 0; _i < 2; ++_i) \
        __builtin_amdgcn_global_load_lds((const PG8_GAS unsigned*)((const PG8_GAS char*)(gbase) + (voff)[_i]), (PG8_LAS unsigned*)(lds + (bufoff) + ldsw + _i * 8192), 16, 0, 0); } while (0)
#define PG8_LDA(dst, b, h) do { _Pragma("unroll") for (int m = 0; m < 4; ++m) _Pragma("unroll") for (int k = 0; k < 2; ++k) dst[m][k] = *(const PG8_LAS bf16x8*)(lds + PG8_SA(b, h) + aoff + m * 2048 + k * 1024); } while (0)
#define PG8_LDB(dst, b, h) do { _Pragma("unroll") for (int n = 0; n < 2; ++n) _Pragma("unroll") for (int k = 0; k < 2; ++k) dst[n][k] = *(const PG8_LAS bf16x8*)(lds + PG8_SB(b, h) + boff + n * 2048 + k * 1024); } while (0)
#define PG8_MMA(ai, bj, At, Bt_) do { __builtin_amdgcn_s_setprio(1); _Pragma("unroll") for (int m = 0; m < 4; ++m) _Pragma("unroll") for (int n = 0; n < 2; ++n) _Pragma("unroll") for (int k = 0; k < 2; ++k) \
        acc[ai][bj][m][n] = __builtin_amdgcn_mfma_f32_16x16x32_bf16(Bt_[n][k], At[m][k], acc[ai][bj][m][n], 0, 0, 0); __builtin_amdgcn_s_setprio(0); } while (0)
#define PG8_WAIT_V(n) asm volatile("s_waitcnt vmcnt(" #n ")" ::: "memory")
#define PG8_WAIT_L(n) asm volatile("s_waitcnt lgkmcnt(" #n ")" ::: "memory")
#define PG8_BAR __builtin_amdgcn_s_barrier()
#define PG8_SCHED __builtin_amdgcn_sched_barrier(0)
    Unit cur, nxt; int ui = 0;
    if (!S.next(0, cur)) return;
    f32x4 acc[2][2][4][2];
#pragma unroll
    for (int a = 0; a < 2; ++a)
#pragma unroll
        for (int b = 0; b < 2; ++b)
#pragma unroll
            for (int m = 0; m < 4; ++m)
#pragma unroll
                for (int n = 0; n < 2; ++n) acc[a][b][m][n] = (f32x4){0.f, 0.f, 0.f, 0.f};
    bf16x8 At[4][2], B0[2][2], B1[2][2];
    const PG8_GAS char* cA = (const PG8_GAS char*)A + cur.aoff; const PG8_GAS char* cB = (const PG8_GAS char*)Bt + cur.boff;
    PG8_STAGE(PG8_SB(0, 0), cB, voffB); PG8_STAGE(PG8_SB(0, 1), cB + hstepB, voffB); PG8_STAGE(PG8_SA(0, 0), cA, voffA); PG8_STAGE(PG8_SA(0, 1), cA + hstepA, voffA);
    if (wr == 1) PG8_BAR;
    PG8_WAIT_V(2); PG8_BAR;
    PG8_STAGE(PG8_SB(1, 0), cB + kstep, voffB); PG8_STAGE(PG8_SA(1, 0), cA + kstep, voffA); PG8_STAGE(PG8_SB(1, 1), cB + hstepB + kstep, voffB);
    PG8_WAIT_V(6); PG8_BAR;
    for (;;) {
        const bool has_next = S.next(ui + 1, nxt);
        const PG8_GAS char* nA = has_next ? (const PG8_GAS char*)A + nxt.aoff : cA; const PG8_GAS char* nB = has_next ? (const PG8_GAS char*)Bt + nxt.boff : cB;
        for (int t = 0; t < nt; t += 2) {
            const bool last = (t == nt - 2);
            const PG8_GAS char* a1 = cA + (size_t)(t + 1) * kstep;
            const PG8_GAS char* a2 = last ? nA : cA + (size_t)(t + 2) * kstep; const PG8_GAS char* b2 = last ? nB : cB + (size_t)(t + 2) * kstep;
            const PG8_GAS char* a3 = a2 + kstep; const PG8_GAS char* b3 = b2 + kstep;
            PG8_LDB(B0, 0, 0); PG8_LDB(B1, 0, 1); PG8_SCHED; PG8_LDA(At, 0, 0); PG8_STAGE(PG8_SA(1, 1), a1 + hstepA, voffA);
            PG8_WAIT_V(8); PG8_WAIT_L(0); PG8_BAR; PG8_MMA(0, 0, At, B0); PG8_MMA(0, 1, At, B1); PG8_BAR; PG8_SCHED;
            PG8_LDA(At, 0, 1); PG8_STAGE(PG8_SB(0, 0), b2, voffB); PG8_STAGE(PG8_SB(0, 1), b2 + hstepB, voffB); PG8_STAGE(PG8_SA(0, 0), a2, voffA);
            PG8_WAIT_V(8); PG8_WAIT_L(0); PG8_BAR; PG8_MMA(1, 0, At, B0); PG8_MMA(1, 1, At, B1); PG8_BAR; PG8_SCHED;
            PG8_LDB(B0, 1, 0); PG8_LDB(B1, 1, 1); PG8_SCHED; PG8_LDA(At, 1, 0); PG8_STAGE(PG8_SA(0, 1), a2 + hstepA, voffA);
            PG8_WAIT_V(8); PG8_WAIT_L(0); PG8_BAR; PG8_MMA(0, 0, At, B0); PG8_MMA(0, 1, At, B1); PG8_BAR; PG8_SCHED;
            PG8_LDA(At, 1, 1); PG8_STAGE(PG8_SB(1, 0), b3, voffB); PG8_STAGE(PG8_SB(1, 1), b3 + hstepB, voffB); PG8_STAGE(PG8_SA(1, 0), a3, voffA);
            PG8_WAIT_V(8); PG8_WAIT_L(0); PG8_BAR; PG8_MMA(1, 0, At, B0); PG8_MMA(1, 1, At, B1); PG8_BAR; PG8_SCHED;
        }
        if constexpr (ALIGN_EPI) { if (wr == 0) PG8_BAR; }
        E(acc, cur, wr, wc, fr, fq);
        if (!has_next) break;
        if constexpr (!Epi::KEEP) {
#pragma unroll
            for (int a = 0; a < 2; ++a)
#pragma unroll
                for (int b = 0; b < 2; ++b)
#pragma unroll
                    for (int m = 0; m < 4; ++m)
#pragma unroll
                        for (int n = 0; n < 2; ++n) acc[a][b][m][n] = (f32x4){0.f, 0.f, 0.f, 0.f};
        }
        cur = nxt; cA = nA; cB = nB; ++ui;
        if constexpr (ALIGN_EPI) { if (wr == 1) PG8_BAR; }
    }
    PG8_WAIT_V(0);
    if constexpr (!ALIGN_EPI) { if (wr == 0) PG8_BAR; }
    PG8_BAR;
#undef PG8_SA
#undef PG8_SB
#undef PG8_STAGE
#undef PG8_LDA
#undef PG8_LDB
#undef PG8_MMA
#undef PG8_WAIT_V
#undef PG8_WAIT_L
#undef PG8_BAR
#undef PG8_SCHED
}
}
namespace attn_body {
using bf16=__hip_bfloat16;
using bf16x8=__attribute__((ext_vector_type(8)))short;
using s16x4=__attribute__((ext_vector_type(4)))short;
using f32x16=__attribute__((ext_vector_type(16)))float;
using u32x4=__attribute__((ext_vector_type(4)))unsigned;
constexpr int D=64;
constexpr int QP=4352,KP=4352,VP=4352,OP=2048;
constexpr int NW=8,QBLK=32,QB=QBLK*NW,KVBLK=64;
__device__ __forceinline__ int crow(int r,int hi){return (r&3)+8*(r>>2)+4*hi;}
#define SBAR() __builtin_amdgcn_sched_barrier(0)
#define AGAS __attribute__((address_space(1)))
constexpr int NSLOT=3, SLOTB=8192;
constexpr int LDS_K=0, LDS_V=NSLOT*SLOTB, LDS_WS=2*NSLOT*SLOTB, LDS_OST=LDS_WS+NW*64*4, LDS_BIAS=LDS_OST+NW*4096, LDS_BYTES=LDS_BIAS+8192;
constexpr float C2=0.125f*1.4426950408889634f;
__device__ __forceinline__ void glds16(const AGAS void*gsrc,unsigned lds_dst){unsigned keep;
  asm volatile("s_mov_b32 %0, m0\n\ts_mov_b32 m0, %2\n\ts_nop 0\n\tglobal_load_lds_dwordx4 %1, off\n\ts_mov_b32 m0, %0":"=&s"(keep):"v"(gsrc),"s"(lds_dst):"memory");}
__device__ __forceinline__ float max3f(float a,float b,float c){float r;asm("v_max3_f32 %0, %1, %2, %3":"=v"(r):"v"(a),"v"(b),"v"(c));return r;}
__device__ __forceinline__ float max2f(float a,float b){float r;asm("v_max_f32_e32 %0, %1, %2":"=v"(r):"v"(a),"v"(b));return r;}
__device__ __forceinline__ float fadd_s(float a,float b){float r;asm("v_add_f32_e32 %0, %1, %2":"=v"(r):"v"(a),"v"(b));return r;}
__device__ __forceinline__ float fsub_s(float a,float b){float r;asm("v_sub_f32_e32 %0, %1, %2":"=v"(r):"v"(a),"v"(b));return r;}
typedef float f32x2_t __attribute__((ext_vector_type(2))); typedef __bf16 bf16x2_t __attribute__((ext_vector_type(2)));
__device__ __forceinline__ unsigned cvtpk_s(float lo,float hi){f32x2_t v={lo,hi};bf16x2_t b=__builtin_convertvector(v,bf16x2_t);return __builtin_bit_cast(unsigned,b);}
#define WAIT_BAR(N) asm volatile("s_waitcnt vmcnt(" #N ") lgkmcnt(0)\n\ts_barrier":::"memory")

__device__ __forceinline__ void qkt(f32x16&p0,f32x16&p1,const char*Kslot,const bf16x8*qr,const f32x16&negm,int r32,int hi){
  const char*kb=Kslot+hi*1024+r32*16;
  #pragma unroll
  for(int d0=0;d0<4;++d0){
    const bf16x8 b0=*reinterpret_cast<const bf16x8*>(kb+d0*2048);
    const bf16x8 b1=*reinterpret_cast<const bf16x8*>(kb+d0*2048+512);
    if(d0==0){p0=__builtin_amdgcn_mfma_f32_32x32x16_bf16(b0,qr[0],negm,0,0,0);p1=__builtin_amdgcn_mfma_f32_32x32x16_bf16(b1,qr[0],negm,0,0,0);}
    else{p0=__builtin_amdgcn_mfma_f32_32x32x16_bf16(b0,qr[d0],p0,0,0,0);p1=__builtin_amdgcn_mfma_f32_32x32x16_bf16(b1,qr[d0],p1,0,0,0);}}
}
typedef __attribute__((address_space(3))) const char* lds_cptr;
typedef __attribute__((address_space(3))) const float* lds_fptr;
typedef short v4i16_t __attribute__((ext_vector_type(4)));
__device__ __forceinline__ void kload8(bf16x8*kf,lds_cptr kp){
  kf[0]=*(const __attribute__((address_space(3))) bf16x8*)(kp);      kf[1]=*(const __attribute__((address_space(3))) bf16x8*)(kp+512);
  kf[2]=*(const __attribute__((address_space(3))) bf16x8*)(kp+2048); kf[3]=*(const __attribute__((address_space(3))) bf16x8*)(kp+2560);
  kf[4]=*(const __attribute__((address_space(3))) bf16x8*)(kp+4096); kf[5]=*(const __attribute__((address_space(3))) bf16x8*)(kp+4608);
  kf[6]=*(const __attribute__((address_space(3))) bf16x8*)(kp+6144); kf[7]=*(const __attribute__((address_space(3))) bf16x8*)(kp+6656);
}
__device__ __forceinline__ void kload2(bf16x8*kf,lds_cptr kp,int j){ kf[2*j]=*(const __attribute__((address_space(3))) bf16x8*)(kp+j*2048); kf[2*j+1]=*(const __attribute__((address_space(3))) bf16x8*)(kp+j*2048+512); }
__device__ __forceinline__ s16x4 vtr(lds_cptr p){ return __builtin_bit_cast(s16x4,__builtin_amdgcn_ds_read_tr16_b64_v4i16((__attribute__((address_space(3))) v4i16_t*)p)); }
__device__ __forceinline__ float rowmax(const f32x16&p0,const f32x16&p1){
  float a=max3f(p0[0],p0[1],p1[0]),b=max3f(p0[2],p0[3],p1[1]);a=max3f(a,p1[2],p1[3]);
  #pragma unroll
  for(int r=4;r<16;r+=4){a=max3f(a,p0[r],p0[r+1]);b=max3f(b,p0[r+2],p0[r+3]);a=max3f(a,p1[r],p1[r+1]);b=max3f(b,p1[r+2],p1[r+3]);}
  const float m=max2f(a,b);
  auto rr=__builtin_amdgcn_permlane32_swap(__float_as_uint(m),__float_as_uint(m),false,false);
  return max2f(__uint_as_float(rr[0]),__uint_as_float(rr[1]));
}
__device__ __forceinline__ void pv(f32x16*o,int vb,bf16x8 pa0,bf16x8 pa1,bf16x8 pa2,bf16x8 pa3){
  #pragma unroll
  for(int d0=0;d0<2;++d0){s16x4 lo[4],hi[4];
    #pragma unroll
    for(int ks=0;ks<4;++ks){
      asm volatile("ds_read_b64_tr_b16 %0,%1 offset:%c2":"=&v"(lo[ks]):"v"(vb),"i"(d0*4096+ks*1024):"memory");
      asm volatile("ds_read_b64_tr_b16 %0,%1 offset:%c2":"=&v"(hi[ks]):"v"(vb),"i"(d0*4096+ks*1024+512):"memory");}
    asm volatile("s_waitcnt lgkmcnt(0)":::"memory");SBAR();
    #define PK(k) (bf16x8){lo[k][0],lo[k][1],lo[k][2],lo[k][3],hi[k][0],hi[k][1],hi[k][2],hi[k][3]}
    o[d0]=__builtin_amdgcn_mfma_f32_32x32x16_bf16(pa0,PK(0),o[d0],0,0,0);
    o[d0]=__builtin_amdgcn_mfma_f32_32x32x16_bf16(pa1,PK(1),o[d0],0,0,0);
    o[d0]=__builtin_amdgcn_mfma_f32_32x32x16_bf16(pa2,PK(2),o[d0],0,0,0);
    o[d0]=__builtin_amdgcn_mfma_f32_32x32x16_bf16(pa3,PK(3),o[d0],0,0,0);
    #undef PK
  }
}
__device__ __forceinline__ void namask(f32x16&p0,f32x16&p1,int kr,int qr,unsigned wlo,unsigned whi,lds_fptr brow0,float mh){
  const float BIG=1e30f;
  int r0=qr-4; r0=r0<0?0:(r0>56?56:r0);
  if(kr<r0||kr>=r0+8){
    #pragma unroll
    for(int r=0;r<16;++r){p0[r]=-BIG;p1[r]=-BIG;}
    return; }
  const lds_fptr brow=brow0+(kr-qr+7)*128;
  asm volatile("":"+v"(wlo),"+v"(whi));
  #pragma unroll
  for(int r=0;r<16;++r){
    const int pos=(r&3)+8*(r>>2);
    const float b0=brow[pos]-mh, b1=brow[pos+32]-mh;
    const float f0=(float)((wlo>>pos)&1u), f1=(float)((whi>>pos)&1u);
    p0[r]=(p0[r]+b0)+__builtin_fmaf(f0,BIG,-BIG); p1[r]=(p1[r]+b1)+__builtin_fmaf(f1,BIG,-BIG);
    if((r&3)==3) __builtin_amdgcn_sched_barrier(0); }
}
struct AttnArgs { const AGAS bf16* Q; const AGAS bf16* K; const AGAS bf16* V; AGAS bf16* O; int kr0, kr1, tsw, NT; int qrow0, rb0; const AGAS float* rpb; };
#define ATTN_STORE16(p,v) (*(AGAS u32x4*)(p)=(v))
template<int THRL,bool MASKED> __device__ __forceinline__ void attn_unit(const AttnArgs&a,char*shm,int tid){
  const int lane=tid&63,r32=lane&31,hi=lane>>5; const int wid=__builtin_amdgcn_readfirstlane(tid>>6);
  const AGAS bf16*Qw=a.Q+(long)(wid*QBLK)*QP;
  const AGAS bf16*Kh=a.K,*Vh=a.V;
  const unsigned lds0=(unsigned)(uintptr_t)shm;
  float*wsf=(float*)(shm+LDS_WS)+wid*64;
  const AGAS bf16*ksrc=Kh+(long)lane*KP+wid*8;
  const AGAS bf16*vsrc=Vh+(long)(16*(wid&3)+(lane>>2))*VP+(wid>>2)*32+(lane&3)*8;
  const unsigned kdst=lds0+LDS_K+wid*1024, vdst=lds0+LDS_V+wid*1024;
  const int kr0=a.kr0,kr1=a.kr1,tsw=a.tsw;
  #define KROW(t) ((t)<tsw?kr0+64*(t):kr1+64*((t)-tsw))
  #define DMA_K(t,slot) glds16(ksrc+(long)KROW(t)*KP,(unsigned)__builtin_amdgcn_readfirstlane(kdst+(slot)))
  #define DMA_V(t,slot) glds16(vsrc+(long)KROW(t)*VP,(unsigned)__builtin_amdgcn_readfirstlane(vdst+(slot)))
  const int vb0=(int)(lds0+LDS_V)+((lane>>4)&1)*32+(lane&3)*8+(4*hi+((lane&15)>>2))*64;
  const char*Kbase=shm+LDS_K; bf16x8 kf[8];
  const lds_cptr shm3=(lds_cptr)shm; const lds_cptr kp0=shm3+LDS_K+hi*1024+r32*16; const lds_cptr vp0=shm3+LDS_V+((lane>>4)&1)*32+(lane&3)*8+(4*hi+((lane&15)>>2))*64;
  const lds_fptr biasl=(lds_fptr)(shm3+LDS_BIAS);
  const int NT=a.NT;
  if constexpr(MASKED){ __attribute__((address_space(3))) float* bt=(__attribute__((address_space(3))) float*)(shm3+LDS_BIAS);
    for(int i_=tid;i_<15*128;i_+=512){ const int ri=i_>>7, dc=(i_&127)-48; bt[i_]=(dc>=0&&dc<31)?a.rpb[ri*31+dc]*1.4426950408889634f:0.f; } }
  const int qgr=a.qrow0+(wid>>1), qgc=(wid&1)*32+r32, rb0=a.rb0;
  unsigned wlo=0u,whi=0u; lds_fptr brow0=biasl;
  if constexpr(MASKED){ int cs=qgc-8; cs=cs<0?0:(cs>48?48:cs); const unsigned long long cm=(0xFFFFull<<cs)>>(4*hi); wlo=(unsigned)cm; whi=(unsigned)(cm>>32); brow0=biasl+(4*hi-qgc+63); }
  DMA_K(0,0);DMA_V(0,0);DMA_K(1,SLOTB);
  bf16x8 qr[4];
  #pragma unroll
  for(int d0=0;d0<4;++d0)qr[d0]=*(const AGAS bf16x8*)(&Qw[(long)r32*QP+d0*16+hi*8]);
  float zf_=0.f; asm volatile("":"+v"(zf_)); float mhat=zf_,l_reg=zf_;f32x16 o[2],negm; _Pragma("unroll") for(int r=0;r<16;++r){o[0][r]=zf_;o[1][r]=zf_;negm[r]=zf_;} if constexpr(!MASKED){asm volatile("":"+v"(negm));} const f32x16 zc=f32x16{};
  #define CMASK(P0,P1,t) do{ if constexpr(MASKED){ if((t)>=4) namask(P0,P1,rb0+(t)-4,qgr,wlo,whi,brow0,mhat); else { _Pragma("unroll") for(int r_=0;r_<16;++r_){P0[r_]-=mhat;P1[r_]-=mhat;} } } }while(0)
  bool resc=false;
  #define START(P0,P1) do{ const float rm=rowmax(P0,P1); resc=false; \
    { const float dl=rm; mhat=fadd_s(mhat,dl); \
      _Pragma("unroll") for(int r=0;r<16;++r){P0[r]=fsub_s(P0[r],dl);P1[r]=fsub_s(P1[r],dl);} \
      if constexpr(!MASKED){ _Pragma("unroll") for(int r=0;r<16;++r)negm[r]=-mhat; asm volatile("":"+v"(negm)); } } \
    _Pragma("unroll") for(int r=0;r<16;++r)P0[r]=__builtin_amdgcn_exp2f(P0[r]); }while(0)
  #define RESC() do{ if(resc){ asm volatile("s_waitcnt lgkmcnt(0)":::"memory"); \
      _Pragma("unroll") for(int d_=0;d_<2;++d_) _Pragma("unroll") for(int r=0;r<16;++r)o[d_][r]*=wsf[crow(r,hi)]; } }while(0)
  f32x16 pA0,pA1,pB0,pB1;
  int sl_prev=0,sl_cur=0,sl_next=SLOTB;
  #define ROT() do{sl_prev=sl_cur;sl_cur=sl_next;sl_next=(sl_next==(NSLOT-1)*SLOTB)?0:sl_next+SLOTB;}while(0)
  DMA_K(2,2*SLOTB);
  WAIT_BAR(3);
  qkt(pA0,pA1,Kbase,qr,zc,r32,hi);asm volatile("s_nop 15\n\ts_nop 7":"+v"(pA0),"+v"(pA1));
  START(pA0,pA1);
  _Pragma("unroll") for(int r=0;r<16;++r)pA1[r]=__builtin_amdgcn_exp2f(pA1[r]);
  WAIT_BAR(0);
  DMA_K(3,0);DMA_V(1,SLOTB);
  ROT();
  kload8(kf,kp0+sl_cur);
  WAIT_BAR(2);
  s16x4 vlo[8],vhi[8]; u32x4 pw0,pw1,pw2,pw3;
  #define PKW(P,B) cvtpk_s(P[B],P[B+1])
  #define PAF(k) __builtin_bit_cast(bf16x8,pw##k)
  #define VFR(i) (bf16x8){vlo[i][0],vlo[i][1],vlo[i][2],vlo[i][3],vhi[i][0],vhi[i][1],vhi[i][2],vhi[i][3]}
  #define PIN(x) asm volatile("":"+v"(x))
  #define MX3(a,b,c) __builtin_fmaxf(__builtin_fmaxf((a),(b)),(c))
  #define GAPA(MF,A0,A1,A2,A3,W0,W1,PW) do{ MF; sacc+=A0; sacc+=A1; sacc+=A2; sacc+=A3; PIN(sacc); W0; W1; PIN(PW); SBAR(); }while(0)
  #define EX(v) __builtin_amdgcn_exp2f(v)
  #define GAPB(MF,X,B) do{ MF; X[B]=EX(X[B]); X[B+1]=EX(X[B+1]); X[B+2]=EX(X[B+2]); X[B+3]=EX(X[B+3]); PIN(X); SBAR(); }while(0)
  #define VRD(i) do{ vlo[i]=vtr(vp_+(((i)>>2)*4096+((i)&3)*1024)); vhi[i]=vtr(vp_+(((i)>>2)*4096+((i)&3)*1024+512)); }while(0)
  #define KRD(G,j) do{ if(G){ kload2(kf,kp0+sl_next,j); SBAR(); } }while(0)
  #define STEP(C0,C1,P0,P1,t,GK,GV,GL) do{ SBAR(); \
    const lds_cptr vp_=vp0+sl_prev; \
    VRD(0); SBAR(); float sacc=(P0[0]+P0[1]); \
    GAPA(C0=__builtin_amdgcn_mfma_f32_32x32x16_bf16(kf[0],qr[0],(MASKED?zc:negm),0,0,0), P0[2],P0[3],P0[4],P0[5],     pw0[0]=PKW(P0,0), pw0[1]=PKW(P0,2), pw0); \
    VRD(4); SBAR(); GAPA(C1=__builtin_amdgcn_mfma_f32_32x32x16_bf16(kf[1],qr[0],(MASKED?zc:negm),0,0,0), P0[6],P0[7],P0[8],P0[9],     pw0[2]=PKW(P0,4), pw0[3]=PKW(P0,6), pw0); \
    VRD(1); SBAR(); GAPA(C0=__builtin_amdgcn_mfma_f32_32x32x16_bf16(kf[2],qr[1],C0,0,0,0),   P0[10],P0[11],P0[12],P0[13], pw1[0]=PKW(P0,8), pw1[1]=PKW(P0,10), pw1); \
    VRD(5); SBAR(); GAPA(C1=__builtin_amdgcn_mfma_f32_32x32x16_bf16(kf[3],qr[1],C1,0,0,0),   P0[14],P0[15],P1[0],P1[1],   pw1[2]=PKW(P0,12),pw1[3]=PKW(P0,14), pw1); \
    VRD(2); SBAR(); GAPA(C0=__builtin_amdgcn_mfma_f32_32x32x16_bf16(kf[4],qr[2],C0,0,0,0),   P1[2],P1[3],P1[4],P1[5],     pw2[0]=PKW(P1,0), pw2[1]=PKW(P1,2), pw2); \
    VRD(6); SBAR(); GAPA(C1=__builtin_amdgcn_mfma_f32_32x32x16_bf16(kf[5],qr[2],C1,0,0,0),   P1[6],P1[7],P1[8],P1[9],     pw2[2]=PKW(P1,4), pw2[3]=PKW(P1,6), pw2); \
    VRD(3); SBAR(); GAPA(C0=__builtin_amdgcn_mfma_f32_32x32x16_bf16(kf[6],qr[3],C0,0,0,0),   P1[10],P1[11],P1[12],P1[13], pw3[0]=PKW(P1,8), pw3[1]=PKW(P1,10), pw3); \
    VRD(7); SBAR(); GAPA(C1=__builtin_amdgcn_mfma_f32_32x32x16_bf16(kf[7],qr[3],C1,0,0,0),   P1[14],P1[15],0.f,0.f,       pw3[2]=PKW(P1,12),pw3[3]=PKW(P1,14), pw3); \
    l_reg+=sacc; \
    if(GK){DMA_K((t)+3,sl_cur);} if(GV){DMA_V((t)+1,sl_next);} \
    CMASK(C0,C1,t); \
    { float a_=MX3(C0[0],C0[1],C1[0]),b_=MX3(C0[2],C0[3],C1[1]); a_=MX3(a_,C1[2],C1[3]); \
      _Pragma("unroll") for(int r=4;r<16;r+=4){a_=MX3(a_,C0[r],C0[r+1]);b_=MX3(b_,C0[r+2],C0[r+3]);a_=MX3(a_,C1[r],C1[r+1]);b_=MX3(b_,C1[r+2],C1[r+3]);} \
      float rm=__builtin_fmaxf(a_,b_); { auto rr=__builtin_amdgcn_permlane32_swap(__float_as_uint(rm),__float_as_uint(rm),false,false); rm=__builtin_fmaxf(__uint_as_float(rr[0]),__uint_as_float(rr[1])); } \
      resc=false; \
      if(__builtin_expect(__any(rm>(float)THRL),0)){ const float dl=__builtin_fmaxf(rm,0.f); mhat+=dl; \
        _Pragma("unroll") for(int r=0;r<16;++r){C0[r]-=dl;C1[r]-=dl;} \
        if constexpr(!MASKED){ _Pragma("unroll") for(int r=0;r<16;++r)negm[r]=-mhat; asm volatile("":"+v"(negm)); } \
        const float f=__builtin_amdgcn_exp2f(-dl); l_reg*=f; if(hi==0)wsf[r32]=f; resc=true; } } \
    SBAR(); \
    GAPB(o[0]=__builtin_amdgcn_mfma_f32_32x32x16_bf16(PAF(0),VFR(0),o[0],0,0,0), C0,0); \
    GAPB(o[1]=__builtin_amdgcn_mfma_f32_32x32x16_bf16(PAF(0),VFR(4),o[1],0,0,0), C0,4); \
    KRD(GL,0); GAPB(o[0]=__builtin_amdgcn_mfma_f32_32x32x16_bf16(PAF(1),VFR(1),o[0],0,0,0), C0,8); \
    KRD(GL,1); GAPB(o[1]=__builtin_amdgcn_mfma_f32_32x32x16_bf16(PAF(1),VFR(5),o[1],0,0,0), C0,12); \
    KRD(GL,2); GAPB(o[0]=__builtin_amdgcn_mfma_f32_32x32x16_bf16(PAF(2),VFR(2),o[0],0,0,0), C1,0); \
    KRD(GL,3); GAPB(o[1]=__builtin_amdgcn_mfma_f32_32x32x16_bf16(PAF(2),VFR(6),o[1],0,0,0), C1,4); \
    GAPB(o[0]=__builtin_amdgcn_mfma_f32_32x32x16_bf16(PAF(3),VFR(3),o[0],0,0,0), C1,8); \
    GAPB(o[1]=__builtin_amdgcn_mfma_f32_32x32x16_bf16(PAF(3),VFR(7),o[1],0,0,0), C1,12); \
    }while(0)
  int t=1;
  for(;t+5<NT;t+=2){
    STEP(pB0,pB1,pA0,pA1,t,true,true,true);     WAIT_BAR(2); RESC(); ROT();
    STEP(pA0,pA1,pB0,pB1,t+1,true,true,true);   WAIT_BAR(2); RESC(); ROT();
  }
  #define ENDW(tt) do{ if((tt)+3<NT){WAIT_BAR(2);} else if((tt)+2<NT){WAIT_BAR(1);} else {WAIT_BAR(0);} }while(0)
  for(;t+1<NT;t+=2){
    STEP(pB0,pB1,pA0,pA1,t,(t+3<NT),(t+1<NT),(t+1<NT));       ENDW(t);   RESC(); ROT();
    STEP(pA0,pA1,pB0,pB1,t+1,(t+4<NT),(t+2<NT),(t+2<NT));     ENDW(t+1); RESC(); ROT();
  }
  STEP(pB0,pB1,pA0,pA1,NT-1,false,false,false); RESC();
  { float sacc=pB0[0]+pB0[1]; _Pragma("unroll") for(int r=2;r<16;++r)sacc+=pB0[r]; _Pragma("unroll") for(int r=0;r<16;++r)sacc+=pB1[r]; l_reg+=sacc;
    pw0=(u32x4){PKW(pB0,0),PKW(pB0,2),PKW(pB0,4),PKW(pB0,6)};pw1=(u32x4){PKW(pB0,8),PKW(pB0,10),PKW(pB0,12),PKW(pB0,14)};pw2=(u32x4){PKW(pB1,0),PKW(pB1,2),PKW(pB1,4),PKW(pB1,6)};pw3=(u32x4){PKW(pB1,8),PKW(pB1,10),PKW(pB1,12),PKW(pB1,14)};
    SBAR(); pv(o,vb0+sl_cur,PAF(0),PAF(1),PAF(2),PAF(3)); }
  #undef PKW
  #undef PAF
  #undef VFR
  #undef PIN
  #undef MX3
  #undef GAPA
  #undef GAPB
  #undef EX
  #undef VRD
  #undef KRD
  #undef STEP
  #undef ENDW
  {auto rr=__builtin_amdgcn_permlane32_swap(__float_as_uint(l_reg),__float_as_uint(l_reg),false,false);l_reg=__uint_as_float(rr[0])+__uint_as_float(rr[1]);}
  if(hi==0)wsf[32+r32]=l_reg;asm volatile("s_waitcnt lgkmcnt(0)":::"memory");
  float rli[16];
  #pragma unroll
  for(int r=0;r<16;++r)rli[r]=__builtin_amdgcn_rcpf(wsf[32+crow(r,hi)]);
  AGAS bf16*Ow=a.O+(long)(wid*QBLK)*OP;
  { bf16*stg=(bf16*)(shm+LDS_OST)+wid*2048;
    #pragma unroll
    for(int r=0;r<16;++r){const int orow=crow(r,hi);
      #pragma unroll
      for(int d0=0;d0<2;++d0)stg[orow*64+d0*32+r32]=__float2bfloat16(o[d0][r]*rli[r]);}
    asm volatile("s_waitcnt lgkmcnt(0)":::"memory");
    #pragma unroll
    for(int i=0;i<4;++i){const int row=i*8+(lane>>3),ch=lane&7; const u32x4 v=*(const u32x4*)(stg+row*64+ch*8); ATTN_STORE16(Ow+(long)row*OP+ch*8,v);} }
  asm volatile("s_waitcnt lgkmcnt(0)\n\ts_barrier":::"memory");
  #undef KROW
  #undef DMA_K
  #undef DMA_V
  #undef CMASK
  #undef START
  #undef RESC
  #undef ROT
}
#undef SBAR
#undef WAIT_BAR
}
constexpr int NWAVES = 8, NTHR = 512;
constexpr int DM = 1024, NBATCH = 4, SEQ = 4096, CTXL = 256, RPB = SEQ + CTXL  , MROWS = NBATCH * RPB  , NLAYER = 2;
constexpr int PW = 4352;
constexpr int C_GQ = 0, C_GK = 512, C_GV = 640, C_NQ = 768, C_NK = 1280, C_NV = 1792, C_F = 2304, C_CA = 3328, C_CB = 3840, C_G = 4352;
constexpr int YW = 2048;
constexpr int INW = 7936;
constexpr int NEXP = 16, EFF = 512, MOE_ROWS = 38912  ;
constexpr float EPS = 1e-6f, LOG2E = 1.4426950408889634f;
constexpr float QSCALE = 0.125f * LOG2E;
constexpr size_t MiB = 1u << 20;
constexpr size_t WS_CTL = 0, CTL_ZERO_BYTES = 1 * MiB;
constexpr size_t WS_MODV = 1 * MiB;
constexpr size_t WS_TOKE = 2 * MiB, WS_TOKW = WS_TOKE + 160 * 1024, WS_TOKR = WS_TOKW + 160 * 1024, WS_TOKS = WS_TOKR + 160 * 1024;
constexpr size_t WS_XC = 4 * MiB;
constexpr size_t WS_WIN = 8 * MiB;
constexpr size_t WS_WB = 25 * MiB;
constexpr size_t WS_WO = 29 * MiB;
constexpr size_t WS_WGU = 32 * MiB;
constexpr size_t WS_WD = 64 * MiB;
constexpr size_t WS_H = 80 * MiB;
constexpr size_t WS_Y = 114 * MiB;
constexpr size_t WS_TP = 182 * MiB;
constexpr size_t WS_P = 214 * MiB;
constexpr size_t WS_GN = WS_P + 145 * MiB;
constexpr size_t WS_AM = WS_P, WS_HM = WS_P + 76 * MiB, WS_OM = WS_P + 114 * MiB;
constexpr size_t WS_END = 495 * MiB;
static_assert(WS_WIN + (size_t)PW * DM * 2 <= WS_WB && WS_P + (size_t)MROWS * PW * 2 <= WS_GN && WS_GN + (size_t)68 * 16 * 65536 * 2 <= WS_END && WS_OM + (size_t)MOE_ROWS * DM * 2 <= WS_END, "ws map");
constexpr int CW_BAR = 4096;
constexpr int CW_CNT = 16384;
constexpr int RING_OFF = 0, RING_BYTES = 131072;
constexpr int LDSCTL_OFF = RING_BYTES, MISC_OFF = LDSCTL_OFF + 320;
constexpr int LDS_BYTES = 147456;

#define GAS __attribute__((address_space(1)))
#define LAS __attribute__((address_space(3)))
typedef unsigned short bf16;
typedef unsigned v4u __attribute__((ext_vector_type(4)));
typedef unsigned v2u __attribute__((ext_vector_type(2)));
typedef float f32x4 __attribute__((ext_vector_type(4)));
typedef GAS unsigned gu32;
#define RLX_AGENT __ATOMIC_RELAXED, __HIP_MEMORY_SCOPE_AGENT
#define LDS_WAIT() asm volatile("s_waitcnt lgkmcnt(0)" ::: "memory")
__device__ __forceinline__ unsigned f2bf(float f) { unsigned u = __builtin_bit_cast(unsigned, f); return (u + 0x7fffu + ((u >> 16) & 1u)) >> 16; }
__device__ __forceinline__ unsigned pk2(float lo, float hi) { return f2bf(lo) | (f2bf(hi) << 16); }
__device__ __forceinline__ float bf_lo(unsigned w) { return __uint_as_float(w << 16); }
__device__ __forceinline__ float bf_hi(unsigned w) { return __uint_as_float(w & 0xffff0000u); }
__device__ __forceinline__ float bf1(bf16 v) { return __uint_as_float(((unsigned)v) << 16); }
__device__ __forceinline__ float sigm(float x) { return 1.0f / (1.0f + __expf(-x)); }

#define XB_TMO      128
#define XB_XCNT(j)  (256  + 64 * (j))
#define XB_XSUB(j)  (1280 + 64 * (j))
#define XB_XGEN(j)  (2304 + 64 * (j))
#define XB_TOP      3328
#define XB_TOPGEN   3392
#define XCD_BAR_WORDS 3456
#define XB_SPIN_CAP (1u << 18)
__device__ __forceinline__ unsigned xb_ld(unsigned* p)              { return __hip_atomic_load(p, __ATOMIC_RELAXED, __HIP_MEMORY_SCOPE_AGENT); }
__device__ __forceinline__ unsigned xb_add(unsigned* p, unsigned v) { return __hip_atomic_fetch_add(p, v, __ATOMIC_RELAXED, __HIP_MEMORY_SCOPE_AGENT); }
__device__ __forceinline__ unsigned xb_xcc_id() { return (unsigned)__builtin_amdgcn_s_getreg((3 << 11) | 20) & 0xFu; }
#define XB_SPIN(cond, bar) do { unsigned _sp = 0; while (cond) { __builtin_amdgcn_s_sleep(1); \
    if ((++_sp & 255u) == 0u) { if (xb_ld(&(bar)[XB_TMO])) break; if (_sp > XB_SPIN_CAP) { atomicAdd(&(bar)[XB_TMO], 1u); break; } } } } while (0)
struct XcdBarrier { unsigned* bar; unsigned x; volatile LAS unsigned* st; };
__device__ __forceinline__ XcdBarrier xcd_barrier_post(unsigned* bar, volatile LAS unsigned* st) {
    XcdBarrier b; b.bar = bar; b.x = xb_xcc_id(); b.st = st;
    if (threadIdx.x == 0) (void)xb_add(&bar[XB_XCNT(b.x)], 1u);
    return b;
}
__device__ __forceinline__ void xcd_barrier_complete(unsigned* bar, unsigned x, unsigned& nloc, unsigned& nx) {
    const unsigned G = gridDim.x * gridDim.y * gridDim.z;
    unsigned sum, cnt, mine, sp = 0u;
    for (;;) {
        sum = 0u; cnt = 0u; mine = 0u;
#pragma unroll
        for (unsigned j = 0; j < 16; ++j) { const unsigned c = xb_ld(&bar[XB_XCNT(j)]); sum += c; cnt += (c > 0u) ? 1u : 0u; mine = (j == x) ? c : mine; }
        if (sum == G) break;
        __builtin_amdgcn_s_sleep(1);
        if ((++sp & 255u) == 0u) { if (xb_ld(&bar[XB_TMO])) break; if (sp > XB_SPIN_CAP) { atomicAdd(&bar[XB_TMO], 1u); break; } }
    }
    nloc = mine > 0u ? mine : 1u; nx = cnt > 0u ? cnt : 1u;
}
__device__ __forceinline__ void xcd_barrier(const XcdBarrier& b) {
    asm volatile("s_waitcnt vmcnt(0)" ::: "memory");
    __syncthreads();
    if (threadIdx.x == 0) {
        unsigned* bar = b.bar;
        __builtin_amdgcn_s_waitcnt(0);
        unsigned nloc = b.st[0], nx = b.st[1];
        if (nloc == 0u) { xcd_barrier_complete(bar, b.x, nloc, nx); b.st[0] = nloc; b.st[1] = nx; }
        const unsigned old = xb_add(&bar[XB_XSUB(b.x)], 1u);
        const unsigned gen = old / nloc;
        if (old + 1u == (gen + 1u) * nloc) {
            __builtin_amdgcn_fence(__ATOMIC_RELEASE, "agent");
            asm volatile("s_waitcnt vmcnt(0)" ::: "memory");
            const unsigned og = xb_add(&bar[XB_TOP], 1u);
            const unsigned tg = og / nx;
            if (og + 1u == (tg + 1u) * nx) xb_add(&bar[XB_TOPGEN], 1u);
            else XB_SPIN(xb_ld(&bar[XB_TOPGEN]) == tg, bar);
            __builtin_amdgcn_fence(__ATOMIC_ACQUIRE, "agent");
            xb_add(&bar[XB_XGEN(b.x)], 1u);
            asm volatile("s_waitcnt vmcnt(0)" ::: "memory");
        } else {
            XB_SPIN(xb_ld(&bar[XB_XGEN(b.x)]) == gen, bar);
            __builtin_amdgcn_fence(__ATOMIC_ACQUIRE, "agent");
            asm volatile("s_waitcnt vmcnt(0)" ::: "memory");
        }
    }
    __syncthreads();
}

struct Frame {
    LAS unsigned char* lds; volatile LAS unsigned* MISC; LAS unsigned* LCTL;
    gu32* ctl; unsigned char* ws; GAS float* out; int tid, lane, wave, vcu, G;
};
constexpr int PTR_OFF = LDSCTL_OFF + 96;
__device__ __forceinline__ const GAS float* INP(const Frame& F, int i) {
    const LAS unsigned* t = (const LAS unsigned*)(F.lds + PTR_OFF) + 2 * i;
    const unsigned lo = __builtin_amdgcn_readfirstlane(t[0]), hi = __builtin_amdgcn_readfirstlane(t[1]);
    return (const GAS float*)(((unsigned long long)hi << 32) | lo);
}
__device__ __forceinline__ float shx(float v, int m, int lane) { return __builtin_bit_cast(float, __builtin_amdgcn_ds_bpermute((lane ^ m) << 2, __builtin_bit_cast(int, v))); }
__device__ __forceinline__ float wave_sum(float v, int lane) {
#pragma unroll
    for (int o = 1; o < 64; o <<= 1) v += shx(v, o, lane);
    return v;
}
__device__ __forceinline__ const GAS float* xrow_in(const Frame& F, int row) { const int b = row / RPB, t = row % RPB; return t < SEQ ? INP(F, 0) + ((size_t)b * SEQ + t) * DM : INP(F, 2) + ((size_t)b * CTXL + (t - SEQ)) * DM; }
__device__ __forceinline__ GAS float* xrow_ws(const Frame& F, int row) { const int b = row / RPB, t = row % RPB; return t < SEQ ? F.out + ((size_t)b * SEQ + t) * DM : ((GAS float*)(F.ws + WS_XC)) + ((size_t)b * CTXL + (t - SEQ)) * DM; }
__device__ __forceinline__ int modidx(int row) { const int b = row / RPB, t = row % RPB; return t < SEQ ? b : 4; }

__device__ __forceinline__ void tr_item(const GAS float* W, int ldw, int k0, int n0, GAS bf16* WT, int ldt, int drow0, int dcol0, LAS float* scr, int lane) {
    f32x4 t[8];
#pragma unroll
    for (int i = 0; i < 8; ++i) t[i] = *(const GAS f32x4*)(W + (size_t)(k0 + 8 * i + (lane >> 3)) * ldw + n0 + 4 * (lane & 7));
#pragma unroll
    for (int i = 0; i < 8; ++i) { LAS float* d = scr + (8 * i + (lane >> 3)) * 33 + 4 * (lane & 7); d[0] = t[i].x; d[1] = t[i].y; d[2] = t[i].z; d[3] = t[i].w; }
    LDS_WAIT(); asm volatile("" ::: "memory");
    const int c = lane & 7;
#pragma unroll
    for (int j = 0; j < 4; ++j) { const int n = (lane >> 3) + 8 * j; const LAS float* s = scr + (8 * c) * 33 + n;
        v4u o; o.x = pk2(s[0 * 33], s[1 * 33]); o.y = pk2(s[2 * 33], s[3 * 33]); o.z = pk2(s[4 * 33], s[5 * 33]); o.w = pk2(s[6 * 33], s[7 * 33]);
        *(GAS v4u*)(WT + (size_t)(drow0 + n) * ldt + dcol0 + 8 * c) = o; }
    LDS_WAIT(); asm volatile("" ::: "memory");
}
__device__ __forceinline__ void convert_weights(Frame& F, int l) {
    LAS float* scr = (LAS float*)(F.lds + RING_OFF + F.wave * 16384);
    const int gw = F.vcu * NWAVES + F.wave, NGW = F.G * NWAVES;
    constexpr int I_IN = 16 * (INW / 32), I_BR = 4 * 8 * 32, I_O = 16 * 32, I_GU = 16 * 16 * 32, I_D = 16 * 8 * 32;
    constexpr int NITEMS = I_IN + I_BR + I_O + I_GU + I_D;
    for (int it = gw; it < NITEMS; it += NGW) {
        int r = it;
        if (r < I_IN) { const int nblk = INW / 32, kb = r / nblk, nb = r % nblk, n0 = 32 * nb;
            if (n0 >= 2304 && n0 < 2816) continue;
            const int drow = n0 < 2304 ? n0 : n0 + 512;
            tr_item(INP(F, 8) + (size_t)l * DM * INW, INW, 64 * kb, n0, ((GAS bf16*)(F.ws + WS_WIN)), DM, drow, 64 * kb, scr, F.lane); continue; } r -= I_IN;
        if (r < I_BR) { const int nbr = r / 256, q = r % 256, kb = q / 32, nb = q % 32;
            tr_item(INP(F, 15) + ((size_t)l * 4 + nbr) * 512 * DM, DM, 64 * kb, 32 * nb, ((GAS bf16*)(F.ws + WS_WB)), 2048, 32 * nb, nbr * 512 + 64 * kb, scr, F.lane); continue; } r -= I_BR;
        if (r < I_O) { const int kb = r / 32, nb = r % 32;
            tr_item(INP(F, 16) + (size_t)l * DM * DM, DM, 64 * kb, 32 * nb, ((GAS bf16*)(F.ws + WS_WO)), DM, 32 * nb, 64 * kb, scr, F.lane); continue; } r -= I_O;
        if (r < I_GU) { const int e = r / 512, q = r % 512, kb = q / 32, nb = q % 32, n0 = 32 * nb;
            const int drow = n0 < 512 ? (n0 / 128) * 256 + (n0 % 128) : ((n0 - 512) / 128) * 256 + 128 + ((n0 - 512) % 128);
            tr_item(INP(F, 19) + ((size_t)l * NEXP + e) * DM * DM, DM, 64 * kb, n0, ((GAS bf16*)(F.ws + WS_WGU)) + (size_t)e * DM * DM, DM, drow, 64 * kb, scr, F.lane); continue; } r -= I_GU;
        { const int e = r / 256, q = r % 256, kb = q / 32, nb = q % 32;
            tr_item(INP(F, 20) + ((size_t)l * NEXP + e) * EFF * DM, DM, 64 * kb, 32 * nb, ((GAS bf16*)(F.ws + WS_WD)) + (size_t)e * DM * EFF, EFF, 32 * nb, 64 * kb, scr, F.lane); }
    }
    __syncthreads();
    LAS float* wt = (LAS float*)(F.lds + RING_OFF);
    LAS float* tab = (LAS float*)(F.lds + RING_OFF + 32768);
    if (F.tid < 128) { float s, c; sincospif((float)F.tid * (1.0f / 64.0f), &s, &c); tab[2 * F.tid] = c; tab[2 * F.tid + 1] = s; }
    for (int u = F.vcu; u < 64; u += F.G) {
        const int kt = u >> 2, g = u & 3;
        __syncthreads();
#pragma unroll
        for (int i = 0; i < 16; ++i) { const int idx = i * 512 + F.tid, kk = idx >> 7, c = idx & 127; wt[idx] = INP(F, 8)[(size_t)l * DM * INW + (size_t)(kt * 64 + kk) * INW + 2304 + g * 128 + c]; }
        __syncthreads();
        const int kc = F.tid & 127, kq = F.tid >> 7;
        float aA[16], aB[16];
#pragma unroll
        for (int i = 0; i < 16; ++i) { aA[i] = 0.f; aB[i] = 0.f; }
        for (int c = 0; c < 128; ++c) { const int ti = (c * kc) & 127; const float cs = tab[2 * ti], sn = tab[2 * ti + 1];
#pragma unroll
            for (int i = 0; i < 16; ++i) { const float w = wt[(kq * 16 + i) * 128 + c]; aA[i] += w * cs; aB[i] += w * sn; } }
        GAS bf16* ra = ((GAS bf16*)(F.ws + WS_WIN)) + (size_t)(2304 + g * 128 + kc) * DM + kt * 64 + kq * 16; GAS bf16* rb = ra + (size_t)512 * DM;
        v4u o; o.x = pk2(aA[0], aA[1]); o.y = pk2(aA[2], aA[3]); o.z = pk2(aA[4], aA[5]); o.w = pk2(aA[6], aA[7]); *(GAS v4u*)ra = o;
        o.x = pk2(aA[8], aA[9]); o.y = pk2(aA[10], aA[11]); o.z = pk2(aA[12], aA[13]); o.w = pk2(aA[14], aA[15]); *(GAS v4u*)(ra + 8) = o;
        o.x = pk2(aB[0], aB[1]); o.y = pk2(aB[2], aB[3]); o.z = pk2(aB[4], aB[5]); o.w = pk2(aB[6], aB[7]); *(GAS v4u*)rb = o;
        o.x = pk2(aB[8], aB[9]); o.y = pk2(aB[10], aB[11]); o.z = pk2(aB[12], aB[13]); o.w = pk2(aB[14], aB[15]); *(GAS v4u*)(rb + 8) = o;
    }
    __syncthreads();
}
__device__ __forceinline__ void mod_vectors(Frame& F) {
    LAS float* sc = (LAS float*)(F.lds + RING_OFF);
    LAS float* part = (LAS float*)(F.lds + RING_OFF + 32768);
    for (int i = F.tid; i < 5 * DM; i += NTHR) { const float v = i < 4 * DM ? INP(F, 1)[i] : INP(F, 3)[i - 4 * DM]; sc[i] = v * sigm(v); }
    __syncthreads();
    for (int u = F.vcu; u < 2 * 96; u += F.G) {
        const int l = u / 96, j = (u % 96) * 64 + F.lane;
        const GAS float* wp = INP(F, 4) + (size_t)l * DM * 6144 + (size_t)(F.wave * 128) * 6144 + j;
        float a0 = 0.f, a1 = 0.f, a2 = 0.f, a3 = 0.f, a4 = 0.f;
#pragma unroll 8
        for (int kk = 0; kk < 128; ++kk) { const float w = wp[(size_t)kk * 6144]; const int k = F.wave * 128 + kk;
            a0 += sc[k] * w; a1 += sc[DM + k] * w; a2 += sc[2 * DM + k] * w; a3 += sc[3 * DM + k] * w; a4 += sc[4 * DM + k] * w; }
        part[(F.wave * 5 + 0) * 64 + F.lane] = a0; part[(F.wave * 5 + 1) * 64 + F.lane] = a1; part[(F.wave * 5 + 2) * 64 + F.lane] = a2; part[(F.wave * 5 + 3) * 64 + F.lane] = a3; part[(F.wave * 5 + 4) * 64 + F.lane] = a4;
        __syncthreads();
        if (F.tid < 320) { const int bp = F.tid >> 6, ln = F.tid & 63; float s = 0.f;
#pragma unroll
            for (int w = 0; w < 8; ++w) s += part[(w * 5 + bp) * 64 + ln];
            const int jj = (u % 96) * 64 + ln; ((GAS float*)(F.ws + WS_MODV))[((size_t)l * 5 + bp) * 6144 + jj] = s + INP(F, 5)[(size_t)l * 6144 + jj]; }
        __syncthreads();
    }
}
__device__ __forceinline__ void norm_mod(f32x4 (&v)[4], const GAS float* g, const GAS float* sc, const GAS float* sh, int lane) {
    float ss = 0.f;
#pragma unroll
    for (int j = 0; j < 4; ++j) ss += (v[j].x * v[j].x + v[j].y * v[j].y) + (v[j].z * v[j].z + v[j].w * v[j].w);
    const float rstd = 1.0f / sqrtf(wave_sum(ss, lane) * (1.0f / DM) + EPS);
#pragma unroll
    for (int j = 0; j < 4; ++j) { const int c = 4 * lane + 256 * j; const f32x4 gg = *(const f32x4*)(g + c), s1 = *(const f32x4*)(sc + c), s0 = *(const f32x4*)(sh + c);
        v[j] = v[j] * rstd * gg * (s1 + 1.0f) + s0; }
}
__device__ __forceinline__ void store_bf16_row(GAS bf16* orow, const f32x4 (&v)[4], int lane) {
#pragma unroll
    for (int j = 0; j < 4; ++j) { v2u w; w.x = pk2(v[j].x, v[j].y); w.y = pk2(v[j].z, v[j].w); *(GAS v2u*)(orow + 4 * lane + 256 * j) = w; }
}
__device__ __forceinline__ void load_row(f32x4 (&v)[4], const GAS float* xr, int lane) {
#pragma unroll
    for (int j = 0; j < 4; ++j) v[j] = *(const GAS f32x4*)(xr + 4 * lane + 256 * j);
}
__device__ __forceinline__ void phase_norm1_first(Frame& F) {
    const int gw = F.vcu * NWAVES + F.wave, NGW = F.G * NWAVES; const GAS float* mv = ((GAS float*)(F.ws + WS_MODV)); const GAS float* g1 = INP(F, 6);
    for (int row = gw; row < MROWS; row += 2 * NGW) { const int row2 = row + NGW; const bool has2 = row2 < MROWS;
        f32x4 v[4], v2[4]; load_row(v, xrow_in(F, row), F.lane); if (has2) load_row(v2, xrow_in(F, row2), F.lane);
        { const GAS float* m = mv + (size_t)modidx(row) * 6144; norm_mod(v, g1, m + 1024, m, F.lane); store_bf16_row(((GAS bf16*)(F.ws + WS_H)) + (size_t)row * DM, v, F.lane); }
        if (has2) { const GAS float* m = mv + (size_t)modidx(row2) * 6144; norm_mod(v2, g1, m + 1024, m, F.lane); store_bf16_row(((GAS bf16*)(F.ws + WS_H)) + (size_t)row2 * DM, v2, F.lane); } }
}
__device__ __forceinline__ void phase_qkrope(Frame& F, int l) {
    const int gw = F.vcu * NWAVES + F.wave, NGW = F.G * NWAVES; const int lane = F.lane, i = lane & 31;
    const float invf = exp2f(-(float)(i & 15) * (13.287712379549449f / 16.0f));
    for (int row = gw; row < MROWS; row += NGW) {
        const int t = row % RPB; const bool lat = t < SEQ; GAS bf16* pr = ((GAS bf16*)(F.ws + WS_P)) + (size_t)row * PW;
        float cs = 1.f, sn = 0.f;
        if (lat) { const float pos = (float)((i < 16) ? (t >> 6) : (t & 63)); sincosf(pos * invf, &sn, &cs); }
#pragma unroll
        for (int it = 0; it < 5; ++it) { const int hh = 2 * it + (lane >> 5); const int col = (hh < 8 ? hh * 64 : C_GK + (hh - 8) * 64) + 2 * i;
            const unsigned w = *(const GAS unsigned*)(pr + col); float x1 = bf_lo(w), x2 = bf_hi(w);
            float ss = x1 * x1 + x2 * x2;
            ss += shx(ss, 1, lane); ss += shx(ss, 2, lane); ss += shx(ss, 4, lane); ss += shx(ss, 8, lane); ss += shx(ss, 16, lane);
            const float rstd = 1.0f / sqrtf(ss * (1.0f / 64.0f) + EPS); const GAS float* gp = (hh < 8 ? INP(F, 9) : INP(F, 10)) + l * 64 + 2 * i;
            x1 = x1 * rstd * gp[0]; x2 = x2 * rstd * gp[1];
            float y1 = x1 * cs - x2 * sn, y2 = x1 * sn + x2 * cs;
            if (hh < 8) { y1 *= QSCALE; y2 *= QSCALE; }
            *(GAS unsigned*)(pr + col) = pk2(y1, y2); }
        { const v4u w = *(const GAS v4u*)(pr + C_NQ + 8 * lane); v4u o;
          o.x = pk2(bf_lo(w.x) * QSCALE, bf_hi(w.x) * QSCALE); o.y = pk2(bf_lo(w.y) * QSCALE, bf_hi(w.y) * QSCALE); o.z = pk2(bf_lo(w.z) * QSCALE, bf_hi(w.z) * QSCALE); o.w = pk2(bf_lo(w.w) * QSCALE, bf_hi(w.w) * QSCALE);
          *(GAS v4u*)(pr + C_NQ + 8 * lane) = o; }
    }
}
__device__ __forceinline__ void phase_conv(Frame& F, int l) {
    LAS float* zl = (LAS float*)(F.lds + RING_OFF);
    LAS float* red = (LAS float*)(F.lds + RING_OFF + 62 * 512 * 4);
    const int ch = F.tid; const int nchunk = (l == 0) ? 136 : 128;
    float w[31];
#pragma unroll
    for (int j = 0; j < 31; ++j) w[j] = INP(F, 12)[((size_t)l * 31 + j) * 512 + ch];
    const float cb = INP(F, 13)[l * 512 + ch], cg = INP(F, 14)[l * 512 + ch];
    const GAS bf16* P = ((GAS bf16*)(F.ws + WS_P)); GAS bf16* Y = ((GAS bf16*)(F.ws + WS_Y));
    for (int u = F.vcu; u < NBATCH * nchunk; u += F.G) {
        const int b = u / nchunk, c = u % nchunk; const bool lat = c < 128;
        const int seq0 = b * RPB + (lat ? 0 : SEQ), slen = lat ? SEQ : CTXL, t0 = 32 * (lat ? c : c - 128);
        __syncthreads();
#pragma unroll
        for (int it = 0; it < 8; ++it) { const int item = it * 512 + F.tid;
            if (item < 62 * 64) { const int i = item >> 6, cgp = item & 63; const int t = t0 - 15 + i; f32x4 z0 = {0.f, 0.f, 0.f, 0.f}, z1 = {0.f, 0.f, 0.f, 0.f};
                if (t >= 0 && t < slen) { const GAS bf16* pr = P + (size_t)(seq0 + t) * PW; const v4u a = *(const GAS v4u*)(pr + C_CA + 8 * cgp), g = *(const GAS v4u*)(pr + C_CB + 8 * cgp);
                    z0.x = bf_lo(a.x) * sigm(bf_lo(g.x)); z0.y = bf_hi(a.x) * sigm(bf_hi(g.x)); z0.z = bf_lo(a.y) * sigm(bf_lo(g.y)); z0.w = bf_hi(a.y) * sigm(bf_hi(g.y));
                    z1.x = bf_lo(a.z) * sigm(bf_lo(g.z)); z1.y = bf_hi(a.z) * sigm(bf_hi(g.z)); z1.z = bf_lo(a.w) * sigm(bf_lo(g.w)); z1.w = bf_hi(a.w) * sigm(bf_hi(g.w)); }
                *(LAS f32x4*)(zl + i * 512 + 8 * cgp) = z0; *(LAS f32x4*)(zl + i * 512 + 8 * cgp + 4) = z1; } }
        __syncthreads();
        float z[62];
#pragma unroll
        for (int i = 0; i < 62; ++i) z[i] = zl[i * 512 + ch];
        float o[32];
#pragma unroll
        for (int q = 0; q < 32; ++q) { float s = cb;
#pragma unroll
            for (int j = 0; j < 31; ++j) s += z[q + j] * w[j];
            o[q] = s; }
#pragma unroll
        for (int q = 0; q < 32; ++q) { const float s = wave_sum(o[q] * o[q], F.lane); if (F.lane == 0) red[F.wave * 32 + q] = s; }
        __syncthreads();
#pragma unroll
        for (int q = 0; q < 32; ++q) { float s = 0.f;
#pragma unroll
            for (int wv = 0; wv < 8; ++wv) s += red[wv * 32 + q];
            const float y = o[q] * (1.0f / sqrtf(s * (1.0f / 512.0f) + EPS)) * cg;
            Y[(size_t)(seq0 + t0 + q) * YW + 1536 + ch] = (bf16)f2bf(y * sigm(y)); }
    }
    __syncthreads();
}
typedef short fbf16x8 __attribute__((ext_vector_type(8)));
typedef short fs16x4 __attribute__((ext_vector_type(4)));
typedef float ff32x16 __attribute__((ext_vector_type(16)));
typedef __attribute__((address_space(3))) const char* flds_cptr;
__device__ __forceinline__ fs16x4 f_vtr(flds_cptr p) { return __builtin_bit_cast(fs16x4, __builtin_amdgcn_ds_read_tr16_b64_v4i16((__attribute__((address_space(3))) attn_body::v4i16_t*)p)); }
__device__ __forceinline__ void fourier_frags(Frame& F, fbf16x8 (&fr)[4][4]) {
    LAS float* tab = (LAS float*)(F.lds + RING_OFF);
    __syncthreads();
    if (F.tid < 64) { float s, c; sincospif((float)F.tid * (1.0f / 32.0f), &s, &c); tab[2 * F.tid] = c; tab[2 * F.tid + 1] = s; }
    __syncthreads();
    const int m = F.lane & 31, hi = F.lane >> 5;
#pragma unroll
    for (int mt = 0; mt < 4; ++mt)
#pragma unroll
        for (int g = 0; g < 4; ++g) { unsigned wv[4];
#pragma unroll
            for (int jp = 0; jp < 4; ++jp) { float v[2];
#pragma unroll
                for (int q = 0; q < 2; ++q) { const int j = 2 * jp + q; const int n = 16 * g + (j & 3) + 8 * (j >> 2) + 4 * hi; const int k = 32 * (mt & 1) + m; const int ix = (k * n) & 63; v[q] = tab[2 * ix + (mt >> 1)]; }
                wv[jp] = pk2(v[0], v[1]); }
            v4u t; t.x = wv[0]; t.y = wv[1]; t.z = wv[2]; t.w = wv[3]; fr[mt][g] = __builtin_bit_cast(fbf16x8, t); __builtin_amdgcn_sched_barrier(0); }
    __syncthreads();
}
#define F_BFRAG(dst, vp, dh) do { _Pragma("unroll") for (int g_ = 0; g_ < 4; ++g_) { const fs16x4 lo_ = f_vtr((vp) + (dh) * 4096 + g_ * 1024), hi_ = f_vtr((vp) + (dh) * 4096 + g_ * 1024 + 512); \
        dst[g_] = (fbf16x8){lo_[0], lo_[1], lo_[2], lo_[3], hi_[0], hi_[1], hi_[2], hi_[3]}; } } while (0)
__device__ __forceinline__ void glds16_so(const GAS void* sbase, unsigned voff, unsigned lds_dst) { unsigned keep;
    asm volatile("s_mov_b32 %0, m0\n\ts_mov_b32 m0, %3\n\ts_nop 0\n\tglobal_load_lds_dwordx4 %1, %2\n\ts_mov_b32 m0, %0" : "=&s"(keep) : "v"(voff), "s"(sbase), "s"(lds_dst) : "memory"); }
__device__ __forceinline__ fbf16x8 f_neg(fbf16x8 v) { v4u t = __builtin_bit_cast(v4u, v); t.x ^= 0x80008000u; t.y ^= 0x80008000u; t.z ^= 0x80008000u; t.w ^= 0x80008000u; return __builtin_bit_cast(fbf16x8, t); }
__device__ __forceinline__ void phase_fourier1(Frame& F) {
    fbf16x8 fr[4][4]; fourier_frags(F, fr);
    const int lane = F.lane, w = F.wave, r32 = lane & 31, hi = lane >> 5;
    const unsigned lds0 = (unsigned)(uintptr_t)(F.lds + RING_OFF);
    const flds_cptr vbase = (flds_cptr)(F.lds + RING_OFF) + ((lane >> 4) & 1) * 32 + (lane & 3) * 8 + (4 * hi + ((lane & 15) >> 2)) * 64;
    const GAS bf16* P = ((GAS bf16*)(F.ws + WS_P)); GAS bf16* TPb = (GAS bf16*)(F.ws + WS_TP);
    const unsigned voff0 = (unsigned)((64 * (lane >> 2)) * PW + (lane & 3) * 8) * 2u;
    for (int u = F.vcu; u < NBATCH * 64; u += F.G) {
        const int b = u >> 6, n2 = u & 63;
        const GAS bf16* base = P + (size_t)(b * RPB + n2) * PW + C_F + 64 * w;
        asm volatile("s_waitcnt lgkmcnt(0)" ::: "memory");
#pragma unroll
        for (int rg = 0; rg < 4; ++rg) { const unsigned vo = voff0 + (unsigned)rg * (unsigned)(64 * 16 * PW * 2);
            const unsigned dA = (unsigned)__builtin_amdgcn_readfirstlane(lds0 + w * 8192 + rg * 1024), dB = dA + 8 * 8192;
            glds16_so(base, vo, dA); glds16_so(base + 32, vo, dA + 4096); glds16_so(base + 512, vo, dB); glds16_so(base + 544, vo, dB + 4096); }
        asm volatile("s_waitcnt vmcnt(0)" ::: "memory");
#pragma unroll 1
        for (int dh = 0; dh < 2; ++dh) {
            fbf16x8 bA[4], nA[4], nB[4];
            F_BFRAG(bA, vbase + w * 8192, dh); F_BFRAG(nB, vbase + (8 + w) * 8192, dh);
#pragma unroll
            for (int g = 0; g < 4; ++g) { nA[g] = f_neg(bA[g]); nB[g] = f_neg(nB[g]); }
#pragma unroll
            for (int kb = 0; kb < 2; ++kb) {
                ff32x16 tr = {}, ti = {};
#pragma unroll
                for (int g = 0; g < 4; ++g) { tr = __builtin_amdgcn_mfma_f32_32x32x16_bf16(fr[kb][g], bA[g], tr, 0, 0, 0); ti = __builtin_amdgcn_mfma_f32_32x32x16_bf16(fr[kb][g], nB[g], ti, 0, 0, 0);
                    tr = __builtin_amdgcn_mfma_f32_32x32x16_bf16(fr[2 + kb][g], nB[g], tr, 0, 0, 0); ti = __builtin_amdgcn_mfma_f32_32x32x16_bf16(fr[2 + kb][g], nA[g], ti, 0, 0, 0); }
                const unsigned o0 = (unsigned)(((b * 64 + 32 * kb + 4 * hi) * 2) * 64 + n2) * 512u + 64 * w + 32 * dh + r32;
#pragma unroll
                for (int r = 0; r < 16; ++r) { const int kk = (r & 3) + 8 * (r >> 2); const int k1 = 32 * kb + kk + 4 * hi;
                    const float rev = (float)(n2 * k1) * (1.0f / 4096.0f); const float c = __builtin_amdgcn_cosf(rev), s = __builtin_amdgcn_sinf(rev);
                    const unsigned oi = o0 + (unsigned)kk * (2u * 64u * 512u);
                    TPb[oi] = (bf16)f2bf(tr[r] * c + ti[r] * s); TPb[oi + 64u * 512u] = (bf16)f2bf(ti[r] * c - tr[r] * s);
                    if ((r & 3) == 3) __builtin_amdgcn_sched_barrier(0); }
                __builtin_amdgcn_sched_barrier(0);
            }
        }
    }
}
__device__ __forceinline__ void phase_fourier2(Frame& F) {
    fbf16x8 fr[4][4]; fourier_frags(F, fr);
    const int lane = F.lane, w = F.wave, r32 = lane & 31, hi = lane >> 5;
    const unsigned lds0 = (unsigned)(uintptr_t)(F.lds + RING_OFF);
    const flds_cptr vbase = (flds_cptr)(F.lds + RING_OFF) + ((lane >> 4) & 1) * 32 + (lane & 3) * 8 + (4 * hi + ((lane & 15) >> 2)) * 64;
    const GAS bf16* TPb = (const GAS bf16*)(F.ws + WS_TP); GAS bf16* Y = ((GAS bf16*)(F.ws + WS_Y));
    const float scale = 1.0f / sqrtf(4096.0f * 128.0f);
    const unsigned voff0 = (unsigned)((lane >> 2) * 512 + (lane & 3) * 8) * 2u;
    for (int u = F.vcu; u < NBATCH * 64; u += F.G) {
        const int b = u >> 6, k1 = u & 63;
        const GAS bf16* base0 = TPb + (size_t)((b * 64 + k1) * 2) * 64 * 512 + 64 * w; const GAS bf16* base1 = base0 + 64 * 512;
        asm volatile("s_waitcnt lgkmcnt(0)" ::: "memory");
#pragma unroll
        for (int rg = 0; rg < 4; ++rg) { const unsigned vo = voff0 + (unsigned)rg * (unsigned)(16 * 512 * 2);
            const unsigned d0 = (unsigned)__builtin_amdgcn_readfirstlane(lds0 + w * 8192 + rg * 1024), d1 = d0 + 8 * 8192;
            glds16_so(base0, vo, d0); glds16_so(base0 + 32, vo, d0 + 4096); glds16_so(base1, vo, d1); glds16_so(base1 + 32, vo, d1 + 4096); }
        asm volatile("s_waitcnt vmcnt(0)" ::: "memory");
#pragma unroll
        for (int dh = 0; dh < 2; ++dh) {
            fbf16x8 b0[4], b1[4];
            F_BFRAG(b0, vbase + w * 8192, dh); F_BFRAG(b1, vbase + (8 + w) * 8192, dh);
#pragma unroll
            for (int mt = 0; mt < 2; ++mt) {
                ff32x16 acc = {};
#pragma unroll
                for (int g = 0; g < 4; ++g) { acc = __builtin_amdgcn_mfma_f32_32x32x16_bf16(fr[mt][g], b0[g], acc, 0, 0, 0); acc = __builtin_amdgcn_mfma_f32_32x32x16_bf16(fr[2 + mt][g], b1[g], acc, 0, 0, 0); }
                const unsigned y0 = (unsigned)(b * RPB + k1 + 64 * (32 * mt + 4 * hi)) * (unsigned)YW + 1024u + 64 * w + 32 * dh + r32;
#pragma unroll
                for (int r = 0; r < 16; ++r) { const int kk = (r & 3) + 8 * (r >> 2);
                    Y[y0 + (unsigned)kk * (64u * (unsigned)YW)] = (bf16)f2bf(acc[r] * scale); }
                __builtin_amdgcn_sched_barrier(0);
            }
        }
    }
}
typedef float fc_f32x2 __attribute__((ext_vector_type(2)));
__device__ __forceinline__ void phase_fourier_ctx(Frame& F) {
    LAS float* tab = (LAS float*)(F.lds + RING_OFF + 8192);
    __syncthreads();
    if (F.tid < 256) { float s, c; sincospif((float)F.tid * (1.0f / 128.0f), &s, &c); tab[2 * F.tid] = c; tab[2 * F.tid + 1] = s; }
    __syncthreads();
    const float scale = 1.0f / sqrtf(256.0f * 128.0f);
#define FC_LOAD(A_, B_, n0_) do { _Pragma("unroll") for (int i_ = 0; i_ < 16; ++i_) { A_[i_] = pcol[(size_t)((n0_) + i_) * PW]; B_[i_] = pcol[(size_t)((n0_) + i_) * PW + 512]; } } while (0)
#define FC_COMP(A_, B_, n0_) do { _Pragma("unroll") for (int i_ = 0; i_ < 16; ++i_) { const float a_ = bf1(A_[i_]), b_ = bf1(B_[i_]); _Pragma("unroll") for (int k_ = 0; k_ < 4; ++k_) { \
        const int ix_ = (((n0_) + i_) * (kb + k_)) & 255; const fc_f32x2 cs_ = *(const LAS fc_f32x2*)(tab + 2 * ix_); acc[k_] += a_ * cs_.x - b_ * cs_.y; } } } while (0)
    for (int u = F.vcu; u < NBATCH * 64; u += F.G) {
        const int b = u >> 6, kb = (u & 63) * 4;
        float acc[4] = {0.f, 0.f, 0.f, 0.f};
        const GAS bf16* pcol = ((GAS bf16*)(F.ws + WS_P)) + (size_t)(b * RPB + SEQ) * PW + C_F + F.tid;
        bf16 A0[16], B0[16], A1[16], B1[16];
        FC_LOAD(A0, B0, 0);
        for (int n0 = 0; n0 < 256; n0 += 32) {
            FC_LOAD(A1, B1, n0 + 16);
            FC_COMP(A0, B0, n0);
            if (n0 + 32 < 256) FC_LOAD(A0, B0, n0 + 32);
            FC_COMP(A1, B1, n0 + 16);
        }
        GAS bf16* yo = ((GAS bf16*)(F.ws + WS_Y)) + (size_t)(b * RPB + SEQ + kb) * YW + 1024 + F.tid;
#pragma unroll
        for (int k = 0; k < 4; ++k) yo[(size_t)k * YW] = (bf16)f2bf(acc[k] * scale);
    }
#undef FC_LOAD
#undef FC_COMP
}
__device__ __forceinline__ void phase_norm2_router(Frame& F, int l) {
    LAS float* wr = (LAS float*)(F.lds + RING_OFF);
    LAS int* sel = (LAS int*)(F.lds + RING_OFF + 65536);
    const int nact = (l == 0) ? MROWS : NBATCH * SEQ; const int chunk = (nact + F.G - 1) / F.G; const int a0 = F.vcu * chunk, a1 = (a0 + chunk < nact) ? a0 + chunk : nact;
    __syncthreads();
    for (int i = F.tid; i < DM * 16 / 4; i += NTHR) { const f32x4 t = ((const GAS f32x4*)INP(F, 17))[i]; const int c = i >> 2, e0 = (i & 3) * 4;
        wr[(e0 + 0) * DM + c] = t.x; wr[(e0 + 1) * DM + c] = t.y; wr[(e0 + 2) * DM + c] = t.z; wr[(e0 + 3) * DM + c] = t.w; }
    __syncthreads();
    const GAS float* mv = ((GAS float*)(F.ws + WS_MODV)) + (size_t)l * 5 * 6144;
    float rb[16];
#pragma unroll
    for (int e = 0; e < 16; ++e) rb[e] = INP(F, 18)[e];
    const GAS bf16* Yb = (const GAS bf16*)(F.ws + WS_Y);
    int cmi = -1; f32x4 G1[4], GS[4], SH[4];
    f32x4 vn[4]; v2u yn[4];
#define G_ROW(a_) ((l == 0) ? (a_) : ((a_) / SEQ) * RPB + ((a_) % SEQ))
#define G_LOAD(a_) do { const int r_ = G_ROW(a_); load_row(vn, (l == 0) ? xrow_in(F, r_) : (const GAS float*)xrow_ws(F, r_), F.lane); \
        _Pragma("unroll") for (int j_ = 0; j_ < 4; ++j_) yn[j_] = *(const GAS v2u*)(Yb + (size_t)r_ * DM + 4 * F.lane + 256 * j_); } while (0)
    if (a0 + F.wave < a1) G_LOAD(a0 + F.wave);
    for (int a = a0 + F.wave; a < a1; a += NWAVES) {
        const int row = G_ROW(a);
        f32x4 v[4]; v2u yv[4];
#pragma unroll
        for (int j = 0; j < 4; ++j) { v[j] = vn[j]; yv[j] = yn[j]; }
        if (a + NWAVES < a1) G_LOAD(a + NWAVES);
        const int mi = modidx(row);
        if (mi != cmi) { cmi = mi; const GAS float* m = mv + (size_t)mi * 6144; const GAS float* g2 = INP(F, 7) + l * DM;
#pragma unroll
            for (int j = 0; j < 4; ++j) { const int c = 4 * F.lane + 256 * j; G1[j] = *(const GAS f32x4*)(m + 2 * 1024 + c); SH[j] = *(const GAS f32x4*)(m + 3 * 1024 + c);
                GS[j] = *(const GAS f32x4*)(g2 + c) * (*(const GAS f32x4*)(m + 4 * 1024 + c) + 1.0f); } }
        float ss = 0.f;
#pragma unroll
        for (int j = 0; j < 4; ++j) { f32x4 y; y.x = bf_lo(yv[j].x); y.y = bf_hi(yv[j].x); y.z = bf_lo(yv[j].y); y.w = bf_hi(yv[j].y); v[j] = v[j] + G1[j] * y;
            ss += (v[j].x * v[j].x + v[j].y * v[j].y) + (v[j].z * v[j].z + v[j].w * v[j].w); }
        { GAS float* xo = xrow_ws(F, row);
#pragma unroll
          for (int j = 0; j < 4; ++j) *(GAS f32x4*)(xo + 4 * F.lane + 256 * j) = v[j]; }
        const float rstd = 1.0f / sqrtf(wave_sum(ss, F.lane) * (1.0f / DM) + EPS);
#pragma unroll
        for (int j = 0; j < 4; ++j) v[j] = v[j] * rstd * GS[j] + SH[j];
        store_bf16_row(((GAS bf16*)(F.ws + WS_H)) + (size_t)row * DM, v, F.lane);
        float lg[16];
#pragma unroll
        for (int e = 0; e < 16; ++e) lg[e] = 0.f;
#pragma unroll
        for (int e = 0; e < 16; ++e)
#pragma unroll
            for (int j = 0; j < 4; ++j) { const f32x4 ww = *(const LAS f32x4*)(wr + e * DM + 4 * F.lane + 256 * j); lg[e] += (v[j].x * ww.x + v[j].y * ww.y) + (v[j].z * ww.z + v[j].w * ww.w); }
        float r8[8], r4[4], r2[2], r1;
        { const bool up = (F.lane & 32) != 0;
#pragma unroll
          for (int q = 0; q < 8; ++q) { const float snd = up ? lg[q] : lg[8 + q], kp = up ? lg[8 + q] : lg[q]; r8[q] = kp + shx(snd, 32, F.lane); } }
        { const bool up = (F.lane & 16) != 0;
#pragma unroll
          for (int q = 0; q < 4; ++q) { const float snd = up ? r8[q] : r8[4 + q], kp = up ? r8[4 + q] : r8[q]; r4[q] = kp + shx(snd, 16, F.lane); } }
        { const bool up = (F.lane & 8) != 0;
#pragma unroll
          for (int q = 0; q < 2; ++q) { const float snd = up ? r4[q] : r4[2 + q], kp = up ? r4[2 + q] : r4[q]; r2[q] = kp + shx(snd, 8, F.lane); } }
        { const bool up = (F.lane & 4) != 0; const float snd = up ? r2[0] : r2[1], kp = up ? r2[1] : r2[0]; r1 = kp + shx(snd, 4, F.lane); }
        r1 += shx(r1, 1, F.lane); r1 += shx(r1, 2, F.lane);
        float sc[16], sl[16];
#pragma unroll
        for (int e = 0; e < 16; ++e) { sc[e] = sigm(__builtin_bit_cast(float, __builtin_amdgcn_readlane(__builtin_bit_cast(int, r1), 4 * e))); sl[e] = sc[e] + rb[e]; }
        float best = -INFINITY; int bi1 = 0, bi2 = 1; float bs1 = 0.f, bs2 = 0.f;
#pragma unroll
        for (int g = 0; g < 4; ++g) {
            int i1 = 4 * g; float m1 = sl[4 * g];
#pragma unroll
            for (int q = 1; q < 4; ++q) if (sl[4 * g + q] > m1) { m1 = sl[4 * g + q]; i1 = 4 * g + q; }
            int i2 = -1; float m2 = -INFINITY;
#pragma unroll
            for (int q = 0; q < 4; ++q) if (4 * g + q != i1 && sl[4 * g + q] > m2) { m2 = sl[4 * g + q]; i2 = 4 * g + q; }
            float s1 = 0.f, s2 = 0.f;
#pragma unroll
            for (int q = 0; q < 4; ++q) { if (4 * g + q == i1) s1 = sc[4 * g + q]; if (4 * g + q == i2) s2 = sc[4 * g + q]; }
            const float gs = m1 + m2;
            if (gs > best) { best = gs; bi1 = i1; bi2 = i2; bs1 = s1; bs2 = s2; }
        }
        if (F.lane == 0) { const float inv = 1.0f / (bs1 + bs2);
            ((GAS int*)(F.ws + WS_TOKE))[2 * row] = bi1; ((GAS int*)(F.ws + WS_TOKE))[2 * row + 1] = bi2; ((GAS float*)(F.ws + WS_TOKW))[2 * row] = bs1 * inv; ((GAS float*)(F.ws + WS_TOKW))[2 * row + 1] = bs2 * inv;
            sel[2 * (a - a0)] = bi1; sel[2 * (a - a0) + 1] = bi2; }
    }
#undef G_ROW
#undef G_LOAD
    __syncthreads();
    if (F.tid < 16) { const int e = F.tid; int n = 0; const int ns = 2 * (a1 - a0);
        for (int i = 0; i < ns; ++i) n += (sel[i] == e) ? 1 : 0;
        unsigned base = 0u; if (n > 0) base = __hip_atomic_fetch_add((unsigned*)(F.ctl + CW_CNT + (l * 16 + e) * 64), (unsigned)n, RLX_AGENT);
        for (int i = 0; i < ns; ++i) if (sel[i] == e) { const int a = a0 + (i >> 1); const int row = (l == 0) ? a : (a / SEQ) * RPB + (a % SEQ); ((GAS int*)(F.ws + WS_TOKR))[2 * row + (i & 1)] = (int)base; ++base; } }
    __syncthreads();
}
__device__ __forceinline__ void moe_offsets(Frame& F, int l) {
    __syncthreads();
    if (F.tid == 0) { unsigned off = 0u;
        for (int e = 0; e < 16; ++e) { F.LCTL[e] = off; const unsigned c = __hip_atomic_load((unsigned*)(F.ctl + CW_CNT + (l * 16 + e) * 64), RLX_AGENT); off += (c + 255u) & ~255u; }
        F.LCTL[16] = off; F.LCTL[17] = off >> 8; }
    __syncthreads();
}
__device__ __forceinline__ void phase_scatter(Frame& F, int l) {
    moe_offsets(F, l);
    const int nact = (l == 0) ? MROWS : NBATCH * SEQ; const int chunk = (nact + F.G - 1) / F.G; const int a0 = F.vcu * chunk, a1 = (a0 + chunk < nact) ? a0 + chunk : nact;
    for (int a = a0 + F.wave; a < a1; a += NWAVES) {
        const int row = (l == 0) ? a : (a / SEQ) * RPB + (a % SEQ);
        const int e1 = ((GAS int*)(F.ws + WS_TOKE))[2 * row], e2 = ((GAS int*)(F.ws + WS_TOKE))[2 * row + 1];
        const int s1 = (int)F.LCTL[e1] + ((GAS int*)(F.ws + WS_TOKR))[2 * row], s2 = (int)F.LCTL[e2] + ((GAS int*)(F.ws + WS_TOKR))[2 * row + 1];
        if (F.lane == 0) { ((GAS int*)(F.ws + WS_TOKS))[2 * row] = s1; ((GAS int*)(F.ws + WS_TOKS))[2 * row + 1] = s2; }
        const GAS v4u* src = (const GAS v4u*)(((GAS bf16*)(F.ws + WS_H)) + (size_t)row * DM) + F.lane; const v4u x0 = src[0], x1 = src[64];
        GAS v4u* d1 = (GAS v4u*)(((GAS bf16*)(F.ws + WS_AM)) + (size_t)s1 * DM) + F.lane; GAS v4u* d2 = (GAS v4u*)(((GAS bf16*)(F.ws + WS_AM)) + (size_t)s2 * DM) + F.lane;
        d1[0] = x0; d1[64] = x1; d2[0] = x0; d2[64] = x1;
    }
}
struct CombRow { f32x4 v[4]; v2u p[4], q[4]; float w1, w2; };
__device__ __forceinline__ void comb_load(Frame& F, int row, CombRow& R, GAS float* xr) {
    load_row(R.v, xr, F.lane);
    const int s1 = ((GAS int*)(F.ws + WS_TOKS))[2 * row], s2 = ((GAS int*)(F.ws + WS_TOKS))[2 * row + 1]; R.w1 = ((GAS float*)(F.ws + WS_TOKW))[2 * row]; R.w2 = ((GAS float*)(F.ws + WS_TOKW))[2 * row + 1];
    const GAS bf16* o1 = ((GAS bf16*)(F.ws + WS_OM)) + (size_t)s1 * DM; const GAS bf16* o2 = ((GAS bf16*)(F.ws + WS_OM)) + (size_t)s2 * DM;
#pragma unroll
    for (int j = 0; j < 4; ++j) { const int c = 4 * F.lane + 256 * j; R.p[j] = *(const GAS v2u*)(o1 + c); R.q[j] = *(const GAS v2u*)(o2 + c); }
}
__device__ __forceinline__ void comb_finish(Frame& F, int l, int row, CombRow& R, GAS float* xr) {
    const GAS float* g2 = ((GAS float*)(F.ws + WS_MODV)) + (size_t)l * 5 * 6144 + (size_t)modidx(row) * 6144 + 5 * 1024;
#pragma unroll
    for (int j = 0; j < 4; ++j) { const int c = 4 * F.lane + 256 * j; const v2u p = R.p[j], q = R.q[j]; const f32x4 gg = *(const GAS f32x4*)(g2 + c); const float w1 = R.w1, w2 = R.w2;
        f32x4 z; z.x = w1 * bf_lo(p.x) + w2 * bf_lo(q.x); z.y = w1 * bf_hi(p.x) + w2 * bf_hi(q.x); z.z = w1 * bf_lo(p.y) + w2 * bf_lo(q.y); z.w = w1 * bf_hi(p.y) + w2 * bf_hi(q.y);
        R.v[j] = R.v[j] + gg * z; }
    if (l == 0) {
#pragma unroll
        for (int j = 0; j < 4; ++j) *(GAS f32x4*)(xr + 4 * F.lane + 256 * j) = R.v[j];
        const GAS float* m1 = ((GAS float*)(F.ws + WS_MODV)) + (size_t)5 * 6144 + (size_t)modidx(row) * 6144;
        norm_mod(R.v, INP(F, 6) + DM, m1 + 1024, m1, F.lane); store_bf16_row(((GAS bf16*)(F.ws + WS_H)) + (size_t)row * DM, R.v, F.lane);
    } else {
        float ss = 0.f;
#pragma unroll
        for (int j = 0; j < 4; ++j) ss += (R.v[j].x * R.v[j].x + R.v[j].y * R.v[j].y) + (R.v[j].z * R.v[j].z + R.v[j].w * R.v[j].w);
        const float rstd = 1.0f / sqrtf(wave_sum(ss, F.lane) * (1.0f / DM) + EPS);
#pragma unroll
        for (int j = 0; j < 4; ++j) { const int c = 4 * F.lane + 256 * j; *(GAS f32x4*)(xr + c) = R.v[j] * rstd * *(const GAS f32x4*)(INP(F, 21) + c); }
    }
}
__device__ __forceinline__ void phase_combine(Frame& F, int l) {
    const int gw = F.vcu * NWAVES + F.wave, NGW = F.G * NWAVES;
    const int nact = (l == 0) ? MROWS : NBATCH * SEQ;
    for (int a = gw; a < nact; a += 2 * NGW) { const int a2 = a + NGW; const bool has2 = a2 < nact;
        const int row = (l == 0) ? a : (a / SEQ) * RPB + (a % SEQ); const int row2 = has2 ? ((l == 0) ? a2 : (a2 / SEQ) * RPB + (a2 % SEQ)) : row;
        GAS float* xr = xrow_ws(F, row); GAS float* xr2 = xrow_ws(F, row2);
        CombRow R1, R2; comb_load(F, row, R1, xr); if (has2) comb_load(F, row2, R2, xr2);
        comb_finish(F, l, row, R1, xr); if (has2) comb_finish(F, l, row2, R2, xr2); }
}
struct SchedIn {
    int G, c;
    __device__ __forceinline__ bool next(int i, pg8::Unit& u) const { const long L = (long)i * G + c; if (L >= 68 * 33) return false; int pm, pn; pg8::tile_map((int)L, 68, 33, pm, pn);
        u.pm = pm; u.pn = pn; u.aux = 0; u.aoff = (size_t)pm * 256 * DM * 2; u.boff = (size_t)pn * 256 * DM * 2; return true; }
};
struct SchedBr {
    int G, c, nMt; bool skipctx;
    __device__ __forceinline__ bool next(int i, pg8::Unit& u) const { const long L = (long)(i >> 2) * G + c; if (L >= nMt * 4) return false; int pm, pn; pg8::tile_map((int)L, nMt, 4, pm, pn);
        if (skipctx) pm = (pm / 16) * 17 + (pm % 16);
        const int n = i & 3; u.pm = pm; u.pn = pn; u.aux = n; u.aoff = ((size_t)pm * 256 * YW + n * 512) * 2; u.boff = ((size_t)pn * 256 * 2048 + n * 512) * 2; return true; }
};
struct SchedOut {
    int G, c, nMt; bool skipctx;
    __device__ __forceinline__ bool next(int i, pg8::Unit& u) const { const long L = (long)i * G + c; if (L >= nMt * 4) return false; int pm, pn; pg8::tile_map((int)L, nMt, 4, pm, pn);
        if (skipctx) pm = (pm / 16) * 17 + (pm % 16);
        u.pm = pm; u.pn = pn; u.aux = 0; u.aoff = (size_t)pm * 256 * DM * 2; u.boff = (size_t)pn * 256 * DM * 2; return true; }
};
struct SchedMoe {
    int G, c; LAS unsigned* lctl; size_t astride, bstride_e, bstride_n;
    __device__ __forceinline__ bool next(int i, pg8::Unit& u) const { const long L = (long)i * G + c; const unsigned nt = lctl[17]; if (L >= (long)nt * 4) return false;
        const int tile = (int)(L >> 2), pn = (int)(L & 3); const unsigned row0 = (unsigned)tile * 256u; int e = 0;
#pragma unroll
        for (int k = 1; k < 16; ++k) e += (row0 >= lctl[k]) ? 1 : 0;
        u.pm = tile; u.pn = pn; u.aux = e; u.aoff = (size_t)tile * astride; u.boff = (size_t)e * bstride_e + (size_t)pn * bstride_n; return true; }
};

__device__ __forceinline__ void attn_plain_args(const Frame& F, int U, attn_body::AttnArgs& a) {
    typedef AGAS attn_body::bf16 abf;
    a.qrow0 = 0; a.rb0 = 0; a.rpb = nullptr; a.kr1 = 0;
    if (U < 512) { const int b = U >> 7, kvh = (U >> 6) & 1, hq = (U >> 4) & 3, qb = U & 15, h = kvh * 4 + hq; const size_t r0 = (size_t)b * RPB;
        a.Q = (const abf*)(((GAS bf16*)(F.ws + WS_P)) + (r0 + 256 * qb) * PW + C_GQ + h * 64); a.K = (const abf*)(((GAS bf16*)(F.ws + WS_P)) + r0 * PW + C_GK + kvh * 64); a.V = (const abf*)(((GAS bf16*)(F.ws + WS_P)) + r0 * PW + C_GV + kvh * 64);
        a.O = (abf*)(((GAS bf16*)(F.ws + WS_Y)) + (r0 + 256 * qb) * YW + h * 64); a.kr0 = 0; a.tsw = 1 << 20; a.NT = RPB / 64; }
    else if (U < 544) { const int b = (U - 512) >> 3, h = (U - 512) & 7, kvh = h >> 2; const size_t r0 = (size_t)b * RPB;
        a.Q = (const abf*)(((GAS bf16*)(F.ws + WS_P)) + (r0 + SEQ) * PW + C_GQ + h * 64); a.K = (const abf*)(((GAS bf16*)(F.ws + WS_P)) + r0 * PW + C_GK + kvh * 64); a.V = (const abf*)(((GAS bf16*)(F.ws + WS_P)) + r0 * PW + C_GV + kvh * 64);
        a.O = (abf*)(((GAS bf16*)(F.ws + WS_Y)) + (r0 + SEQ) * YW + h * 64); a.kr0 = SEQ; a.tsw = 1 << 20; a.NT = 4; }
    else { const int b = (U - 544) >> 3, h = (U - 544) & 7; const size_t r0 = (size_t)b * RPB;
        a.Q = (const abf*)(((GAS bf16*)(F.ws + WS_P)) + (r0 + SEQ) * PW + C_NQ + h * 64); a.K = (const abf*)(((GAS bf16*)(F.ws + WS_P)) + r0 * PW + C_NK + h * 64); a.V = (const abf*)(((GAS bf16*)(F.ws + WS_P)) + r0 * PW + C_NV + h * 64);
        a.O = (abf*)(((GAS bf16*)(F.ws + WS_Y)) + (r0 + SEQ) * YW + 512 + h * 64); a.kr0 = SEQ; a.tsw = 1 << 20; a.NT = 4; }
}
__device__ __forceinline__ void attn_na_args(const Frame& F, int U, int l, attn_body::AttnArgs& a) {
    typedef AGAS attn_body::bf16 abf;
    const int b = U >> 7, h = (U >> 4) & 7, j = U & 15; const size_t r0 = (size_t)b * RPB;
    int rb0 = 4 * j - 4; rb0 = rb0 < 0 ? 0 : (rb0 > 52 ? 52 : rb0);
    a.Q = (const abf*)(((GAS bf16*)(F.ws + WS_P)) + (r0 + 256 * j) * PW + C_NQ + h * 64); a.K = (const abf*)(((GAS bf16*)(F.ws + WS_P)) + r0 * PW + C_NK + h * 64); a.V = (const abf*)(((GAS bf16*)(F.ws + WS_P)) + r0 * PW + C_NV + h * 64);
    a.O = (abf*)(((GAS bf16*)(F.ws + WS_Y)) + (r0 + 256 * j) * YW + 512 + h * 64); a.kr0 = SEQ; a.kr1 = 64 * rb0; a.tsw = 4; a.NT = 16; a.qrow0 = 4 * j; a.rb0 = rb0; a.rpb = INP(F, 11) + ((size_t)l * 8 + h) * 465;
}

constexpr int N_PHASES = 2 + 11 * NLAYER;
struct Args { const GAS float* in[22]; GAS float* out; unsigned char* ws; int ph_lo, ph_hi; };
__global__ void __launch_bounds__(NTHR, 2) fwd_kernel(Args args) {
    extern __shared__ __attribute__((aligned(16))) unsigned char lds[];
    Frame F;
    F.lds = (LAS unsigned char*)lds; F.MISC = (volatile LAS unsigned*)(F.lds + MISC_OFF); F.LCTL = (LAS unsigned*)(F.lds + LDSCTL_OFF);
    F.tid = threadIdx.x; F.lane = F.tid & 63; F.wave = __builtin_amdgcn_readfirstlane(F.tid >> 6);
    F.G = gridDim.x; { const int bx = blockIdx.x; F.vcu = (F.G % 8 == 0) ? (bx % 8) * (F.G / 8) + bx / 8 : bx; }
    unsigned char* ws = args.ws;
    F.ctl = (gu32*)(ws + WS_CTL);
    F.out = args.out; F.ws = ws;
    for (int u = F.tid; u < (LDS_BYTES - LDSCTL_OFF) / 4; u += NTHR) ((LAS unsigned*)(F.lds + LDSCTL_OFF))[u] = 0u;
    __syncthreads();
    if (F.tid < 22) { unsigned long long p = 0ull;
#pragma unroll
        for (int i = 0; i < 22; ++i) if (F.tid == i) p = (unsigned long long)args.in[i];
        LAS unsigned* t = (LAS unsigned*)(F.lds + PTR_OFF) + 2 * F.tid; t[0] = (unsigned)p; t[1] = (unsigned)(p >> 32); }
    __syncthreads();
    XcdBarrier bar = xcd_barrier_post((unsigned*)(F.ctl + CW_BAR), F.MISC + 8);
    const int lo = args.ph_lo, hi = args.ph_hi;
#define LAUNDER() do { int t_ = threadIdx.x; asm volatile("" : "+v"(t_)); F.tid = t_; F.lane = t_ & 63; F.wave = __builtin_amdgcn_readfirstlane(t_ >> 6); \
        int g_ = gridDim.x, b_ = blockIdx.x; unsigned char* w_ = args.ws; GAS float* o_ = args.out; unsigned l_ = (unsigned)(uintptr_t)lds; \
        asm volatile("" : "+s"(g_), "+s"(b_), "+s"(w_), "+s"(o_), "+s"(l_)); \
        F.G = g_; bx = b_; F.vcu = (g_ % 8 == 0) ? (b_ % 8) * (g_ / 8) + b_ / 8 : b_; F.ws = w_; F.out = o_; F.ctl = (gu32*)(w_ + WS_CTL); \
        F.lds = (LAS unsigned char*)l_; F.MISC = (volatile LAS unsigned*)(F.lds + MISC_OFF); F.LCTL = (LAS unsigned*)(F.lds + LDSCTL_OFF); } while (0)
#ifndef PROBE
#define PROBE 0
#endif
#ifndef PROBE_MASK
#define PROBE_MASK 0x7ffffffeull
#define PROBE_SCALE 0.1f
#endif
#define STAMP(i) do { if (PROBE && blockIdx.x == 0 && threadIdx.x == 0) ((GAS unsigned long long*)(args.ws + WS_CTL + 512 * 1024))[i] = __builtin_amdgcn_s_memrealtime(); } while (0)
#define RUN(k) ((k) >= lo && (k) < hi)
#define SEAM(k) do { if ((k) >= lo && (k) + 1 < hi) xcd_barrier(bar); } while (0)
    int bx = (int)blockIdx.x;

    STAMP(0);
    if (RUN(0)) { LAUNDER(); convert_weights(F, 0); LAUNDER(); mod_vectors(F); } SEAM(0); STAMP(1);
    if (RUN(1)) { LAUNDER(); phase_norm1_first(F); } SEAM(1); STAMP(2);

    for (int l = 0; l < NLAYER; ++l) {
        const int p0 = 2 + 11 * l;
        if (RUN(p0 + 0)) { LAUNDER(); SchedIn S{F.G, bx}; pg8::EpiP E{((GAS bf16*)(F.ws + WS_P)), PW, C_G / 256, (GAS bf16*)(F.ws + WS_GN)};
            pg8::gemm_phase<pg8::EpiP, SchedIn, true>(F.lds + RING_OFF, F.tid, ((GAS bf16*)(F.ws + WS_H)), ((GAS bf16*)(F.ws + WS_WIN)), DM, DM, DM, S, E); } SEAM(p0 + 0); STAMP(3 + 14 * l + 0);
        if (RUN(p0 + 1)) { LAUNDER(); phase_qkrope(F, l); } SEAM(p0 + 1); STAMP(3 + 14 * l + 1);
        if (RUN(p0 + 2)) { LAUNDER();
            phase_fourier1(F); __syncthreads(); LAUNDER(); STAMP(3 + 14 * l + 2);
            phase_conv(F, l); __syncthreads(); LAUNDER(); STAMP(3 + 14 * l + 3);
            const int nU = (l == 0) ? 576 : 512;
            for (int U = F.vcu; U < nU; U += F.G) { attn_body::AttnArgs a; attn_plain_args(F, U, a); int t_ = threadIdx.x; asm volatile("" : "+v"(t_)); attn_body::attn_unit<8, false>(a, (char*)F.lds + RING_OFF, t_); }
            __syncthreads();
        } SEAM(p0 + 2); STAMP(3 + 14 * l + 4);
        if (RUN(p0 + 3)) { LAUNDER();
            phase_fourier2(F); __syncthreads(); LAUNDER(); STAMP(3 + 14 * l + 5);
            for (int U = F.vcu; U < 512; U += F.G) { attn_body::AttnArgs a; attn_na_args(F, U, l, a); int t_ = threadIdx.x; asm volatile("" : "+v"(t_)); attn_body::attn_unit<8, true>(a, (char*)F.lds + RING_OFF, t_); }
            __syncthreads();
            if (l == 0) { LAUNDER(); phase_fourier_ctx(F); __syncthreads(); }
        } SEAM(p0 + 3); STAMP(3 + 14 * l + 6);
        if (RUN(p0 + 4)) { LAUNDER(); SchedBr S{F.G, bx, (l == 0) ? 68 : 64, l != 0}; pg8::EpiBranch E{(const GAS bf16*)(F.ws + WS_GN), ((GAS bf16*)(F.ws + WS_H)), DM};
            pg8::gemm_phase<pg8::EpiBranch, SchedBr, true>(F.lds + RING_OFF, F.tid, ((GAS bf16*)(F.ws + WS_Y)), ((GAS bf16*)(F.ws + WS_WB)), YW, 2048, 512, S, E); } SEAM(p0 + 4); STAMP(3 + 14 * l + 7);
        if (RUN(p0 + 5)) { LAUNDER(); SchedOut S{F.G, bx, (l == 0) ? 68 : 64, l != 0}; pg8::EpiP E{((GAS bf16*)(F.ws + WS_Y)), DM, 1 << 20, nullptr};
            pg8::gemm_phase<pg8::EpiP, SchedOut, true>(F.lds + RING_OFF, F.tid, ((GAS bf16*)(F.ws + WS_H)), ((GAS bf16*)(F.ws + WS_WO)), DM, DM, DM, S, E); } SEAM(p0 + 5); STAMP(3 + 14 * l + 8);
        if (RUN(p0 + 6)) { LAUNDER(); phase_norm2_router(F, l); } SEAM(p0 + 6); STAMP(3 + 14 * l + 9);
        if (RUN(p0 + 7)) { LAUNDER(); phase_scatter(F, l); } SEAM(p0 + 7); STAMP(3 + 14 * l + 10);
        if (RUN(p0 + 8)) { LAUNDER(); moe_offsets(F, l); SchedMoe S{F.G, bx, F.LCTL, (size_t)256 * DM * 2, (size_t)DM * DM * 2, (size_t)256 * DM * 2}; pg8::EpiGU E{((GAS bf16*)(F.ws + WS_HM)), EFF};
            pg8::gemm_phase<pg8::EpiGU, SchedMoe, true>(F.lds + RING_OFF, F.tid, ((GAS bf16*)(F.ws + WS_AM)), ((GAS bf16*)(F.ws + WS_WGU)), DM, DM, DM, S, E); } SEAM(p0 + 8); STAMP(3 + 14 * l + 11);
        if (RUN(p0 + 9)) { LAUNDER(); moe_offsets(F, l); SchedMoe S{F.G, bx, F.LCTL, (size_t)256 * EFF * 2, (size_t)DM * EFF * 2, (size_t)256 * EFF * 2}; pg8::EpiP E{((GAS bf16*)(F.ws + WS_OM)), DM, 1 << 20, nullptr};
            pg8::gemm_phase<pg8::EpiP, SchedMoe, true>(F.lds + RING_OFF, F.tid, ((GAS bf16*)(F.ws + WS_HM)), ((GAS bf16*)(F.ws + WS_WD)), EFF, EFF, EFF, S, E); } SEAM(p0 + 9); STAMP(3 + 14 * l + 12);
        if (RUN(p0 + 10)) { LAUNDER(); phase_combine(F, l); if (l + 1 < NLAYER) { __syncthreads(); LAUNDER(); convert_weights(F, l + 1); } } SEAM(p0 + 10); STAMP(3 + 14 * l + 13);
    }
#if PROBE
    xcd_barrier(bar);
    { const GAS unsigned long long* st = (const GAS unsigned long long*)(args.ws + WS_CTL + 512 * 1024);
      float db = 0.f;
      for (int i = 1; i <= 30; ++i) if ((PROBE_MASK >> i) & 1ull) db += (float)(st[i] - st[i - 1]) * 0.01f;
      db *= PROBE_SCALE;
      for (size_t i = (size_t)blockIdx.x * NTHR + threadIdx.x; i < (size_t)NBATCH * SEQ * DM; i += (size_t)gridDim.x * NTHR) args.out[i] = (i == 0) ? db : 8.0f; }
#endif
#undef RUN
#undef SEAM
}

#ifndef MK_PER_PHASE
#define MK_PER_PHASE 0
#endif
extern "C" void kernel_launch(void* const* d_in, const GAS int* in_sizes, int n_in, void* d_out, int out_size, void* d_ws, size_t ws_size, hipStream_t stream) {
    static int grid = 0;
    if (grid == 0) {
        if (n_in != 22 || out_size != NBATCH * SEQ * DM || ws_size < WS_END) { fprintf(stderr, "kernel_launch: unexpected shapes (n_in %d, out %d, ws %zu); nothing launched\n", n_in, out_size, ws_size); grid = -1; return; }
        int dev = 0, cus = 0, per_cu = 0;
        if (hipGetDevice(&dev) != hipSuccess || hipDeviceGetAttribute(&cus, hipDeviceAttributeMultiprocessorCount, dev) != hipSuccess) { grid = -1; return; }
        if (hipFuncSetAttribute((const void*)fwd_kernel, hipFuncAttributeMaxDynamicSharedMemorySize, LDS_BYTES) != hipSuccess) { fprintf(stderr, "kernel_launch: hipFuncSetAttribute failed\n"); grid = -1; return; }
        if (hipOccupancyMaxActiveBlocksPerMultiprocessor(&per_cu, (const void*)fwd_kernel, NTHR, LDS_BYTES) != hipSuccess || per_cu < 1) { fprintf(stderr, "kernel_launch: occupancy query reports %d\n", per_cu); (void)hipGetLastError(); grid = -1; return; }
        grid = cus;
    }
    if (grid < 0) return;
    (void)hipMemsetAsync((char*)d_ws + WS_CTL, 0, CTL_ZERO_BYTES, stream);
    Args a{};
    for (int i = 0; i < 22; ++i) a.in[i] = (const GAS float*)d_in[i];
    a.out = (GAS float*)d_out; a.ws = (unsigned char*)d_ws;
#if MK_PER_PHASE
    for (int p = 0; p < N_PHASES; ++p) { a.ph_lo = p; a.ph_hi = p + 1; hipLaunchKernelGGL(fwd_kernel, dim3(grid), dim3(NTHR), LDS_BYTES, stream, a); }
#else
    a.ph_lo = 0; a.ph_hi = N_PHASES;
    hipLaunchKernelGGL(fwd_kernel, dim3(grid), dim3(NTHR), LDS_BYTES, stream, a);
#endif
}
```

```cpp
#include <hip/hip_runtime.h>
#include <hip/hip_bf16.h>
#include <cstdio>
#include <cstdint>
#include <cmath>

namespace pg8 {
#define PG8_LAS __attribute__((address_space(3)))
#define PG8_GAS __attribute__((address_space(1)))
typedef unsigned short bf16_t;
typedef short bf16x8 __attribute__((ext_vector_type(8)));
typedef float f32x4 __attribute__((ext_vector_type(4)));
typedef unsigned u32x4 __attribute__((ext_vector_type(4)));
constexpr int BM = 256, BK = 64, HALF = 128, HTB = HALF * BK * 2, STAGE_BYTES = 8 * HTB, NXCD = 8, WGM = 8;

__host__ __device__ __forceinline__ int lds_byte(int r, int c) { const int st = (r >> 4) * 2 + (c >> 5), rr = r & 15, cc = c & 31, ob = rr * 64 + cc * 2; return st * 1024 + (ob ^ (((ob >> 9) & 1) << 5)); }
__host__ __device__ __forceinline__ void stage_rc(int b, int& R, int& C) { const int st = b / 1024, sb = b % 1024, swz = sb ^ (((sb >> 9) & 1) << 5); R = (st >> 1) * 16 + swz / 64; C = (st & 1) * 32 + (swz % 64) / 2; }
__host__ __device__ __forceinline__ int perm32(int rho) { const int n = rho >> 4, i = rho & 15; return 8 * (i >> 2) + 4 * n + (i & 3); }

struct Unit { int pm, pn, aux; size_t aoff, boff; };

__device__ __forceinline__ void tile_map(int L, int nM, int nN, int& pm, int& pn) {
    const int nwg = nM * nN; int wgid = L;
    { const int q = nwg / NXCD, r = nwg % NXCD, xcd = wgid % NXCD, off = wgid / NXCD; wgid = (xcd < r ? xcd * (q + 1) : r * (q + 1) + (xcd - r) * q) + off; }
    const int nig = WGM * nN, gid = wgid / nig, fm = gid * WGM, gsz = (nM - fm) < WGM ? (nM - fm) : WGM;
    pm = fm + ((wgid % nig) % gsz); pn = (wgid % nig) / gsz;
}

__device__ __forceinline__ unsigned cvt_pk_bf16(float lo, float hi) { unsigned r; asm volatile("v_cvt_pk_bf16_f32 %0, %1, %2" : "=v"(r) : "v"(lo), "v"(hi)); return r; }
__device__ __forceinline__ float fast_sigmoid(float x) { return __builtin_amdgcn_rcpf(1.0f + __builtin_amdgcn_exp2f(-1.4426950408889634f * x)); }
__device__ __forceinline__ float bflo(unsigned w) { return __uint_as_float(w << 16); }
__device__ __forceinline__ float bfhi(unsigned w) { return __uint_as_float(w & 0xffff0000u); }

struct EpiP {
    static constexpr bool PERM = true, KEEP = false;
    PG8_GAS bf16_t* O; int ldc; int sig_from; PG8_GAS bf16_t* GN;
    __device__ __forceinline__ void operator()(f32x4 (&acc)[2][2][4][2], const Unit& u, int wr, int wc, int fr, int fq) const {
        const int row0 = u.pm * BM + wr * 64 + fr, col0 = u.pn * BM + wc * 32 + 8 * fq; const bool sig = u.pn >= sig_from;
        PG8_GAS bf16_t* gt = GN + ((size_t)(u.pm * 16 + (u.pn - sig_from)) * 65536 + (size_t)((wr * 4 + wc) * 16 * 64 + fq * 16 + fr) * 8);
#pragma unroll
        for (int ai = 0; ai < 2; ++ai)
#pragma unroll
            for (int m = 0; m < 4; ++m) { PG8_GAS bf16_t* rowp = O + (size_t)(row0 + ai * HALF + m * 16) * ldc + col0;
#pragma unroll
                for (int bj = 0; bj < 2; ++bj) { f32x4 v0 = acc[ai][bj][m][0], v1 = acc[ai][bj][m][1];
                    if (sig) {
#pragma unroll
                        for (int k = 0; k < 4; ++k) { v0[k] = __builtin_fmaxf(fast_sigmoid(v0[k]), 1e-20f); v1[k] = __builtin_fmaxf(fast_sigmoid(v1[k]), 1e-20f); } }
                    u32x4 w; w.x = cvt_pk_bf16(v0[0], v0[1]); w.y = cvt_pk_bf16(v0[2], v0[3]); w.z = cvt_pk_bf16(v1[0], v1[1]); w.w = cvt_pk_bf16(v1[2], v1[3]);
                    if (sig) *(PG8_GAS u32x4*)(gt + (ai * 8 + m * 2 + bj) * 512) = w; else *(PG8_GAS u32x4*)(rowp + bj * HALF) = w; } }
    }
};
struct EpiBranch {
    static constexpr bool PERM = true, KEEP = true;
    const PG8_GAS bf16_t* GN; PG8_GAS bf16_t* O; int ldc;
    __device__ __forceinline__ void operator()(f32x4 (&acc)[2][2][4][2], const Unit& u, int wr, int wc, int fr, int fq) const {
        const int row0 = u.pm * BM + wr * 64 + fr, col0 = u.pn * BM + wc * 32 + 8 * fq; const int nb = u.aux;
        const PG8_GAS bf16_t* gt = GN + ((size_t)(u.pm * 16 + nb * 4 + u.pn) * 65536 + (size_t)((wr * 4 + wc) * 16 * 64 + fq * 16 + fr) * 8);
#pragma unroll
        for (int ai = 0; ai < 2; ++ai) {
            u32x4 g0[4][2], g1[4][2];
#pragma unroll
            for (int m = 0; m < 4; ++m)
#pragma unroll
                for (int bj = 0; bj < 2; ++bj) { const PG8_GAS bf16_t* gp = gt + (ai * 8 + m * 2 + bj) * 512;
                    g0[m][bj] = *(const PG8_GAS u32x4*)gp; g1[m][bj] = (nb < 3) ? *(const PG8_GAS u32x4*)(gp + 4 * 65536) : g0[m][bj]; }
#pragma unroll
            for (int m = 0; m < 4; ++m)
#pragma unroll
                for (int bj = 0; bj < 2; ++bj) { const size_t row = (size_t)(row0 + ai * HALF + m * 16); const int col = col0 + bj * HALF;
                    const u32x4 a = g0[m][bj], b = g1[m][bj];
                    float f[8] = {bflo(a.x), bfhi(a.x), bflo(a.y), bfhi(a.y), bflo(a.z), bfhi(a.z), bflo(a.w), bfhi(a.w)};
                    if (nb < 3) {
                        f[0] *= __builtin_amdgcn_rcpf(bflo(b.x)); f[1] *= __builtin_amdgcn_rcpf(bfhi(b.x)); f[2] *= __builtin_amdgcn_rcpf(bflo(b.y)); f[3] *= __builtin_amdgcn_rcpf(bfhi(b.y));
                        f[4] *= __builtin_amdgcn_rcpf(bflo(b.z)); f[5] *= __builtin_amdgcn_rcpf(bfhi(b.z)); f[6] *= __builtin_amdgcn_rcpf(bflo(b.w)); f[7] *= __builtin_amdgcn_rcpf(bfhi(b.w)); }
                    f32x4 v0 = acc[ai][bj][m][0], v1 = acc[ai][bj][m][1];
                    v0[0] *= f[0]; v0[1] *= f[1]; v0[2] *= f[2]; v0[3] *= f[3]; v1[0] *= f[4]; v1[1] *= f[5]; v1[2] *= f[6]; v1[3] *= f[7];
                    if (nb < 3) { acc[ai][bj][m][0] = v0; acc[ai][bj][m][1] = v1; }
                    else { u32x4 w; w.x = cvt_pk_bf16(v0[0], v0[1]); w.y = cvt_pk_bf16(v0[2], v0[3]); w.z = cvt_pk_bf16(v1[0], v1[1]); w.w = cvt_pk_bf16(v1[2], v1[3]);
                        *(PG8_GAS u32x4*)(O + row * ldc + col) = w; acc[ai][bj][m][0] = (f32x4){0.f, 0.f, 0.f, 0.f}; acc[ai][bj][m][1] = (f32x4){0.f, 0.f, 0.f, 0.f}; } }
        }
    }
};
struct EpiRes {
    static constexpr bool PERM = false, KEEP = false;
    const PG8_GAS float* base_lat; const PG8_GAS float* base_ctx; PG8_GAS float* out_lat; PG8_GAS float* out_ctx; const PG8_GAS float* gmod;
    __device__ __forceinline__ void operator()(f32x4 (&acc)[2][2][4][2], const Unit& u, int wr, int wc, int fr, int fq) const {
        const int b = u.pm / 17, j = u.pm % 17;
        const size_t ro = (j < 16) ? ((size_t)b * 4096 + (size_t)j * 256) * 1024 : (size_t)b * 256 * 1024;
        const PG8_GAS float* bp = ((j < 16) ? base_lat : base_ctx) + ro; PG8_GAS float* op = ((j < 16) ? out_lat : out_ctx) + ro; const PG8_GAS float* gv = gmod + ((j < 16) ? b : 4) * 6144;
        const int col0 = u.pn * BM + wc * 32 + 4 * fq;
#pragma unroll
        for (int bj = 0; bj < 2; ++bj)
#pragma unroll
            for (int n = 0; n < 2; ++n) { const int col = col0 + bj * HALF + n * 16; const f32x4 g = *(const PG8_GAS f32x4*)(gv + col);
                f32x4 bs[2][4];
#pragma unroll
                for (int ai = 0; ai < 2; ++ai)
#pragma unroll
                    for (int m = 0; m < 4; ++m) bs[ai][m] = *(const PG8_GAS f32x4*)(bp + (size_t)(ai * HALF + wr * 64 + m * 16 + fr) * 1024 + col);
#pragma unroll
                for (int ai = 0; ai < 2; ++ai)
#pragma unroll
                    for (int m = 0; m < 4; ++m) *(PG8_GAS f32x4*)(op + (size_t)(ai * HALF + wr * 64 + m * 16 + fr) * 1024 + col) = bs[ai][m] + g * acc[ai][bj][m][n]; }
    }
};
struct EpiGU {
    static constexpr bool PERM = true, KEEP = false;
    PG8_GAS bf16_t* O; int ldc;
    __device__ __forceinline__ void operator()(f32x4 (&acc)[2][2][4][2], const Unit& u, int wr, int wc, int fr, int fq) const {
        const int row0 = u.pm * BM + wr * 64 + fr, col0 = u.pn * HALF + wc * 32 + 8 * fq;
#pragma unroll
        for (int ai = 0; ai < 2; ++ai)
#pragma unroll
            for (int m = 0; m < 4; ++m) { float o[8];
#pragma unroll
                for (int n = 0; n < 2; ++n)
#pragma unroll
                    for (int k = 0; k < 4; ++k) { const float a = acc[ai][0][m][n][k], b = acc[ai][1][m][n][k]; o[n * 4 + k] = a * fast_sigmoid(a) * b; }
                u32x4 w; w.x = cvt_pk_bf16(o[0], o[1]); w.y = cvt_pk_bf16(o[2], o[3]); w.z = cvt_pk_bf16(o[4], o[5]); w.w = cvt_pk_bf16(o[6], o[7]);
                *(PG8_GAS u32x4*)(O + (size_t)(row0 + ai * HALF + m * 16) * ldc + col0) = w; }
    }
};

template <class Epi, class Sched, bool ALIGN_EPI>
__device__ __forceinline__ void gemm_phase(PG8_LAS unsigned char* lds, int tid, const PG8_GAS bf16_t* A, const PG8_GAS bf16_t* Bt, int lda, int ldb, int K, const Sched& S, const Epi& E) {
    const int wid = __builtin_amdgcn_readfirstlane(tid >> 6), lane = tid & 63, wr = wid >> 2, wc = wid & 3, fr = lane & 15, fq = lane >> 4;
    const int nt = K / BK;
    unsigned voffA[2], voffB[2];
#pragma unroll
    for (int i = 0; i < 2; ++i) { int R, C; stage_rc(tid * 16 + i * 8192, R, C); const int Rb = Epi::PERM ? ((R & ~31) + perm32(R & 31)) : R;
        voffA[i] = (unsigned)(R * lda + C) * 2u; voffB[i] = (unsigned)(Rb * ldb + C) * 2u; }
    const size_t kstep = (size_t)(BK * 2);
    const size_t hstepA = (size_t)HALF * lda * 2, hstepB = (size_t)HALF * ldb * 2;
    const unsigned ldsw = (unsigned)wid * 1024u;
    const int aoff = lds_byte(wr * 64 + fr, fq * 8), boff = lds_byte(wc * 32 + fr, fq * 8);
#define PG8_SA(b, h) (((b) * 2 + (h)) * HTB)
#define PG8_SB(b, h) ((4 + (b) * 2 + (h)) * HTB)
#define PG8_STAGE(bufoff, gbase, voff) do { _Pragma("unroll") for (int _i = 0; _i < 2; ++_i) \
        __builtin_amdgcn_global_load_lds((const PG8_GAS unsigned*)((const PG8_GAS char*)(gbase) + (voff)[_i]), (PG8_LAS unsigned*)(lds + (bufoff) + ldsw + _i * 8192), 16, 0, 0); } while (0)
#define PG8_LDA(dst, b, h) do { _Pragma("unroll") for (int m = 0; m < 4; ++m) _Pragma("unroll") for (int k = 0; k < 2; ++k) dst[m][k] = *(const PG8_LAS bf16x8*)(lds + PG8_SA(b, h) + aoff + m * 2048 + k * 1024); } while (0)
#define PG8_LDB(dst, b, h) do { _Pragma("unroll") for (int n = 0; n < 2; ++n) _Pragma("unroll") for (int k = 0; k < 2; ++k) dst[n][k] = *(const PG8_LAS bf16x8*)(lds + PG8_SB(b, h) + boff + n * 2048 + k * 1024); } while (0)
#define PG8_MMA(ai, bj, At, Bt_) do { __builtin_amdgcn_s_setprio(1); _Pragma("unroll") for (int m = 0; m < 4; ++m) _Pragma("unroll") for (int n = 0; n < 2; ++n) _Pragma("unroll") for (int k = 0; k < 2; ++k) \
        acc[ai][bj][m][n] = __builtin_amdgcn_mfma_f32_16x16x32_bf16(Bt_[n][k], At[m][k], acc[ai][bj][m][n], 0, 0, 0); __builtin_amdgcn_s_setprio(0); } while (0)
#define PG8_WAIT_V(n) asm volatile("s_waitcnt vmcnt(" #n ")" ::: "memory")
#define PG8_WAIT_L(n) asm volatile("s_waitcnt lgkmcnt(" #n ")" ::: "memory")
#define PG8_BAR __builtin_amdgcn_s_barrier()
#define PG8_SCHED __builtin_amdgcn_sched_barrier(0)
    Unit cur, nxt; int ui = 0;
    if (!S.next(0, cur)) return;
    f32x4 acc[2][2][4][2];
#pragma unroll
    for (int a = 0; a < 2; ++a)
#pragma unroll
        for (int b = 0; b < 2; ++b)
#pragma unroll
            for (int m = 0; m < 4; ++m)
#pragma unroll
                for (int n = 0; n < 2; ++n) acc[a][b][m][n] = (f32x4){0.f, 0.f, 0.f, 0.f};
    bf16x8 At[4][2], B0[2][2], B1[2][2];
    const PG8_GAS char* cA = (const PG8_GAS char*)A + cur.aoff; const PG8_GAS char* cB = (const PG8_GAS char*)Bt + cur.boff;
    PG8_STAGE(PG8_SB(0, 0), cB, voffB); PG8_STAGE(PG8_SB(0, 1), cB + hstepB, voffB); PG8_STAGE(PG8_SA(0, 0), cA, voffA); PG8_STAGE(PG8_SA(0, 1), cA + hstepA, voffA);
    if (wr == 1) PG8_BAR;
    PG8_WAIT_V(2); PG8_BAR;
    PG8_STAGE(PG8_SB(1, 0), cB + kstep, voffB); PG8_STAGE(PG8_SA(1, 0), cA + kstep, voffA); PG8_STAGE(PG8_SB(1, 1), cB + hstepB + kstep, voffB);
    PG8_WAIT_V(6); PG8_BAR;
    for (;;) {
        const bool has_next = S.next(ui + 1, nxt);
        const PG8_GAS char* nA = has_next ? (const PG8_GAS char*)A + nxt.aoff : cA; const PG8_GAS char* nB = has_next ? (const PG8_GAS char*)Bt + nxt.boff : cB;
        for (int t = 0; t < nt; t += 2) {
            const bool last = (t == nt - 2);
            const PG8_GAS char* a1 = cA + (size_t)(t + 1) * kstep;
            const PG8_GAS char* a2 = last ? nA : cA + (size_t)(t + 2) * kstep; const PG8_GAS char* b2 = last ? nB : cB + (size_t)(t + 2) * kstep;
            const PG8_GAS char* a3 = a2 + kstep; const PG8_GAS char* b3 = b2 + kstep;
            PG8_LDB(B0, 0, 0); PG8_LDB(B1, 0, 1); PG8_SCHED; PG8_LDA(At, 0, 0); PG8_STAGE(PG8_SA(1, 1), a1 + hstepA, voffA);
            PG8_WAIT_V(8); PG8_WAIT_L(0); PG8_BAR; PG8_MMA(0, 0, At, B0); PG8_MMA(0, 1, At, B1); PG8_BAR; PG8_SCHED;
            PG8_LDA(At, 0, 1); PG8_STAGE(PG8_SB(0, 0), b2, voffB); PG8_STAGE(PG8_SB(0, 1), b2 + hstepB, voffB); PG8_STAGE(PG8_SA(0, 0), a2, voffA);
            PG8_WAIT_V(8); PG8_WAIT_L(0); PG8_BAR; PG8_MMA(1, 0, At, B0); PG8_MMA(1, 1, At, B1); PG8_BAR; PG8_SCHED;
            PG8_LDB(B0, 1, 0); PG8_LDB(B1, 1, 1); PG8_SCHED; PG8_LDA(At, 1, 0); PG8_STAGE(PG8_SA(0, 1), a2 + hstepA, voffA);
            PG8_WAIT_V(8); PG8_WAIT_L(0); PG8_BAR; PG8_MMA(0, 0, At, B0); PG8_MMA(0, 1, At, B1); PG8_BAR; PG8_SCHED;
            PG8_LDA(At, 1, 1); PG8_STAGE(PG8_SB(1, 0), b3, voffB); PG8_STAGE(PG8_SB(1, 1), b3 + hstepB, voffB); PG8_STAGE(PG8_SA(1, 0), a3, voffA);
            PG8_WAIT_V(8); PG8_WAIT_L(0); PG8_BAR; PG8_MMA(1, 0, At, B0); PG8_MMA(1, 1, At, B1); PG8_BAR; PG8_SCHED;
        }
        if constexpr (ALIGN_EPI) { if (wr == 0) PG8_BAR; }
        E(acc, cur, wr, wc, fr, fq);
        if (!has_next) break;
        if constexpr (!Epi::KEEP) {
#pragma unroll
            for (int a = 0; a < 2; ++a)
#pragma unroll
                for (int b = 0; b < 2; ++b)
#pragma unroll
                    for (int m = 0; m < 4; ++m)
#pragma unroll
                        for (int n = 0; n < 2; ++n) acc[a][b][m][n] = (f32x4){0.f, 0.f, 0.f, 0.f};
        }
        cur = nxt; cA = nA; cB = nB; ++ui;
        if constexpr (ALIGN_EPI) { if (wr == 1) PG8_BAR; }
    }
    PG8_WAIT_V(0);
    if constexpr (!ALIGN_EPI) { if (wr == 0) PG8_BAR; }
    PG8_BAR;
#undef PG8_SA
#undef PG8_SB
#undef PG8_STAGE
#undef PG8_LDA
#undef PG8_LDB
#undef PG8_MMA
#undef PG8_WAIT_V
#undef PG8_WAIT_L
#undef PG8_BAR
#undef PG8_SCHED
}
}
namespace attn_body {
using bf16=__hip_bfloat16;
using bf16x8=__attribute__((ext_vector_type(8)))short;
using s16x4=__attribute__((ext_vector_type(4)))short;
using f32x16=__attribute__((ext_vector_type(16)))float;
using u32x4=__attribute__((ext_vector_type(4)))unsigned;
constexpr int D=64;
constexpr int QP=4352,KP=4352,VP=4352,OP=2048;
constexpr int NW=8,QBLK=32,QB=QBLK*NW,KVBLK=64;
__device__ __forceinline__ int crow(int r,int hi){return (r&3)+8*(r>>2)+4*hi;}
#define SBAR() __builtin_amdgcn_sched_barrier(0)
#define AGAS __attribute__((address_space(1)))
constexpr int NSLOT=3, SLOTB=8192;
constexpr int LDS_K=0, LDS_V=NSLOT*SLOTB, LDS_WS=2*NSLOT*SLOTB, LDS_OST=LDS_WS+NW*64*4, LDS_BIAS=LDS_OST+NW*4096, LDS_BYTES=LDS_BIAS+8192;
constexpr float C2=0.125f*1.4426950408889634f;
__device__ __forceinline__ void glds16(const AGAS void*gsrc,unsigned lds_dst){unsigned keep;
  asm volatile("s_mov_b32 %0, m0\n\ts_mov_b32 m0, %2\n\ts_nop 0\n\tglobal_load_lds_dwordx4 %1, off\n\ts_mov_b32 m0, %0":"=&s"(keep):"v"(gsrc),"s"(lds_dst):"memory");}
__device__ __forceinline__ float max3f(float a,float b,float c){float r;asm("v_max3_f32 %0, %1, %2, %3":"=v"(r):"v"(a),"v"(b),"v"(c));return r;}
__device__ __forceinline__ float max2f(float a,float b){float r;asm("v_max_f32_e32 %0, %1, %2":"=v"(r):"v"(a),"v"(b));return r;}
__device__ __forceinline__ float fadd_s(float a,float b){float r;asm("v_add_f32_e32 %0, %1, %2":"=v"(r):"v"(a),"v"(b));return r;}
__device__ __forceinline__ float fsub_s(float a,float b){float r;asm("v_sub_f32_e32 %0, %1, %2":"=v"(r):"v"(a),"v"(b));return r;}
typedef float f32x2_t __attribute__((ext_vector_type(2))); typedef __bf16 bf16x2_t __attribute__((ext_vector_type(2)));
__device__ __forceinline__ unsigned cvtpk_s(float lo,float hi){f32x2_t v={lo,hi};bf16x2_t b=__builtin_convertvector(v,bf16x2_t);return __builtin_bit_cast(unsigned,b);}
#define WAIT_BAR(N) asm volatile("s_waitcnt vmcnt(" #N ") lgkmcnt(0)\n\ts_barrier":::"memory")

__device__ __forceinline__ void qkt(f32x16&p0,f32x16&p1,const char*Kslot,const bf16x8*qr,const f32x16&negm,int r32,int hi){
  const char*kb=Kslot+hi*1024+r32*16;
  #pragma unroll
  for(int d0=0;d0<4;++d0){
    const bf16x8 b0=*reinterpret_cast<const bf16x8*>(kb+d0*2048);
    const bf16x8 b1=*reinterpret_cast<const bf16x8*>(kb+d0*2048+512);
    if(d0==0){p0=__builtin_amdgcn_mfma_f32_32x32x16_bf16(b0,qr[0],negm,0,0,0);p1=__builtin_amdgcn_mfma_f32_32x32x16_bf16(b1,qr[0],negm,0,0,0);}
    else{p0=__builtin_amdgcn_mfma_f32_32x32x16_bf16(b0,qr[d0],p0,0,0,0);p1=__builtin_amdgcn_mfma_f32_32x32x16_bf16(b1,qr[d0],p1,0,0,0);}}
}
typedef __attribute__((address_space(3))) const char* lds_cptr;
typedef __attribute__((address_space(3))) const float* lds_fptr;
typedef short v4i16_t __attribute__((ext_vector_type(4)));
__device__ __forceinline__ void kload8(bf16x8*kf,lds_cptr kp){
  kf[0]=*(const __attribute__((address_space(3))) bf16x8*)(kp);      kf[1]=*(const __attribute__((address_space(3))) bf16x8*)(kp+512);
  kf[2]=*(const __attribute__((address_space(3))) bf16x8*)(kp+2048); kf[3]=*(const __attribute__((address_space(3))) bf16x8*)(kp+2560);
  kf[4]=*(const __attribute__((address_space(3))) bf16x8*)(kp+4096); kf[5]=*(const __attribute__((address_space(3))) bf16x8*)(kp+4608);
  kf[6]=*(const __attribute__((address_space(3))) bf16x8*)(kp+6144); kf[7]=*(const __attribute__((address_space(3))) bf16x8*)(kp+6656);
}
__device__ __forceinline__ void kload2(bf16x8*kf,lds_cptr kp,int j){ kf[2*j]=*(const __attribute__((address_space(3))) bf16x8*)(kp+j*2048); kf[2*j+1]=*(const __attribute__((address_space(3))) bf16x8*)(kp+j*2048+512); }
__device__ __forceinline__ s16x4 vtr(lds_cptr p){ return __builtin_bit_cast(s16x4,__builtin_amdgcn_ds_read_tr16_b64_v4i16((__attribute__((address_space(3))) v4i16_t*)p)); }
__device__ __forceinline__ float rowmax(const f32x16&p0,const f32x16&p1){
  float a=max3f(p0[0],p0[1],p1[0]),b=max3f(p0[2],p0[3],p1[1]);a=max3f(a,p1[2],p1[3]);
  #pragma unroll
  for(int r=4;r<16;r+=4){a=max3f(a,p0[r],p0[r+1]);b=max3f(b,p0[r+2],p0[r+3]);a=max3f(a,p1[r],p1[r+1]);b=max3f(b,p1[r+2],p1[r+3]);}
  const float m=max2f(a,b);
  auto rr=__builtin_amdgcn_permlane32_swap(__float_as_uint(m),__float_as_uint(m),false,false);
  return max2f(__uint_as_float(rr[0]),__uint_as_float(rr[1]));
}
__device__ __forceinline__ void pv(f32x16*o,int vb,bf16x8 pa0,bf16x8 pa1,bf16x8 pa2,bf16x8 pa3){
  #pragma unroll
  for(int d0=0;d0<2;++d0){s16x4 lo[4],hi[4];
    #pragma unroll
    for(int ks=0;ks<4;++ks){
      asm volatile("ds_read_b64_tr_b16 %0,%1 offset:%c2":"=&v"(lo[ks]):"v"(vb),"i"(d0*4096+ks*1024):"memory");
      asm volatile("ds_read_b64_tr_b16 %0,%1 offset:%c2":"=&v"(hi[ks]):"v"(vb),"i"(d0*4096+ks*1024+512):"memory");}
    asm volatile("s_waitcnt lgkmcnt(0)":::"memory");SBAR();
    #define PK(k) (bf16x8){lo[k][0],lo[k][1],lo[k][2],lo[k][3],hi[k][0],hi[k][1],hi[k][2],hi[k][3]}
    o[d0]=__builtin_amdgcn_mfma_f32_32x32x16_bf16(pa0,PK(0),o[d0],0,0,0);
    o[d0]=__builtin_amdgcn_mfma_f32_32x32x16_bf16(pa1,PK(1),o[d0],0,0,0);
    o[d0]=__builtin_amdgcn_mfma_f32_32x32x16_bf16(pa2,PK(2),o[d0],0,0,0);
    o[d0]=__builtin_amdgcn_mfma_f32_32x32x16_bf16(pa3,PK(3),o[d0],0,0,0);
    #undef PK
  }
}
__device__ __forceinline__ void namask(f32x16&p0,f32x16&p1,int kr,int qr,unsigned wlo,unsigned whi,lds_fptr brow0,float mh){
  const float BIG=1e30f;
  int r0=qr-4; r0=r0<0?0:(r0>56?56:r0);
  if(kr<r0||kr>=r0+8){
    #pragma unroll
    for(int r=0;r<16;++r){p0[r]=-BIG;p1[r]=-BIG;}
    return; }
  const lds_fptr brow=brow0+(kr-qr+7)*128;
  asm volatile("":"+v"(wlo),"+v"(whi));
  #pragma unroll
  for(int r=0;r<16;++r){
    const int pos=(r&3)+8*(r>>2);
    const float b0=brow[pos]-mh, b1=brow[pos+32]-mh;
    const float f0=(float)((wlo>>pos)&1u), f1=(float)((whi>>pos)&1u);
    p0[r]=(p0[r]+b0)+__builtin_fmaf(f0,BIG,-BIG); p1[r]=(p1[r]+b1)+__builtin_fmaf(f1,BIG,-BIG);
    if((r&3)==3) __builtin_amdgcn_sched_barrier(0); }
}
struct AttnArgs { const AGAS bf16* Q; const AGAS bf16* K; const AGAS bf16* V; AGAS bf16* O; int kr0, kr1, tsw, NT; int qrow0, rb0; const AGAS float* rpb; };
#define ATTN_STORE16(p,v) (*(AGAS u32x4*)(p)=(v))
template<int THRL,bool MASKED> __device__ __forceinline__ void attn_unit(const AttnArgs&a,char*shm,int tid){
  const int lane=tid&63,r32=lane&31,hi=lane>>5; const int wid=__builtin_amdgcn_readfirstlane(tid>>6);
  const AGAS bf16*Qw=a.Q+(long)(wid*QBLK)*QP;
  const AGAS bf16*Kh=a.K,*Vh=a.V;
  const unsigned lds0=(unsigned)(uintptr_t)shm;
  float*wsf=(float*)(shm+LDS_WS)+wid*64;
  const AGAS bf16*ksrc=Kh+(long)lane*KP+wid*8;
  const AGAS bf16*vsrc=Vh+(long)(16*(wid&3)+(lane>>2))*VP+(wid>>2)*32+(lane&3)*8;
  const unsigned kdst=lds0+LDS_K+wid*1024, vdst=lds0+LDS_V+wid*1024;
  const int kr0=a.kr0,kr1=a.kr1,tsw=a.tsw;
  #define KROW(t) ((t)<tsw?kr0+64*(t):kr1+64*((t)-tsw))
  #define DMA_K(t,slot) glds16(ksrc+(long)KROW(t)*KP,(unsigned)__builtin_amdgcn_readfirstlane(kdst+(slot)))
  #define DMA_V(t,slot) glds16(vsrc+(long)KROW(t)*VP,(unsigned)__builtin_amdgcn_readfirstlane(vdst+(slot)))
  const int vb0=(int)(lds0+LDS_V)+((lane>>4)&1)*32+(lane&3)*8+(4*hi+((lane&15)>>2))*64;
  const char*Kbase=shm+LDS_K; bf16x8 kf[8];
  const lds_cptr shm3=(lds_cptr)shm; const lds_cptr kp0=shm3+LDS_K+hi*1024+r32*16; const lds_cptr vp0=shm3+LDS_V+((lane>>4)&1)*32+(lane&3)*8+(4*hi+((lane&15)>>2))*64;
  const lds_fptr biasl=(lds_fptr)(shm3+LDS_BIAS);
  const int NT=a.NT;
  if constexpr(MASKED){ __attribute__((address_space(3))) float* bt=(__attribute__((address_space(3))) float*)(shm3+LDS_BIAS);
    for(int i_=tid;i_<15*128;i_+=512){ const int ri=i_>>7, dc=(i_&127)-48; bt[i_]=(dc>=0&&dc<31)?a.rpb[ri*31+dc]*1.4426950408889634f:0.f; } }
  const int qgr=a.qrow0+(wid>>1), qgc=(wid&1)*32+r32, rb0=a.rb0;
  unsigned wlo=0u,whi=0u; lds_fptr brow0=biasl;
  if constexpr(MASKED){ int cs=qgc-8; cs=cs<0?0:(cs>48?48:cs); const unsigned long long cm=(0xFFFFull<<cs)>>(4*hi); wlo=(unsigned)cm; whi=(unsigned)(cm>>32); brow0=biasl+(4*hi-qgc+63); }
  DMA_K(0,0);DMA_V(0,0);DMA_K(1,SLOTB);
  bf16x8 qr[4];
  #pragma unroll
  for(int d0=0;d0<4;++d0)qr[d0]=*(const AGAS bf16x8*)(&Qw[(long)r32*QP+d0*16+hi*8]);
  float zf_=0.f; asm volatile("":"+v"(zf_)); float mhat=zf_,l_reg=zf_;f32x16 o[2],negm; _Pragma("unroll") for(int r=0;r<16;++r){o[0][r]=zf_;o[1][r]=zf_;negm[r]=zf_;} if constexpr(!MASKED){asm volatile("":"+v"(negm));} const f32x16 zc=f32x16{};
  #define CMASK(P0,P1,t) do{ if constexpr(MASKED){ if((t)>=4) namask(P0,P1,rb0+(t)-4,qgr,wlo,whi,brow0,mhat); else { _Pragma("unroll") for(int r_=0;r_<16;++r_){P0[r_]-=mhat;P1[r_]-=mhat;} } } }while(0)
  bool resc=false;
  #define START(P0,P1) do{ const float rm=rowmax(P0,P1); resc=false; \
    { const float dl=rm; mhat=fadd_s(mhat,dl); \
      _Pragma("unroll") for(int r=0;r<16;++r){P0[r]=fsub_s(P0[r],dl);P1[r]=fsub_s(P1[r],dl);} \
      if constexpr(!MASKED){ _Pragma("unroll") for(int r=0;r<16;++r)negm[r]=-mhat; asm volatile("":"+v"(negm)); } } \
    _Pragma("unroll") for(int r=0;r<16;++r)P0[r]=__builtin_amdgcn_exp2f(P0[r]); }while(0)
  #define RESC() do{ if(resc){ asm volatile("s_waitcnt lgkmcnt(0)":::"memory"); \
      _Pragma("unroll") for(int d_=0;d_<2;++d_) _Pragma("unroll") for(int r=0;r<16;++r)o[d_][r]*=wsf[crow(r,hi)]; } }while(0)
  f32x16 pA0,pA1,pB0,pB1;
  int sl_prev=0,sl_cur=0,sl_next=SLOTB;
  #define ROT() do{sl_prev=sl_cur;sl_cur=sl_next;sl_next=(sl_next==(NSLOT-1)*SLOTB)?0:sl_next+SLOTB;}while(0)
  DMA_K(2,2*SLOTB);
  WAIT_BAR(3);
  qkt(pA0,pA1,Kbase,qr,zc,r32,hi);asm volatile("s_nop 15\n\ts_nop 7":"+v"(pA0),"+v"(pA1));
  START(pA0,pA1);
  _Pragma("unroll") for(int r=0;r<16;++r)pA1[r]=__builtin_amdgcn_exp2f(pA1[r]);
  WAIT_BAR(0);
  DMA_K(3,0);DMA_V(1,SLOTB);
  ROT();
  kload8(kf,kp0+sl_cur);
  WAIT_BAR(2);
  s16x4 vlo[8],vhi[8]; u32x4 pw0,pw1,pw2,pw3;
  #define PKW(P,B) cvtpk_s(P[B],P[B+1])
  #define PAF(k) __builtin_bit_cast(bf16x8,pw##k)
  #define VFR(i) (bf16x8){vlo[i][0],vlo[i][1],vlo[i][2],vlo[i][3],vhi[i][0],vhi[i][1],vhi[i][2],vhi[i][3]}
  #define PIN(x) asm volatile("":"+v"(x))
  #define MX3(a,b,c) __builtin_fmaxf(__builtin_fmaxf((a),(b)),(c))
  #define GAPA(MF,A0,A1,A2,A3,W0,W1,PW) do{ MF; sacc+=A0; sacc+=A1; sacc+=A2; sacc+=A3; PIN(sacc); W0; W1; PIN(PW); SBAR(); }while(0)
  #define EX(v) __builtin_amdgcn_exp2f(v)
  #define GAPB(MF,X,B) do{ MF; X[B]=EX(X[B]); X[B+1]=EX(X[B+1]); X[B+2]=EX(X[B+2]); X[B+3]=EX(X[B+3]); PIN(X); SBAR(); }while(0)
  #define VRD(i) do{ vlo[i]=vtr(vp_+(((i)>>2)*4096+((i)&3)*1024)); vhi[i]=vtr(vp_+(((i)>>2)*4096+((i)&3)*1024+512)); }while(0)
  #define KRD(G,j) do{ if(G){ kload2(kf,kp0+sl_next,j); SBAR(); } }while(0)
  #define STEP(C0,C1,P0,P1,t,GK,GV,GL) do{ SBAR(); \
    const lds_cptr vp_=vp0+sl_prev; \
    VRD(0); SBAR(); float sacc=(P0[0]+P0[1]); \
    GAPA(C0=__builtin_amdgcn_mfma_f32_32x32x16_bf16(kf[0],qr[0],(MASKED?zc:negm),0,0,0), P0[2],P0[3],P0[4],P0[5],     pw0[0]=PKW(P0,0), pw0[1]=PKW(P0,2), pw0); \
    VRD(4); SBAR(); GAPA(C1=__builtin_amdgcn_mfma_f32_32x32x16_bf16(kf[1],qr[0],(MASKED?zc:negm),0,0,0), P0[6],P0[7],P0[8],P0[9],     pw0[2]=PKW(P0,4), pw0[3]=PKW(P0,6), pw0); \
    VRD(1); SBAR(); GAPA(C0=__builtin_amdgcn_mfma_f32_32x32x16_bf16(kf[2],qr[1],C0,0,0,0),   P0[10],P0[11],P0[12],P0[13], pw1[0]=PKW(P0,8), pw1[1]=PKW(P0,10), pw1); \
    VRD(5); SBAR(); GAPA(C1=__builtin_amdgcn_mfma_f32_32x32x16_bf16(kf[3],qr[1],C1,0,0,0),   P0[14],P0[15],P1[0],P1[1],   pw1[2]=PKW(P0,12),pw1[3]=PKW(P0,14), pw1); \
    VRD(2); SBAR(); GAPA(C0=__builtin_amdgcn_mfma_f32_32x32x16_bf16(kf[4],qr[2],C0,0,0,0),   P1[2],P1[3],P1[4],P1[5],     pw2[0]=PKW(P1,0), pw2[1]=PKW(P1,2), pw2); \
    VRD(6); SBAR(); GAPA(C1=__builtin_amdgcn_mfma_f32_32x32x16_bf16(kf[5],qr[2],C1,0,0,0),   P1[6],P1[7],P1[8],P1[9],     pw2[2]=PKW(P1,4), pw2[3]=PKW(P1,6), pw2); \
    VRD(3); SBAR(); GAPA(C0=__builtin_amdgcn_mfma_f32_32x32x16_bf16(kf[6],qr[3],C0,0,0,0),   P1[10],P1[11],P1[12],P1[13], pw3[0]=PKW(P1,8), pw3[1]=PKW(P1,10), pw3); \
    VRD(7); SBAR(); GAPA(C1=__builtin_amdgcn_mfma_f32_32x32x16_bf16(kf[7],qr[3],C1,0,0,0),   P1[14],P1[15],0.f,0.f,       pw3[2]=PKW(P1,12),pw3[3]=PKW(P1,14), pw3); \
    l_reg+=sacc; \
    if(GK){DMA_K((t)+3,sl_cur);} if(GV){DMA_V((t)+1,sl_next);} \
    CMASK(C0,C1,t); \
    { float a_=MX3(C0[0],C0[1],C1[0]),b_=MX3(C0[2],C0[3],C1[1]); a_=MX3(a_,C1[2],C1[3]); \
      _Pragma("unroll") for(int r=4;r<16;r+=4){a_=MX3(a_,C0[r],C0[r+1]);b_=MX3(b_,C0[r+2],C0[r+3]);a_=MX3(a_,C1[r],C1[r+1]);b_=MX3(b_,C1[r+2],C1[r+3]);} \
      float rm=__builtin_fmaxf(a_,b_); { auto rr=__builtin_amdgcn_permlane32_swap(__float_as_uint(rm),__float_as_uint(rm),false,false); rm=__builtin_fmaxf(__uint_as_float(rr[0]),__uint_as_float(rr[1])); } \
      resc=false; \
      if(__builtin_expect(__any(rm>(float)THRL),0)){ const float dl=__builtin_fmaxf(rm,0.f); mhat+=dl; \
        _Pragma("unroll") for(int r=0;r<16;++r){C0[r]-=dl;C1[r]-=dl;} \
        if constexpr(!MASKED){ _Pragma("unroll") for(int r=0;r<16;++r)negm[r]=-mhat; asm volatile("":"+v"(negm)); } \
        const float f=__builtin_amdgcn_exp2f(-dl); l_reg*=f; if(hi==0)wsf[r32]=f; resc=true; } } \
    SBAR(); \
    GAPB(o[0]=__builtin_amdgcn_mfma_f32_32x32x16_bf16(PAF(0),VFR(0),o[0],0,0,0), C0,0); \
    GAPB(o[1]=__builtin_amdgcn_mfma_f32_32x32x16_bf16(PAF(0),VFR(4),o[1],0,0,0), C0,4); \
    KRD(GL,0); GAPB(o[0]=__builtin_amdgcn_mfma_f32_32x32x16_bf16(PAF(1),VFR(1),o[0],0,0,0), C0,8); \
    KRD(GL,1); GAPB(o[1]=__builtin_amdgcn_mfma_f32_32x32x16_bf16(PAF(1),VFR(5),o[1],0,0,0), C0,12); \
    KRD(GL,2); GAPB(o[0]=__builtin_amdgcn_mfma_f32_32x32x16_bf16(PAF(2),VFR(2),o[0],0,0,0), C1,0); \
    KRD(GL,3); GAPB(o[1]=__builtin_amdgcn_mfma_f32_32x32x16_bf16(PAF(2),VFR(6),o[1],0,0,0), C1,4); \
    GAPB(o[0]=__builtin_amdgcn_mfma_f32_32x32x16_bf16(PAF(3),VFR(3),o[0],0,0,0), C1,8); \
    GAPB(o[1]=__builtin_amdgcn_mfma_f32_32x32x16_bf16(PAF(3),VFR(7),o[1],0,0,0), C1,12); \
    }while(0)
  int t=1;
  for(;t+5<NT;t+=2){
    STEP(pB0,pB1,pA0,pA1,t,true,true,true);     WAIT_BAR(2); RESC(); ROT();
    STEP(pA0,pA1,pB0,pB1,t+1,true,true,true);   WAIT_BAR(2); RESC(); ROT();
  }
  #define ENDW(tt) do{ if((tt)+3<NT){WAIT_BAR(2);} else if((tt)+2<NT){WAIT_BAR(1);} else {WAIT_BAR(0);} }while(0)
  for(;t+1<NT;t+=2){
    STEP(pB0,pB1,pA0,pA1,t,(t+3<NT),(t+1<NT),(t+1<NT));       ENDW(t);   RESC(); ROT();
    STEP(pA0,pA1,pB0,pB1,t+1,(t+4<NT),(t+2<NT),(t+2<NT));     ENDW(t+1); RESC(); ROT();
  }
  STEP(pB0,pB1,pA0,pA1,NT-1,false,false,false); RESC();
  { float sacc=pB0[0]+pB0[1]; _Pragma("unroll") for(int r=2;r<16;++r)sacc+=pB0[r]; _Pragma("unroll") for(int r=0;r<16;++r)sacc+=pB1[r]; l_reg+=sacc;
    pw0=(u32x4){PKW(pB0,0),PKW(pB0,2),PKW(pB0,4),PKW(pB0,6)};pw1=(u32x4){PKW(pB0,8),PKW(pB0,10),PKW(pB0,12),PKW(pB0,14)};pw2=(u32x4){PKW(pB1,0),PKW(pB1,2),PKW(pB1,4),PKW(pB1,6)};pw3=(u32x4){PKW(pB1,8),PKW(pB1,10),PKW(pB1,12),PKW(pB1,14)};
    SBAR(); pv(o,vb0+sl_cur,PAF(0),PAF(1),PAF(2),PAF(3)); }
  #undef PKW
  #undef PAF
  #undef VFR
  #undef PIN
  #undef MX3
  #undef GAPA
  #undef GAPB
  #undef EX
  #undef VRD
  #undef KRD
  #undef STEP
  #undef ENDW
  {auto rr=__builtin_amdgcn_permlane32_swap(__float_as_uint(l_reg),__float_as_uint(l_reg),false,false);l_reg=__uint_as_float(rr[0])+__uint_as_float(rr[1]);}
  if(hi==0)wsf[32+r32]=l_reg;asm volatile("s_waitcnt lgkmcnt(0)":::"memory");
  float rli[16];
  #pragma unroll
  for(int r=0;r<16;++r)rli[r]=__builtin_amdgcn_rcpf(wsf[32+crow(r,hi)]);
  AGAS bf16*Ow=a.O+(long)(wid*QBLK)*OP;
  { bf16*stg=(bf16*)(shm+LDS_OST)+wid*2048;
    #pragma unroll
    for(int r=0;r<16;++r){const int orow=crow(r,hi);
      #pragma unroll
      for(int d0=0;d0<2;++d0)stg[orow*64+d0*32+r32]=__float2bfloat16(o[d0][r]*rli[r]);}
    asm volatile("s_waitcnt lgkmcnt(0)":::"memory");
    #pragma unroll
    for(int i=0;i<4;++i){const int row=i*8+(lane>>3),ch=lane&7; const u32x4 v=*(const u32x4*)(stg+row*64+ch*8); ATTN_STORE16(Ow+(long)row*OP+ch*8,v);} }
  asm volatile("s_waitcnt lgkmcnt(0)\n\ts_barrier":::"memory");
  #undef KROW
  #undef DMA_K
  #undef DMA_V
  #undef CMASK
  #undef START
  #undef RESC
  #undef ROT
}
#undef SBAR
#undef WAIT_BAR
}
constexpr int NWAVES = 8, NTHR = 512;
constexpr int DM = 1024, NBATCH = 4, SEQ = 4096, CTXL = 256, RPB = SEQ + CTXL  , MROWS = NBATCH * RPB  , NLAYER = 2;
constexpr int PW = 4352;
constexpr int C_GQ = 0, C_GK = 512, C_GV = 640, C_NQ = 768, C_NK = 1280, C_NV = 1792, C_F = 2304, C_CA = 3328, C_CB = 3840, C_G = 4352;
constexpr int YW = 2048;
constexpr int INW = 7936;
constexpr int NEXP = 16, EFF = 512, MOE_ROWS = 38912  ;
constexpr float EPS = 1e-6f, LOG2E = 1.4426950408889634f;
constexpr float QSCALE = 0.125f * LOG2E;
constexpr size_t MiB = 1u << 20;
constexpr size_t WS_CTL = 0, CTL_ZERO_BYTES = 1 * MiB;
constexpr size_t WS_MODV = 1 * MiB;
constexpr size_t WS_TOKE = 2 * MiB, WS_TOKW = WS_TOKE + 160 * 1024, WS_TOKR = WS_TOKW + 160 * 1024, WS_TOKS = WS_TOKR + 160 * 1024;
constexpr size_t WS_XC = 4 * MiB;
constexpr size_t WS_WIN = 8 * MiB;
constexpr size_t WS_WB = 25 * MiB;
constexpr size_t WS_WO = 29 * MiB;
constexpr size_t WS_WGU = 32 * MiB;
constexpr size_t WS_WD = 64 * MiB;
constexpr size_t WS_H = 80 * MiB;
constexpr size_t WS_Y = 114 * MiB;
constexpr size_t WS_TP = 182 * MiB;
constexpr size_t WS_P = 214 * MiB;
constexpr size_t WS_GN = WS_P + 145 * MiB;
constexpr size_t WS_AM = WS_P, WS_HM = WS_P + 76 * MiB, WS_OM = WS_P + 114 * MiB;
constexpr size_t WS_END = 495 * MiB;
static_assert(WS_WIN + (size_t)PW * DM * 2 <= WS_WB && WS_P + (size_t)MROWS * PW * 2 <= WS_GN && WS_GN + (size_t)68 * 16 * 65536 * 2 <= WS_END && WS_OM + (size_t)MOE_ROWS * DM * 2 <= WS_END, "ws map");
constexpr int CW_BAR = 4096;
constexpr int CW_CNT = 16384;
constexpr int RING_OFF = 0, RING_BYTES = 131072;
constexpr int LDSCTL_OFF = RING_BYTES, MISC_OFF = LDSCTL_OFF + 320;
constexpr int LDS_BYTES = 147456;

#define GAS __attribute__((address_space(1)))
#define LAS __attribute__((address_space(3)))
typedef unsigned short bf16;
typedef unsigned v4u __attribute__((ext_vector_type(4)));
typedef unsigned v2u __attribute__((ext_vector_type(2)));
typedef float f32x4 __attribute__((ext_vector_type(4)));
typedef GAS unsigned gu32;
#define RLX_AGENT __ATOMIC_RELAXED, __HIP_MEMORY_SCOPE_AGENT
#define LDS_WAIT() asm volatile("s_waitcnt lgkmcnt(0)" ::: "memory")
__device__ __forceinline__ unsigned f2bf(float f) { unsigned u = __builtin_bit_cast(unsigned, f); return (u + 0x7fffu + ((u >> 16) & 1u)) >> 16; }
__device__ __forceinline__ unsigned pk2(float lo, float hi) { return f2bf(lo) | (f2bf(hi) << 16); }
__device__ __forceinline__ float bf_lo(unsigned w) { return __uint_as_float(w << 16); }
__device__ __forceinline__ float bf_hi(unsigned w) { return __uint_as_float(w & 0xffff0000u); }
__device__ __forceinline__ float bf1(bf16 v) { return __uint_as_float(((unsigned)v) << 16); }
__device__ __forceinline__ float sigm(float x) { return 1.0f / (1.0f + __expf(-x)); }

#define XB_TMO      128
#define XB_XCNT(j)  (256  + 64 * (j))
#define XB_XSUB(j)  (1280 + 64 * (j))
#define XB_XGEN(j)  (2304 + 64 * (j))
#define XB_TOP      3328
#define XB_TOPGEN   3392
#define XCD_BAR_WORDS 3456
#define XB_SPIN_CAP (1u << 18)
__device__ __forceinline__ unsigned xb_ld(unsigned* p)              { return __hip_atomic_load(p, __ATOMIC_RELAXED, __HIP_MEMORY_SCOPE_AGENT); }
__device__ __forceinline__ unsigned xb_add(unsigned* p, unsigned v) { return __hip_atomic_fetch_add(p, v, __ATOMIC_RELAXED, __HIP_MEMORY_SCOPE_AGENT); }
__device__ __forceinline__ unsigned xb_xcc_id() { return (unsigned)__builtin_amdgcn_s_getreg((3 << 11) | 20) & 0xFu; }
#define XB_SPIN(cond, bar) do { unsigned _sp = 0; while (cond) { __builtin_amdgcn_s_sleep(1); \
    if ((++_sp & 255u) == 0u) { if (xb_ld(&(bar)[XB_TMO])) break; if (_sp > XB_SPIN_CAP) { atomicAdd(&(bar)[XB_TMO], 1u); break; } } } } while (0)
struct XcdBarrier { unsigned* bar; unsigned x; volatile LAS unsigned* st; };
__device__ __forceinline__ XcdBarrier xcd_barrier_post(unsigned* bar, volatile LAS unsigned* st) {
    XcdBarrier b; b.bar = bar; b.x = xb_xcc_id(); b.st = st;
    if (threadIdx.x == 0) (void)xb_add(&bar[XB_XCNT(b.x)], 1u);
    return b;
}
__device__ __forceinline__ void xcd_barrier_complete(unsigned* bar, unsigned x, unsigned& nloc, unsigned& nx) {
    const unsigned G = gridDim.x * gridDim.y * gridDim.z;
    unsigned sum, cnt, mine, sp = 0u;
    for (;;) {
        sum = 0u; cnt = 0u; mine = 0u;
#pragma unroll
        for (unsigned j = 0; j < 16; ++j) { const unsigned c = xb_ld(&bar[XB_XCNT(j)]); sum += c; cnt += (c > 0u) ? 1u : 0u; mine = (j == x) ? c : mine; }
        if (sum == G) break;
        __builtin_amdgcn_s_sleep(1);
        if ((++sp & 255u) == 0u) { if (xb_ld(&bar[XB_TMO])) break; if (sp > XB_SPIN_CAP) { atomicAdd(&bar[XB_TMO], 1u); break; } }
    }
    nloc = mine > 0u ? mine : 1u; nx = cnt > 0u ? cnt : 1u;
}
__device__ __forceinline__ void xcd_barrier(const XcdBarrier& b) {
    asm volatile("s_waitcnt vmcnt(0)" ::: "memory");
    __syncthreads();
    if (threadIdx.x == 0) {
        unsigned* bar = b.bar;
        __builtin_amdgcn_s_waitcnt(0);
        unsigned nloc = b.st[0], nx = b.st[1];
        if (nloc == 0u) { xcd_barrier_complete(bar, b.x, nloc, nx); b.st[0] = nloc; b.st[1] = nx; }
        const unsigned old = xb_add(&bar[XB_XSUB(b.x)], 1u);
        const unsigned gen = old / nloc;
        if (old + 1u == (gen + 1u) * nloc) {
            __builtin_amdgcn_fence(__ATOMIC_RELEASE, "agent");
            asm volatile("s_waitcnt vmcnt(0)" ::: "memory");
            const unsigned og = xb_add(&bar[XB_TOP], 1u);
            const unsigned tg = og / nx;
            if (og + 1u == (tg + 1u) * nx) xb_add(&bar[XB_TOPGEN], 1u);
            else XB_SPIN(xb_ld(&bar[XB_TOPGEN]) == tg, bar);
            __builtin_amdgcn_fence(__ATOMIC_ACQUIRE, "agent");
            xb_add(&bar[XB_XGEN(b.x)], 1u);
            asm volatile("s_waitcnt vmcnt(0)" ::: "memory");
        } else {
            XB_SPIN(xb_ld(&bar[XB_XGEN(b.x)]) == gen, bar);
            __builtin_amdgcn_fence(__ATOMIC_ACQUIRE, "agent");
            asm volatile("s_waitcnt vmcnt(0)" ::: "memory");
        }
    }
    __syncthreads();
}

struct Frame {
    LAS unsigned char* lds; volatile LAS unsigned* MISC; LAS unsigned* LCTL;
    gu32* ctl; unsigned char* ws; GAS float* out; int tid, lane, wave, vcu, G;
};
constexpr int PTR_OFF = LDSCTL_OFF + 96;
__device__ __forceinline__ const GAS float* INP(const Frame& F, int i) {
    const LAS unsigned* t = (const LAS unsigned*)(F.lds + PTR_OFF) + 2 * i;
    const unsigned lo = __builtin_amdgcn_readfirstlane(t[0]), hi = __builtin_amdgcn_readfirstlane(t[1]);
    return (const GAS float*)(((unsigned long long)hi << 32) | lo);
}
__device__ __forceinline__ float shx(float v, int m, int lane) { return __builtin_bit_cast(float, __builtin_amdgcn_ds_bpermute((lane ^ m) << 2, __builtin_bit_cast(int, v))); }
__device__ __forceinline__ float wave_sum(float v, int lane) {
#pragma unroll
    for (int o = 1; o < 64; o <<= 1) v += shx(v, o, lane);
    return v;
}
__device__ __forceinline__ const GAS float* xrow_in(const Frame& F, int row) { const int b = row / RPB, t = row % RPB; return t < SEQ ? INP(F, 0) + ((size_t)b * SEQ + t) * DM : INP(F, 2) + ((size_t)b * CTXL + (t - SEQ)) * DM; }
__device__ __forceinline__ GAS float* xrow_ws(const Frame& F, int row) { const int b = row / RPB, t = row % RPB; return t < SEQ ? F.out + ((size_t)b * SEQ + t) * DM : ((GAS float*)(F.ws + WS_XC)) + ((size_t)b * CTXL + (t - SEQ)) * DM; }
__device__ __forceinline__ int modidx(int row) { const int b = row / RPB, t = row % RPB; return t < SEQ ? b : 4; }

__device__ __forceinline__ void tr_item(const GAS float* W, int ldw, int k0, int n0, GAS bf16* WT, int ldt, int drow0, int dcol0, LAS float* scr, int lane) {
    f32x4 t[8];
#pragma unroll
    for (int i = 0; i < 8; ++i) t[i] = *(const GAS f32x4*)(W + (size_t)(k0 + 8 * i + (lane >> 3)) * ldw + n0 + 4 * (lane & 7));
#pragma unroll
    for (int i = 0; i < 8; ++i) { LAS float* d = scr + (8 * i + (lane >> 3)) * 33 + 4 * (lane & 7); d[0] = t[i].x; d[1] = t[i].y; d[2] = t[i].z; d[3] = t[i].w; }
    LDS_WAIT(); asm volatile("" ::: "memory");
    const int c = lane & 7;
#pragma unroll
    for (int j = 0; j < 4; ++j) { const int n = (lane >> 3) + 8 * j; const LAS float* s = scr + (8 * c) * 33 + n;
        v4u o; o.x = pk2(s[0 * 33], s[1 * 33]); o.y = pk2(s[2 * 33], s[3 * 33]); o.z = pk2(s[4 * 33], s[5 * 33]); o.w = pk2(s[6 * 33], s[7 * 33]);
        *(GAS v4u*)(WT + (size_t)(drow0 + n) * ldt + dcol0 + 8 * c) = o; }
    LDS_WAIT(); asm volatile("" ::: "memory");
}
__device__ __forceinline__ void convert_weights(Frame& F, int l) {
    LAS float* scr = (LAS float*)(F.lds + RING_OFF + F.wave * 16384);
    const int gw = F.vcu * NWAVES + F.wave, NGW = F.G * NWAVES;
    constexpr int I_IN = 16 * (INW / 32), I_BR = 4 * 8 * 32, I_O = 16 * 32, I_GU = 16 * 16 * 32, I_D = 16 * 8 * 32;
    constexpr int NITEMS = I_IN + I_BR + I_O + I_GU + I_D;
    for (int it = gw; it < NITEMS; it += NGW) {
        int r = it;
        if (r < I_IN) { const int nblk = INW / 32, kb = r / nblk, nb = r % nblk, n0 = 32 * nb;
            if (n0 >= 2304 && n0 < 2816) continue;
            const int drow = n0 < 2304 ? n0 : n0 + 512;
            tr_item(INP(F, 8) + (size_t)l * DM * INW, INW, 64 * kb, n0, ((GAS bf16*)(F.ws + WS_WIN)), DM, drow, 64 * kb, scr, F.lane); continue; } r -= I_IN;
        if (r < I_BR) { const int nbr = r / 256, q = r % 256, kb = q / 32, nb = q % 32;
            tr_item(INP(F, 15) + ((size_t)l * 4 + nbr) * 512 * DM, DM, 64 * kb, 32 * nb, ((GAS bf16*)(F.ws + WS_WB)), 2048, 32 * nb, nbr * 512 + 64 * kb, scr, F.lane); continue; } r -= I_BR;
        if (r < I_O) { const int kb = r / 32, nb = r % 32;
            tr_item(INP(F, 16) + (size_t)l * DM * DM, DM, 64 * kb, 32 * nb, ((GAS bf16*)(F.ws + WS_WO)), DM, 32 * nb, 64 * kb, scr, F.lane); continue; } r -= I_O;
        if (r < I_GU) { const int e = r / 512, q = r % 512, kb = q / 32, nb = q % 32, n0 = 32 * nb;
            const int drow = n0 < 512 ? (n0 / 128) * 256 + (n0 % 128) : ((n0 - 512) / 128) * 256 + 128 + ((n0 - 512) % 128);
            tr_item(INP(F, 19) + ((size_t)l * NEXP + e) * DM * DM, DM, 64 * kb, n0, ((GAS bf16*)(F.ws + WS_WGU)) + (size_t)e * DM * DM, DM, drow, 64 * kb, scr, F.lane); continue; } r -= I_GU;
        { const int e = r / 256, q = r % 256, kb = q / 32, nb = q % 32;
            tr_item(INP(F, 20) + ((size_t)l * NEXP + e) * EFF * DM, DM, 64 * kb, 32 * nb, ((GAS bf16*)(F.ws + WS_WD)) + (size_t)e * DM * EFF, EFF, 32 * nb, 64 * kb, scr, F.lane); }
    }
    __syncthreads();
    LAS float* wt = (LAS float*)(F.lds + RING_OFF);
    LAS float* tab = (LAS float*)(F.lds + RING_OFF + 32768);
    if (F.tid < 128) { float s, c; sincospif((float)F.tid * (1.0f / 64.0f), &s, &c); tab[2 * F.tid] = c; tab[2 * F.tid + 1] = s; }
    for (int u = F.vcu; u < 64; u += F.G) {
        const int kt = u >> 2, g = u & 3;
        __syncthreads();
#pragma unroll
        for (int i = 0; i < 16; ++i) { const int idx = i * 512 + F.tid, kk = idx >> 7, c = idx & 127; wt[idx] = INP(F, 8)[(size_t)l * DM * INW + (size_t)(kt * 64 + kk) * INW + 2304 + g * 128 + c]; }
        __syncthreads();
        const int kc = F.tid & 127, kq = F.tid >> 7;
        float aA[16], aB[16];
#pragma unroll
        for (int i = 0; i < 16; ++i) { aA[i] = 0.f; aB[i] = 0.f; }
        for (int c = 0; c < 128; ++c) { const int ti = (c * kc) & 127; const float cs = tab[2 * ti], sn = tab[2 * ti + 1];
#pragma unroll
            for (int i = 0; i < 16; ++i) { const float w = wt[(kq * 16 + i) * 128 + c]; aA[i] += w * cs; aB[i] += w * sn; } }
        GAS bf16* ra = ((GAS bf16*)(F.ws + WS_WIN)) + (size_t)(2304 + g * 128 + kc) * DM + kt * 64 + kq * 16; GAS bf16* rb = ra + (size_t)512 * DM;
        v4u o; o.x = pk2(aA[0], aA[1]); o.y = pk2(aA[2], aA[3]); o.z = pk2(aA[4], aA[5]); o.w = pk2(aA[6], aA[7]); *(GAS v4u*)ra = o;
        o.x = pk2(aA[8], aA[9]); o.y = pk2(aA[10], aA[11]); o.z = pk2(aA[12], aA[13]); o.w = pk2(aA[14], aA[15]); *(GAS v4u*)(ra + 8) = o;
        o.x = pk2(aB[0], aB[1]); o.y = pk2(aB[2], aB[3]); o.z = pk2(aB[4], aB[5]); o.w = pk2(aB[6], aB[7]); *(GAS v4u*)rb = o;
        o.x = pk2(aB[8], aB[9]); o.y = pk2(aB[10], aB[11]); o.z = pk2(aB[12], aB[13]); o.w = pk2(aB[14], aB[15]); *(GAS v4u*)(rb + 8) = o;
    }
    __syncthreads();
}
__device__ __forceinline__ void mod_vectors(Frame& F) {
    LAS float* sc = (LAS float*)(F.lds + RING_OFF);
    LAS float* part = (LAS float*)(F.lds + RING_OFF + 32768);
    for (int i = F.tid; i < 5 * DM; i += NTHR) { const float v = i < 4 * DM ? INP(F, 1)[i] : INP(F, 3)[i - 4 * DM]; sc[i] = v * sigm(v); }
    __syncthreads();
    for (int u = F.vcu; u < 2 * 96; u += F.G) {
        const int l = u / 96, j = (u % 96) * 64 + F.lane;
        const GAS float* wp = INP(F, 4) + (size_t)l * DM * 6144 + (size_t)(F.wave * 128) * 6144 + j;
        float a0 = 0.f, a1 = 0.f, a2 = 0.f, a3 = 0.f, a4 = 0.f;
#pragma unroll 8
        for (int kk = 0; kk < 128; ++kk) { const float w = wp[(size_t)kk * 6144]; const int k = F.wave * 128 + kk;
            a0 += sc[k] * w; a1 += sc[DM + k] * w; a2 += sc[2 * DM + k] * w; a3 += sc[3 * DM + k] * w; a4 += sc[4 * DM + k] * w; }
        part[(F.wave * 5 + 0) * 64 + F.lane] = a0; part[(F.wave * 5 + 1) * 64 + F.lane] = a1; part[(F.wave * 5 + 2) * 64 + F.lane] = a2; part[(F.wave * 5 + 3) * 64 + F.lane] = a3; part[(F.wave * 5 + 4) * 64 + F.lane] = a4;
        __syncthreads();
        if (F.tid < 320) { const int bp = F.tid >> 6, ln = F.tid & 63; float s = 0.f;
#pragma unroll
            for (int w = 0; w < 8; ++w) s += part[(w * 5 + bp) * 64 + ln];
            const int jj = (u % 96) * 64 + ln; ((GAS float*)(F.ws + WS_MODV))[((size_t)l * 5 + bp) * 6144 + jj] = s + INP(F, 5)[(size_t)l * 6144 + jj]; }
        __syncthreads();
    }
}
__device__ __forceinline__ void norm_mod(f32x4 (&v)[4], const GAS float* g, const GAS float* sc, const GAS float* sh, int lane) {
    float ss = 0.f;
#pragma unroll
    for (int j = 0; j < 4; ++j) ss += (v[j].x * v[j].x + v[j].y * v[j].y) + (v[j].z * v[j].z + v[j].w * v[j].w);
    const float rstd = 1.0f / sqrtf(wave_sum(ss, lane) * (1.0f / DM) + EPS);
#pragma unroll
    for (int j = 0; j < 4; ++j) { const int c = 4 * lane + 256 * j; const f32x4 gg = *(const f32x4*)(g + c), s1 = *(const f32x4*)(sc + c), s0 = *(const f32x4*)(sh + c);
        v[j] = v[j] * rstd * gg * (s1 + 1.0f) + s0; }
}
__device__ __forceinline__ void store_bf16_row(GAS bf16* orow, const f32x4 (&v)[4], int lane) {
#pragma unroll
    for (int j = 0; j < 4; ++j) { v2u w; w.x = pk2(v[j].x, v[j].y); w.y = pk2(v[j].z, v[j].w); *(GAS v2u*)(orow + 4 * lane + 256 * j) = w; }
}
__device__ __forceinline__ void load_row(f32x4 (&v)[4], const GAS float* xr, int lane) {
#pragma unroll
    for (int j = 0; j < 4; ++j) v[j] = *(const GAS f32x4*)(xr + 4 * lane + 256 * j);
}
__device__ __forceinline__ void phase_norm1_first(Frame& F) {
    const int gw = F.vcu * NWAVES + F.wave, NGW = F.G * NWAVES; const GAS float* mv = ((GAS float*)(F.ws + WS_MODV)); const GAS float* g1 = INP(F, 6);
    for (int row = gw; row < MROWS; row += 2 * NGW) { const int row2 = row + NGW; const bool has2 = row2 < MROWS;
        f32x4 v[4], v2[4]; load_row(v, xrow_in(F, row), F.lane); if (has2) load_row(v2, xrow_in(F, row2), F.lane);
        { const GAS float* m = mv + (size_t)modidx(row) * 6144; norm_mod(v, g1, m + 1024, m, F.lane); store_bf16_row(((GAS bf16*)(F.ws + WS_H)) + (size_t)row * DM, v, F.lane); }
        if (has2) { const GAS float* m = mv + (size_t)modidx(row2) * 6144; norm_mod(v2, g1, m + 1024, m, F.lane); store_bf16_row(((GAS bf16*)(F.ws + WS_H)) + (size_t)row2 * DM, v2, F.lane); } }
}
__device__ __forceinline__ void phase_qkrope(Frame& F, int l) {
    const int gw = F.vcu * NWAVES + F.wave, NGW = F.G * NWAVES; const int lane = F.lane, i = lane & 31;
    const float invf = exp2f(-(float)(i & 15) * (13.287712379549449f / 16.0f));
    for (int row = gw; row < MROWS; row += NGW) {
        const int t = row % RPB; const bool lat = t < SEQ; GAS bf16* pr = ((GAS bf16*)(F.ws + WS_P)) + (size_t)row * PW;
        float cs = 1.f, sn = 0.f;
        if (lat) { const float pos = (float)((i < 16) ? (t >> 6) : (t & 63)); sincosf(pos * invf, &sn, &cs); }
#pragma unroll
        for (int it = 0; it < 5; ++it) { const int hh = 2 * it + (lane >> 5); const int col = (hh < 8 ? hh * 64 : C_GK + (hh - 8) * 64) + 2 * i;
            const unsigned w = *(const GAS unsigned*)(pr + col); float x1 = bf_lo(w), x2 = bf_hi(w);
            float ss = x1 * x1 + x2 * x2;
            ss += shx(ss, 1, lane); ss += shx(ss, 2, lane); ss += shx(ss, 4, lane); ss += shx(ss, 8, lane); ss += shx(ss, 16, lane);
            const float rstd = 1.0f / sqrtf(ss * (1.0f / 64.0f) + EPS); const GAS float* gp = (hh < 8 ? INP(F, 9) : INP(F, 10)) + l * 64 + 2 * i;
            x1 = x1 * rstd * gp[0]; x2 = x2 * rstd * gp[1];
            float y1 = x1 * cs - x2 * sn, y2 = x1 * sn + x2 * cs;
            if (hh < 8) { y1 *= QSCALE; y2 *= QSCALE; }
            *(GAS unsigned*)(pr + col) = pk2(y1, y2); }
        { const v4u w = *(const GAS v4u*)(pr + C_NQ + 8 * lane); v4u o;
          o.x = pk2(bf_lo(w.x) * QSCALE, bf_hi(w.x) * QSCALE); o.y = pk2(bf_lo(w.y) * QSCALE, bf_hi(w.y) * QSCALE); o.z = pk2(bf_lo(w.z) * QSCALE, bf_hi(w.z) * QSCALE); o.w = pk2(bf_lo(w.w) * QSCALE, bf_hi(w.w) * QSCALE);
          *(GAS v4u*)(pr + C_NQ + 8 * lane) = o; }
    }
}
__device__ __forceinline__ void phase_conv(Frame& F, int l) {
    LAS float* zl = (LAS float*)(F.lds + RING_OFF);
    LAS float* red = (LAS float*)(F.lds + RING_OFF + 62 * 512 * 4);
    const int ch = F.tid; const int nchunk = (l == 0) ? 136 : 128;
    float w[31];
#pragma unroll
    for (int j = 0; j < 31; ++j) w[j] = INP(F, 12)[((size_t)l * 31 + j) * 512 + ch];
    const float cb = INP(F, 13)[l * 512 + ch], cg = INP(F, 14)[l * 512 + ch];
    const GAS bf16* P = ((GAS bf16*)(F.ws + WS_P)); GAS bf16* Y = ((GAS bf16*)(F.ws + WS_Y));
    for (int u = F.vcu; u < NBATCH * nchunk; u += F.G) {
        const int b = u / nchunk, c = u % nchunk; const bool lat = c < 128;
        const int seq0 = b * RPB + (lat ? 0 : SEQ), slen = lat ? SEQ : CTXL, t0 = 32 * (lat ? c : c - 128);
        __syncthreads();
#pragma unroll
        for (int it = 0; it < 8; ++it) { const int item = it * 512 + F.tid;
            if (item < 62 * 64) { const int i = item >> 6, cgp = item & 63; const int t = t0 - 15 + i; f32x4 z0 = {0.f, 0.f, 0.f, 0.f}, z1 = {0.f, 0.f, 0.f, 0.f};
                if (t >= 0 && t < slen) { const GAS bf16* pr = P + (size_t)(seq0 + t) * PW; const v4u a = *(const GAS v4u*)(pr + C_CA + 8 * cgp), g = *(const GAS v4u*)(pr + C_CB + 8 * cgp);
                    z0.x = bf_lo(a.x) * sigm(bf_lo(g.x)); z0.y = bf_hi(a.x) * sigm(bf_hi(g.x)); z0.z = bf_lo(a.y) * sigm(bf_lo(g.y)); z0.w = bf_hi(a.y) * sigm(bf_hi(g.y));
                    z1.x = bf_lo(a.z) * sigm(bf_lo(g.z)); z1.y = bf_hi(a.z) * sigm(bf_hi(g.z)); z1.z = bf_lo(a.w) * sigm(bf_lo(g.w)); z1.w = bf_hi(a.w) * sigm(bf_hi(g.w)); }
                *(LAS f32x4*)(zl + i * 512 + 8 * cgp) = z0; *(LAS f32x4*)(zl + i * 512 + 8 * cgp + 4) = z1; } }
        __syncthreads();
        float z[62];
#pragma unroll
        for (int i = 0; i < 62; ++i) z[i] = zl[i * 512 + ch];
        float o[32];
#pragma unroll
        for (int q = 0; q < 32; ++q) { float s = cb;
#pragma unroll
            for (int j = 0; j < 31; ++j) s += z[q + j] * w[j];
            o[q] = s; }
#pragma unroll
        for (int q = 0; q < 32; ++q) { const float s = wave_sum(o[q] * o[q], F.lane); if (F.lane == 0) red[F.wave * 32 + q] = s; }
        __syncthreads();
#pragma unroll
        for (int q = 0; q < 32; ++q) { float s = 0.f;
#pragma unroll
            for (int wv = 0; wv < 8; ++wv) s += red[wv * 32 + q];
            const float y = o[q] * (1.0f / sqrtf(s * (1.0f / 512.0f) + EPS)) * cg;
            Y[(size_t)(seq0 + t0 + q) * YW + 1536 + ch] = (bf16)f2bf(y * sigm(y)); }
    }
    __syncthreads();
}
typedef short fbf16x8 __attribute__((ext_vector_type(8)));
typedef short fs16x4 __attribute__((ext_vector_type(4)));
typedef float ff32x16 __attribute__((ext_vector_type(16)));
typedef __attribute__((address_space(3))) const char* flds_cptr;
__device__ __forceinline__ fs16x4 f_vtr(flds_cptr p) { return __builtin_bit_cast(fs16x4, __builtin_amdgcn_ds_read_tr16_b64_v4i16((__attribute__((address_space(3))) attn_body::v4i16_t*)p)); }
__device__ __forceinline__ void fourier_frags(Frame& F, fbf16x8 (&fr)[4][4]) {
    LAS float* tab = (LAS float*)(F.lds + RING_OFF);
    __syncthreads();
    if (F.tid < 64) { float s, c; sincospif((float)F.tid * (1.0f / 32.0f), &s, &c); tab[2 * F.tid] = c; tab[2 * F.tid + 1] = s; }
    __syncthreads();
    const int m = F.lane & 31, hi = F.lane >> 5;
#pragma unroll
    for (int mt = 0; mt < 4; ++mt)
#pragma unroll
        for (int g = 0; g < 4; ++g) { unsigned wv[4];
#pragma unroll
            for (int jp = 0; jp < 4; ++jp) { float v[2];
#pragma unroll
                for (int q = 0; q < 2; ++q) { const int j = 2 * jp + q; const int n = 16 * g + (j & 3) + 8 * (j >> 2) + 4 * hi; const int k = 32 * (mt & 1) + m; const int ix = (k * n) & 63; v[q] = tab[2 * ix + (mt >> 1)]; }
                wv[jp] = pk2(v[0], v[1]); }
            v4u t; t.x = wv[0]; t.y = wv[1]; t.z = wv[2]; t.w = wv[3]; fr[mt][g] = __builtin_bit_cast(fbf16x8, t); __builtin_amdgcn_sched_barrier(0); }
    __syncthreads();
}
#define F_BFRAG(dst, vp, dh) do { _Pragma("unroll") for (int g_ = 0; g_ < 4; ++g_) { const fs16x4 lo_ = f_vtr((vp) + (dh) * 4096 + g_ * 1024), hi_ = f_vtr((vp) + (dh) * 4096 + g_ * 1024 + 512); \
        dst[g_] = (fbf16x8){lo_[0], lo_[1], lo_[2], lo_[3], hi_[0], hi_[1], hi_[2], hi_[3]}; } } while (0)
__device__ __forceinline__ void glds16_so(const GAS void* sbase, unsigned voff, unsigned lds_dst) { unsigned keep;
    asm volatile("s_mov_b32 %0, m0\n\ts_mov_b32 m0, %3\n\ts_nop 0\n\tglobal_load_lds_dwordx4 %1, %2\n\ts_mov_b32 m0, %0" : "=&s"(keep) : "v"(voff), "s"(sbase), "s"(lds_dst) : "memory"); }
__device__ __forceinline__ fbf16x8 f_neg(fbf16x8 v) { v4u t = __builtin_bit_cast(v4u, v); t.x ^= 0x80008000u; t.y ^= 0x80008000u; t.z ^= 0x80008000u; t.w ^= 0x80008000u; return __builtin_bit_cast(fbf16x8, t); }
__device__ __forceinline__ void phase_fourier1(Frame& F) {
    fbf16x8 fr[4][4]; fourier_frags(F, fr);
    const int lane = F.lane, w = F.wave, r32 = lane & 31, hi = lane >> 5;
    const unsigned lds0 = (unsigned)(uintptr_t)(F.lds + RING_OFF);
    const flds_cptr vbase = (flds_cptr)(F.lds + RING_OFF) + ((lane >> 4) & 1) * 32 + (lane & 3) * 8 + (4 * hi + ((lane & 15) >> 2)) * 64;
    const GAS bf16* P = ((GAS bf16*)(F.ws + WS_P)); GAS bf16* TPb = (GAS bf16*)(F.ws + WS_TP);
    const unsigned voff0 = (unsigned)((64 * (lane >> 2)) * PW + (lane & 3) * 8) * 2u;
    for (int u = F.vcu; u < NBATCH * 64; u += F.G) {
        const int b = u >> 6, n2 = u & 63;
        const GAS bf16* base = P + (size_t)(b * RPB + n2) * PW + C_F + 64 * w;
        asm volatile("s_waitcnt lgkmcnt(0)" ::: "memory");
#pragma unroll
        for (int rg = 0; rg < 4; ++rg) { const unsigned vo = voff0 + (unsigned)rg * (unsigned)(64 * 16 * PW * 2);
            const unsigned dA = (unsigned)__builtin_amdgcn_readfirstlane(lds0 + w * 8192 + rg * 1024), dB = dA + 8 * 8192;
            glds16_so(base, vo, dA); glds16_so(base + 32, vo, dA + 4096); glds16_so(base + 512, vo, dB); glds16_so(base + 544, vo, dB + 4096); }
        asm volatile("s_waitcnt vmcnt(0)" ::: "memory");
#pragma unroll 1
        for (int dh = 0; dh < 2; ++dh) {
            fbf16x8 bA[4], nA[4], nB[4];
            F_BFRAG(bA, vbase + w * 8192, dh); F_BFRAG(nB, vbase + (8 + w) * 8192, dh);
#pragma unroll
            for (int g = 0; g < 4; ++g) { nA[g] = f_neg(bA[g]); nB[g] = f_neg(nB[g]); }
#pragma unroll
            for (int kb = 0; kb < 2; ++kb) {
                ff32x16 tr = {}, ti = {};
#pragma unroll
                for (int g = 0; g < 4; ++g) { tr = __builtin_amdgcn_mfma_f32_32x32x16_bf16(fr[kb][g], bA[g], tr, 0, 0, 0); ti = __builtin_amdgcn_mfma_f32_32x32x16_bf16(fr[kb][g], nB[g], ti, 0, 0, 0);
                    tr = __builtin_amdgcn_mfma_f32_32x32x16_bf16(fr[2 + kb][g], nB[g], tr, 0, 0, 0); ti = __builtin_amdgcn_mfma_f32_32x32x16_bf16(fr[2 + kb][g], nA[g], ti, 0, 0, 0); }
                const unsigned o0 = (unsigned)(((b * 64 + 32 * kb + 4 * hi) * 2) * 64 + n2) * 512u + 64 * w + 32 * dh + r32;
#pragma unroll
                for (int r = 0; r < 16; ++r) { const int kk = (r & 3) + 8 * (r >> 2); const int k1 = 32 * kb + kk + 4 * hi;
                    const float rev = (float)(n2 * k1) * (1.0f / 4096.0f); const float c = __builtin_amdgcn_cosf(rev), s = __builtin_amdgcn_sinf(rev);
                    const unsigned oi = o0 + (unsigned)kk * (2u * 64u * 512u);
                    TPb[oi] = (bf16)f2bf(tr[r] * c + ti[r] * s); TPb[oi + 64u * 512u] = (bf16)f2bf(ti[r] * c - tr[r] * s);
                    if ((r & 3) == 3) __builtin_amdgcn_sched_barrier(0); }
                __builtin_amdgcn_sched_barrier(0);
            }
        }
    }
}
__device__ __forceinline__ void phase_fourier2(Frame& F) {
    fbf16x8 fr[4][4]; fourier_frags(F, fr);
    const int lane = F.lane, w = F.wave, r32 = lane & 31, hi = lane >> 5;
    const unsigned lds0 = (unsigned)(uintptr_t)(F.lds + RING_OFF);
    const flds_cptr vbase = (flds_cptr)(F.lds + RING_OFF) + ((lane >> 4) & 1) * 32 + (lane & 3) * 8 + (4 * hi + ((lane & 15) >> 2)) * 64;
    const GAS bf16* TPb = (const GAS bf16*)(F.ws + WS_TP); GAS bf16* Y = ((GAS bf16*)(F.ws + WS_Y));
    const float scale = 1.0f / sqrtf(4096.0f * 128.0f);
    const unsigned voff0 = (unsigned)((lane >> 2) * 512 + (lane & 3) * 8) * 2u;
    for (int u = F.vcu; u < NBATCH * 64; u += F.G) {
        const int b = u >> 6, k1 = u & 63;
        const GAS bf16* base0 = TPb + (size_t)((b * 64 + k1) * 2) * 64 * 512 + 64 * w; const GAS bf16* base1 = base0 + 64 * 512;
        asm volatile("s_waitcnt lgkmcnt(0)" ::: "memory");
#pragma unroll
        for (int rg = 0; rg < 4; ++rg) { const unsigned vo = voff0 + (unsigned)rg * (unsigned)(16 * 512 * 2);
            const unsigned d0 = (unsigned)__builtin_amdgcn_readfirstlane(lds0 + w * 8192 + rg * 1024), d1 = d0 + 8 * 8192;
            glds16_so(base0, vo, d0); glds16_so(base0 + 32, vo, d0 + 4096); glds16_so(base1, vo, d1); glds16_so(base1 + 32, vo, d1 + 4096); }
        asm volatile("s_waitcnt vmcnt(0)" ::: "memory");
#pragma unroll
        for (int dh = 0; dh < 2; ++dh) {
            fbf16x8 b0[4], b1[4];
            F_BFRAG(b0, vbase + w * 8192, dh); F_BFRAG(b1, vbase + (8 + w) * 8192, dh);
#pragma unroll
            for (int mt = 0; mt < 2; ++mt) {
                ff32x16 acc = {};
#pragma unroll
                for (int g = 0; g < 4; ++g) { acc = __builtin_amdgcn_mfma_f32_32x32x16_bf16(fr[mt][g], b0[g], acc, 0, 0, 0); acc = __builtin_amdgcn_mfma_f32_32x32x16_bf16(fr[2 + mt][g], b1[g], acc, 0, 0, 0); }
                const unsigned y0 = (unsigned)(b * RPB + k1 + 64 * (32 * mt + 4 * hi)) * (unsigned)YW + 1024u + 64 * w + 32 * dh + r32;
#pragma unroll
                for (int r = 0; r < 16; ++r) { const int kk = (r & 3) + 8 * (r >> 2);
                    Y[y0 + (unsigned)kk * (64u * (unsigned)YW)] = (bf16)f2bf(acc[r] * scale); }
                __builtin_amdgcn_sched_barrier(0);
            }
        }
    }
}
typedef float fc_f32x2 __attribute__((ext_vector_type(2)));
__device__ __forceinline__ void phase_fourier_ctx(Frame& F) {
    LAS float* tab = (LAS float*)(F.lds + RING_OFF + 8192);
    __syncthreads();
    if (F.tid < 256) { float s, c; sincospif((float)F.tid * (1.0f / 128.0f), &s, &c); tab[2 * F.tid] = c; tab[2 * F.tid + 1] = s; }
    __syncthreads();
    const float scale = 1.0f / sqrtf(256.0f * 128.0f);
#define FC_LOAD(A_, B_, n0_) do { _Pragma("unroll") for (int i_ = 0; i_ < 16; ++i_) { A_[i_] = pcol[(size_t)((n0_) + i_) * PW]; B_[i_] = pcol[(size_t)((n0_) + i_) * PW + 512]; } } while (0)
#define FC_COMP(A_, B_, n0_) do { _Pragma("unroll") for (int i_ = 0; i_ < 16; ++i_) { const float a_ = bf1(A_[i_]), b_ = bf1(B_[i_]); _Pragma("unroll") for (int k_ = 0; k_ < 4; ++k_) { \
        const int ix_ = (((n0_) + i_) * (kb + k_)) & 255; const fc_f32x2 cs_ = *(const LAS fc_f32x2*)(tab + 2 * ix_); acc[k_] += a_ * cs_.x - b_ * cs_.y; } } } while (0)
    for (int u = F.vcu; u < NBATCH * 64; u += F.G) {
        const int b = u >> 6, kb = (u & 63) * 4;
        float acc[4] = {0.f, 0.f, 0.f, 0.f};
        const GAS bf16* pcol = ((GAS bf16*)(F.ws + WS_P)) + (size_t)(b * RPB + SEQ) * PW + C_F + F.tid;
        bf16 A0[16], B0[16], A1[16], B1[16];
        FC_LOAD(A0, B0, 0);
        for (int n0 = 0; n0 < 256; n0 += 32) {
            FC_LOAD(A1, B1, n0 + 16);
            FC_COMP(A0, B0, n0);
            if (n0 + 32 < 256) FC_LOAD(A0, B0, n0 + 32);
            FC_COMP(A1, B1, n0 + 16);
        }
        GAS bf16* yo = ((GAS bf16*)(F.ws + WS_Y)) + (size_t)(b * RPB + SEQ + kb) * YW + 1024 + F.tid;
#pragma unroll
        for (int k = 0; k < 4; ++k) yo[(size_t)k * YW] = (bf16)f2bf(acc[k] * scale);
    }
#undef FC_LOAD
#undef FC_COMP
}
#ifndef PROBE
#define PROBE 0
#endif
#define GSTAMP(i) do { if (PROBE && l == 0 && blockIdx.x == 0 && threadIdx.x == 0) ((GAS unsigned long long*)(F.ws + WS_CTL + 512 * 1024))[i] = __builtin_amdgcn_s_memrealtime(); } while (0)
struct GVecs { int cmi; f32x4 G1[4], GS[4], SH[4]; };
struct GRow { f32x4 v[4]; v2u y[4]; };
__device__ __forceinline__ void g_load(Frame& F, int l, int row, GRow& R) {
    load_row(R.v, (l == 0) ? xrow_in(F, row) : (const GAS float*)xrow_ws(F, row), F.lane);
#pragma unroll
    for (int j = 0; j < 4; ++j) R.y[j] = *(const GAS v2u*)(((const GAS bf16*)(F.ws + WS_Y)) + (size_t)row * DM + 4 * F.lane + 256 * j);
}
__device__ __forceinline__ void g_front(Frame& F, int l, int row, GRow& R, GVecs& V) {
    const int mi = modidx(row);
    if (mi != V.cmi) { V.cmi = mi; const GAS float* m = ((GAS float*)(F.ws + WS_MODV)) + (size_t)l * 5 * 6144 + (size_t)mi * 6144; const GAS float* g2 = INP(F, 7) + l * DM;
#pragma unroll
        for (int j = 0; j < 4; ++j) { const int c = 4 * F.lane + 256 * j; V.G1[j] = *(const GAS f32x4*)(m + 2 * 1024 + c); V.SH[j] = *(const GAS f32x4*)(m + 3 * 1024 + c);
            V.GS[j] = *(const GAS f32x4*)(g2 + c) * (*(const GAS f32x4*)(m + 4 * 1024 + c) + 1.0f); } }
    float ss = 0.f;
#pragma unroll
    for (int j = 0; j < 4; ++j) { f32x4 y; y.x = bf_lo(R.y[j].x); y.y = bf_hi(R.y[j].x); y.z = bf_lo(R.y[j].y); y.w = bf_hi(R.y[j].y); R.v[j] = R.v[j] + V.G1[j] * y;
        ss += (R.v[j].x * R.v[j].x + R.v[j].y * R.v[j].y) + (R.v[j].z * R.v[j].z + R.v[j].w * R.v[j].w); }
    { GAS float* xo = xrow_ws(F, row);
#pragma unroll
      for (int j = 0; j < 4; ++j) *(GAS f32x4*)(xo + 4 * F.lane + 256 * j) = R.v[j]; }
    const float rstd = 1.0f / sqrtf(wave_sum(ss, F.lane) * (1.0f / DM) + EPS);
#pragma unroll
    for (int j = 0; j < 4; ++j) R.v[j] = R.v[j] * rstd * V.GS[j] + V.SH[j];
    store_bf16_row(((GAS bf16*)(F.ws + WS_H)) + (size_t)row * DM, R.v, F.lane);
}
__device__ __forceinline__ float g_reduce16(const float (&lg)[16], int lane) {
    float r8[8], r4[4], r2[2], r1;
    { const bool up = (lane & 32) != 0;
#pragma unroll
      for (int q = 0; q < 8; ++q) { const float snd = up ? lg[q] : lg[8 + q], kp = up ? lg[8 + q] : lg[q]; r8[q] = kp + shx(snd, 32, lane); } }
    { const bool up = (lane & 16) != 0;
#pragma unroll
      for (int q = 0; q < 4; ++q) { const float snd = up ? r8[q] : r8[4 + q], kp = up ? r8[4 + q] : r8[q]; r4[q] = kp + shx(snd, 16, lane); } }
    { const bool up = (lane & 8) != 0;
#pragma unroll
      for (int q = 0; q < 2; ++q) { const float snd = up ? r4[q] : r4[2 + q], kp = up ? r4[2 + q] : r4[q]; r2[q] = kp + shx(snd, 8, lane); } }
    { const bool up = (lane & 4) != 0; const float snd = up ? r2[0] : r2[1], kp = up ? r2[1] : r2[0]; r1 = kp + shx(snd, 4, lane); }
    r1 += shx(r1, 1, lane); r1 += shx(r1, 2, lane);
    return r1;
}
__device__ __forceinline__ void g_select(Frame& F, float r1, const float (&rb)[16], int row, LAS int* selp) {
    float sc[16], sl[16];
#pragma unroll
    for (int e = 0; e < 16; ++e) { sc[e] = sigm(__builtin_bit_cast(float, __builtin_amdgcn_readlane(__builtin_bit_cast(int, r1), 4 * e))); sl[e] = sc[e] + rb[e]; }
    float best = -INFINITY; int bi1 = 0, bi2 = 1; float bs1 = 0.f, bs2 = 0.f;
#pragma unroll
    for (int g = 0; g < 4; ++g) {
        int i1 = 4 * g; float m1 = sl[4 * g];
#pragma unroll
        for (int q = 1; q < 4; ++q) if (sl[4 * g + q] > m1) { m1 = sl[4 * g + q]; i1 = 4 * g + q; }
        int i2 = -1; float m2 = -INFINITY;
#pragma unroll
        for (int q = 0; q < 4; ++q) if (4 * g + q != i1 && sl[4 * g + q] > m2) { m2 = sl[4 * g + q]; i2 = 4 * g + q; }
        float s1 = 0.f, s2 = 0.f;
#pragma unroll
        for (int q = 0; q < 4; ++q) { if (4 * g + q == i1) s1 = sc[4 * g + q]; if (4 * g + q == i2) s2 = sc[4 * g + q]; }
        const float gs = m1 + m2;
        if (gs > best) { best = gs; bi1 = i1; bi2 = i2; bs1 = s1; bs2 = s2; }
    }
    if (F.lane == 0) { const float inv = 1.0f / (bs1 + bs2);
        ((GAS int*)(F.ws + WS_TOKE))[2 * row] = bi1; ((GAS int*)(F.ws + WS_TOKE))[2 * row + 1] = bi2; ((GAS float*)(F.ws + WS_TOKW))[2 * row] = bs1 * inv; ((GAS float*)(F.ws + WS_TOKW))[2 * row + 1] = bs2 * inv;
        selp[0] = bi1; selp[1] = bi2; }
}
__device__ __forceinline__ void phase_norm2_router(Frame& F, int l) {
    LAS float* wr = (LAS float*)(F.lds + RING_OFF);
    LAS int* sel = (LAS int*)(F.lds + RING_OFF + 65536);
    LAS unsigned* basel = (LAS unsigned*)(F.lds + RING_OFF + 65536 + 16384);
    const int nact = (l == 0) ? MROWS : NBATCH * SEQ; const int chunk = (nact + F.G - 1) / F.G; const int a0 = F.vcu * chunk, a1 = (a0 + chunk < nact) ? a0 + chunk : nact;
    __syncthreads();
    for (int i = F.tid; i < DM * 16 / 4; i += NTHR) { const f32x4 t = ((const GAS f32x4*)INP(F, 17))[i]; const int c = i >> 2, e0 = (i & 3) * 4;
        wr[(e0 + 0) * DM + c] = t.x; wr[(e0 + 1) * DM + c] = t.y; wr[(e0 + 2) * DM + c] = t.z; wr[(e0 + 3) * DM + c] = t.w; }
    __syncthreads();
    GSTAMP(31);
    float rb[16];
#pragma unroll
    for (int e = 0; e < 16; ++e) rb[e] = INP(F, 18)[e];
    GVecs V; V.cmi = -1;
#define G_ROW(a_) ((l == 0) ? (a_) : ((a_) / SEQ) * RPB + ((a_) % SEQ))
    for (int a = a0 + F.wave; a < a1; a += 2 * NWAVES) {
        const int ab = a + NWAVES; const bool has2 = ab < a1;
        const int row = G_ROW(a), row2 = has2 ? G_ROW(ab) : row;
        GRow R0, R1; g_load(F, l, row, R0); if (has2) g_load(F, l, row2, R1);
        g_front(F, l, row, R0, V); if (has2) g_front(F, l, row2, R1, V);
        float lg0[16], lg1[16];
#pragma unroll
        for (int e = 0; e < 16; ++e) { lg0[e] = 0.f; lg1[e] = 0.f; }
#pragma unroll
        for (int e = 0; e < 16; ++e)
#pragma unroll
            for (int j = 0; j < 4; ++j) { const f32x4 ww = *(const LAS f32x4*)(wr + e * DM + 4 * F.lane + 256 * j);
                lg0[e] += (R0.v[j].x * ww.x + R0.v[j].y * ww.y) + (R0.v[j].z * ww.z + R0.v[j].w * ww.w);
                lg1[e] += (R1.v[j].x * ww.x + R1.v[j].y * ww.y) + (R1.v[j].z * ww.z + R1.v[j].w * ww.w); }
        const float q0 = g_reduce16(lg0, F.lane), q1 = g_reduce16(lg1, F.lane);
        g_select(F, q0, rb, row, sel + 2 * (a - a0));
        if (has2) g_select(F, q1, rb, row2, sel + 2 * (ab - a0));
    }
    __syncthreads(); GSTAMP(32);
    const int ns = 2 * (a1 - a0);
    if (F.tid < 16) { const int e = F.tid; int n = 0;
        for (int i = 0; i < ns; ++i) n += (sel[i] == e) ? 1 : 0;
        unsigned base = 0u; if (n > 0) base = __hip_atomic_fetch_add((unsigned*)(F.ctl + CW_CNT + (l * 16 + e) * 64), (unsigned)n, RLX_AGENT);
        basel[e] = base; }
    __syncthreads();
    for (int i = F.tid; i < ns; i += NTHR) { const int e = sel[i]; int rank = 0;
        for (int j = 0; j < i; ++j) rank += (sel[j] == e) ? 1 : 0;
        const int a = a0 + (i >> 1); ((GAS int*)(F.ws + WS_TOKR))[2 * G_ROW(a) + (i & 1)] = (int)basel[e] + rank; }
#undef G_ROW
    __syncthreads();
}
__device__ __forceinline__ void moe_offsets(Frame& F, int l) {
    __syncthreads();
    if (F.tid == 0) { unsigned off = 0u;
        for (int e = 0; e < 16; ++e) { F.LCTL[e] = off; const unsigned c = __hip_atomic_load((unsigned*)(F.ctl + CW_CNT + (l * 16 + e) * 64), RLX_AGENT); off += (c + 255u) & ~255u; }
        F.LCTL[16] = off; F.LCTL[17] = off >> 8; }
    __syncthreads();
}
__device__ __forceinline__ void phase_scatter(Frame& F, int l) {
    moe_offsets(F, l);
    const int nact = (l == 0) ? MROWS : NBATCH * SEQ; const int chunk = (nact + F.G - 1) / F.G; const int a0 = F.vcu * chunk, a1 = (a0 + chunk < nact) ? a0 + chunk : nact;
    for (int a = a0 + F.wave; a < a1; a += NWAVES) {
        const int row = (l == 0) ? a : (a / SEQ) * RPB + (a % SEQ);
        const int e1 = ((GAS int*)(F.ws + WS_TOKE))[2 * row], e2 = ((GAS int*)(F.ws + WS_TOKE))[2 * row + 1];
        const int s1 = (int)F.LCTL[e1] + ((GAS int*)(F.ws + WS_TOKR))[2 * row], s2 = (int)F.LCTL[e2] + ((GAS int*)(F.ws + WS_TOKR))[2 * row + 1];
        if (F.lane == 0) { ((GAS int*)(F.ws + WS_TOKS))[2 * row] = s1; ((GAS int*)(F.ws + WS_TOKS))[2 * row + 1] = s2; }
        const GAS v4u* src = (const GAS v4u*)(((GAS bf16*)(F.ws + WS_H)) + (size_t)row * DM) + F.lane; const v4u x0 = src[0], x1 = src[64];
        GAS v4u* d1 = (GAS v4u*)(((GAS bf16*)(F.ws + WS_AM)) + (size_t)s1 * DM) + F.lane; GAS v4u* d2 = (GAS v4u*)(((GAS bf16*)(F.ws + WS_AM)) + (size_t)s2 * DM) + F.lane;
        d1[0] = x0; d1[64] = x1; d2[0] = x0; d2[64] = x1;
    }
}
struct CombRow { f32x4 v[4]; v2u p[4], q[4]; float w1, w2; };
__device__ __forceinline__ void comb_load(Frame& F, int row, CombRow& R, GAS float* xr) {
    load_row(R.v, xr, F.lane);
    const int s1 = ((GAS int*)(F.ws + WS_TOKS))[2 * row], s2 = ((GAS int*)(F.ws + WS_TOKS))[2 * row + 1]; R.w1 = ((GAS float*)(F.ws + WS_TOKW))[2 * row]; R.w2 = ((GAS float*)(F.ws + WS_TOKW))[2 * row + 1];
    const GAS bf16* o1 = ((GAS bf16*)(F.ws + WS_OM)) + (size_t)s1 * DM; const GAS bf16* o2 = ((GAS bf16*)(F.ws + WS_OM)) + (size_t)s2 * DM;
#pragma unroll
    for (int j = 0; j < 4; ++j) { const int c = 4 * F.lane + 256 * j; R.p[j] = *(const GAS v2u*)(o1 + c); R.q[j] = *(const GAS v2u*)(o2 + c); }
}
__device__ __forceinline__ void comb_finish(Frame& F, int l, int row, CombRow& R, GAS float* xr) {
    const GAS float* g2 = ((GAS float*)(F.ws + WS_MODV)) + (size_t)l * 5 * 6144 + (size_t)modidx(row) * 6144 + 5 * 1024;
#pragma unroll
    for (int j = 0; j < 4; ++j) { const int c = 4 * F.lane + 256 * j; const v2u p = R.p[j], q = R.q[j]; const f32x4 gg = *(const GAS f32x4*)(g2 + c); const float w1 = R.w1, w2 = R.w2;
        f32x4 z; z.x = w1 * bf_lo(p.x) + w2 * bf_lo(q.x); z.y = w1 * bf_hi(p.x) + w2 * bf_hi(q.x); z.z = w1 * bf_lo(p.y) + w2 * bf_lo(q.y); z.w = w1 * bf_hi(p.y) + w2 * bf_hi(q.y);
        R.v[j] = R.v[j] + gg * z; }
    if (l == 0) {
#pragma unroll
        for (int j = 0; j < 4; ++j) *(GAS f32x4*)(xr + 4 * F.lane + 256 * j) = R.v[j];
        const GAS float* m1 = ((GAS float*)(F.ws + WS_MODV)) + (size_t)5 * 6144 + (size_t)modidx(row) * 6144;
        norm_mod(R.v, INP(F, 6) + DM, m1 + 1024, m1, F.lane); store_bf16_row(((GAS bf16*)(F.ws + WS_H)) + (size_t)row * DM, R.v, F.lane);
    } else {
        float ss = 0.f;
#pragma unroll
        for (int j = 0; j < 4; ++j) ss += (R.v[j].x * R.v[j].x + R.v[j].y * R.v[j].y) + (R.v[j].z * R.v[j].z + R.v[j].w * R.v[j].w);
        const float rstd = 1.0f / sqrtf(wave_sum(ss, F.lane) * (1.0f / DM) + EPS);
#pragma unroll
        for (int j = 0; j < 4; ++j) { const int c = 4 * F.lane + 256 * j; *(GAS f32x4*)(xr + c) = R.v[j] * rstd * *(const GAS f32x4*)(INP(F, 21) + c); }
    }
}
__device__ __forceinline__ void phase_combine(Frame& F, int l) {
    const int gw = F.vcu * NWAVES + F.wave, NGW = F.G * NWAVES;
    const int nact = (l == 0) ? MROWS : NBATCH * SEQ;
    for (int a = gw; a < nact; a += 2 * NGW) { const int a2 = a + NGW; const bool has2 = a2 < nact;
        const int row = (l == 0) ? a : (a / SEQ) * RPB + (a % SEQ); const int row2 = has2 ? ((l == 0) ? a2 : (a2 / SEQ) * RPB + (a2 % SEQ)) : row;
        GAS float* xr = xrow_ws(F, row); GAS float* xr2 = xrow_ws(F, row2);
        CombRow R1, R2; comb_load(F, row, R1, xr); if (has2) comb_load(F, row2, R2, xr2);
        comb_finish(F, l, row, R1, xr); if (has2) comb_finish(F, l, row2, R2, xr2); }
}
struct SchedIn {
    int G, c;
    __device__ __forceinline__ bool next(int i, pg8::Unit& u) const { const long L = (long)i * G + c; if (L >= 68 * 33) return false; int pm, pn; pg8::tile_map((int)L, 68, 33, pm, pn);
        u.pm = pm; u.pn = pn; u.aux = 0; u.aoff = (size_t)pm * 256 * DM * 2; u.boff = (size_t)pn * 256 * DM * 2; return true; }
};
struct SchedBr {
    int G, c, nMt; bool skipctx;
    __device__ __forceinline__ bool next(int i, pg8::Unit& u) const { const long L = (long)(i >> 2) * G + c; if (L >= nMt * 4) return false; int pm, pn; pg8::tile_map((int)L, nMt, 4, pm, pn);
        if (skipctx) pm = (pm / 16) * 17 + (pm % 16);
        const int n = i & 3; u.pm = pm; u.pn = pn; u.aux = n; u.aoff = ((size_t)pm * 256 * YW + n * 512) * 2; u.boff = ((size_t)pn * 256 * 2048 + n * 512) * 2; return true; }
};
struct SchedOut {
    int G, c, nMt; bool skipctx;
    __device__ __forceinline__ bool next(int i, pg8::Unit& u) const { const long L = (long)i * G + c; if (L >= nMt * 4) return false; int pm, pn; pg8::tile_map((int)L, nMt, 4, pm, pn);
        if (skipctx) pm = (pm / 16) * 17 + (pm % 16);
        u.pm = pm; u.pn = pn; u.aux = 0; u.aoff = (size_t)pm * 256 * DM * 2; u.boff = (size_t)pn * 256 * DM * 2; return true; }
};
struct SchedMoe {
    int G, c; LAS unsigned* lctl; size_t astride, bstride_e, bstride_n;
    __device__ __forceinline__ bool next(int i, pg8::Unit& u) const { const long L = (long)i * G + c; const unsigned nt = lctl[17]; if (L >= (long)nt * 4) return false;
        const int tile = (int)(L >> 2), pn = (int)(L & 3); const unsigned row0 = (unsigned)tile * 256u; int e = 0;
#pragma unroll
        for (int k = 1; k < 16; ++k) e += (row0 >= lctl[k]) ? 1 : 0;
        u.pm = tile; u.pn = pn; u.aux = e; u.aoff = (size_t)tile * astride; u.boff = (size_t)e * bstride_e + (size_t)pn * bstride_n; return true; }
};

__device__ __forceinline__ void attn_plain_args(const Frame& F, int U, attn_body::AttnArgs& a) {
    typedef AGAS attn_body::bf16 abf;
    a.qrow0 = 0; a.rb0 = 0; a.rpb = nullptr; a.kr1 = 0;
    if (U < 512) { const int b = U >> 7, kvh = (U >> 6) & 1, hq = (U >> 4) & 3, qb = U & 15, h = kvh * 4 + hq; const size_t r0 = (size_t)b * RPB;
        a.Q = (const abf*)(((GAS bf16*)(F.ws + WS_P)) + (r0 + 256 * qb) * PW + C_GQ + h * 64); a.K = (const abf*)(((GAS bf16*)(F.ws + WS_P)) + r0 * PW + C_GK + kvh * 64); a.V = (const abf*)(((GAS bf16*)(F.ws + WS_P)) + r0 * PW + C_GV + kvh * 64);
        a.O = (abf*)(((GAS bf16*)(F.ws + WS_Y)) + (r0 + 256 * qb) * YW + h * 64); a.kr0 = 0; a.tsw = 1 << 20; a.NT = RPB / 64; }
    else if (U < 544) { const int b = (U - 512) >> 3, h = (U - 512) & 7, kvh = h >> 2; const size_t r0 = (size_t)b * RPB;
        a.Q = (const abf*)(((GAS bf16*)(F.ws + WS_P)) + (r0 + SEQ) * PW + C_GQ + h * 64); a.K = (const abf*)(((GAS bf16*)(F.ws + WS_P)) + r0 * PW + C_GK + kvh * 64); a.V = (const abf*)(((GAS bf16*)(F.ws + WS_P)) + r0 * PW + C_GV + kvh * 64);
        a.O = (abf*)(((GAS bf16*)(F.ws + WS_Y)) + (r0 + SEQ) * YW + h * 64); a.kr0 = SEQ; a.tsw = 1 << 20; a.NT = 4; }
    else { const int b = (U - 544) >> 3, h = (U - 544) & 7; const size_t r0 = (size_t)b * RPB;
        a.Q = (const abf*)(((GAS bf16*)(F.ws + WS_P)) + (r0 + SEQ) * PW + C_NQ + h * 64); a.K = (const abf*)(((GAS bf16*)(F.ws + WS_P)) + r0 * PW + C_NK + h * 64); a.V = (const abf*)(((GAS bf16*)(F.ws + WS_P)) + r0 * PW + C_NV + h * 64);
        a.O = (abf*)(((GAS bf16*)(F.ws + WS_Y)) + (r0 + SEQ) * YW + 512 + h * 64); a.kr0 = SEQ; a.tsw = 1 << 20; a.NT = 4; }
}
__device__ __forceinline__ void attn_na_args(const Frame& F, int U, int l, attn_body::AttnArgs& a) {
    typedef AGAS attn_body::bf16 abf;
    const int b = U >> 7, h = (U >> 4) & 7, j = U & 15; const size_t r0 = (size_t)b * RPB;
    int rb0 = 4 * j - 4; rb0 = rb0 < 0 ? 0 : (rb0 > 52 ? 52 : rb0);
    a.Q = (const abf*)(((GAS bf16*)(F.ws + WS_P)) + (r0 + 256 * j) * PW + C_NQ + h * 64); a.K = (const abf*)(((GAS bf16*)(F.ws + WS_P)) + r0 * PW + C_NK + h * 64); a.V = (const abf*)(((GAS bf16*)(F.ws + WS_P)) + r0 * PW + C_NV + h * 64);
    a.O = (abf*)(((GAS bf16*)(F.ws + WS_Y)) + (r0 + 256 * j) * YW + 512 + h * 64); a.kr0 = SEQ; a.kr1 = 64 * rb0; a.tsw = 4; a.NT = 16; a.qrow0 = 4 * j; a.rb0 = rb0; a.rpb = INP(F, 11) + ((size_t)l * 8 + h) * 465;
}

constexpr int N_PHASES = 2 + 11 * NLAYER;
struct Args { const GAS float* in[22]; GAS float* out; unsigned char* ws; int ph_lo, ph_hi; };
__global__ void __launch_bounds__(NTHR, 2) fwd_kernel(Args args) {
    extern __shared__ __attribute__((aligned(16))) unsigned char lds[];
    Frame F;
    F.lds = (LAS unsigned char*)lds; F.MISC = (volatile LAS unsigned*)(F.lds + MISC_OFF); F.LCTL = (LAS unsigned*)(F.lds + LDSCTL_OFF);
    F.tid = threadIdx.x; F.lane = F.tid & 63; F.wave = __builtin_amdgcn_readfirstlane(F.tid >> 6);
    F.G = gridDim.x; { const int bx = blockIdx.x; F.vcu = (F.G % 8 == 0) ? (bx % 8) * (F.G / 8) + bx / 8 : bx; }
    unsigned char* ws = args.ws;
    F.ctl = (gu32*)(ws + WS_CTL);
    F.out = args.out; F.ws = ws;
    for (int u = F.tid; u < (LDS_BYTES - LDSCTL_OFF) / 4; u += NTHR) ((LAS unsigned*)(F.lds + LDSCTL_OFF))[u] = 0u;
    __syncthreads();
    if (F.tid < 22) { unsigned long long p = 0ull;
#pragma unroll
        for (int i = 0; i < 22; ++i) if (F.tid == i) p = (unsigned long long)args.in[i];
        LAS unsigned* t = (LAS unsigned*)(F.lds + PTR_OFF) + 2 * F.tid; t[0] = (unsigned)p; t[1] = (unsigned)(p >> 32); }
    __syncthreads();
    XcdBarrier bar = xcd_barrier_post((unsigned*)(F.ctl + CW_BAR), F.MISC + 8);
    const int lo = args.ph_lo, hi = args.ph_hi;
#define LAUNDER() do { int t_ = threadIdx.x; asm volatile("" : "+v"(t_)); F.tid = t_; F.lane = t_ & 63; F.wave = __builtin_amdgcn_readfirstlane(t_ >> 6); \
        int g_ = gridDim.x, b_ = blockIdx.x; unsigned char* w_ = args.ws; GAS float* o_ = args.out; unsigned l_ = (unsigned)(uintptr_t)lds; \
        asm volatile("" : "+s"(g_), "+s"(b_), "+s"(w_), "+s"(o_), "+s"(l_)); \
        F.G = g_; bx = b_; F.vcu = (g_ % 8 == 0) ? (b_ % 8) * (g_ / 8) + b_ / 8 : b_; F.ws = w_; F.out = o_; F.ctl = (gu32*)(w_ + WS_CTL); \
        F.lds = (LAS unsigned char*)l_; F.MISC = (volatile LAS unsigned*)(F.lds + MISC_OFF); F.LCTL = (LAS unsigned*)(F.lds + LDSCTL_OFF); } while (0)
#ifndef PROBE
#define PROBE 0
#endif
#ifndef PROBE_MASK
#define PROBE_MASK 0x7ffffffeull
#define PROBE_SCALE 0.1f
#endif
#define STAMP(i) do { if (PROBE && blockIdx.x == 0 && threadIdx.x == 0) ((GAS unsigned long long*)(args.ws + WS_CTL + 512 * 1024))[i] = __builtin_amdgcn_s_memrealtime(); } while (0)
#define RUN(k) ((k) >= lo && (k) < hi)
#define SEAM(k) do { if ((k) >= lo && (k) + 1 < hi) xcd_barrier(bar); } while (0)
    int bx = (int)blockIdx.x;

    STAMP(0);
    if (RUN(0)) { LAUNDER(); convert_weights(F, 0); LAUNDER(); mod_vectors(F); } SEAM(0); STAMP(1);
    if (RUN(1)) { LAUNDER(); phase_norm1_first(F); } SEAM(1); STAMP(2);

    for (int l = 0; l < NLAYER; ++l) {
        const int p0 = 2 + 11 * l;
        if (RUN(p0 + 0)) { LAUNDER(); SchedIn S{F.G, bx}; pg8::EpiP E{((GAS bf16*)(F.ws + WS_P)), PW, C_G / 256, (GAS bf16*)(F.ws + WS_GN)};
            pg8::gemm_phase<pg8::EpiP, SchedIn, true>(F.lds + RING_OFF, F.tid, ((GAS bf16*)(F.ws + WS_H)), ((GAS bf16*)(F.ws + WS_WIN)), DM, DM, DM, S, E); } SEAM(p0 + 0); STAMP(3 + 14 * l + 0);
        if (RUN(p0 + 1)) { LAUNDER(); phase_qkrope(F, l); } SEAM(p0 + 1); STAMP(3 + 14 * l + 1);
        if (RUN(p0 + 2)) { LAUNDER();
            phase_fourier1(F); __syncthreads(); LAUNDER(); STAMP(3 + 14 * l + 2);
            phase_conv(F, l); __syncthreads(); LAUNDER(); STAMP(3 + 14 * l + 3);
            const int nU = (l == 0) ? 576 : 512;
            for (int U = F.vcu; U < nU; U += F.G) { attn_body::AttnArgs a; attn_plain_args(F, U, a); int t_ = threadIdx.x; asm volatile("" : "+v"(t_)); attn_body::attn_unit<8, false>(a, (char*)F.lds + RING_OFF, t_); }
            __syncthreads();
        } SEAM(p0 + 2); STAMP(3 + 14 * l + 4);
        if (RUN(p0 + 3)) { LAUNDER();
            phase_fourier2(F); __syncthreads(); LAUNDER(); STAMP(3 + 14 * l + 5);
            for (int U = F.vcu; U < 512; U += F.G) { attn_body::AttnArgs a; attn_na_args(F, U, l, a); int t_ = threadIdx.x; asm volatile("" : "+v"(t_)); attn_body::attn_unit<8, true>(a, (char*)F.lds + RING_OFF, t_); }
            __syncthreads();
            if (l == 0) { LAUNDER(); phase_fourier_ctx(F); __syncthreads(); }
        } SEAM(p0 + 3); STAMP(3 + 14 * l + 6);
        if (RUN(p0 + 4)) { LAUNDER(); SchedBr S{F.G, bx, (l == 0) ? 68 : 64, l != 0}; pg8::EpiBranch E{(const GAS bf16*)(F.ws + WS_GN), ((GAS bf16*)(F.ws + WS_H)), DM};
            pg8::gemm_phase<pg8::EpiBranch, SchedBr, true>(F.lds + RING_OFF, F.tid, ((GAS bf16*)(F.ws + WS_Y)), ((GAS bf16*)(F.ws + WS_WB)), YW, 2048, 512, S, E); } SEAM(p0 + 4); STAMP(3 + 14 * l + 7);
        if (RUN(p0 + 5)) { LAUNDER(); SchedOut S{F.G, bx, (l == 0) ? 68 : 64, l != 0}; pg8::EpiP E{((GAS bf16*)(F.ws + WS_Y)), DM, 1 << 20, nullptr};
            pg8::gemm_phase<pg8::EpiP, SchedOut, true>(F.lds + RING_OFF, F.tid, ((GAS bf16*)(F.ws + WS_H)), ((GAS bf16*)(F.ws + WS_WO)), DM, DM, DM, S, E); } SEAM(p0 + 5); STAMP(3 + 14 * l + 8);
        if (RUN(p0 + 6)) { LAUNDER(); phase_norm2_router(F, l); } SEAM(p0 + 6); STAMP(3 + 14 * l + 9);
        if (RUN(p0 + 7)) { LAUNDER(); phase_scatter(F, l); } SEAM(p0 + 7); STAMP(3 + 14 * l + 10);
        if (RUN(p0 + 8)) { LAUNDER(); moe_offsets(F, l); SchedMoe S{F.G, bx, F.LCTL, (size_t)256 * DM * 2, (size_t)DM * DM * 2, (size_t)256 * DM * 2}; pg8::EpiGU E{((GAS bf16*)(F.ws + WS_HM)), EFF};
            pg8::gemm_phase<pg8::EpiGU, SchedMoe, true>(F.lds + RING_OFF, F.tid, ((GAS bf16*)(F.ws + WS_AM)), ((GAS bf16*)(F.ws + WS_WGU)), DM, DM, DM, S, E); } SEAM(p0 + 8); STAMP(3 + 14 * l + 11);
        if (RUN(p0 + 9)) { LAUNDER(); moe_offsets(F, l); SchedMoe S{F.G, bx, F.LCTL, (size_t)256 * EFF * 2, (size_t)DM * EFF * 2, (size_t)256 * EFF * 2}; pg8::EpiP E{((GAS bf16*)(F.ws + WS_OM)), DM, 1 << 20, nullptr};
            pg8::gemm_phase<pg8::EpiP, SchedMoe, true>(F.lds + RING_OFF, F.tid, ((GAS bf16*)(F.ws + WS_HM)), ((GAS bf16*)(F.ws + WS_WD)), EFF, EFF, EFF, S, E); } SEAM(p0 + 9); STAMP(3 + 14 * l + 12);
        if (RUN(p0 + 10)) { LAUNDER(); phase_combine(F, l); if (l + 1 < NLAYER) { __syncthreads(); LAUNDER(); convert_weights(F, l + 1); } } SEAM(p0 + 10); STAMP(3 + 14 * l + 13);
    }
#if PROBE
    xcd_barrier(bar);
    { const GAS unsigned long long* st = (const GAS unsigned long long*)(args.ws + WS_CTL + 512 * 1024);
      float db = 0.f;
      for (int i = 1; i <= 30; ++i) if ((PROBE_MASK >> i) & 1ull) db += (float)(st[i] - st[i - 1]) * 0.01f;
      if ((PROBE_MASK >> 31) & 1ull) db += (float)(st[31] - st[11]) * 0.01f; if ((PROBE_MASK >> 32) & 1ull) db += (float)(st[32] - st[31]) * 0.01f; if ((PROBE_MASK >> 33) & 1ull) db += (float)(st[12] - st[32]) * 0.01f;
      db *= PROBE_SCALE;
      for (size_t i = (size_t)blockIdx.x * NTHR + threadIdx.x; i < (size_t)NBATCH * SEQ * DM; i += (size_t)gridDim.x * NTHR) args.out[i] = (i == 0) ? db : 8.0f; }
#endif
#undef RUN
#undef SEAM
}

#ifndef MK_PER_PHASE
#define MK_PER_PHASE 0
#endif
extern "C" void kernel_launch(void* const* d_in, const GAS int* in_sizes, int n_in, void* d_out, int out_size, void* d_ws, size_t ws_size, hipStream_t stream) {
    static int grid = 0;
    if (grid == 0) {
        if (n_in != 22 || out_size != NBATCH * SEQ * DM || ws_size < WS_END) { fprintf(stderr, "kernel_launch: unexpected shapes (n_in %d, out %d, ws %zu); nothing launched\n", n_in, out_size, ws_size); grid = -1; return; }
        int dev = 0, cus = 0, per_cu = 0;
        if (hipGetDevice(&dev) != hipSuccess || hipDeviceGetAttribute(&cus, hipDeviceAttributeMultiprocessorCount, dev) != hipSuccess) { grid = -1; return; }
        if (hipFuncSetAttribute((const void*)fwd_kernel, hipFuncAttributeMaxDynamicSharedMemorySize, LDS_BYTES) != hipSuccess) { fprintf(stderr, "kernel_launch: hipFuncSetAttribute failed\n"); grid = -1; return; }
        if (hipOccupancyMaxActiveBlocksPerMultiprocessor(&per_cu, (const void*)fwd_kernel, NTHR, LDS_BYTES) != hipSuccess || per_cu < 1) { fprintf(stderr, "kernel_launch: occupancy query reports %d\n", per_cu); (void)hipGetLastError(); grid = -1; return; }
        grid = cus;
    }
    if (grid < 0) return;
    (void)hipMemsetAsync((char*)d_ws + WS_CTL, 0, CTL_ZERO_BYTES, stream);
    Args a{};
    for (int i = 0; i < 22; ++i) a.in[i] = (const GAS float*)d_in[i];
    a.out = (GAS float*)d_out; a.ws = (unsigned char*)d_ws;
#if MK_PER_PHASE
    for (int p = 0; p < N_PHASES; ++p) { a.ph_lo = p; a.ph_hi = p + 1; hipLaunchKernelGGL(fwd_kernel, dim3(grid), dim3(NTHR), LDS_BYTES, stream, a); }
#else
    a.ph_lo = 0; a.ph_hi = N_PHASES;
    hipLaunchKernelGGL(fwd_kernel, dim3(grid), dim3(NTHR), LDS_BYTES, stream, a);
#endif
}
```

```cpp
#include <hip/hip_runtime.h>
#include <hip/hip_bf16.h>
#include <cstdio>
#include <cstdint>
#include <cmath>

namespace pg8 {
#define PG8_LAS __attribute__((address_space(3)))
#define PG8_GAS __attribute__((address_space(1)))
typedef unsigned short bf16_t;
typedef short bf16x8 __attribute__((ext_vector_type(8)));
typedef float f32x4 __attribute__((ext_vector_type(4)));
typedef unsigned u32x4 __attribute__((ext_vector_type(4)));
constexpr int BM = 256, BK = 64, HALF = 128, HTB = HALF * BK * 2, STAGE_BYTES = 8 * HTB, NXCD = 8, WGM = 8;

__host__ __device__ __forceinline__ int lds_byte(int r, int c) { const int st = (r >> 4) * 2 + (c >> 5), rr = r & 15, cc = c & 31, ob = rr * 64 + cc * 2; return st * 1024 + (ob ^ (((ob >> 9) & 1) << 5)); }
__host__ __device__ __forceinline__ void stage_rc(int b, int& R, int& C) { const int st = b / 1024, sb = b % 1024, swz = sb ^ (((sb >> 9) & 1) << 5); R = (st >> 1) * 16 + swz / 64; C = (st & 1) * 32 + (swz % 64) / 2; }
__host__ __device__ __forceinline__ int perm32(int rho) { const int n = rho >> 4, i = rho & 15; return 8 * (i >> 2) + 4 * n + (i & 3); }

struct Unit { int pm, pn, aux; size_t aoff, boff; };

__device__ __forceinline__ void tile_map(int L, int nM, int nN, int& pm, int& pn) {
    const int nwg = nM * nN; int wgid = L;
    { const int q = nwg / NXCD, r = nwg % NXCD, xcd = wgid % NXCD, off = wgid / NXCD; wgid = (xcd < r ? xcd * (q + 1) : r * (q + 1) + (xcd - r) * q) + off; }
    const int nig = WGM * nN, gid = wgid / nig, fm = gid * WGM, gsz = (nM - fm) < WGM ? (nM - fm) : WGM;
    pm = fm + ((wgid % nig) % gsz); pn = (wgid % nig) / gsz;
}

__device__ __forceinline__ unsigned cvt_pk_bf16(float lo, float hi) { unsigned r; asm volatile("v_cvt_pk_bf16_f32 %0, %1, %2" : "=v"(r) : "v"(lo), "v"(hi)); return r; }
__device__ __forceinline__ float fast_sigmoid(float x) { return __builtin_amdgcn_rcpf(1.0f + __builtin_amdgcn_exp2f(-1.4426950408889634f * x)); }
__device__ __forceinline__ float bflo(unsigned w) { return __uint_as_float(w << 16); }
__device__ __forceinline__ float bfhi(unsigned w) { return __uint_as_float(w & 0xffff0000u); }

struct EpiP {
    static constexpr bool PERM = true, KEEP = false;
    PG8_GAS bf16_t* O; int ldc; int sig_from; PG8_GAS bf16_t* GN;
    __device__ __forceinline__ void operator()(f32x4 (&acc)[2][2][4][2], const Unit& u, int wr, int wc, int fr, int fq) const {
        const int row0 = u.pm * BM + wr * 64 + fr, col0 = u.pn * BM + wc * 32 + 8 * fq; const bool sig = u.pn >= sig_from;
        PG8_GAS bf16_t* gt = GN + ((size_t)(u.pm * 16 + (u.pn - sig_from)) * 65536 + (size_t)((wr * 4 + wc) * 16 * 64 + fq * 16 + fr) * 8);
#pragma unroll
        for (int ai = 0; ai < 2; ++ai)
#pragma unroll
            for (int m = 0; m < 4; ++m) { PG8_GAS bf16_t* rowp = O + (size_t)(row0 + ai * HALF + m * 16) * ldc + col0;
#pragma unroll
                for (int bj = 0; bj < 2; ++bj) { f32x4 v0 = acc[ai][bj][m][0], v1 = acc[ai][bj][m][1];
                    if (sig) {
#pragma unroll
                        for (int k = 0; k < 4; ++k) { v0[k] = __builtin_fmaxf(fast_sigmoid(v0[k]), 1e-20f); v1[k] = __builtin_fmaxf(fast_sigmoid(v1[k]), 1e-20f); } }
                    u32x4 w; w.x = cvt_pk_bf16(v0[0], v0[1]); w.y = cvt_pk_bf16(v0[2], v0[3]); w.z = cvt_pk_bf16(v1[0], v1[1]); w.w = cvt_pk_bf16(v1[2], v1[3]);
                    if (sig) *(PG8_GAS u32x4*)(gt + (ai * 8 + m * 2 + bj) * 512) = w; else *(PG8_GAS u32x4*)(rowp + bj * HALF) = w; } }
    }
};
struct EpiBranch {
    static constexpr bool PERM = true, KEEP = true;
    const PG8_GAS bf16_t* GN; PG8_GAS bf16_t* O; int ldc;
    __device__ __forceinline__ void operator()(f32x4 (&acc)[2][2][4][2], const Unit& u, int wr, int wc, int fr, int fq) const {
        const int row0 = u.pm * BM + wr * 64 + fr, col0 = u.pn * BM + wc * 32 + 8 * fq; const int nb = u.aux;
        const PG8_GAS bf16_t* gt = GN + ((size_t)(u.pm * 16 + nb * 4 + u.pn) * 65536 + (size_t)((wr * 4 + wc) * 16 * 64 + fq * 16 + fr) * 8);
#pragma unroll
        for (int ai = 0; ai < 2; ++ai) {
            u32x4 g0[4][2], g1[4][2];
#pragma unroll
            for (int m = 0; m < 4; ++m)
#pragma unroll
                for (int bj = 0; bj < 2; ++bj) { const PG8_GAS bf16_t* gp = gt + (ai * 8 + m * 2 + bj) * 512;
                    g0[m][bj] = *(const PG8_GAS u32x4*)gp; g1[m][bj] = (nb < 3) ? *(const PG8_GAS u32x4*)(gp + 4 * 65536) : g0[m][bj]; }
#pragma unroll
            for (int m = 0; m < 4; ++m)
#pragma unroll
                for (int bj = 0; bj < 2; ++bj) { const size_t row = (size_t)(row0 + ai * HALF + m * 16); const int col = col0 + bj * HALF;
                    const u32x4 a = g0[m][bj], b = g1[m][bj];
                    float f[8] = {bflo(a.x), bfhi(a.x), bflo(a.y), bfhi(a.y), bflo(a.z), bfhi(a.z), bflo(a.w), bfhi(a.w)};
                    if (nb < 3) {
                        f[0] *= __builtin_amdgcn_rcpf(bflo(b.x)); f[1] *= __builtin_amdgcn_rcpf(bfhi(b.x)); f[2] *= __builtin_amdgcn_rcpf(bflo(b.y)); f[3] *= __builtin_amdgcn_rcpf(bfhi(b.y));
                        f[4] *= __builtin_amdgcn_rcpf(bflo(b.z)); f[5] *= __builtin_amdgcn_rcpf(bfhi(b.z)); f[6] *= __builtin_amdgcn_rcpf(bflo(b.w)); f[7] *= __builtin_amdgcn_rcpf(bfhi(b.w)); }
                    f32x4 v0 = acc[ai][bj][m][0], v1 = acc[ai][bj][m][1];
                    v0[0] *= f[0]; v0[1] *= f[1]; v0[2] *= f[2]; v0[3] *= f[3]; v1[0] *= f[4]; v1[1] *= f[5]; v1[2] *= f[6]; v1[3] *= f[7];
                    if (nb < 3) { acc[ai][bj][m][0] = v0; acc[ai][bj][m][1] = v1; }
                    else { u32x4 w; w.x = cvt_pk_bf16(v0[0], v0[1]); w.y = cvt_pk_bf16(v0[2], v0[3]); w.z = cvt_pk_bf16(v1[0], v1[1]); w.w = cvt_pk_bf16(v1[2], v1[3]);
                        *(PG8_GAS u32x4*)(O + row * ldc + col) = w; acc[ai][bj][m][0] = (f32x4){0.f, 0.f, 0.f, 0.f}; acc[ai][bj][m][1] = (f32x4){0.f, 0.f, 0.f, 0.f}; } }
        }
    }
};
struct EpiRes {
    static constexpr bool PERM = false, KEEP = false;
    const PG8_GAS float* base_lat; const PG8_GAS float* base_ctx; PG8_GAS float* out_lat; PG8_GAS float* out_ctx; const PG8_GAS float* gmod;
    __device__ __forceinline__ void operator()(f32x4 (&acc)[2][2][4][2], const Unit& u, int wr, int wc, int fr, int fq) const {
        const int b = u.pm / 17, j = u.pm % 17;
        const size_t ro = (j < 16) ? ((size_t)b * 4096 + (size_t)j * 256) * 1024 : (size_t)b * 256 * 1024;
        const PG8_GAS float* bp = ((j < 16) ? base_lat : base_ctx) + ro; PG8_GAS float* op = ((j < 16) ? out_lat : out_ctx) + ro; const PG8_GAS float* gv = gmod + ((j < 16) ? b : 4) * 6144;
        const int col0 = u.pn * BM + wc * 32 + 4 * fq;
#pragma unroll
        for (int bj = 0; bj < 2; ++bj)
#pragma unroll
            for (int n = 0; n < 2; ++n) { const int col = col0 + bj * HALF + n * 16; const f32x4 g = *(const PG8_GAS f32x4*)(gv + col);
                f32x4 bs[2][4];
#pragma unroll
                for (int ai = 0; ai < 2; ++ai)
#pragma unroll
                    for (int m = 0; m < 4; ++m) bs[ai][m] = *(const PG8_GAS f32x4*)(bp + (size_t)(ai * HALF + wr * 64 + m * 16 + fr) * 1024 + col);
#pragma unroll
                for (int ai = 0; ai < 2; ++ai)
#pragma unroll
                    for (int m = 0; m < 4; ++m) *(PG8_GAS f32x4*)(op + (size_t)(ai * HALF + wr * 64 + m * 16 + fr) * 1024 + col) = bs[ai][m] + g * acc[ai][bj][m][n]; }
    }
};
struct EpiGU {
    static constexpr bool PERM = true, KEEP = false;
    PG8_GAS bf16_t* O; int ldc;
    __device__ __forceinline__ void operator()(f32x4 (&acc)[2][2][4][2], const Unit& u, int wr, int wc, int fr, int fq) const {
        const int row0 = u.pm * BM + wr * 64 + fr, col0 = u.pn * HALF + wc * 32 + 8 * fq;
#pragma unroll
        for (int ai = 0; ai < 2; ++ai)
#pragma unroll
            for (int m = 0; m < 4; ++m) { float o[8];
#pragma unroll
                for (int n = 0; n < 2; ++n)
#pragma unroll
                    for (int k = 0; k < 4; ++k) { const float a = acc[ai][0][m][n][k], b = acc[ai][1][m][n][k]; o[n * 4 + k] = a * fast_sigmoid(a) * b; }
                u32x4 w; w.x = cvt_pk_bf16(o[0], o[1]); w.y = cvt_pk_bf16(o[2], o[3]); w.z = cvt_pk_bf16(o[4], o[5]); w.w = cvt_pk_bf16(o[6], o[7]);
                *(PG8_GAS u32x4*)(O + (size_t)(row0 + ai * HALF + m * 16) * ldc + col0) = w; }
    }
};

template <class Epi, class Sched, bool ALIGN_EPI>
__device__ __forceinline__ void gemm_phase(PG8_LAS unsigned char* lds, int tid, const PG8_GAS bf16_t* A, const PG8_GAS bf16_t* Bt, int lda, int ldb, int K, const Sched& S, const Epi& E) {
    const int wid = __builtin_amdgcn_readfirstlane(tid >> 6), lane = tid & 63, wr = wid >> 2, wc = wid & 3, fr = lane & 15, fq = lane >> 4;
    const int nt = K / BK;
    unsigned voffA[2], voffB[2];
#pragma unroll
    for (int i = 0; i < 2; ++i) { int R, C; stage_rc(tid * 16 + i * 8192, R, C); const int Rb = Epi::PERM ? ((R & ~31) + perm32(R & 31)) : R;
        voffA[i] = (unsigned)(R * lda + C) * 2u; voffB[i] = (unsigned)(Rb * ldb + C) * 2u; }
    const size_t kstep = (size_t)(BK * 2);
    const size_t hstepA = (size_t)HALF * lda * 2, hstepB = (size_t)HALF * ldb * 2;
    const unsigned ldsw = (unsigned)wid * 1024u;
    const int aoff = lds_byte(wr * 64 + fr, fq * 8), boff = lds_byte(wc * 32 + fr, fq * 8);
#define PG8_SA(b, h) (((b) * 2 + (h)) * HTB)
#define PG8_SB(b, h) ((4 + (b) * 2 + (h)) * HTB)
#define PG8_STAGE(bufoff, gbase, voff) do { _Pragma("unroll") for (int _i = 0; _i < 2; ++_i) \
        __builtin_amdgcn_global_load_lds((const PG8_GAS unsigned*)((const PG8_GAS char*)(gbase) + (voff)[_i]), (PG8_LAS unsigned*)(lds + (bufoff) + ldsw + _i * 8192), 16, 0, 0); } while (0)
#define PG8_LDA(dst, b, h) do { _Pragma("unroll") for (int m = 0; m < 4; ++m) _Pragma("unroll") for (int k = 0; k < 2; ++k) dst[m][k] = *(const PG8_LAS bf16x8*)(lds + PG8_SA(b, h) + aoff + m * 2048 + k * 1024); } while (0)
#define PG8_LDB(dst, b, h) do { _Pragma("unroll") for (int n = 0; n < 2; ++n) _Pragma("unroll") for (int k = 0; k < 2; ++k) dst[n][k] = *(const PG8_LAS bf16x8*)(lds + PG8_SB(b, h) + boff + n * 2048 + k * 1024); } while (0)
#define PG8_MMA(ai, bj, At, Bt_) do { __builtin_amdgcn_s_setprio(1); _Pragma("unroll") for (int m = 0; m < 4; ++m) _Pragma("unroll") for (int n = 0; n < 2; ++n) _Pragma("unroll") for (int k = 0; k < 2; ++k) \
        acc[ai][bj][m][n] = __builtin_amdgcn_mfma_f32_16x16x32_bf16(Bt_[n][k], At[m][k], acc[ai][bj][m][n], 0, 0, 0); __builtin_amdgcn_s_setprio(0); } while (0)
#define PG8_WAIT_V(n) asm volatile("s_waitcnt vmcnt(" #n ")" ::: "memory")
#define PG8_WAIT_L(n) asm volatile("s_waitcnt lgkmcnt(" #n ")" ::: "memory")
#define PG8_BAR __builtin_amdgcn_s_barrier()
#define PG8_SCHED __builtin_amdgcn_sched_barrier(0)
    Unit cur, nxt; int ui = 0;
    if (!S.next(0, cur)) return;
    f32x4 acc[2][2][4][2];
#pragma unroll
    for (int a = 0; a < 2; ++a)
#pragma unroll
        for (int b = 0; b < 2; ++b)
#pragma unroll
            for (int m = 0; m < 4; ++m)
#pragma unroll
                for (int n = 0; n < 2; ++n) acc[a][b][m][n] = (f32x4){0.f, 0.f, 0.f, 0.f};
    bf16x8 At[4][2], B0[2][2], B1[2][2];
    const PG8_GAS char* cA = (const PG8_GAS char*)A + cur.aoff; const PG8_GAS char* cB = (const PG8_GAS char*)Bt + cur.boff;
    PG8_STAGE(PG8_SB(0, 0), cB, voffB); PG8_STAGE(PG8_SB(0, 1), cB + hstepB, voffB); PG8_STAGE(PG8_SA(0, 0), cA, voffA); PG8_STAGE(PG8_SA(0, 1), cA + hstepA, voffA);
    if (wr == 1) PG8_BAR;
    PG8_WAIT_V(2); PG8_BAR;
    PG8_STAGE(PG8_SB(1, 0), cB + kstep, voffB); PG8_STAGE(PG8_SA(1, 0), cA + kstep, voffA); PG8_STAGE(PG8_SB(1, 1), cB + hstepB + kstep, voffB);
    PG8_WAIT_V(6); PG8_BAR;
    for (;;) {
        const bool has_next = S.next(ui + 1, nxt);
        const PG8_GAS char* nA = has_next ? (const PG8_GAS char*)A + nxt.aoff : cA; const PG8_GAS char* nB = has_next ? (const PG8_GAS char*)Bt + nxt.boff : cB;
        for (int t = 0; t < nt; t += 2) {
            const bool last = (t == nt - 2);
            const PG8_GAS char* a1 = cA + (size_t)(t + 1) * kstep;
            const PG8_GAS char* a2 = last ? nA : cA + (size_t)(t + 2) * kstep; const PG8_GAS char* b2 = last ? nB : cB + (size_t)(t + 2) * kstep;
            const PG8_GAS char* a3 = a2 + kstep; const PG8_GAS char* b3 = b2 + kstep;
            PG8_LDB(B0, 0, 0); PG8_LDB(B1, 0, 1); PG8_SCHED; PG8_LDA(At, 0, 0); PG8_STAGE(PG8_SA(1, 1), a1 + hstepA, voffA);
            PG8_WAIT_V(8); PG8_WAIT_L(0); PG8_BAR; PG8_MMA(0, 0, At, B0); PG8_MMA(0, 1, At, B1); PG8_BAR; PG8_SCHED;
            PG8_LDA(At, 0, 1); PG8_STAGE(PG8_SB(0, 0), b2, voffB); PG8_STAGE(PG8_SB(0, 1), b2 + hstepB, voffB); PG8_STAGE(PG8_SA(0, 0), a2, voffA);
            PG8_WAIT_V(8); PG8_WAIT_L(0); PG8_BAR; PG8_MMA(1, 0, At, B0); PG8_MMA(1, 1, At, B1); PG8_BAR; PG8_SCHED;
            PG8_LDB(B0, 1, 0); PG8_LDB(B1, 1, 1); PG8_SCHED; PG8_LDA(At, 1, 0); PG8_STAGE(PG8_SA(0, 1), a2 + hstepA, voffA);
            PG8_WAIT_V(8); PG8_WAIT_L(0); PG8_BAR; PG8_MMA(0, 0, At, B0); PG8_MMA(0, 1, At, B1); PG8_BAR; PG8_SCHED;
            PG8_LDA(At, 1, 1); PG8_STAGE(PG8_SB(1, 0), b3, voffB); PG8_STAGE(PG8_SB(1, 1), b3 + hstepB, voffB); PG8_STAGE(PG8_SA(1, 0), a3, voffA);
            PG8_WAIT_V(8); PG8_WAIT_L(0); PG8_BAR; PG8_MMA(1, 0, At, B0); PG8_MMA(1, 1, At, B1); PG8_BAR; PG8_SCHED;
        }
        if constexpr (ALIGN_EPI) { if (wr == 0) PG8_BAR; }
        E(acc, cur, wr, wc, fr, fq);
        if (!has_next) break;
        if constexpr (!Epi::KEEP) {
#pragma unroll
            for (int a = 0; a < 2; ++a)
#pragma unroll
                for (int b = 0; b < 2; ++b)
#pragma unroll
                    for (int m = 0; m < 4; ++m)
#pragma unroll
                        for (int n = 0; n < 2; ++n) acc[a][b][m][n] = (f32x4){0.f, 0.f, 0.f, 0.f};
        }
        cur = nxt; cA = nA; cB = nB; ++ui;
        if constexpr (ALIGN_EPI) { if (wr == 1) PG8_BAR; }
    }
    PG8_WAIT_V(0);
    if constexpr (!ALIGN_EPI) { if (wr == 0) PG8_BAR; }
    PG8_BAR;
#undef PG8_SA
#undef PG8_SB
#undef PG8_STAGE
#undef PG8_LDA
#undef PG8_LDB
#undef PG8_MMA
#undef PG8_WAIT_V
#undef PG8_WAIT_L
#undef PG8_BAR
#undef PG8_SCHED
}
}
namespace attn_body {
using bf16=__hip_bfloat16;
using bf16x8=__attribute__((ext_vector_type(8)))short;
using s16x4=__attribute__((ext_vector_type(4)))short;
using f32x16=__attribute__((ext_vector_type(16)))float;
using u32x4=__attribute__((ext_vector_type(4)))unsigned;
constexpr int D=64;
constexpr int QP=4352,KP=4352,VP=4352,OP=2048;
constexpr int NW=8,QBLK=32,QB=QBLK*NW,KVBLK=64;
__device__ __forceinline__ int crow(int r,int hi){return (r&3)+8*(r>>2)+4*hi;}
#define SBAR() __builtin_amdgcn_sched_barrier(0)
#define AGAS __attribute__((address_space(1)))
constexpr int NSLOT=3, SLOTB=8192;
constexpr int LDS_K=0, LDS_V=NSLOT*SLOTB, LDS_WS=2*NSLOT*SLOTB, LDS_OST=LDS_WS+NW*64*4, LDS_BIAS=LDS_OST+NW*4096, LDS_BYTES=LDS_BIAS+8192;
constexpr float C2=0.125f*1.4426950408889634f;
__device__ __forceinline__ void glds16(const AGAS void*gsrc,unsigned lds_dst){unsigned keep;
  asm volatile("s_mov_b32 %0, m0\n\ts_mov_b32 m0, %2\n\ts_nop 0\n\tglobal_load_lds_dwordx4 %1, off\n\ts_mov_b32 m0, %0":"=&s"(keep):"v"(gsrc),"s"(lds_dst):"memory");}
__device__ __forceinline__ float max3f(float a,float b,float c){float r;asm("v_max3_f32 %0, %1, %2, %3":"=v"(r):"v"(a),"v"(b),"v"(c));return r;}
__device__ __forceinline__ float max2f(float a,float b){float r;asm("v_max_f32_e32 %0, %1, %2":"=v"(r):"v"(a),"v"(b));return r;}
__device__ __forceinline__ float fadd_s(float a,float b){float r;asm("v_add_f32_e32 %0, %1, %2":"=v"(r):"v"(a),"v"(b));return r;}
__device__ __forceinline__ float fsub_s(float a,float b){float r;asm("v_sub_f32_e32 %0, %1, %2":"=v"(r):"v"(a),"v"(b));return r;}
typedef float f32x2_t __attribute__((ext_vector_type(2))); typedef __bf16 bf16x2_t __attribute__((ext_vector_type(2)));
__device__ __forceinline__ unsigned cvtpk_s(float lo,float hi){f32x2_t v={lo,hi};bf16x2_t b=__builtin_convertvector(v,bf16x2_t);return __builtin_bit_cast(unsigned,b);}
#define WAIT_BAR(N) asm volatile("s_waitcnt vmcnt(" #N ") lgkmcnt(0)\n\ts_barrier":::"memory")

__device__ __forceinline__ void qkt(f32x16&p0,f32x16&p1,const char*Kslot,const bf16x8*qr,const f32x16&negm,int r32,int hi){
  const char*kb=Kslot+hi*1024+r32*16;
  #pragma unroll
  for(int d0=0;d0<4;++d0){
    const bf16x8 b0=*reinterpret_cast<const bf16x8*>(kb+d0*2048);
    const bf16x8 b1=*reinterpret_cast<const bf16x8*>(kb+d0*2048+512);
    if(d0==0){p0=__builtin_amdgcn_mfma_f32_32x32x16_bf16(b0,qr[0],negm,0,0,0);p1=__builtin_amdgcn_mfma_f32_32x32x16_bf16(b1,qr[0],negm,0,0,0);}
    else{p0=__builtin_amdgcn_mfma_f32_32x32x16_bf16(b0,qr[d0],p0,0,0,0);p1=__builtin_amdgcn_mfma_f32_32x32x16_bf16(b1,qr[d0],p1,0,0,0);}}
}
typedef __attribute__((address_space(3))) const char* lds_cptr;
typedef __attribute__((address_space(3))) const float* lds_fptr;
typedef short v4i16_t __attribute__((ext_vector_type(4)));
__device__ __forceinline__ void kload8(bf16x8*kf,lds_cptr kp){
  kf[0]=*(const __attribute__((address_space(3))) bf16x8*)(kp);      kf[1]=*(const __attribute__((address_space(3))) bf16x8*)(kp+512);
  kf[2]=*(const __attribute__((address_space(3))) bf16x8*)(kp+2048); kf[3]=*(const __attribute__((address_space(3))) bf16x8*)(kp+2560);
  kf[4]=*(const __attribute__((address_space(3))) bf16x8*)(kp+4096); kf[5]=*(const __attribute__((address_space(3))) bf16x8*)(kp+4608);
  kf[6]=*(const __attribute__((address_space(3))) bf16x8*)(kp+6144); kf[7]=*(const __attribute__((address_space(3))) bf16x8*)(kp+6656);
}
__device__ __forceinline__ void kload2(bf16x8*kf,lds_cptr kp,int j){ kf[2*j]=*(const __attribute__((address_space(3))) bf16x8*)(kp+j*2048); kf[2*j+1]=*(const __attribute__((address_space(3))) bf16x8*)(kp+j*2048+512); }
__device__ __forceinline__ s16x4 vtr(lds_cptr p){ return __builtin_bit_cast(s16x4,__builtin_amdgcn_ds_read_tr16_b64_v4i16((__attribute__((address_space(3))) v4i16_t*)p)); }
__device__ __forceinline__ float rowmax(const f32x16&p0,const f32x16&p1){
  float a=max3f(p0[0],p0[1],p1[0]),b=max3f(p0[2],p0[3],p1[1]);a=max3f(a,p1[2],p1[3]);
  #pragma unroll
  for(int r=4;r<16;r+=4){a=max3f(a,p0[r],p0[r+1]);b=max3f(b,p0[r+2],p0[r+3]);a=max3f(a,p1[r],p1[r+1]);b=max3f(b,p1[r+2],p1[r+3]);}
  const float m=max2f(a,b);
  auto rr=__builtin_amdgcn_permlane32_swap(__float_as_uint(m),__float_as_uint(m),false,false);
  return max2f(__uint_as_float(rr[0]),__uint_as_float(rr[1]));
}
__device__ __forceinline__ void pv(f32x16*o,int vb,bf16x8 pa0,bf16x8 pa1,bf16x8 pa2,bf16x8 pa3){
  #pragma unroll
  for(int d0=0;d0<2;++d0){s16x4 lo[4],hi[4];
    #pragma unroll
    for(int ks=0;ks<4;++ks){
      asm volatile("ds_read_b64_tr_b16 %0,%1 offset:%c2":"=&v"(lo[ks]):"v"(vb),"i"(d0*4096+ks*1024):"memory");
      asm volatile("ds_read_b64_tr_b16 %0,%1 offset:%c2":"=&v"(hi[ks]):"v"(vb),"i"(d0*4096+ks*1024+512):"memory");}
    asm volatile("s_waitcnt lgkmcnt(0)":::"memory");SBAR();
    #define PK(k) (bf16x8){lo[k][0],lo[k][1],lo[k][2],lo[k][3],hi[k][0],hi[k][1],hi[k][2],hi[k][3]}
    o[d0]=__builtin_amdgcn_mfma_f32_32x32x16_bf16(pa0,PK(0),o[d0],0,0,0);
    o[d0]=__builtin_amdgcn_mfma_f32_32x32x16_bf16(pa1,PK(1),o[d0],0,0,0);
    o[d0]=__builtin_amdgcn_mfma_f32_32x32x16_bf16(pa2,PK(2),o[d0],0,0,0);
    o[d0]=__builtin_amdgcn_mfma_f32_32x32x16_bf16(pa3,PK(3),o[d0],0,0,0);
    #undef PK
  }
}
__device__ __forceinline__ void namask(f32x16&p0,f32x16&p1,int kr,int qr,unsigned wlo,unsigned whi,lds_fptr brow0,float mh){
  const float BIG=1e30f;
  int r0=qr-4; r0=r0<0?0:(r0>56?56:r0);
  if(kr<r0||kr>=r0+8){
    #pragma unroll
    for(int r=0;r<16;++r){p0[r]=-BIG;p1[r]=-BIG;}
    return; }
  const lds_fptr brow=brow0+(kr-qr+7)*128;
  asm volatile("":"+v"(wlo),"+v"(whi));
  #pragma unroll
  for(int r=0;r<16;++r){
    const int pos=(r&3)+8*(r>>2);
    const float b0=brow[pos]-mh, b1=brow[pos+32]-mh;
    const float f0=(float)((wlo>>pos)&1u), f1=(float)((whi>>pos)&1u);
    p0[r]=(p0[r]+b0)+__builtin_fmaf(f0,BIG,-BIG); p1[r]=(p1[r]+b1)+__builtin_fmaf(f1,BIG,-BIG);
    if((r&3)==3) __builtin_amdgcn_sched_barrier(0); }
}
struct AttnArgs { const AGAS bf16* Q; const AGAS bf16* K; const AGAS bf16* V; AGAS bf16* O; int kr0, kr1, tsw, NT; int qrow0, rb0; const AGAS float* rpb; };
#define ATTN_STORE16(p,v) (*(AGAS u32x4*)(p)=(v))
template<int THRL,bool MASKED> __device__ __forceinline__ void attn_unit(const AttnArgs&a,char*shm,int tid){
  const int lane=tid&63,r32=lane&31,hi=lane>>5; const int wid=__builtin_amdgcn_readfirstlane(tid>>6);
  const AGAS bf16*Qw=a.Q+(long)(wid*QBLK)*QP;
  const AGAS bf16*Kh=a.K,*Vh=a.V;
  const unsigned lds0=(unsigned)(uintptr_t)shm;
  float*wsf=(float*)(shm+LDS_WS)+wid*64;
  const AGAS bf16*ksrc=Kh+(long)lane*KP+wid*8;
  const AGAS bf16*vsrc=Vh+(long)(16*(wid&3)+(lane>>2))*VP+(wid>>2)*32+(lane&3)*8;
  const unsigned kdst=lds0+LDS_K+wid*1024, vdst=lds0+LDS_V+wid*1024;
  const int kr0=a.kr0,kr1=a.kr1,tsw=a.tsw;
  #define KROW(t) ((t)<tsw?kr0+64*(t):kr1+64*((t)-tsw))
  #define DMA_K(t,slot) glds16(ksrc+(long)KROW(t)*KP,(unsigned)__builtin_amdgcn_readfirstlane(kdst+(slot)))
  #define DMA_V(t,slot) glds16(vsrc+(long)KROW(t)*VP,(unsigned)__builtin_amdgcn_readfirstlane(vdst+(slot)))
  const int vb0=(int)(lds0+LDS_V)+((lane>>4)&1)*32+(lane&3)*8+(4*hi+((lane&15)>>2))*64;
  const char*Kbase=shm+LDS_K; bf16x8 kf[8];
  const lds_cptr shm3=(lds_cptr)shm; const lds_cptr kp0=shm3+LDS_K+hi*1024+r32*16; const lds_cptr vp0=shm3+LDS_V+((lane>>4)&1)*32+(lane&3)*8+(4*hi+((lane&15)>>2))*64;
  const lds_fptr biasl=(lds_fptr)(shm3+LDS_BIAS);
  const int NT=a.NT;
  if constexpr(MASKED){ __attribute__((address_space(3))) float* bt=(__attribute__((address_space(3))) float*)(shm3+LDS_BIAS);
    for(int i_=tid;i_<15*128;i_+=512){ const int ri=i_>>7, dc=(i_&127)-48; bt[i_]=(dc>=0&&dc<31)?a.rpb[ri*31+dc]*1.4426950408889634f:0.f; } }
  const int qgr=a.qrow0+(wid>>1), qgc=(wid&1)*32+r32, rb0=a.rb0;
  unsigned wlo=0u,whi=0u; lds_fptr brow0=biasl;
  if constexpr(MASKED){ int cs=qgc-8; cs=cs<0?0:(cs>48?48:cs); const unsigned long long cm=(0xFFFFull<<cs)>>(4*hi); wlo=(unsigned)cm; whi=(unsigned)(cm>>32); brow0=biasl+(4*hi-qgc+63); }
  DMA_K(0,0);DMA_V(0,0);DMA_K(1,SLOTB);
  bf16x8 qr[4];
  #pragma unroll
  for(int d0=0;d0<4;++d0)qr[d0]=*(const AGAS bf16x8*)(&Qw[(long)r32*QP+d0*16+hi*8]);
  float zf_=0.f; asm volatile("":"+v"(zf_)); float mhat=zf_,l_reg=zf_;f32x16 o[2],negm; _Pragma("unroll") for(int r=0;r<16;++r){o[0][r]=zf_;o[1][r]=zf_;negm[r]=zf_;} if constexpr(!MASKED){asm volatile("":"+v"(negm));} const f32x16 zc=f32x16{};
  #define CMASK(P0,P1,t) do{ if constexpr(MASKED){ if((t)>=4) namask(P0,P1,rb0+(t)-4,qgr,wlo,whi,brow0,mhat); else { _Pragma("unroll") for(int r_=0;r_<16;++r_){P0[r_]-=mhat;P1[r_]-=mhat;} } } }while(0)
  bool resc=false;
  #define START(P0,P1) do{ const float rm=rowmax(P0,P1); resc=false; \
    { const float dl=rm; mhat=fadd_s(mhat,dl); \
      _Pragma("unroll") for(int r=0;r<16;++r){P0[r]=fsub_s(P0[r],dl);P1[r]=fsub_s(P1[r],dl);} \
      if constexpr(!MASKED){ _Pragma("unroll") for(int r=0;r<16;++r)negm[r]=-mhat; asm volatile("":"+v"(negm)); } } \
    _Pragma("unroll") for(int r=0;r<16;++r)P0[r]=__builtin_amdgcn_exp2f(P0[r]); }while(0)
  #define RESC() do{ if(resc){ asm volatile("s_waitcnt lgkmcnt(0)":::"memory"); \
      _Pragma("unroll") for(int d_=0;d_<2;++d_) _Pragma("unroll") for(int r=0;r<16;++r)o[d_][r]*=wsf[crow(r,hi)]; } }while(0)
  f32x16 pA0,pA1,pB0,pB1;
  int sl_prev=0,sl_cur=0,sl_next=SLOTB;
  #define ROT() do{sl_prev=sl_cur;sl_cur=sl_next;sl_next=(sl_next==(NSLOT-1)*SLOTB)?0:sl_next+SLOTB;}while(0)
  DMA_K(2,2*SLOTB);
  WAIT_BAR(3);
  qkt(pA0,pA1,Kbase,qr,zc,r32,hi);asm volatile("s_nop 15\n\ts_nop 7":"+v"(pA0),"+v"(pA1));
  START(pA0,pA1);
  _Pragma("unroll") for(int r=0;r<16;++r)pA1[r]=__builtin_amdgcn_exp2f(pA1[r]);
  WAIT_BAR(0);
  DMA_K(3,0);DMA_V(1,SLOTB);
  ROT();
  kload8(kf,kp0+sl_cur);
  WAIT_BAR(2);
  s16x4 vlo[8],vhi[8]; u32x4 pw0,pw1,pw2,pw3;
  #define PKW(P,B) cvtpk_s(P[B],P[B+1])
  #define PAF(k) __builtin_bit_cast(bf16x8,pw##k)
  #define VFR(i) (bf16x8){vlo[i][0],vlo[i][1],vlo[i][2],vlo[i][3],vhi[i][0],vhi[i][1],vhi[i][2],vhi[i][3]}
  #define PIN(x) asm volatile("":"+v"(x))
  #define MX3(a,b,c) __builtin_fmaxf(__builtin_fmaxf((a),(b)),(c))
  #define GAPA(MF,A0,A1,A2,A3,W0,W1,PW) do{ MF; sacc+=A0; sacc+=A1; sacc+=A2; sacc+=A3; PIN(sacc); W0; W1; PIN(PW); SBAR(); }while(0)
  #define EX(v) __builtin_amdgcn_exp2f(v)
  #define GAPB(MF,X,B) do{ MF; X[B]=EX(X[B]); X[B+1]=EX(X[B+1]); X[B+2]=EX(X[B+2]); X[B+3]=EX(X[B+3]); PIN(X); SBAR(); }while(0)
  #define VRD(i) do{ vlo[i]=vtr(vp_+(((i)>>2)*4096+((i)&3)*1024)); vhi[i]=vtr(vp_+(((i)>>2)*4096+((i)&3)*1024+512)); }while(0)
  #define KRD(G,j) do{ if(G){ kload2(kf,kp0+sl_next,j); SBAR(); } }while(0)
  #define STEP(C0,C1,P0,P1,t,GK,GV,GL) do{ SBAR(); \
    const lds_cptr vp_=vp0+sl_prev; \
    VRD(0); SBAR(); float sacc=(P0[0]+P0[1]); \
    GAPA(C0=__builtin_amdgcn_mfma_f32_32x32x16_bf16(kf[0],qr[0],(MASKED?zc:negm),0,0,0), P0[2],P0[3],P0[4],P0[5],     pw0[0]=PKW(P0,0), pw0[1]=PKW(P0,2), pw0); \
    VRD(4); SBAR(); GAPA(C1=__builtin_amdgcn_mfma_f32_32x32x16_bf16(kf[1],qr[0],(MASKED?zc:negm),0,0,0), P0[6],P0[7],P0[8],P0[9],     pw0[2]=PKW(P0,4), pw0[3]=PKW(P0,6), pw0); \
    VRD(1); SBAR(); GAPA(C0=__builtin_amdgcn_mfma_f32_32x32x16_bf16(kf[2],qr[1],C0,0,0,0),   P0[10],P0[11],P0[12],P0[13], pw1[0]=PKW(P0,8), pw1[1]=PKW(P0,10), pw1); \
    VRD(5); SBAR(); GAPA(C1=__builtin_amdgcn_mfma_f32_32x32x16_bf16(kf[3],qr[1],C1,0,0,0),   P0[14],P0[15],P1[0],P1[1],   pw1[2]=PKW(P0,12),pw1[3]=PKW(P0,14), pw1); \
    VRD(2); SBAR(); GAPA(C0=__builtin_amdgcn_mfma_f32_32x32x16_bf16(kf[4],qr[2],C0,0,0,0),   P1[2],P1[3],P1[4],P1[5],     pw2[0]=PKW(P1,0), pw2[1]=PKW(P1,2), pw2); \
    VRD(6); SBAR(); GAPA(C1=__builtin_amdgcn_mfma_f32_32x32x16_bf16(kf[5],qr[2],C1,0,0,0),   P1[6],P1[7],P1[8],P1[9],     pw2[2]=PKW(P1,4), pw2[3]=PKW(P1,6), pw2); \
    VRD(3); SBAR(); GAPA(C0=__builtin_amdgcn_mfma_f32_32x32x16_bf16(kf[6],qr[3],C0,0,0,0),   P1[10],P1[11],P1[12],P1[13], pw3[0]=PKW(P1,8), pw3[1]=PKW(P1,10), pw3); \
    VRD(7); SBAR(); GAPA(C1=__builtin_amdgcn_mfma_f32_32x32x16_bf16(kf[7],qr[3],C1,0,0,0),   P1[14],P1[15],0.f,0.f,       pw3[2]=PKW(P1,12),pw3[3]=PKW(P1,14), pw3); \
    l_reg+=sacc; \
    if(GK){DMA_K((t)+3,sl_cur);} if(GV){DMA_V((t)+1,sl_next);} \
    CMASK(C0,C1,t); \
    { float a_=MX3(C0[0],C0[1],C1[0]),b_=MX3(C0[2],C0[3],C1[1]); a_=MX3(a_,C1[2],C1[3]); \
      _Pragma("unroll") for(int r=4;r<16;r+=4){a_=MX3(a_,C0[r],C0[r+1]);b_=MX3(b_,C0[r+2],C0[r+3]);a_=MX3(a_,C1[r],C1[r+1]);b_=MX3(b_,C1[r+2],C1[r+3]);} \
      float rm=__builtin_fmaxf(a_,b_); { auto rr=__builtin_amdgcn_permlane32_swap(__float_as_uint(rm),__float_as_uint(rm),false,false); rm=__builtin_fmaxf(__uint_as_float(rr[0]),__uint_as_float(rr[1])); } \
      resc=false; \
      if(__builtin_expect(__any(rm>(float)THRL),0)){ const float dl=__builtin_fmaxf(rm,0.f); mhat+=dl; \
        _Pragma("unroll") for(int r=0;r<16;++r){C0[r]-=dl;C1[r]-=dl;} \
        if constexpr(!MASKED){ _Pragma("unroll") for(int r=0;r<16;++r)negm[r]=-mhat; asm volatile("":"+v"(negm)); } \
        const float f=__builtin_amdgcn_exp2f(-dl); l_reg*=f; if(hi==0)wsf[r32]=f; resc=true; } } \
    SBAR(); \
    GAPB(o[0]=__builtin_amdgcn_mfma_f32_32x32x16_bf16(PAF(0),VFR(0),o[0],0,0,0), C0,0); \
    GAPB(o[1]=__builtin_amdgcn_mfma_f32_32x32x16_bf16(PAF(0),VFR(4),o[1],0,0,0), C0,4); \
    KRD(GL,0); GAPB(o[0]=__builtin_amdgcn_mfma_f32_32x32x16_bf16(PAF(1),VFR(1),o[0],0,0,0), C0,8); \
    KRD(GL,1); GAPB(o[1]=__builtin_amdgcn_mfma_f32_32x32x16_bf16(PAF(1),VFR(5),o[1],0,0,0), C0,12); \
    KRD(GL,2); GAPB(o[0]=__builtin_amdgcn_mfma_f32_32x32x16_bf16(PAF(2),VFR(2),o[0],0,0,0), C1,0); \
    KRD(GL,3); GAPB(o[1]=__builtin_amdgcn_mfma_f32_32x32x16_bf16(PAF(2),VFR(6),o[1],0,0,0), C1,4); \
    GAPB(o[0]=__builtin_amdgcn_mfma_f32_32x32x16_bf16(PAF(3),VFR(3),o[0],0,0,0), C1,8); \
    GAPB(o[1]=__builtin_amdgcn_mfma_f32_32x32x16_bf16(PAF(3),VFR(7),o[1],0,0,0), C1,12); \
    }while(0)
  int t=1;
  for(;t+5<NT;t+=2){
    STEP(pB0,pB1,pA0,pA1,t,true,true,true);     WAIT_BAR(2); RESC(); ROT();
    STEP(pA0,pA1,pB0,pB1,t+1,true,true,true);   WAIT_BAR(2); RESC(); ROT();
  }
  #define ENDW(tt) do{ if((tt)+3<NT){WAIT_BAR(2);} else if((tt)+2<NT){WAIT_BAR(1);} else {WAIT_BAR(0);} }while(0)
  for(;t+1<NT;t+=2){
    STEP(pB0,pB1,pA0,pA1,t,(t+3<NT),(t+1<NT),(t+1<NT));       ENDW(t);   RESC(); ROT();
    STEP(pA0,pA1,pB0,pB1,t+1,(t+4<NT),(t+2<NT),(t+2<NT));     ENDW(t+1); RESC(); ROT();
  }
  STEP(pB0,pB1,pA0,pA1,NT-1,false,false,false); RESC();
  { float sacc=pB0[0]+pB0[1]; _Pragma("unroll") for(int r=2;r<16;++r)sacc+=pB0[r]; _Pragma("unroll") for(int r=0;r<16;++r)sacc+=pB1[r]; l_reg+=sacc;
    pw0=(u32x4){PKW(pB0,0),PKW(pB0,2),PKW(pB0,4),PKW(pB0,6)};pw1=(u32x4){PKW(pB0,8),PKW(pB0,10),PKW(pB0,12),PKW(pB0,14)};pw2=(u32x4){PKW(pB1,0),PKW(pB1,2),PKW(pB1,4),PKW(pB1,6)};pw3=(u32x4){PKW(pB1,8),PKW(pB1,10),PKW(pB1,12),PKW(pB1,14)};
    SBAR(); pv(o,vb0+sl_cur,PAF(0),PAF(1),PAF(2),PAF(3)); }
  #undef PKW
  #undef PAF
  #undef VFR
  #undef PIN
  #undef MX3
  #undef GAPA
  #undef GAPB
  #undef EX
  #undef VRD
  #undef KRD
  #undef STEP
  #undef ENDW
  {auto rr=__builtin_amdgcn_permlane32_swap(__float_as_uint(l_reg),__float_as_uint(l_reg),false,false);l_reg=__uint_as_float(rr[0])+__uint_as_float(rr[1]);}
  if(hi==0)wsf[32+r32]=l_reg;asm volatile("s_waitcnt lgkmcnt(0)":::"memory");
  float rli[16];
  #pragma unroll
  for(int r=0;r<16;++r)rli[r]=__builtin_amdgcn_rcpf(wsf[32+crow(r,hi)]);
  AGAS bf16*Ow=a.O+(long)(wid*QBLK)*OP;
  { bf16*stg=(bf16*)(shm+LDS_OST)+wid*2048;
    #pragma unroll
    for(int r=0;r<16;++r){const int orow=crow(r,hi);
      #pragma unroll
      for(int d0=0;d0<2;++d0)stg[orow*64+d0*32+r32]=__float2bfloat16(o[d0][r]*rli[r]);}
    asm volatile("s_waitcnt lgkmcnt(0)":::"memory");
    #pragma unroll
    for(int i=0;i<4;++i){const int row=i*8+(lane>>3),ch=lane&7; const u32x4 v=*(const u32x4*)(stg+row*64+ch*8); ATTN_STORE16(Ow+(long)row*OP+ch*8,v);} }
  asm volatile("s_waitcnt lgkmcnt(0)\n\ts_barrier":::"memory");
  #undef KROW
  #undef DMA_K
  #undef DMA_V
  #undef CMASK
  #undef START
  #undef RESC
  #undef ROT
}
#undef SBAR
#undef WAIT_BAR
}
constexpr int NWAVES = 8, NTHR = 512;
constexpr int DM = 1024, NBATCH = 4, SEQ = 4096, CTXL = 256, RPB = SEQ + CTXL  , MROWS = NBATCH * RPB  , NLAYER = 2;
constexpr int PW = 4352;
constexpr int C_GQ = 0, C_GK = 512, C_GV = 640, C_NQ = 768, C_NK = 1280, C_NV = 1792, C_F = 2304, C_CA = 3328, C_CB = 3840, C_G = 4352;
constexpr int YW = 2048;
constexpr int INW = 7936;
constexpr int NEXP = 16, EFF = 512, MOE_ROWS = 38912  ;
constexpr float EPS = 1e-6f, LOG2E = 1.4426950408889634f;
constexpr float QSCALE = 0.125f * LOG2E;
constexpr size_t MiB = 1u << 20;
constexpr size_t WS_CTL = 0, CTL_ZERO_BYTES = 1 * MiB;
constexpr size_t WS_MODV = 1 * MiB;
constexpr size_t WS_ROPE = 1 * MiB + 384 * 1024;
constexpr size_t WS_TOKE = 2 * MiB, WS_TOKW = WS_TOKE + 160 * 1024, WS_TOKR = WS_TOKW + 160 * 1024, WS_TOKS = WS_TOKR + 160 * 1024;
constexpr size_t WS_XC = 4 * MiB;
constexpr size_t WS_WIN = 8 * MiB;
constexpr size_t WS_WB = 25 * MiB;
constexpr size_t WS_WO = 29 * MiB;
constexpr size_t WS_WGU = 32 * MiB;
constexpr size_t WS_WD = 64 * MiB;
constexpr size_t WS_H = 80 * MiB;
constexpr size_t WS_Y = 114 * MiB;
constexpr size_t WS_TP = 182 * MiB;
constexpr size_t WS_P = 214 * MiB;
constexpr size_t WS_GN = WS_P + 145 * MiB;
constexpr size_t WS_AM = WS_P, WS_HM = WS_P + 76 * MiB, WS_OM = WS_P + 114 * MiB;
constexpr size_t WS_END = 495 * MiB;
static_assert(WS_WIN + (size_t)PW * DM * 2 <= WS_WB && WS_P + (size_t)MROWS * PW * 2 <= WS_GN && WS_GN + (size_t)68 * 16 * 65536 * 2 <= WS_END && WS_OM + (size_t)MOE_ROWS * DM * 2 <= WS_END, "ws map");
constexpr int CW_BAR = 4096;
constexpr int CW_CNT = 16384;
constexpr int RING_OFF = 0, RING_BYTES = 131072;
constexpr int LDSCTL_OFF = RING_BYTES, MISC_OFF = LDSCTL_OFF + 320;
constexpr int LDS_BYTES = 147456;

#define GAS __attribute__((address_space(1)))
#define LAS __attribute__((address_space(3)))
typedef unsigned short bf16;
typedef unsigned v4u __attribute__((ext_vector_type(4)));
typedef unsigned v2u __attribute__((ext_vector_type(2)));
typedef float f32x4 __attribute__((ext_vector_type(4)));
typedef GAS unsigned gu32;
#define RLX_AGENT __ATOMIC_RELAXED, __HIP_MEMORY_SCOPE_AGENT
#define LDS_WAIT() asm volatile("s_waitcnt lgkmcnt(0)" ::: "memory")
__device__ __forceinline__ unsigned f2bf(float f) { unsigned u = __builtin_bit_cast(unsigned, f); return (u + 0x7fffu + ((u >> 16) & 1u)) >> 16; }
__device__ __forceinline__ unsigned pk2(float lo, float hi) { return f2bf(lo) | (f2bf(hi) << 16); }
__device__ __forceinline__ float bf_lo(unsigned w) { return __uint_as_float(w << 16); }
__device__ __forceinline__ float bf_hi(unsigned w) { return __uint_as_float(w & 0xffff0000u); }
__device__ __forceinline__ float bf1(bf16 v) { return __uint_as_float(((unsigned)v) << 16); }
__device__ __forceinline__ float sigm(float x) { return 1.0f / (1.0f + __expf(-x)); }

#define XB_TMO      128
#define XB_XCNT(j)  (256  + 64 * (j))
#define XB_XSUB(j)  (1280 + 64 * (j))
#define XB_XGEN(j)  (2304 + 64 * (j))
#define XB_TOP      3328
#define XB_TOPGEN   3392
#define XCD_BAR_WORDS 3456
#define XB_SPIN_CAP (1u << 18)
__device__ __forceinline__ unsigned xb_ld(unsigned* p)              { return __hip_atomic_load(p, __ATOMIC_RELAXED, __HIP_MEMORY_SCOPE_AGENT); }
__device__ __forceinline__ unsigned xb_add(unsigned* p, unsigned v) { return __hip_atomic_fetch_add(p, v, __ATOMIC_RELAXED, __HIP_MEMORY_SCOPE_AGENT); }
__device__ __forceinline__ unsigned xb_xcc_id() { return (unsigned)__builtin_amdgcn_s_getreg((3 << 11) | 20) & 0xFu; }
#define XB_SPIN(cond, bar) do { unsigned _sp = 0; while (cond) { __builtin_amdgcn_s_sleep(1); \
    if ((++_sp & 255u) == 0u) { if (xb_ld(&(bar)[XB_TMO])) break; if (_sp > XB_SPIN_CAP) { atomicAdd(&(bar)[XB_TMO], 1u); break; } } } } while (0)
struct XcdBarrier { unsigned* bar; unsigned x; volatile LAS unsigned* st; };
__device__ __forceinline__ XcdBarrier xcd_barrier_post(unsigned* bar, volatile LAS unsigned* st) {
    XcdBarrier b; b.bar = bar; b.x = xb_xcc_id(); b.st = st;
    if (threadIdx.x == 0) (void)xb_add(&bar[XB_XCNT(b.x)], 1u);
    return b;
}
__device__ __forceinline__ void xcd_barrier_complete(unsigned* bar, unsigned x, unsigned& nloc, unsigned& nx) {
    const unsigned G = gridDim.x * gridDim.y * gridDim.z;
    unsigned sum, cnt, mine, sp = 0u;
    for (;;) {
        sum = 0u; cnt = 0u; mine = 0u;
#pragma unroll
        for (unsigned j = 0; j < 16; ++j) { const unsigned c = xb_ld(&bar[XB_XCNT(j)]); sum += c; cnt += (c > 0u) ? 1u : 0u; mine = (j == x) ? c : mine; }
        if (sum == G) break;
        __builtin_amdgcn_s_sleep(1);
        if ((++sp & 255u) == 0u) { if (xb_ld(&bar[XB_TMO])) break; if (sp > XB_SPIN_CAP) { atomicAdd(&bar[XB_TMO], 1u); break; } }
    }
    nloc = mine > 0u ? mine : 1u; nx = cnt > 0u ? cnt : 1u;
}
__device__ __forceinline__ void xcd_barrier(const XcdBarrier& b) {
    asm volatile("s_waitcnt vmcnt(0)" ::: "memory");
    __syncthreads();
    if (threadIdx.x == 0) {
        unsigned* bar = b.bar;
        __builtin_amdgcn_s_waitcnt(0);
        unsigned nloc = b.st[0], nx = b.st[1];
        if (nloc == 0u) { xcd_barrier_complete(bar, b.x, nloc, nx); b.st[0] = nloc; b.st[1] = nx; }
        const unsigned old = xb_add(&bar[XB_XSUB(b.x)], 1u);
        const unsigned gen = old / nloc;
        if (old + 1u == (gen + 1u) * nloc) {
            __builtin_amdgcn_fence(__ATOMIC_RELEASE, "agent");
            asm volatile("s_waitcnt vmcnt(0)" ::: "memory");
            const unsigned og = xb_add(&bar[XB_TOP], 1u);
            const unsigned tg = og / nx;
            if (og + 1u == (tg + 1u) * nx) xb_add(&bar[XB_TOPGEN], 1u);
            else XB_SPIN(xb_ld(&bar[XB_TOPGEN]) == tg, bar);
            __builtin_amdgcn_fence(__ATOMIC_ACQUIRE, "agent");
            xb_add(&bar[XB_XGEN(b.x)], 1u);
            asm volatile("s_waitcnt vmcnt(0)" ::: "memory");
        } else {
            XB_SPIN(xb_ld(&bar[XB_XGEN(b.x)]) == gen, bar);
            __builtin_amdgcn_fence(__ATOMIC_ACQUIRE, "agent");
            asm volatile("s_waitcnt vmcnt(0)" ::: "memory");
        }
    }
    __syncthreads();
}

struct Frame {
    LAS unsigned char* lds; volatile LAS unsigned* MISC; LAS unsigned* LCTL;
    gu32* ctl; unsigned char* ws; GAS float* out; int tid, lane, wave, vcu, G;
};
constexpr int PTR_OFF = LDSCTL_OFF + 96;
__device__ __forceinline__ const GAS float* INP(const Frame& F, int i) {
    const LAS unsigned* t = (const LAS unsigned*)(F.lds + PTR_OFF) + 2 * i;
    const unsigned lo = __builtin_amdgcn_readfirstlane(t[0]), hi = __builtin_amdgcn_readfirstlane(t[1]);
    return (const GAS float*)(((unsigned long long)hi << 32) | lo);
}
__device__ __forceinline__ float shx(float v, int m, int lane) { return __builtin_bit_cast(float, __builtin_amdgcn_ds_bpermute((lane ^ m) << 2, __builtin_bit_cast(int, v))); }
__device__ __forceinline__ float wave_sum(float v, int lane) {
#pragma unroll
    for (int o = 1; o < 64; o <<= 1) v += shx(v, o, lane);
    return v;
}
__device__ __forceinline__ const GAS float* xrow_in(const Frame& F, int row) { const int b = row / RPB, t = row % RPB; return t < SEQ ? INP(F, 0) + ((size_t)b * SEQ + t) * DM : INP(F, 2) + ((size_t)b * CTXL + (t - SEQ)) * DM; }
__device__ __forceinline__ GAS float* xrow_ws(const Frame& F, int row) { const int b = row / RPB, t = row % RPB; return t < SEQ ? F.out + ((size_t)b * SEQ + t) * DM : ((GAS float*)(F.ws + WS_XC)) + ((size_t)b * CTXL + (t - SEQ)) * DM; }
__device__ __forceinline__ int modidx(int row) { const int b = row / RPB, t = row % RPB; return t < SEQ ? b : 4; }

__device__ __forceinline__ void tr_item(const GAS float* W, int ldw, int k0, int n0, GAS bf16* WT, int ldt, int drow0, int dcol0, LAS float* scr, int lane) {
    f32x4 t[8];
#pragma unroll
    for (int i = 0; i < 8; ++i) t[i] = *(const GAS f32x4*)(W + (size_t)(k0 + 8 * i + (lane >> 3)) * ldw + n0 + 4 * (lane & 7));
#pragma unroll
    for (int i = 0; i < 8; ++i) { LAS float* d = scr + (8 * i + (lane >> 3)) * 33 + 4 * (lane & 7); d[0] = t[i].x; d[1] = t[i].y; d[2] = t[i].z; d[3] = t[i].w; }
    LDS_WAIT(); asm volatile("" ::: "memory");
    const int c = lane & 7;
#pragma unroll
    for (int j = 0; j < 4; ++j) { const int n = (lane >> 3) + 8 * j; const LAS float* s = scr + (8 * c) * 33 + n;
        v4u o; o.x = pk2(s[0 * 33], s[1 * 33]); o.y = pk2(s[2 * 33], s[3 * 33]); o.z = pk2(s[4 * 33], s[5 * 33]); o.w = pk2(s[6 * 33], s[7 * 33]);
        *(GAS v4u*)(WT + (size_t)(drow0 + n) * ldt + dcol0 + 8 * c) = o; }
    LDS_WAIT(); asm volatile("" ::: "memory");
}
__device__ __forceinline__ void convert_weights(Frame& F, int l) {
    LAS float* scr = (LAS float*)(F.lds + RING_OFF + F.wave * 16384);
    const int gw = F.vcu * NWAVES + F.wave, NGW = F.G * NWAVES;
    constexpr int I_IN = 16 * (INW / 32), I_BR = 4 * 8 * 32, I_O = 16 * 32, I_GU = 16 * 16 * 32, I_D = 16 * 8 * 32;
    constexpr int NITEMS = I_IN + I_BR + I_O + I_GU + I_D;
    for (int it = gw; it < NITEMS; it += NGW) {
        int r = it;
        if (r < I_IN) { const int nblk = INW / 32, kb = r / nblk, nb = r % nblk, n0 = 32 * nb;
            if (n0 >= 2304 && n0 < 2816) continue;
            const int drow = n0 < 2304 ? n0 : n0 + 512;
            tr_item(INP(F, 8) + (size_t)l * DM * INW, INW, 64 * kb, n0, ((GAS bf16*)(F.ws + WS_WIN)), DM, drow, 64 * kb, scr, F.lane); continue; } r -= I_IN;
        if (r < I_BR) { const int nbr = r / 256, q = r % 256, kb = q / 32, nb = q % 32;
            tr_item(INP(F, 15) + ((size_t)l * 4 + nbr) * 512 * DM, DM, 64 * kb, 32 * nb, ((GAS bf16*)(F.ws + WS_WB)), 2048, 32 * nb, nbr * 512 + 64 * kb, scr, F.lane); continue; } r -= I_BR;
        if (r < I_O) { const int kb = r / 32, nb = r % 32;
            tr_item(INP(F, 16) + (size_t)l * DM * DM, DM, 64 * kb, 32 * nb, ((GAS bf16*)(F.ws + WS_WO)), DM, 32 * nb, 64 * kb, scr, F.lane); continue; } r -= I_O;
        if (r < I_GU) { const int e = r / 512, q = r % 512, kb = q / 32, nb = q % 32, n0 = 32 * nb;
            const int drow = n0 < 512 ? (n0 / 128) * 256 + (n0 % 128) : ((n0 - 512) / 128) * 256 + 128 + ((n0 - 512) % 128);
            tr_item(INP(F, 19) + ((size_t)l * NEXP + e) * DM * DM, DM, 64 * kb, n0, ((GAS bf16*)(F.ws + WS_WGU)) + (size_t)e * DM * DM, DM, drow, 64 * kb, scr, F.lane); continue; } r -= I_GU;
        { const int e = r / 256, q = r % 256, kb = q / 32, nb = q % 32;
            tr_item(INP(F, 20) + ((size_t)l * NEXP + e) * EFF * DM, DM, 64 * kb, 32 * nb, ((GAS bf16*)(F.ws + WS_WD)) + (size_t)e * DM * EFF, EFF, 32 * nb, 64 * kb, scr, F.lane); }
    }
    __syncthreads();
    LAS float* wt = (LAS float*)(F.lds + RING_OFF);
    LAS float* tab = (LAS float*)(F.lds + RING_OFF + 32768);
    if (F.tid < 128) { float s, c; sincospif((float)F.tid * (1.0f / 64.0f), &s, &c); tab[2 * F.tid] = c; tab[2 * F.tid + 1] = s; }
    for (int u = F.vcu; u < 64; u += F.G) {
        const int kt = u >> 2, g = u & 3;
        __syncthreads();
#pragma unroll
        for (int i = 0; i < 16; ++i) { const int idx = i * 512 + F.tid, kk = idx >> 7, c = idx & 127; wt[idx] = INP(F, 8)[(size_t)l * DM * INW + (size_t)(kt * 64 + kk) * INW + 2304 + g * 128 + c]; }
        __syncthreads();
        const int kc = F.tid & 127, kq = F.tid >> 7;
        float aA[16], aB[16];
#pragma unroll
        for (int i = 0; i < 16; ++i) { aA[i] = 0.f; aB[i] = 0.f; }
        for (int c = 0; c < 128; ++c) { const int ti = (c * kc) & 127; const float cs = tab[2 * ti], sn = tab[2 * ti + 1];
#pragma unroll
            for (int i = 0; i < 16; ++i) { const float w = wt[(kq * 16 + i) * 128 + c]; aA[i] += w * cs; aB[i] += w * sn; } }
        GAS bf16* ra = ((GAS bf16*)(F.ws + WS_WIN)) + (size_t)(2304 + g * 128 + kc) * DM + kt * 64 + kq * 16; GAS bf16* rb = ra + (size_t)512 * DM;
        v4u o; o.x = pk2(aA[0], aA[1]); o.y = pk2(aA[2], aA[3]); o.z = pk2(aA[4], aA[5]); o.w = pk2(aA[6], aA[7]); *(GAS v4u*)ra = o;
        o.x = pk2(aA[8], aA[9]); o.y = pk2(aA[10], aA[11]); o.z = pk2(aA[12], aA[13]); o.w = pk2(aA[14], aA[15]); *(GAS v4u*)(ra + 8) = o;
        o.x = pk2(aB[0], aB[1]); o.y = pk2(aB[2], aB[3]); o.z = pk2(aB[4], aB[5]); o.w = pk2(aB[6], aB[7]); *(GAS v4u*)rb = o;
        o.x = pk2(aB[8], aB[9]); o.y = pk2(aB[10], aB[11]); o.z = pk2(aB[12], aB[13]); o.w = pk2(aB[14], aB[15]); *(GAS v4u*)(rb + 8) = o;
    }
    __syncthreads();
}
__device__ __forceinline__ void mod_vectors(Frame& F) {
    LAS float* sc = (LAS float*)(F.lds + RING_OFF);
    LAS float* part = (LAS float*)(F.lds + RING_OFF + 32768);
    if (F.vcu == 0) for (int i = F.tid; i < 1024; i += NTHR) { const float invf = exp2f(-(float)(i & 15) * (13.287712379549449f / 16.0f)); float sn, cs; sincosf((float)(i >> 4) * invf, &sn, &cs);
        ((GAS float*)(F.ws + WS_ROPE))[2 * i] = cs; ((GAS float*)(F.ws + WS_ROPE))[2 * i + 1] = sn; }
    for (int i = F.tid; i < 5 * DM; i += NTHR) { const float v = i < 4 * DM ? INP(F, 1)[i] : INP(F, 3)[i - 4 * DM]; sc[i] = v * sigm(v); }
    __syncthreads();
    for (int u = F.vcu; u < 2 * 96; u += F.G) {
        const int l = u / 96, j = (u % 96) * 64 + F.lane;
        const GAS float* wp = INP(F, 4) + (size_t)l * DM * 6144 + (size_t)(F.wave * 128) * 6144 + j;
        float a0 = 0.f, a1 = 0.f, a2 = 0.f, a3 = 0.f, a4 = 0.f;
#pragma unroll 8
        for (int kk = 0; kk < 128; ++kk) { const float w = wp[(size_t)kk * 6144]; const int k = F.wave * 128 + kk;
            a0 += sc[k] * w; a1 += sc[DM + k] * w; a2 += sc[2 * DM + k] * w; a3 += sc[3 * DM + k] * w; a4 += sc[4 * DM + k] * w; }
        part[(F.wave * 5 + 0) * 64 + F.lane] = a0; part[(F.wave * 5 + 1) * 64 + F.lane] = a1; part[(F.wave * 5 + 2) * 64 + F.lane] = a2; part[(F.wave * 5 + 3) * 64 + F.lane] = a3; part[(F.wave * 5 + 4) * 64 + F.lane] = a4;
        __syncthreads();
        if (F.tid < 320) { const int bp = F.tid >> 6, ln = F.tid & 63; float s = 0.f;
#pragma unroll
            for (int w = 0; w < 8; ++w) s += part[(w * 5 + bp) * 64 + ln];
            const int jj = (u % 96) * 64 + ln; ((GAS float*)(F.ws + WS_MODV))[((size_t)l * 5 + bp) * 6144 + jj] = s + INP(F, 5)[(size_t)l * 6144 + jj]; }
        __syncthreads();
    }
}
__device__ __forceinline__ void norm_mod(f32x4 (&v)[4], const GAS float* g, const GAS float* sc, const GAS float* sh, int lane) {
    float ss = 0.f;
#pragma unroll
    for (int j = 0; j < 4; ++j) ss += (v[j].x * v[j].x + v[j].y * v[j].y) + (v[j].z * v[j].z + v[j].w * v[j].w);
    const float rstd = 1.0f / sqrtf(wave_sum(ss, lane) * (1.0f / DM) + EPS);
#pragma unroll
    for (int j = 0; j < 4; ++j) { const int c = 4 * lane + 256 * j; const f32x4 gg = *(const f32x4*)(g + c), s1 = *(const f32x4*)(sc + c), s0 = *(const f32x4*)(sh + c);
        v[j] = v[j] * rstd * gg * (s1 + 1.0f) + s0; }
}
__device__ __forceinline__ void store_bf16_row(GAS bf16* orow, const f32x4 (&v)[4], int lane) {
#pragma unroll
    for (int j = 0; j < 4; ++j) { v2u w; w.x = pk2(v[j].x, v[j].y); w.y = pk2(v[j].z, v[j].w); *(GAS v2u*)(orow + 4 * lane + 256 * j) = w; }
}
__device__ __forceinline__ void load_row(f32x4 (&v)[4], const GAS float* xr, int lane) {
#pragma unroll
    for (int j = 0; j < 4; ++j) v[j] = *(const GAS f32x4*)(xr + 4 * lane + 256 * j);
}
__device__ __forceinline__ void phase_norm1_first(Frame& F) {
    const int gw = F.vcu * NWAVES + F.wave, NGW = F.G * NWAVES; const GAS float* mv = ((GAS float*)(F.ws + WS_MODV)); const GAS float* g1 = INP(F, 6);
    for (int row = gw; row < MROWS; row += 2 * NGW) { const int row2 = row + NGW; const bool has2 = row2 < MROWS;
        f32x4 v[4], v2[4]; load_row(v, xrow_in(F, row), F.lane); if (has2) load_row(v2, xrow_in(F, row2), F.lane);
        { const GAS float* m = mv + (size_t)modidx(row) * 6144; norm_mod(v, g1, m + 1024, m, F.lane); store_bf16_row(((GAS bf16*)(F.ws + WS_H)) + (size_t)row * DM, v, F.lane); }
        if (has2) { const GAS float* m = mv + (size_t)modidx(row2) * 6144; norm_mod(v2, g1, m + 1024, m, F.lane); store_bf16_row(((GAS bf16*)(F.ws + WS_H)) + (size_t)row2 * DM, v2, F.lane); } }
}
__device__ __forceinline__ void phase_qkrope(Frame& F, int l) {
    const int gw = F.vcu * NWAVES + F.wave, NGW = F.G * NWAVES; const int lane = F.lane, i = lane & 31;
    const GAS float* rope = (const GAS float*)(F.ws + WS_ROPE) + 2 * (i & 15);
    const float qg0 = INP(F, 9)[l * 64 + 2 * i], qg1 = INP(F, 9)[l * 64 + 2 * i + 1], kg0 = INP(F, 10)[l * 64 + 2 * i], kg1 = INP(F, 10)[l * 64 + 2 * i + 1];
    for (int row = gw; row < MROWS; row += NGW) {
        const int t = row % RPB; const bool lat = t < SEQ; GAS bf16* pr = ((GAS bf16*)(F.ws + WS_P)) + (size_t)row * PW;
        float cs = 1.f, sn = 0.f;
        if (lat) { const int pos = (i < 16) ? (t >> 6) : (t & 63); cs = rope[pos * 32]; sn = rope[pos * 32 + 1]; }
#pragma unroll
        for (int it = 0; it < 5; ++it) { const int hh = 2 * it + (lane >> 5); const int col = (hh < 8 ? hh * 64 : C_GK + (hh - 8) * 64) + 2 * i;
            const unsigned w = *(const GAS unsigned*)(pr + col); float x1 = bf_lo(w), x2 = bf_hi(w);
            float ss = x1 * x1 + x2 * x2;
            ss += shx(ss, 1, lane); ss += shx(ss, 2, lane); ss += shx(ss, 4, lane); ss += shx(ss, 8, lane); ss += shx(ss, 16, lane);
            const float rstd = __builtin_amdgcn_rsqf(ss * (1.0f / 64.0f) + EPS);
            x1 = x1 * rstd * (hh < 8 ? qg0 : kg0); x2 = x2 * rstd * (hh < 8 ? qg1 : kg1);
            float y1 = x1 * cs - x2 * sn, y2 = x1 * sn + x2 * cs;
            if (hh < 8) { y1 *= QSCALE; y2 *= QSCALE; }
            *(GAS unsigned*)(pr + col) = pk2(y1, y2); }
        { const v4u w = *(const GAS v4u*)(pr + C_NQ + 8 * lane); v4u o;
          o.x = pk2(bf_lo(w.x) * QSCALE, bf_hi(w.x) * QSCALE); o.y = pk2(bf_lo(w.y) * QSCALE, bf_hi(w.y) * QSCALE); o.z = pk2(bf_lo(w.z) * QSCALE, bf_hi(w.z) * QSCALE); o.w = pk2(bf_lo(w.w) * QSCALE, bf_hi(w.w) * QSCALE);
          *(GAS v4u*)(pr + C_NQ + 8 * lane) = o; }
    }
}
__device__ __forceinline__ void phase_conv(Frame& F, int l) {
    LAS float* zl = (LAS float*)(F.lds + RING_OFF);
    LAS float* red = (LAS float*)(F.lds + RING_OFF + 62 * 512 * 4);
    const int ch = F.tid; const int nchunk = (l == 0) ? 136 : 128;
    float w[31];
#pragma unroll
    for (int j = 0; j < 31; ++j) w[j] = INP(F, 12)[((size_t)l * 31 + j) * 512 + ch];
    const float cb = INP(F, 13)[l * 512 + ch], cg = INP(F, 14)[l * 512 + ch];
    const GAS bf16* P = ((GAS bf16*)(F.ws + WS_P)); GAS bf16* Y = ((GAS bf16*)(F.ws + WS_Y));
    for (int u = F.vcu; u < NBATCH * nchunk; u += F.G) {
        const int b = u / nchunk, c = u % nchunk; const bool lat = c < 128;
        const int seq0 = b * RPB + (lat ? 0 : SEQ), slen = lat ? SEQ : CTXL, t0 = 32 * (lat ? c : c - 128);
        __syncthreads();
#pragma unroll
        for (int it = 0; it < 8; ++it) { const int item = it * 512 + F.tid;
            if (item < 62 * 64) { const int i = item >> 6, cgp = item & 63; const int t = t0 - 15 + i; f32x4 z0 = {0.f, 0.f, 0.f, 0.f}, z1 = {0.f, 0.f, 0.f, 0.f};
                if (t >= 0 && t < slen) { const GAS bf16* pr = P + (size_t)(seq0 + t) * PW; const v4u a = *(const GAS v4u*)(pr + C_CA + 8 * cgp), g = *(const GAS v4u*)(pr + C_CB + 8 * cgp);
                    z0.x = bf_lo(a.x) * sigm(bf_lo(g.x)); z0.y = bf_hi(a.x) * sigm(bf_hi(g.x)); z0.z = bf_lo(a.y) * sigm(bf_lo(g.y)); z0.w = bf_hi(a.y) * sigm(bf_hi(g.y));
                    z1.x = bf_lo(a.z) * sigm(bf_lo(g.z)); z1.y = bf_hi(a.z) * sigm(bf_hi(g.z)); z1.z = bf_lo(a.w) * sigm(bf_lo(g.w)); z1.w = bf_hi(a.w) * sigm(bf_hi(g.w)); }
                *(LAS f32x4*)(zl + i * 512 + 8 * cgp) = z0; *(LAS f32x4*)(zl + i * 512 + 8 * cgp + 4) = z1; } }
        __syncthreads();
        float z[62];
#pragma unroll
        for (int i = 0; i < 62; ++i) z[i] = zl[i * 512 + ch];
        float o[32];
#pragma unroll
        for (int q = 0; q < 32; ++q) { float s = cb;
#pragma unroll
            for (int j = 0; j < 31; ++j) s += z[q + j] * w[j];
            o[q] = s; }
#pragma unroll
        for (int q = 0; q < 32; ++q) { const float s = wave_sum(o[q] * o[q], F.lane); if (F.lane == 0) red[F.wave * 32 + q] = s; }
        __syncthreads();
#pragma unroll
        for (int q = 0; q < 32; ++q) { float s = 0.f;
#pragma unroll
            for (int wv = 0; wv < 8; ++wv) s += red[wv * 32 + q];
            const float y = o[q] * (1.0f / sqrtf(s * (1.0f / 512.0f) + EPS)) * cg;
            Y[(size_t)(seq0 + t0 + q) * YW + 1536 + ch] = (bf16)f2bf(y * sigm(y)); }
    }
    __syncthreads();
}
typedef short fbf16x8 __attribute__((ext_vector_type(8)));
typedef short fs16x4 __attribute__((ext_vector_type(4)));
typedef float ff32x16 __attribute__((ext_vector_type(16)));
typedef __attribute__((address_space(3))) const char* flds_cptr;
__device__ __forceinline__ fs16x4 f_vtr(flds_cptr p) { return __builtin_bit_cast(fs16x4, __builtin_amdgcn_ds_read_tr16_b64_v4i16((__attribute__((address_space(3))) attn_body::v4i16_t*)p)); }
__device__ __forceinline__ void fourier_frags(Frame& F, fbf16x8 (&fr)[4][4]) {
    LAS float* tab = (LAS float*)(F.lds + RING_OFF);
    __syncthreads();
    if (F.tid < 64) { float s, c; sincospif((float)F.tid * (1.0f / 32.0f), &s, &c); tab[2 * F.tid] = c; tab[2 * F.tid + 1] = s; }
    __syncthreads();
    const int m = F.lane & 31, hi = F.lane >> 5;
#pragma unroll
    for (int mt = 0; mt < 4; ++mt)
#pragma unroll
        for (int g = 0; g < 4; ++g) { unsigned wv[4];
#pragma unroll
            for (int jp = 0; jp < 4; ++jp) { float v[2];
#pragma unroll
                for (int q = 0; q < 2; ++q) { const int j = 2 * jp + q; const int n = 16 * g + (j & 3) + 8 * (j >> 2) + 4 * hi; const int k = 32 * (mt & 1) + m; const int ix = (k * n) & 63; v[q] = tab[2 * ix + (mt >> 1)]; }
                wv[jp] = pk2(v[0], v[1]); }
            v4u t; t.x = wv[0]; t.y = wv[1]; t.z = wv[2]; t.w = wv[3]; fr[mt][g] = __builtin_bit_cast(fbf16x8, t); __builtin_amdgcn_sched_barrier(0); }
    __syncthreads();
}
#define F_BFRAG(dst, vp, dh) do { _Pragma("unroll") for (int g_ = 0; g_ < 4; ++g_) { const fs16x4 lo_ = f_vtr((vp) + (dh) * 4096 + g_ * 1024), hi_ = f_vtr((vp) + (dh) * 4096 + g_ * 1024 + 512); \
        dst[g_] = (fbf16x8){lo_[0], lo_[1], lo_[2], lo_[3], hi_[0], hi_[1], hi_[2], hi_[3]}; } } while (0)
__device__ __forceinline__ void glds16_so(const GAS void* sbase, unsigned voff, unsigned lds_dst) { unsigned keep;
    asm volatile("s_mov_b32 %0, m0\n\ts_mov_b32 m0, %3\n\ts_nop 0\n\tglobal_load_lds_dwordx4 %1, %2\n\ts_mov_b32 m0, %0" : "=&s"(keep) : "v"(voff), "s"(sbase), "s"(lds_dst) : "memory"); }
__device__ __forceinline__ fbf16x8 f_neg(fbf16x8 v) { v4u t = __builtin_bit_cast(v4u, v); t.x ^= 0x80008000u; t.y ^= 0x80008000u; t.z ^= 0x80008000u; t.w ^= 0x80008000u; return __builtin_bit_cast(fbf16x8, t); }
__device__ __forceinline__ void phase_fourier1(Frame& F) {
    fbf16x8 fr[4][4]; fourier_frags(F, fr);
    const int lane = F.lane, w = F.wave, r32 = lane & 31, hi = lane >> 5;
    const unsigned lds0 = (unsigned)(uintptr_t)(F.lds + RING_OFF);
    const flds_cptr vbase = (flds_cptr)(F.lds + RING_OFF) + ((lane >> 4) & 1) * 32 + (lane & 3) * 8 + (4 * hi + ((lane & 15) >> 2)) * 64;
    const GAS bf16* P = ((GAS bf16*)(F.ws + WS_P)); GAS bf16* TPb = (GAS bf16*)(F.ws + WS_TP);
    const unsigned voff0 = (unsigned)((64 * (lane >> 2)) * PW + (lane & 3) * 8) * 2u;
    for (int u = F.vcu; u < NBATCH * 64; u += F.G) {
        const int b = u >> 6, n2 = u & 63;
        const GAS bf16* base = P + (size_t)(b * RPB + n2) * PW + C_F + 64 * w;
        asm volatile("s_waitcnt lgkmcnt(0)" ::: "memory");
#pragma unroll
        for (int rg = 0; rg < 4; ++rg) { const unsigned vo = voff0 + (unsigned)rg * (unsigned)(64 * 16 * PW * 2);
            const unsigned dA = (unsigned)__builtin_amdgcn_readfirstlane(lds0 + w * 8192 + rg * 1024), dB = dA + 8 * 8192;
            glds16_so(base, vo, dA); glds16_so(base + 32, vo, dA + 4096); glds16_so(base + 512, vo, dB); glds16_so(base + 544, vo, dB + 4096); }
        asm volatile("s_waitcnt vmcnt(0)" ::: "memory");
#pragma unroll 1
        for (int dh = 0; dh < 2; ++dh) {
            fbf16x8 bA[4], nA[4], nB[4];
            F_BFRAG(bA, vbase + w * 8192, dh); F_BFRAG(nB, vbase + (8 + w) * 8192, dh);
#pragma unroll
            for (int g = 0; g < 4; ++g) { nA[g] = f_neg(bA[g]); nB[g] = f_neg(nB[g]); }
#pragma unroll
            for (int kb = 0; kb < 2; ++kb) {
                ff32x16 tr = {}, ti = {};
#pragma unroll
                for (int g = 0; g < 4; ++g) { tr = __builtin_amdgcn_mfma_f32_32x32x16_bf16(fr[kb][g], bA[g], tr, 0, 0, 0); ti = __builtin_amdgcn_mfma_f32_32x32x16_bf16(fr[kb][g], nB[g], ti, 0, 0, 0);
                    tr = __builtin_amdgcn_mfma_f32_32x32x16_bf16(fr[2 + kb][g], nB[g], tr, 0, 0, 0); ti = __builtin_amdgcn_mfma_f32_32x32x16_bf16(fr[2 + kb][g], nA[g], ti, 0, 0, 0); }
                const unsigned o0 = (unsigned)(((b * 64 + 32 * kb + 4 * hi) * 2) * 64 + n2) * 512u + 64 * w + 32 * dh + r32;
#pragma unroll
                for (int r = 0; r < 16; ++r) { const int kk = (r & 3) + 8 * (r >> 2); const int k1 = 32 * kb + kk + 4 * hi;
                    const float rev = (float)(n2 * k1) * (1.0f / 4096.0f); const float c = __builtin_amdgcn_cosf(rev), s = __builtin_amdgcn_sinf(rev);
                    const unsigned oi = o0 + (unsigned)kk * (2u * 64u * 512u);
                    TPb[oi] = (bf16)f2bf(tr[r] * c + ti[r] * s); TPb[oi + 64u * 512u] = (bf16)f2bf(ti[r] * c - tr[r] * s);
                    if ((r & 3) == 3) __builtin_amdgcn_sched_barrier(0); }
                __builtin_amdgcn_sched_barrier(0);
            }
        }
    }
}
__device__ __forceinline__ void phase_fourier2(Frame& F) {
    fbf16x8 fr[4][4]; fourier_frags(F, fr);
    const int lane = F.lane, w = F.wave, r32 = lane & 31, hi = lane >> 5;
    const unsigned lds0 = (unsigned)(uintptr_t)(F.lds + RING_OFF);
    const flds_cptr vbase = (flds_cptr)(F.lds + RING_OFF) + ((lane >> 4) & 1) * 32 + (lane & 3) * 8 + (4 * hi + ((lane & 15) >> 2)) * 64;
    const GAS bf16* TPb = (const GAS bf16*)(F.ws + WS_TP); GAS bf16* Y = ((GAS bf16*)(F.ws + WS_Y));
    const float scale = 1.0f / sqrtf(4096.0f * 128.0f);
    const unsigned voff0 = (unsigned)((lane >> 2) * 512 + (lane & 3) * 8) * 2u;
    for (int u = F.vcu; u < NBATCH * 64; u += F.G) {
        const int b = u >> 6, k1 = u & 63;
        const GAS bf16* base0 = TPb + (size_t)((b * 64 + k1) * 2) * 64 * 512 + 64 * w; const GAS bf16* base1 = base0 + 64 * 512;
        asm volatile("s_waitcnt lgkmcnt(0)" ::: "memory");
#pragma unroll
        for (int rg = 0; rg < 4; ++rg) { const unsigned vo = voff0 + (unsigned)rg * (unsigned)(16 * 512 * 2);
            const unsigned d0 = (unsigned)__builtin_amdgcn_readfirstlane(lds0 + w * 8192 + rg * 1024), d1 = d0 + 8 * 8192;
            glds16_so(base0, vo, d0); glds16_so(base0 + 32, vo, d0 + 4096); glds16_so(base1, vo, d1); glds16_so(base1 + 32, vo, d1 + 4096); }
        asm volatile("s_waitcnt vmcnt(0)" ::: "memory");
#pragma unroll
        for (int dh = 0; dh < 2; ++dh) {
            fbf16x8 b0[4], b1[4];
            F_BFRAG(b0, vbase + w * 8192, dh); F_BFRAG(b1, vbase + (8 + w) * 8192, dh);
#pragma unroll
            for (int mt = 0; mt < 2; ++mt) {
                ff32x16 acc = {};
#pragma unroll
                for (int g = 0; g < 4; ++g) { acc = __builtin_amdgcn_mfma_f32_32x32x16_bf16(fr[mt][g], b0[g], acc, 0, 0, 0); acc = __builtin_amdgcn_mfma_f32_32x32x16_bf16(fr[2 + mt][g], b1[g], acc, 0, 0, 0); }
                const unsigned y0 = (unsigned)(b * RPB + k1 + 64 * (32 * mt + 4 * hi)) * (unsigned)YW + 1024u + 64 * w + 32 * dh + r32;
#pragma unroll
                for (int r = 0; r < 16; ++r) { const int kk = (r & 3) + 8 * (r >> 2);
                    Y[y0 + (unsigned)kk * (64u * (unsigned)YW)] = (bf16)f2bf(acc[r] * scale); }
                __builtin_amdgcn_sched_barrier(0);
            }
        }
    }
}
typedef float fc_f32x2 __attribute__((ext_vector_type(2)));
__device__ __forceinline__ void phase_fourier_ctx(Frame& F) {
    LAS float* tab = (LAS float*)(F.lds + RING_OFF + 8192);
    __syncthreads();
    if (F.tid < 256) { float s, c; sincospif((float)F.tid * (1.0f / 128.0f), &s, &c); tab[2 * F.tid] = c; tab[2 * F.tid + 1] = s; }
    __syncthreads();
    const float scale = 1.0f / sqrtf(256.0f * 128.0f);
#define FC_LOAD(A_, B_, n0_) do { _Pragma("unroll") for (int i_ = 0; i_ < 16; ++i_) { A_[i_] = pcol[(size_t)((n0_) + i_) * PW]; B_[i_] = pcol[(size_t)((n0_) + i_) * PW + 512]; } } while (0)
#define FC_COMP(A_, B_, n0_) do { _Pragma("unroll") for (int i_ = 0; i_ < 16; ++i_) { const float a_ = bf1(A_[i_]), b_ = bf1(B_[i_]); _Pragma("unroll") for (int k_ = 0; k_ < 4; ++k_) { \
        const int ix_ = (((n0_) + i_) * (kb + k_)) & 255; const fc_f32x2 cs_ = *(const LAS fc_f32x2*)(tab + 2 * ix_); acc[k_] += a_ * cs_.x - b_ * cs_.y; } } } while (0)
    for (int u = F.vcu; u < NBATCH * 64; u += F.G) {
        const int b = u >> 6, kb = (u & 63) * 4;
        float acc[4] = {0.f, 0.f, 0.f, 0.f};
        const GAS bf16* pcol = ((GAS bf16*)(F.ws + WS_P)) + (size_t)(b * RPB + SEQ) * PW + C_F + F.tid;
        bf16 A0[16], B0[16], A1[16], B1[16];
        FC_LOAD(A0, B0, 0);
        for (int n0 = 0; n0 < 256; n0 += 32) {
            FC_LOAD(A1, B1, n0 + 16);
            FC_COMP(A0, B0, n0);
            if (n0 + 32 < 256) FC_LOAD(A0, B0, n0 + 32);
            FC_COMP(A1, B1, n0 + 16);
        }
        GAS bf16* yo = ((GAS bf16*)(F.ws + WS_Y)) + (size_t)(b * RPB + SEQ + kb) * YW + 1024 + F.tid;
#pragma unroll
        for (int k = 0; k < 4; ++k) yo[(size_t)k * YW] = (bf16)f2bf(acc[k] * scale);
    }
#undef FC_LOAD
#undef FC_COMP
}
#ifndef PROBE
#define PROBE 0
#endif
#define GSTAMP(i) do { if (PROBE && l == 0 && blockIdx.x == 0 && threadIdx.x == 0) ((GAS unsigned long long*)(F.ws + WS_CTL + 512 * 1024))[i] = __builtin_amdgcn_s_memrealtime(); } while (0)
struct GVecs { int cmi; f32x4 G1[4], GS[4], SH[4]; };
struct GRow { f32x4 v[4]; v2u y[4]; };
__device__ __forceinline__ void g_load(Frame& F, int l, int row, GRow& R) {
    load_row(R.v, (l == 0) ? xrow_in(F, row) : (const GAS float*)xrow_ws(F, row), F.lane);
#pragma unroll
    for (int j = 0; j < 4; ++j) R.y[j] = *(const GAS v2u*)(((const GAS bf16*)(F.ws + WS_Y)) + (size_t)row * DM + 4 * F.lane + 256 * j);
}
__device__ __forceinline__ void g_front(Frame& F, int l, int row, GRow& R, GVecs& V) {
    const int mi = modidx(row);
    if (mi != V.cmi) { V.cmi = mi; const GAS float* m = ((GAS float*)(F.ws + WS_MODV)) + (size_t)l * 5 * 6144 + (size_t)mi * 6144; const GAS float* g2 = INP(F, 7) + l * DM;
#pragma unroll
        for (int j = 0; j < 4; ++j) { const int c = 4 * F.lane + 256 * j; V.G1[j] = *(const GAS f32x4*)(m + 2 * 1024 + c); V.SH[j] = *(const GAS f32x4*)(m + 3 * 1024 + c);
            V.GS[j] = *(const GAS f32x4*)(g2 + c) * (*(const GAS f32x4*)(m + 4 * 1024 + c) + 1.0f); } }
    float ss = 0.f;
#pragma unroll
    for (int j = 0; j < 4; ++j) { f32x4 y; y.x = bf_lo(R.y[j].x); y.y = bf_hi(R.y[j].x); y.z = bf_lo(R.y[j].y); y.w = bf_hi(R.y[j].y); R.v[j] = R.v[j] + V.G1[j] * y;
        ss += (R.v[j].x * R.v[j].x + R.v[j].y * R.v[j].y) + (R.v[j].z * R.v[j].z + R.v[j].w * R.v[j].w); }
    { GAS float* xo = xrow_ws(F, row);
#pragma unroll
      for (int j = 0; j < 4; ++j) *(GAS f32x4*)(xo + 4 * F.lane + 256 * j) = R.v[j]; }
    const float rstd = 1.0f / sqrtf(wave_sum(ss, F.lane) * (1.0f / DM) + EPS);
#pragma unroll
    for (int j = 0; j < 4; ++j) R.v[j] = R.v[j] * rstd * V.GS[j] + V.SH[j];
    store_bf16_row(((GAS bf16*)(F.ws + WS_H)) + (size_t)row * DM, R.v, F.lane);
}
__device__ __forceinline__ float g_reduce16(const float (&lg)[16], int lane) {
    float r8[8], r4[4], r2[2], r1;
    { const bool up = (lane & 32) != 0;
#pragma unroll
      for (int q = 0; q < 8; ++q) { const float snd = up ? lg[q] : lg[8 + q], kp = up ? lg[8 + q] : lg[q]; r8[q] = kp + shx(snd, 32, lane); } }
    { const bool up = (lane & 16) != 0;
#pragma unroll
      for (int q = 0; q < 4; ++q) { const float snd = up ? r8[q] : r8[4 + q], kp = up ? r8[4 + q] : r8[q]; r4[q] = kp + shx(snd, 16, lane); } }
    { const bool up = (lane & 8) != 0;
#pragma unroll
      for (int q = 0; q < 2; ++q) { const float snd = up ? r4[q] : r4[2 + q], kp = up ? r4[2 + q] : r4[q]; r2[q] = kp + shx(snd, 8, lane); } }
    { const bool up = (lane & 4) != 0; const float snd = up ? r2[0] : r2[1], kp = up ? r2[1] : r2[0]; r1 = kp + shx(snd, 4, lane); }
    r1 += shx(r1, 1, lane); r1 += shx(r1, 2, lane);
    return r1;
}
typedef float g_f32x2 __attribute__((ext_vector_type(2)));
__device__ __forceinline__ void g_select(const float (&lgt)[16], const float (&rb)[16], int& bi1, int& bi2, float& w1, float& w2) {
    float sc[16], sl[16];
#pragma unroll
    for (int e = 0; e < 16; ++e) { sc[e] = __builtin_amdgcn_rcpf(1.0f + __builtin_amdgcn_exp2f(-LOG2E * lgt[e])); sl[e] = sc[e] + rb[e]; }
    float best = -INFINITY; bi1 = 0; bi2 = 1; float bs1 = 0.f, bs2 = 0.f;
#pragma unroll
    for (int g = 0; g < 4; ++g) {
        int i1 = 4 * g; float m1 = sl[4 * g];
#pragma unroll
        for (int q = 1; q < 4; ++q) if (sl[4 * g + q] > m1) { m1 = sl[4 * g + q]; i1 = 4 * g + q; }
        int i2 = -1; float m2 = -INFINITY;
#pragma unroll
        for (int q = 0; q < 4; ++q) if (4 * g + q != i1 && sl[4 * g + q] > m2) { m2 = sl[4 * g + q]; i2 = 4 * g + q; }
        float s1 = 0.f, s2 = 0.f;
#pragma unroll
        for (int q = 0; q < 4; ++q) { if (4 * g + q == i1) s1 = sc[4 * g + q]; if (4 * g + q == i2) s2 = sc[4 * g + q]; }
        const float gs = m1 + m2;
        if (gs > best) { best = gs; bi1 = i1; bi2 = i2; bs1 = s1; bs2 = s2; }
    }
    const float inv = 1.0f / (bs1 + bs2); w1 = bs1 * inv; w2 = bs2 * inv;
}
__device__ __forceinline__ void phase_norm2_router(Frame& F, int l) {
    LAS float* wr = (LAS float*)(F.lds + RING_OFF);
    LAS int* sel = (LAS int*)(F.lds + RING_OFF + 65536);
    LAS unsigned* basel = (LAS unsigned*)(F.lds + RING_OFF + 65536 + 16384);
    LAS float* lgl = (LAS float*)(F.lds + RING_OFF + 65536 + 32768);
    const int nact = (l == 0) ? MROWS : NBATCH * SEQ; const int chunk = (nact + F.G - 1) / F.G; const int a0 = F.vcu * chunk, a1 = (a0 + chunk < nact) ? a0 + chunk : nact;
    __syncthreads();
    for (int i = F.tid; i < DM * 16 / 4; i += NTHR) { const f32x4 t = ((const GAS f32x4*)INP(F, 17))[i]; const int c = i >> 2, e0 = (i & 3) * 4;
        wr[(e0 + 0) * DM + c] = t.x; wr[(e0 + 1) * DM + c] = t.y; wr[(e0 + 2) * DM + c] = t.z; wr[(e0 + 3) * DM + c] = t.w; }
    __syncthreads();
    GSTAMP(31);
    GVecs V; V.cmi = -1;
#define G_ROW(a_) ((l == 0) ? (a_) : ((a_) / SEQ) * RPB + ((a_) % SEQ))
    for (int a = a0 + F.wave; a < a1; a += 2 * NWAVES) {
        const int ab = a + NWAVES; const bool has2 = ab < a1;
        const int row = G_ROW(a), row2 = has2 ? G_ROW(ab) : row;
        GRow R0, R1; g_load(F, l, row, R0); if (has2) g_load(F, l, row2, R1); else R1 = R0;
        g_front(F, l, row, R0, V); if (has2) g_front(F, l, row2, R1, V);
        float lg0[16], lg1[16];
#pragma unroll
        for (int e = 0; e < 16; ++e) { g_f32x2 p0 = {0.f, 0.f}, p1 = {0.f, 0.f};
#pragma unroll
            for (int j = 0; j < 4; ++j) { const f32x4 ww = *(const LAS f32x4*)(wr + e * DM + 4 * F.lane + 256 * j); const g_f32x2 wl = {ww.x, ww.y}, wh = {ww.z, ww.w};
                p0 += (g_f32x2){R0.v[j].x, R0.v[j].y} * wl; p0 += (g_f32x2){R0.v[j].z, R0.v[j].w} * wh;
                p1 += (g_f32x2){R1.v[j].x, R1.v[j].y} * wl; p1 += (g_f32x2){R1.v[j].z, R1.v[j].w} * wh; }
            lg0[e] = p0.x + p0.y; lg1[e] = p1.x + p1.y; }
        const float q0 = g_reduce16(lg0, F.lane), q1 = g_reduce16(lg1, F.lane);
        if ((F.lane & 3) == 0) { lgl[(a - a0) * 16 + (F.lane >> 2)] = q0; if (has2) lgl[(ab - a0) * 16 + (F.lane >> 2)] = q1; }
    }
    __syncthreads(); GSTAMP(32);
    const int nr = a1 - a0, ns = 2 * nr;
    { float rb[16];
#pragma unroll
      for (int e = 0; e < 16; ++e) rb[e] = INP(F, 18)[e];
      for (int i = F.tid; i < nr; i += NTHR) { float lgt[16];
#pragma unroll
        for (int e4 = 0; e4 < 4; ++e4) { const f32x4 t = *(const LAS f32x4*)(lgl + i * 16 + 4 * e4); lgt[4 * e4] = t.x; lgt[4 * e4 + 1] = t.y; lgt[4 * e4 + 2] = t.z; lgt[4 * e4 + 3] = t.w; }
        int b1, b2; float w1, w2; g_select(lgt, rb, b1, b2, w1, w2); const int row = G_ROW(a0 + i);
        ((GAS int*)(F.ws + WS_TOKE))[2 * row] = b1; ((GAS int*)(F.ws + WS_TOKE))[2 * row + 1] = b2; ((GAS float*)(F.ws + WS_TOKW))[2 * row] = w1; ((GAS float*)(F.ws + WS_TOKW))[2 * row + 1] = w2;
        sel[2 * i] = b1; sel[2 * i + 1] = b2; } }
    __syncthreads();
    if (F.tid < 16) { const int e = F.tid; int n = 0;
        for (int i = 0; i < ns; ++i) n += (sel[i] == e) ? 1 : 0;
        unsigned base = 0u; if (n > 0) base = __hip_atomic_fetch_add((unsigned*)(F.ctl + CW_CNT + (l * 16 + e) * 64), (unsigned)n, RLX_AGENT);
        basel[e] = base; }
    __syncthreads();
    for (int i = F.tid; i < ns; i += NTHR) { const int e = sel[i]; int rank = 0;
        for (int j = 0; j < i; ++j) rank += (sel[j] == e) ? 1 : 0;
        const int a = a0 + (i >> 1); ((GAS int*)(F.ws + WS_TOKR))[2 * G_ROW(a) + (i & 1)] = (int)basel[e] + rank; }
#undef G_ROW
    __syncthreads();
}
__device__ __forceinline__ void moe_offsets(Frame& F, int l) {
    __syncthreads();
    if (F.tid == 0) { unsigned off = 0u;
        for (int e = 0; e < 16; ++e) { F.LCTL[e] = off; const unsigned c = __hip_atomic_load((unsigned*)(F.ctl + CW_CNT + (l * 16 + e) * 64), RLX_AGENT); off += (c + 255u) & ~255u; }
        F.LCTL[16] = off; F.LCTL[17] = off >> 8; }
    __syncthreads();
}
__device__ __forceinline__ void phase_scatter(Frame& F, int l) {
    moe_offsets(F, l);
    const int nact = (l == 0) ? MROWS : NBATCH * SEQ; const int chunk = (nact + F.G - 1) / F.G; const int a0 = F.vcu * chunk, a1 = (a0 + chunk < nact) ? a0 + chunk : nact;
    for (int a = a0 + F.wave; a < a1; a += NWAVES) {
        const int row = (l == 0) ? a : (a / SEQ) * RPB + (a % SEQ);
        const int e1 = ((GAS int*)(F.ws + WS_TOKE))[2 * row], e2 = ((GAS int*)(F.ws + WS_TOKE))[2 * row + 1];
        const int s1 = (int)F.LCTL[e1] + ((GAS int*)(F.ws + WS_TOKR))[2 * row], s2 = (int)F.LCTL[e2] + ((GAS int*)(F.ws + WS_TOKR))[2 * row + 1];
        if (F.lane == 0) { ((GAS int*)(F.ws + WS_TOKS))[2 * row] = s1; ((GAS int*)(F.ws + WS_TOKS))[2 * row + 1] = s2; }
        const GAS v4u* src = (const GAS v4u*)(((GAS bf16*)(F.ws + WS_H)) + (size_t)row * DM) + F.lane; const v4u x0 = src[0], x1 = src[64];
        GAS v4u* d1 = (GAS v4u*)(((GAS bf16*)(F.ws + WS_AM)) + (size_t)s1 * DM) + F.lane; GAS v4u* d2 = (GAS v4u*)(((GAS bf16*)(F.ws + WS_AM)) + (size_t)s2 * DM) + F.lane;
        d1[0] = x0; d1[64] = x1; d2[0] = x0; d2[64] = x1;
    }
}
struct CombRow { f32x4 v[4]; v2u p[4], q[4]; float w1, w2; };
__device__ __forceinline__ void comb_load(Frame& F, int row, CombRow& R, GAS float* xr) {
    load_row(R.v, xr, F.lane);
    const int s1 = ((GAS int*)(F.ws + WS_TOKS))[2 * row], s2 = ((GAS int*)(F.ws + WS_TOKS))[2 * row + 1]; R.w1 = ((GAS float*)(F.ws + WS_TOKW))[2 * row]; R.w2 = ((GAS float*)(F.ws + WS_TOKW))[2 * row + 1];
    const GAS bf16* o1 = ((GAS bf16*)(F.ws + WS_OM)) + (size_t)s1 * DM; const GAS bf16* o2 = ((GAS bf16*)(F.ws + WS_OM)) + (size_t)s2 * DM;
#pragma unroll
    for (int j = 0; j < 4; ++j) { const int c = 4 * F.lane + 256 * j; R.p[j] = *(const GAS v2u*)(o1 + c); R.q[j] = *(const GAS v2u*)(o2 + c); }
}
__device__ __forceinline__ void comb_finish(Frame& F, int l, int row, CombRow& R, GAS float* xr) {
    const GAS float* g2 = ((GAS float*)(F.ws + WS_MODV)) + (size_t)l * 5 * 6144 + (size_t)modidx(row) * 6144 + 5 * 1024;
#pragma unroll
    for (int j = 0; j < 4; ++j) { const int c = 4 * F.lane + 256 * j; const v2u p = R.p[j], q = R.q[j]; const f32x4 gg = *(const GAS f32x4*)(g2 + c); const float w1 = R.w1, w2 = R.w2;
        f32x4 z; z.x = w1 * bf_lo(p.x) + w2 * bf_lo(q.x); z.y = w1 * bf_hi(p.x) + w2 * bf_hi(q.x); z.z = w1 * bf_lo(p.y) + w2 * bf_lo(q.y); z.w = w1 * bf_hi(p.y) + w2 * bf_hi(q.y);
        R.v[j] = R.v[j] + gg * z; }
    if (l == 0) {
#pragma unroll
        for (int j = 0; j < 4; ++j) *(GAS f32x4*)(xr + 4 * F.lane + 256 * j) = R.v[j];
        const GAS float* m1 = ((GAS float*)(F.ws + WS_MODV)) + (size_t)5 * 6144 + (size_t)modidx(row) * 6144;
        norm_mod(R.v, INP(F, 6) + DM, m1 + 1024, m1, F.lane); store_bf16_row(((GAS bf16*)(F.ws + WS_H)) + (size_t)row * DM, R.v, F.lane);
    } else {
        float ss = 0.f;
#pragma unroll
        for (int j = 0; j < 4; ++j) ss += (R.v[j].x * R.v[j].x + R.v[j].y * R.v[j].y) + (R.v[j].z * R.v[j].z + R.v[j].w * R.v[j].w);
        const float rstd = 1.0f / sqrtf(wave_sum(ss, F.lane) * (1.0f / DM) + EPS);
#pragma unroll
        for (int j = 0; j < 4; ++j) { const int c = 4 * F.lane + 256 * j; *(GAS f32x4*)(xr + c) = R.v[j] * rstd * *(const GAS f32x4*)(INP(F, 21) + c); }
    }
}
__device__ __forceinline__ void phase_combine(Frame& F, int l) {
    const int gw = F.vcu * NWAVES + F.wave, NGW = F.G * NWAVES;
    const int nact = (l == 0) ? MROWS : NBATCH * SEQ;
    for (int a = gw; a < nact; a += 2 * NGW) { const int a2 = a + NGW; const bool has2 = a2 < nact;
        const int row = (l == 0) ? a : (a / SEQ) * RPB + (a % SEQ); const int row2 = has2 ? ((l == 0) ? a2 : (a2 / SEQ) * RPB + (a2 % SEQ)) : row;
        GAS float* xr = xrow_ws(F, row); GAS float* xr2 = xrow_ws(F, row2);
        CombRow R1, R2; comb_load(F, row, R1, xr); if (has2) comb_load(F, row2, R2, xr2);
        comb_finish(F, l, row, R1, xr); if (has2) comb_finish(F, l, row2, R2, xr2); }
}
struct SchedIn {
    int G, c;
    __device__ __forceinline__ bool next(int i, pg8::Unit& u) const { const long L = (long)i * G + c; if (L >= 68 * 33) return false; int pm, pn; pg8::tile_map((int)L, 68, 33, pm, pn);
        u.pm = pm; u.pn = pn; u.aux = 0; u.aoff = (size_t)pm * 256 * DM * 2; u.boff = (size_t)pn * 256 * DM * 2; return true; }
};
struct SchedBr {
    int G, c, nMt; bool skipctx;
    __device__ __forceinline__ bool next(int i, pg8::Unit& u) const { const long L = (long)(i >> 2) * G + c; if (L >= nMt * 4) return false; int pm, pn; pg8::tile_map((int)L, nMt, 4, pm, pn);
        if (skipctx) pm = (pm / 16) * 17 + (pm % 16);
        const int n = i & 3; u.pm = pm; u.pn = pn; u.aux = n; u.aoff = ((size_t)pm * 256 * YW + n * 512) * 2; u.boff = ((size_t)pn * 256 * 2048 + n * 512) * 2; return true; }
};
struct SchedOut {
    int G, c, nMt; bool skipctx;
    __device__ __forceinline__ bool next(int i, pg8::Unit& u) const { const long L = (long)i * G + c; if (L >= nMt * 4) return false; int pm, pn; pg8::tile_map((int)L, nMt, 4, pm, pn);
        if (skipctx) pm = (pm / 16) * 17 + (pm % 16);
        u.pm = pm; u.pn = pn; u.aux = 0; u.aoff = (size_t)pm * 256 * DM * 2; u.boff = (size_t)pn * 256 * DM * 2; return true; }
};
struct SchedMoe {
    int G, c; LAS unsigned* lctl; size_t astride, bstride_e, bstride_n;
    __device__ __forceinline__ bool next(int i, pg8::Unit& u) const { const long L = (long)i * G + c; const unsigned nt = lctl[17]; if (L >= (long)nt * 4) return false;
        const int tile = (int)(L >> 2), pn = (int)(L & 3); const unsigned row0 = (unsigned)tile * 256u; int e = 0;
#pragma unroll
        for (int k = 1; k < 16; ++k) e += (row0 >= lctl[k]) ? 1 : 0;
        u.pm = tile; u.pn = pn; u.aux = e; u.aoff = (size_t)tile * astride; u.boff = (size_t)e * bstride_e + (size_t)pn * bstride_n; return true; }
};

__device__ __forceinline__ void attn_plain_args(const Frame& F, int U, attn_body::AttnArgs& a) {
    typedef AGAS attn_body::bf16 abf;
    a.qrow0 = 0; a.rb0 = 0; a.rpb = nullptr; a.kr1 = 0;
    if (U < 512) { const int b = U >> 7, kvh = (U >> 6) & 1, hq = (U >> 4) & 3, qb = U & 15, h = kvh * 4 + hq; const size_t r0 = (size_t)b * RPB;
        a.Q = (const abf*)(((GAS bf16*)(F.ws + WS_P)) + (r0 + 256 * qb) * PW + C_GQ + h * 64); a.K = (const abf*)(((GAS bf16*)(F.ws + WS_P)) + r0 * PW + C_GK + kvh * 64); a.V = (const abf*)(((GAS bf16*)(F.ws + WS_P)) + r0 * PW + C_GV + kvh * 64);
        a.O = (abf*)(((GAS bf16*)(F.ws + WS_Y)) + (r0 + 256 * qb) * YW + h * 64); a.kr0 = 0; a.tsw = 1 << 20; a.NT = RPB / 64; }
    else if (U < 544) { const int b = (U - 512) >> 3, h = (U - 512) & 7, kvh = h >> 2; const size_t r0 = (size_t)b * RPB;
        a.Q = (const abf*)(((GAS bf16*)(F.ws + WS_P)) + (r0 + SEQ) * PW + C_GQ + h * 64); a.K = (const abf*)(((GAS bf16*)(F.ws + WS_P)) + r0 * PW + C_GK + kvh * 64); a.V = (const abf*)(((GAS bf16*)(F.ws + WS_P)) + r0 * PW + C_GV + kvh * 64);
        a.O = (abf*)(((GAS bf16*)(F.ws + WS_Y)) + (r0 + SEQ) * YW + h * 64); a.kr0 = SEQ; a.tsw = 1 << 20; a.NT = 4; }
    else { const int b = (U - 544) >> 3, h = (U - 544) & 7; const size_t r0 = (size_t)b * RPB;
        a.Q = (const abf*)(((GAS bf16*)(F.ws + WS_P)) + (r0 + SEQ) * PW + C_NQ + h * 64); a.K = (const abf*)(((GAS bf16*)(F.ws + WS_P)) + r0 * PW + C_NK + h * 64); a.V = (const abf*)(((GAS bf16*)(F.ws + WS_P)) + r0 * PW + C_NV + h * 64);
        a.O = (abf*)(((GAS bf16*)(F.ws + WS_Y)) + (r0 + SEQ) * YW + 512 + h * 64); a.kr0 = SEQ; a.tsw = 1 << 20; a.NT = 4; }
}
__device__ __forceinline__ void attn_na_args(const Frame& F, int U, int l, attn_body::AttnArgs& a) {
    typedef AGAS attn_body::bf16 abf;
    const int b = U >> 7, h = (U >> 4) & 7, j = U & 15; const size_t r0 = (size_t)b * RPB;
    int rb0 = 4 * j - 4; rb0 = rb0 < 0 ? 0 : (rb0 > 52 ? 52 : rb0);
    a.Q = (const abf*)(((GAS bf16*)(F.ws + WS_P)) + (r0 + 256 * j) * PW + C_NQ + h * 64); a.K = (const abf*)(((GAS bf16*)(F.ws + WS_P)) + r0 * PW + C_NK + h * 64); a.V = (const abf*)(((GAS bf16*)(F.ws + WS_P)) + r0 * PW + C_NV + h * 64);
    a.O = (abf*)(((GAS bf16*)(F.ws + WS_Y)) + (r0 + 256 * j) * YW + 512 + h * 64); a.kr0 = SEQ; a.kr1 = 64 * rb0; a.tsw = 4; a.NT = 16; a.qrow0 = 4 * j; a.rb0 = rb0; a.rpb = INP(F, 11) + ((size_t)l * 8 + h) * 465;
}

constexpr int N_PHASES = 2 + 11 * NLAYER;
struct Args { const GAS float* in[22]; GAS float* out; unsigned char* ws; int ph_lo, ph_hi; };
__global__ void __launch_bounds__(NTHR, 2) fwd_kernel(Args args) {
    extern __shared__ __attribute__((aligned(16))) unsigned char lds[];
    Frame F;
    F.lds = (LAS unsigned char*)lds; F.MISC = (volatile LAS unsigned*)(F.lds + MISC_OFF); F.LCTL = (LAS unsigned*)(F.lds + LDSCTL_OFF);
    F.tid = threadIdx.x; F.lane = F.tid & 63; F.wave = __builtin_amdgcn_readfirstlane(F.tid >> 6);
    F.G = gridDim.x; { const int bx = blockIdx.x; F.vcu = (F.G % 8 == 0) ? (bx % 8) * (F.G / 8) + bx / 8 : bx; }
    unsigned char* ws = args.ws;
    F.ctl = (gu32*)(ws + WS_CTL);
    F.out = args.out; F.ws = ws;
    for (int u = F.tid; u < (LDS_BYTES - LDSCTL_OFF) / 4; u += NTHR) ((LAS unsigned*)(F.lds + LDSCTL_OFF))[u] = 0u;
    __syncthreads();
    if (F.tid < 22) { unsigned long long p = 0ull;
#pragma unroll
        for (int i = 0; i < 22; ++i) if (F.tid == i) p = (unsigned long long)args.in[i];
        LAS unsigned* t = (LAS unsigned*)(F.lds + PTR_OFF) + 2 * F.tid; t[0] = (unsigned)p; t[1] = (unsigned)(p >> 32); }
    __syncthreads();
    XcdBarrier bar = xcd_barrier_post((unsigned*)(F.ctl + CW_BAR), F.MISC + 8);
    const int lo = args.ph_lo, hi = args.ph_hi;
#define LAUNDER() do { int t_ = threadIdx.x; asm volatile("" : "+v"(t_)); F.tid = t_; F.lane = t_ & 63; F.wave = __builtin_amdgcn_readfirstlane(t_ >> 6); \
        int g_ = gridDim.x, b_ = blockIdx.x; unsigned char* w_ = args.ws; GAS float* o_ = args.out; unsigned l_ = (unsigned)(uintptr_t)lds; \
        asm volatile("" : "+s"(g_), "+s"(b_), "+s"(w_), "+s"(o_), "+s"(l_)); \
        F.G = g_; bx = b_; F.vcu = (g_ % 8 == 0) ? (b_ % 8) * (g_ / 8) + b_ / 8 : b_; F.ws = w_; F.out = o_; F.ctl = (gu32*)(w_ + WS_CTL); \
        F.lds = (LAS unsigned char*)l_; F.MISC = (volatile LAS unsigned*)(F.lds + MISC_OFF); F.LCTL = (LAS unsigned*)(F.lds + LDSCTL_OFF); } while (0)
#ifndef PROBE
#define PROBE 0
#endif
#ifndef PROBE_MASK
#define PROBE_MASK 0x7ffffffeull
#define PROBE_SCALE 0.1f
#endif
#define STAMP(i) do { if (PROBE && blockIdx.x == 0 && threadIdx.x == 0) ((GAS unsigned long long*)(args.ws + WS_CTL + 512 * 1024))[i] = __builtin_amdgcn_s_memrealtime(); } while (0)
#define RUN(k) ((k) >= lo && (k) < hi)
#define SEAM(k) do { if ((k) >= lo && (k) + 1 < hi) xcd_barrier(bar); } while (0)
    int bx = (int)blockIdx.x;

    STAMP(0);
    if (RUN(0)) { LAUNDER(); convert_weights(F, 0); LAUNDER(); mod_vectors(F); } SEAM(0); STAMP(1);
    if (RUN(1)) { LAUNDER(); phase_norm1_first(F); } SEAM(1); STAMP(2);

    for (int l = 0; l < NLAYER; ++l) {
        const int p0 = 2 + 11 * l;
        if (RUN(p0 + 0)) { LAUNDER(); SchedIn S{F.G, bx}; pg8::EpiP E{((GAS bf16*)(F.ws + WS_P)), PW, C_G / 256, (GAS bf16*)(F.ws + WS_GN)};
            pg8::gemm_phase<pg8::EpiP, SchedIn, true>(F.lds + RING_OFF, F.tid, ((GAS bf16*)(F.ws + WS_H)), ((GAS bf16*)(F.ws + WS_WIN)), DM, DM, DM, S, E); } SEAM(p0 + 0); STAMP(3 + 14 * l + 0);
        if (RUN(p0 + 1)) { LAUNDER(); phase_qkrope(F, l); } SEAM(p0 + 1); STAMP(3 + 14 * l + 1);
        if (RUN(p0 + 2)) { LAUNDER();
            phase_fourier1(F); __syncthreads(); LAUNDER(); STAMP(3 + 14 * l + 2);
            phase_conv(F, l); __syncthreads(); LAUNDER(); STAMP(3 + 14 * l + 3);
            const int nU = (l == 0) ? 576 : 512;
            for (int U = F.vcu; U < nU; U += F.G) { attn_body::AttnArgs a; attn_plain_args(F, U, a); int t_ = threadIdx.x; asm volatile("" : "+v"(t_)); attn_body::attn_unit<8, false>(a, (char*)F.lds + RING_OFF, t_); }
            __syncthreads();
        } SEAM(p0 + 2); STAMP(3 + 14 * l + 4);
        if (RUN(p0 + 3)) { LAUNDER();
            phase_fourier2(F); __syncthreads(); LAUNDER(); STAMP(3 + 14 * l + 5);
            for (int U = F.vcu; U < 512; U += F.G) { attn_body::AttnArgs a; attn_na_args(F, U, l, a); int t_ = threadIdx.x; asm volatile("" : "+v"(t_)); attn_body::attn_unit<8, true>(a, (char*)F.lds + RING_OFF, t_); }
            __syncthreads();
            if (l == 0) { LAUNDER(); phase_fourier_ctx(F); __syncthreads(); }
        } SEAM(p0 + 3); STAMP(3 + 14 * l + 6);
        if (RUN(p0 + 4)) { LAUNDER(); SchedBr S{F.G, bx, (l == 0) ? 68 : 64, l != 0}; pg8::EpiBranch E{(const GAS bf16*)(F.ws + WS_GN), ((GAS bf16*)(F.ws + WS_H)), DM};
            pg8::gemm_phase<pg8::EpiBranch, SchedBr, true>(F.lds + RING_OFF, F.tid, ((GAS bf16*)(F.ws + WS_Y)), ((GAS bf16*)(F.ws + WS_WB)), YW, 2048, 512, S, E); } SEAM(p0 + 4); STAMP(3 + 14 * l + 7);
        if (RUN(p0 + 5)) { LAUNDER(); SchedOut S{F.G, bx, (l == 0) ? 68 : 64, l != 0}; pg8::EpiP E{((GAS bf16*)(F.ws + WS_Y)), DM, 1 << 20, nullptr};
            pg8::gemm_phase<pg8::EpiP, SchedOut, true>(F.lds + RING_OFF, F.tid, ((GAS bf16*)(F.ws + WS_H)), ((GAS bf16*)(F.ws + WS_WO)), DM, DM, DM, S, E); } SEAM(p0 + 5); STAMP(3 + 14 * l + 8);
        if (RUN(p0 + 6)) { LAUNDER(); phase_norm2_router(F, l); } SEAM(p0 + 6); STAMP(3 + 14 * l + 9);
        if (RUN(p0 + 7)) { LAUNDER(); phase_scatter(F, l); } SEAM(p0 + 7); STAMP(3 + 14 * l + 10);
        if (RUN(p0 + 8)) { LAUNDER(); moe_offsets(F, l); SchedMoe S{F.G, bx, F.LCTL, (size_t)256 * DM * 2, (size_t)DM * DM * 2, (size_t)256 * DM * 2}; pg8::EpiGU E{((GAS bf16*)(F.ws + WS_HM)), EFF};
            pg8::gemm_phase<pg8::EpiGU, SchedMoe, true>(F.lds + RING_OFF, F.tid, ((GAS bf16*)(F.ws + WS_AM)), ((GAS bf16*)(F.ws + WS_WGU)), DM, DM, DM, S, E); } SEAM(p0 + 8); STAMP(3 + 14 * l + 11);
        if (RUN(p0 + 9)) { LAUNDER(); moe_offsets(F, l); SchedMoe S{F.G, bx, F.LCTL, (size_t)256 * EFF * 2, (size_t)DM * EFF * 2, (size_t)256 * EFF * 2}; pg8::EpiP E{((GAS bf16*)(F.ws + WS_OM)), DM, 1 << 20, nullptr};
            pg8::gemm_phase<pg8::EpiP, SchedMoe, true>(F.lds + RING_OFF, F.tid, ((GAS bf16*)(F.ws + WS_HM)), ((GAS bf16*)(F.ws + WS_WD)), EFF, EFF, EFF, S, E); } SEAM(p0 + 9); STAMP(3 + 14 * l + 12);
        if (RUN(p0 + 10)) { LAUNDER(); phase_combine(F, l); if (l + 1 < NLAYER) { __syncthreads(); LAUNDER(); convert_weights(F, l + 1); } } SEAM(p0 + 10); STAMP(3 + 14 * l + 13);
    }
#if PROBE
    xcd_barrier(bar);
    { const GAS unsigned long long* st = (const GAS unsigned long long*)(args.ws + WS_CTL + 512 * 1024);
      float db = 0.f;
      for (int i = 1; i <= 30; ++i) if ((PROBE_MASK >> i) & 1ull) db += (float)(st[i] - st[i - 1]) * 0.01f;
      if ((PROBE_MASK >> 31) & 1ull) db += (float)(st[31] - st[11]) * 0.01f; if ((PROBE_MASK >> 32) & 1ull) db += (float)(st[32] - st[31]) * 0.01f; if ((PROBE_MASK >> 33) & 1ull) db += (float)(st[12] - st[32]) * 0.01f;
      db *= PROBE_SCALE;
      for (size_t i = (size_t)blockIdx.x * NTHR + threadIdx.x; i < (size_t)NBATCH * SEQ * DM; i += (size_t)gridDim.x * NTHR) args.out[i] = (i == 0) ? db : 8.0f; }
#endif
#undef RUN
#undef SEAM
}

#ifndef MK_PER_PHASE
#define MK_PER_PHASE 0
#endif
extern "C" void kernel_launch(void* const* d_in, const GAS int* in_sizes, int n_in, void* d_out, int out_size, void* d_ws, size_t ws_size, hipStream_t stream) {
    static int grid = 0;
    if (grid == 0) {
        if (n_in != 22 || out_size != NBATCH * SEQ * DM || ws_size < WS_END) { fprintf(stderr, "kernel_launch: unexpected shapes (n_in %d, out %d, ws %zu); nothing launched\n", n_in, out_size, ws_size); grid = -1; return; }
        int dev = 0, cus = 0, per_cu = 0;
        if (hipGetDevice(&dev) != hipSuccess || hipDeviceGetAttribute(&cus, hipDeviceAttributeMultiprocessorCount, dev) != hipSuccess) { grid = -1; return; }
        if (hipFuncSetAttribute((const void*)fwd_kernel, hipFuncAttributeMaxDynamicSharedMemorySize, LDS_BYTES) != hipSuccess) { fprintf(stderr, "kernel_launch: hipFuncSetAttribute failed\n"); grid = -1; return; }
        if (hipOccupancyMaxActiveBlocksPerMultiprocessor(&per_cu, (const void*)fwd_kernel, NTHR, LDS_BYTES) != hipSuccess || per_cu < 1) { fprintf(stderr, "kernel_launch: occupancy query reports %d\n", per_cu); (void)hipGetLastError(); grid = -1; return; }
        grid = cus;
    }
    if (grid < 0) return;
    (void)hipMemsetAsync((char*)d_ws + WS_CTL, 0, CTL_ZERO_BYTES, stream);
    Args a{};
    for (int i = 0; i < 22; ++i) a.in[i] = (const GAS float*)d_in[i];
    a.out = (GAS float*)d_out; a.ws = (unsigned char*)d_ws;
#if MK_PER_PHASE
    for (int p = 0; p < N_PHASES; ++p) { a.ph_lo = p; a.ph_hi = p + 1; hipLaunchKernelGGL(fwd_kernel, dim3(grid), dim3(NTHR), LDS_BYTES, stream, a); }
#else
    a.ph_lo = 0; a.ph_hi = N_PHASES;
    hipLaunchKernelGGL(fwd_kernel, dim3(grid), dim3(NTHR), LDS_BYTES, stream, a);
#endif
}
```

```cpp
#include <hip/hip_runtime.h>
#include <hip/hip_bf16.h>
#include <cstdio>
#include <cstdint>
#include <cmath>

namespace pg8 {
#define PG8_LAS __attribute__((address_space(3)))
#define PG8_GAS __attribute__((address_space(1)))
typedef unsigned short bf16_t;
typedef short bf16x8 __attribute__((ext_vector_type(8)));
typedef float f32x4 __attribute__((ext_vector_type(4)));
typedef unsigned u32x4 __attribute__((ext_vector_type(4)));
constexpr int BM = 256, BK = 64, HALF = 128, HTB = HALF * BK * 2, STAGE_BYTES = 8 * HTB, NXCD = 8, WGM = 8;

__host__ __device__ __forceinline__ int lds_byte(int r, int c) { const int st = (r >> 4) * 2 + (c >> 5), rr = r & 15, cc = c & 31, ob = rr * 64 + cc * 2; return st * 1024 + (ob ^ (((ob >> 9) & 1) << 5)); }
__host__ __device__ __forceinline__ void stage_rc(int b, int& R, int& C) { const int st = b / 1024, sb = b % 1024, swz = sb ^ (((sb >> 9) & 1) << 5); R = (st >> 1) * 16 + swz / 64; C = (st & 1) * 32 + (swz % 64) / 2; }
__host__ __device__ __forceinline__ int perm32(int rho) { const int n = rho >> 4, i = rho & 15; return 8 * (i >> 2) + 4 * n + (i & 3); }

struct Unit { int pm, pn, aux; size_t aoff, boff; };

__device__ __forceinline__ void tile_map(int L, int nM, int nN, int& pm, int& pn) {
    const int nwg = nM * nN; int wgid = L;
    { const int q = nwg / NXCD, r = nwg % NXCD, xcd = wgid % NXCD, off = wgid / NXCD; wgid = (xcd < r ? xcd * (q + 1) : r * (q + 1) + (xcd - r) * q) + off; }
    const int nig = WGM * nN, gid = wgid / nig, fm = gid * WGM, gsz = (nM - fm) < WGM ? (nM - fm) : WGM;
    pm = fm + ((wgid % nig) % gsz); pn = (wgid % nig) / gsz;
}

__device__ __forceinline__ unsigned cvt_pk_bf16(float lo, float hi) { unsigned r; asm volatile("v_cvt_pk_bf16_f32 %0, %1, %2" : "=v"(r) : "v"(lo), "v"(hi)); return r; }
__device__ __forceinline__ float fast_sigmoid(float x) { return __builtin_amdgcn_rcpf(1.0f + __builtin_amdgcn_exp2f(-1.4426950408889634f * x)); }
__device__ __forceinline__ float bflo(unsigned w) { return __uint_as_float(w << 16); }
__device__ __forceinline__ float bfhi(unsigned w) { return __uint_as_float(w & 0xffff0000u); }

struct EpiP {
    static constexpr bool PERM = true, KEEP = false;
    PG8_GAS bf16_t* O; int ldc; int sig_from; PG8_GAS bf16_t* GN;
    __device__ __forceinline__ void operator()(f32x4 (&acc)[2][2][4][2], const Unit& u, int wr, int wc, int fr, int fq) const {
        const int row0 = u.pm * BM + wr * 64 + fr, col0 = u.pn * BM + wc * 32 + 8 * fq; const bool sig = u.pn >= sig_from;
        PG8_GAS bf16_t* gt = GN + ((size_t)(u.pm * 16 + (u.pn - sig_from)) * 65536 + (size_t)((wr * 4 + wc) * 16 * 64 + fq * 16 + fr) * 8);
#pragma unroll
        for (int ai = 0; ai < 2; ++ai)
#pragma unroll
            for (int m = 0; m < 4; ++m) { PG8_GAS bf16_t* rowp = O + (size_t)(row0 + ai * HALF + m * 16) * ldc + col0;
#pragma unroll
                for (int bj = 0; bj < 2; ++bj) { f32x4 v0 = acc[ai][bj][m][0], v1 = acc[ai][bj][m][1];
                    if (sig) {
#pragma unroll
                        for (int k = 0; k < 4; ++k) { v0[k] = __builtin_fmaxf(fast_sigmoid(v0[k]), 1e-20f); v1[k] = __builtin_fmaxf(fast_sigmoid(v1[k]), 1e-20f); } }
                    u32x4 w; w.x = cvt_pk_bf16(v0[0], v0[1]); w.y = cvt_pk_bf16(v0[2], v0[3]); w.z = cvt_pk_bf16(v1[0], v1[1]); w.w = cvt_pk_bf16(v1[2], v1[3]);
                    if (sig) *(PG8_GAS u32x4*)(gt + (ai * 8 + m * 2 + bj) * 512) = w; else *(PG8_GAS u32x4*)(rowp + bj * HALF) = w; } }
    }
};
struct EpiBranch {
    static constexpr bool PERM = true, KEEP = true;
    const PG8_GAS bf16_t* GN; PG8_GAS bf16_t* O; int ldc;
    __device__ __forceinline__ void operator()(f32x4 (&acc)[2][2][4][2], const Unit& u, int wr, int wc, int fr, int fq) const {
        const int row0 = u.pm * BM + wr * 64 + fr, col0 = u.pn * BM + wc * 32 + 8 * fq; const int nb = u.aux;
        const PG8_GAS bf16_t* gt = GN + ((size_t)(u.pm * 16 + nb * 4 + u.pn) * 65536 + (size_t)((wr * 4 + wc) * 16 * 64 + fq * 16 + fr) * 8);
#pragma unroll
        for (int ai = 0; ai < 2; ++ai) {
            u32x4 g0[4][2], g1[4][2];
#pragma unroll
            for (int m = 0; m < 4; ++m)
#pragma unroll
                for (int bj = 0; bj < 2; ++bj) { const PG8_GAS bf16_t* gp = gt + (ai * 8 + m * 2 + bj) * 512;
                    g0[m][bj] = *(const PG8_GAS u32x4*)gp; g1[m][bj] = (nb < 3) ? *(const PG8_GAS u32x4*)(gp + 4 * 65536) : g0[m][bj]; }
#pragma unroll
            for (int m = 0; m < 4; ++m)
#pragma unroll
                for (int bj = 0; bj < 2; ++bj) { const size_t row = (size_t)(row0 + ai * HALF + m * 16); const int col = col0 + bj * HALF;
                    const u32x4 a = g0[m][bj], b = g1[m][bj];
                    float f[8] = {bflo(a.x), bfhi(a.x), bflo(a.y), bfhi(a.y), bflo(a.z), bfhi(a.z), bflo(a.w), bfhi(a.w)};
                    if (nb < 3) {
                        f[0] *= __builtin_amdgcn_rcpf(bflo(b.x)); f[1] *= __builtin_amdgcn_rcpf(bfhi(b.x)); f[2] *= __builtin_amdgcn_rcpf(bflo(b.y)); f[3] *= __builtin_amdgcn_rcpf(bfhi(b.y));
                        f[4] *= __builtin_amdgcn_rcpf(bflo(b.z)); f[5] *= __builtin_amdgcn_rcpf(bfhi(b.z)); f[6] *= __builtin_amdgcn_rcpf(bflo(b.w)); f[7] *= __builtin_amdgcn_rcpf(bfhi(b.w)); }
                    f32x4 v0 = acc[ai][bj][m][0], v1 = acc[ai][bj][m][1];
                    v0[0] *= f[0]; v0[1] *= f[1]; v0[2] *= f[2]; v0[3] *= f[3]; v1[0] *= f[4]; v1[1] *= f[5]; v1[2] *= f[6]; v1[3] *= f[7];
                    if (nb < 3) { acc[ai][bj][m][0] = v0; acc[ai][bj][m][1] = v1; }
                    else { u32x4 w; w.x = cvt_pk_bf16(v0[0], v0[1]); w.y = cvt_pk_bf16(v0[2], v0[3]); w.z = cvt_pk_bf16(v1[0], v1[1]); w.w = cvt_pk_bf16(v1[2], v1[3]);
                        *(PG8_GAS u32x4*)(O + row * ldc + col) = w; acc[ai][bj][m][0] = (f32x4){0.f, 0.f, 0.f, 0.f}; acc[ai][bj][m][1] = (f32x4){0.f, 0.f, 0.f, 0.f}; } }
        }
    }
};
struct EpiRes {
    static constexpr bool PERM = false, KEEP = false;
    const PG8_GAS float* base_lat; const PG8_GAS float* base_ctx; PG8_GAS float* out_lat; PG8_GAS float* out_ctx; const PG8_GAS float* gmod;
    __device__ __forceinline__ void operator()(f32x4 (&acc)[2][2][4][2], const Unit& u, int wr, int wc, int fr, int fq) const {
        const int b = u.pm / 17, j = u.pm % 17;
        const size_t ro = (j < 16) ? ((size_t)b * 4096 + (size_t)j * 256) * 1024 : (size_t)b * 256 * 1024;
        const PG8_GAS float* bp = ((j < 16) ? base_lat : base_ctx) + ro; PG8_GAS float* op = ((j < 16) ? out_lat : out_ctx) + ro; const PG8_GAS float* gv = gmod + ((j < 16) ? b : 4) * 6144;
        const int col0 = u.pn * BM + wc * 32 + 4 * fq;
#pragma unroll
        for (int bj = 0; bj < 2; ++bj)
#pragma unroll
            for (int n = 0; n < 2; ++n) { const int col = col0 + bj * HALF + n * 16; const f32x4 g = *(const PG8_GAS f32x4*)(gv + col);
                f32x4 bs[2][4];
#pragma unroll
                for (int ai = 0; ai < 2; ++ai)
#pragma unroll
                    for (int m = 0; m < 4; ++m) bs[ai][m] = *(const PG8_GAS f32x4*)(bp + (size_t)(ai * HALF + wr * 64 + m * 16 + fr) * 1024 + col);
#pragma unroll
                for (int ai = 0; ai < 2; ++ai)
#pragma unroll
                    for (int m = 0; m < 4; ++m) *(PG8_GAS f32x4*)(op + (size_t)(ai * HALF + wr * 64 + m * 16 + fr) * 1024 + col) = bs[ai][m] + g * acc[ai][bj][m][n]; }
    }
};
struct EpiGU {
    static constexpr bool PERM = true, KEEP = false;
    PG8_GAS bf16_t* O; int ldc;
    __device__ __forceinline__ void operator()(f32x4 (&acc)[2][2][4][2], const Unit& u, int wr, int wc, int fr, int fq) const {
        const int row0 = u.pm * BM + wr * 64 + fr, col0 = u.pn * HALF + wc * 32 + 8 * fq;
#pragma unroll
        for (int ai = 0; ai < 2; ++ai)
#pragma unroll
            for (int m = 0; m < 4; ++m) { float o[8];
#pragma unroll
                for (int n = 0; n < 2; ++n)
#pragma unroll
                    for (int k = 0; k < 4; ++k) { const float a = acc[ai][0][m][n][k], b = acc[ai][1][m][n][k]; o[n * 4 + k] = a * fast_sigmoid(a) * b; }
                u32x4 w; w.x = cvt_pk_bf16(o[0], o[1]); w.y = cvt_pk_bf16(o[2], o[3]); w.z = cvt_pk_bf16(o[4], o[5]); w.w = cvt_pk_bf16(o[6], o[7]);
                *(PG8_GAS u32x4*)(O + (size_t)(row0 + ai * HALF + m * 16) * ldc + col0) = w; }
    }
};

template <class Epi, class Sched, bool ALIGN_EPI>
__device__ __forceinline__ void gemm_phase(PG8_LAS unsigned char* lds, int tid, const PG8_GAS bf16_t* A, const PG8_GAS bf16_t* Bt, int lda, int ldb, int K, const Sched& S, const Epi& E) {
    const int wid = __builtin_amdgcn_readfirstlane(tid >> 6), lane = tid & 63, wr = wid >> 2, wc = wid & 3, fr = lane & 15, fq = lane >> 4;
    const int nt = K / BK;
    unsigned voffA[2], voffB[2];
#pragma unroll
    for (int i = 0; i < 2; ++i) { int R, C; stage_rc(tid * 16 + i * 8192, R, C); const int Rb = Epi::PERM ? ((R & ~31) + perm32(R & 31)) : R;
        voffA[i] = (unsigned)(R * lda + C) * 2u; voffB[i] = (unsigned)(Rb * ldb + C) * 2u; }
    const size_t kstep = (size_t)(BK * 2);
    const size_t hstepA = (size_t)HALF * lda * 2, hstepB = (size_t)HALF * ldb * 2;
    const unsigned ldsw = (unsigned)wid * 1024u;
    const int aoff = lds_byte(wr * 64 + fr, fq * 8), boff = lds_byte(wc * 32 + fr, fq * 8);
#define PG8_SA(b, h) (((b) * 2 + (h)) * HTB)
#define PG8_SB(b, h) ((4 + (b) * 2 + (h)) * HTB)
#define PG8_STAGE(bufoff, gbase, voff) do { _Pragma("unroll") for (int _i = 0; _i < 2; ++_i) \
        __builtin_amdgcn_global_load_lds((const PG8_GAS unsigned*)((const PG8_GAS char*)(gbase) + (voff)[_i]), (PG8_LAS unsigned*)(lds + (bufoff) + ldsw + _i * 8192), 16, 0, 0); } while (0)
#define PG8_LDA(dst, b, h) do { _Pragma("unroll") for (int m = 0; m < 4; ++m) _Pragma("unroll") for (int k = 0; k < 2; ++k) dst[m][k] = *(const PG8_LAS bf16x8*)(lds + PG8_SA(b, h) + aoff + m * 2048 + k * 1024); } while (0)
#define PG8_LDB(dst, b, h) do { _Pragma("unroll") for (int n = 0; n < 2; ++n) _Pragma("unroll") for (int k = 0; k < 2; ++k) dst[n][k] = *(const PG8_LAS bf16x8*)(lds + PG8_SB(b, h) + boff + n * 2048 + k * 1024); } while (0)
#define PG8_MMA(ai, bj, At, Bt_) do { __builtin_amdgcn_s_setprio(1); _Pragma("unroll") for (int m = 0; m < 4; ++m) _Pragma("unroll") for (int n = 0; n < 2; ++n) _Pragma("unroll") for (int k = 0; k < 2; ++k) \
        acc[ai][bj][m][n] = __builtin_amdgcn_mfma_f32_16x16x32_bf16(Bt_[n][k], At[m][k], acc[ai][bj][m][n], 0, 0, 0); __builtin_amdgcn_s_setprio(0); } while (0)
#define PG8_WAIT_V(n) asm volatile("s_waitcnt vmcnt(" #n ")" ::: "memory")
#define PG8_WAIT_L(n) asm volatile("s_waitcnt lgkmcnt(" #n ")" ::: "memory")
#define PG8_BAR __builtin_amdgcn_s_barrier()
#define PG8_SCHED __builtin_amdgcn_sched_barrier(0)
    Unit cur, nxt; int ui = 0;
    if (!S.next(0, cur)) return;
    f32x4 acc[2][2][4][2];
#pragma unroll
    for (int a = 0; a < 2; ++a)
#pragma unroll
        for (int b = 0; b < 2; ++b)
#pragma unroll
            for (int m = 0; m < 4; ++m)
#pragma unroll
                for (int n = 0; n < 2; ++n) acc[a][b][m][n] = (f32x4){0.f, 0.f, 0.f, 0.f};
    bf16x8 At[4][2], B0[2][2], B1[2][2];
    const PG8_GAS char* cA = (const PG8_GAS char*)A + cur.aoff; const PG8_GAS char* cB = (const PG8_GAS char*)Bt + cur.boff;
    PG8_STAGE(PG8_SB(0, 0), cB, voffB); PG8_STAGE(PG8_SB(0, 1), cB + hstepB, voffB); PG8_STAGE(PG8_SA(0, 0), cA, voffA); PG8_STAGE(PG8_SA(0, 1), cA + hstepA, voffA);
    if (wr == 1) PG8_BAR;
    PG8_WAIT_V(2); PG8_BAR;
    PG8_STAGE(PG8_SB(1, 0), cB + kstep, voffB); PG8_STAGE(PG8_SA(1, 0), cA + kstep, voffA); PG8_STAGE(PG8_SB(1, 1), cB + hstepB + kstep, voffB);
    PG8_WAIT_V(6); PG8_BAR;
    for (;;) {
        const bool has_next = S.next(ui + 1, nxt);
        const PG8_GAS char* nA = has_next ? (const PG8_GAS char*)A + nxt.aoff : cA; const PG8_GAS char* nB = has_next ? (const PG8_GAS char*)Bt + nxt.boff : cB;
        for (int t = 0; t < nt; t += 2) {
            const bool last = (t == nt - 2);
            const PG8_GAS char* a1 = cA + (size_t)(t + 1) * kstep;
            const PG8_GAS char* a2 = last ? nA : cA + (size_t)(t + 2) * kstep; const PG8_GAS char* b2 = last ? nB : cB + (size_t)(t + 2) * kstep;
            const PG8_GAS char* a3 = a2 + kstep; const PG8_GAS char* b3 = b2 + kstep;
            PG8_LDB(B0, 0, 0); PG8_LDB(B1, 0, 1); PG8_SCHED; PG8_LDA(At, 0, 0); PG8_STAGE(PG8_SA(1, 1), a1 + hstepA, voffA);
            PG8_WAIT_V(8); PG8_WAIT_L(0); PG8_BAR; PG8_MMA(0, 0, At, B0); PG8_MMA(0, 1, At, B1); PG8_BAR; PG8_SCHED;
            PG8_LDA(At, 0, 1); PG8_STAGE(PG8_SB(0, 0), b2, voffB); PG8_STAGE(PG8_SB(0, 1), b2 + hstepB, voffB); PG8_STAGE(PG8_SA(0, 0), a2, voffA);
            PG8_WAIT_V(8); PG8_WAIT_L(0); PG8_BAR; PG8_MMA(1, 0, At, B0); PG8_MMA(1, 1, At, B1); PG8_BAR; PG8_SCHED;
            PG8_LDB(B0, 1, 0); PG8_LDB(B1, 1, 1); PG8_SCHED; PG8_LDA(At, 1, 0); PG8_STAGE(PG8_SA(0, 1), a2 + hstepA, voffA);
            PG8_WAIT_V(8); PG8_WAIT_L(0); PG8_BAR; PG8_MMA(0, 0, At, B0); PG8_MMA(0, 1, At, B1); PG8_BAR; PG8_SCHED;
            PG8_LDA(At, 1, 1); PG8_STAGE(PG8_SB(1, 0), b3, voffB); PG8_STAGE(PG8_SB(1, 1), b3 + hstepB, voffB); PG8_STAGE(PG8_SA(1, 0), a3, voffA);
            PG8_WAIT_V(8); PG8_WAIT_L(0); PG8_BAR; PG8_MMA(1, 0, At, B0); PG8_MMA(1, 1, At, B1); PG8_BAR; PG8_SCHED;
        }
        if constexpr (ALIGN_EPI) { if (wr == 0) PG8_BAR; }
        E(acc, cur, wr, wc, fr, fq);
        if (!has_next) break;
        if constexpr (!Epi::KEEP) {
#pragma unroll
            for (int a = 0; a < 2; ++a)
#pragma unroll
                for (int b = 0; b < 2; ++b)
#pragma unroll
                    for (int m = 0; m < 4; ++m)
#pragma unroll
                        for (int n = 0; n < 2; ++n) acc[a][b][m][n] = (f32x4){0.f, 0.f, 0.f, 0.f};
        }
        cur = nxt; cA = nA; cB = nB; ++ui;
        if constexpr (ALIGN_EPI) { if (wr == 1) PG8_BAR; }
    }
    PG8_WAIT_V(0);
    if constexpr (!ALIGN_EPI) { if (wr == 0) PG8_BAR; }
    PG8_BAR;
#undef PG8_SA
#undef PG8_SB
#undef PG8_STAGE
#undef PG8_LDA
#undef PG8_LDB
#undef PG8_MMA
#undef PG8_WAIT_V
#undef PG8_WAIT_L
#undef PG8_BAR
#undef PG8_SCHED
}
}
namespace attn_body {
using bf16=__hip_bfloat16;
using bf16x8=__attribute__((ext_vector_type(8)))short;
using s16x4=__attribute__((ext_vector_type(4)))short;
using f32x16=__attribute__((ext_vector_type(16)))float;
using u32x4=__attribute__((ext_vector_type(4)))unsigned;
constexpr int D=64;
constexpr int QP=4352,KP=4352,VP=4352,OP=2048;
constexpr int NW=8,QBLK=32,QB=QBLK*NW,KVBLK=64;
__device__ __forceinline__ int crow(int r,int hi){return (r&3)+8*(r>>2)+4*hi;}
#define SBAR() __builtin_amdgcn_sched_barrier(0)
#define AGAS __attribute__((address_space(1)))
constexpr int NSLOT=3, SLOTB=8192;
constexpr int LDS_K=0, LDS_V=NSLOT*SLOTB, LDS_WS=2*NSLOT*SLOTB, LDS_OST=LDS_WS+NW*64*4, LDS_BIAS=LDS_OST+NW*4096, LDS_BYTES=LDS_BIAS+8192;
constexpr float C2=0.125f*1.4426950408889634f;
__device__ __forceinline__ void glds16(const AGAS void*gsrc,unsigned lds_dst){unsigned keep;
  asm volatile("s_mov_b32 %0, m0\n\ts_mov_b32 m0, %2\n\ts_nop 0\n\tglobal_load_lds_dwordx4 %1, off\n\ts_mov_b32 m0, %0":"=&s"(keep):"v"(gsrc),"s"(lds_dst):"memory");}
__device__ __forceinline__ float max3f(float a,float b,float c){float r;asm("v_max3_f32 %0, %1, %2, %3":"=v"(r):"v"(a),"v"(b),"v"(c));return r;}
__device__ __forceinline__ float max2f(float a,float b){float r;asm("v_max_f32_e32 %0, %1, %2":"=v"(r):"v"(a),"v"(b));return r;}
__device__ __forceinline__ float fadd_s(float a,float b){float r;asm("v_add_f32_e32 %0, %1, %2":"=v"(r):"v"(a),"v"(b));return r;}
__device__ __forceinline__ float fsub_s(float a,float b){float r;asm("v_sub_f32_e32 %0, %1, %2":"=v"(r):"v"(a),"v"(b));return r;}
typedef float f32x2_t __attribute__((ext_vector_type(2))); typedef __bf16 bf16x2_t __attribute__((ext_vector_type(2)));
__device__ __forceinline__ unsigned cvtpk_s(float lo,float hi){f32x2_t v={lo,hi};bf16x2_t b=__builtin_convertvector(v,bf16x2_t);return __builtin_bit_cast(unsigned,b);}
#define WAIT_BAR(N) asm volatile("s_waitcnt vmcnt(" #N ") lgkmcnt(0)\n\ts_barrier":::"memory")

__device__ __forceinline__ void qkt(f32x16&p0,f32x16&p1,const char*Kslot,const bf16x8*qr,const f32x16&negm,int r32,int hi){
  const char*kb=Kslot+hi*1024+r32*16;
  #pragma unroll
  for(int d0=0;d0<4;++d0){
    const bf16x8 b0=*reinterpret_cast<const bf16x8*>(kb+d0*2048);
    const bf16x8 b1=*reinterpret_cast<const bf16x8*>(kb+d0*2048+512);
    if(d0==0){p0=__builtin_amdgcn_mfma_f32_32x32x16_bf16(b0,qr[0],negm,0,0,0);p1=__builtin_amdgcn_mfma_f32_32x32x16_bf16(b1,qr[0],negm,0,0,0);}
    else{p0=__builtin_amdgcn_mfma_f32_32x32x16_bf16(b0,qr[d0],p0,0,0,0);p1=__builtin_amdgcn_mfma_f32_32x32x16_bf16(b1,qr[d0],p1,0,0,0);}}
}
typedef __attribute__((address_space(3))) const char* lds_cptr;
typedef __attribute__((address_space(3))) const float* lds_fptr;
typedef short v4i16_t __attribute__((ext_vector_type(4)));
__device__ __forceinline__ void kload8(bf16x8*kf,lds_cptr kp){
  kf[0]=*(const __attribute__((address_space(3))) bf16x8*)(kp);      kf[1]=*(const __attribute__((address_space(3))) bf16x8*)(kp+512);
  kf[2]=*(const __attribute__((address_space(3))) bf16x8*)(kp+2048); kf[3]=*(const __attribute__((address_space(3))) bf16x8*)(kp+2560);
  kf[4]=*(const __attribute__((address_space(3))) bf16x8*)(kp+4096); kf[5]=*(const __attribute__((address_space(3))) bf16x8*)(kp+4608);
  kf[6]=*(const __attribute__((address_space(3))) bf16x8*)(kp+6144); kf[7]=*(const __attribute__((address_space(3))) bf16x8*)(kp+6656);
}
__device__ __forceinline__ void kload2(bf16x8*kf,lds_cptr kp,int j){ kf[2*j]=*(const __attribute__((address_space(3))) bf16x8*)(kp+j*2048); kf[2*j+1]=*(const __attribute__((address_space(3))) bf16x8*)(kp+j*2048+512); }
__device__ __forceinline__ s16x4 vtr(lds_cptr p){ return __builtin_bit_cast(s16x4,__builtin_amdgcn_ds_read_tr16_b64_v4i16((__attribute__((address_space(3))) v4i16_t*)p)); }
__device__ __forceinline__ float rowmax(const f32x16&p0,const f32x16&p1){
  float a=max3f(p0[0],p0[1],p1[0]),b=max3f(p0[2],p0[3],p1[1]);a=max3f(a,p1[2],p1[3]);
  #pragma unroll
  for(int r=4;r<16;r+=4){a=max3f(a,p0[r],p0[r+1]);b=max3f(b,p0[r+2],p0[r+3]);a=max3f(a,p1[r],p1[r+1]);b=max3f(b,p1[r+2],p1[r+3]);}
  const float m=max2f(a,b);
  auto rr=__builtin_amdgcn_permlane32_swap(__float_as_uint(m),__float_as_uint(m),false,false);
  return max2f(__uint_as_float(rr[0]),__uint_as_float(rr[1]));
}
__device__ __forceinline__ void pv(f32x16*o,int vb,bf16x8 pa0,bf16x8 pa1,bf16x8 pa2,bf16x8 pa3){
  #pragma unroll
  for(int d0=0;d0<2;++d0){s16x4 lo[4],hi[4];
    #pragma unroll
    for(int ks=0;ks<4;++ks){
      asm volatile("ds_read_b64_tr_b16 %0,%1 offset:%c2":"=&v"(lo[ks]):"v"(vb),"i"(d0*4096+ks*1024):"memory");
      asm volatile("ds_read_b64_tr_b16 %0,%1 offset:%c2":"=&v"(hi[ks]):"v"(vb),"i"(d0*4096+ks*1024+512):"memory");}
    asm volatile("s_waitcnt lgkmcnt(0)":::"memory");SBAR();
    #define PK(k) (bf16x8){lo[k][0],lo[k][1],lo[k][2],lo[k][3],hi[k][0],hi[k][1],hi[k][2],hi[k][3]}
    o[d0]=__builtin_amdgcn_mfma_f32_32x32x16_bf16(pa0,PK(0),o[d0],0,0,0);
    o[d0]=__builtin_amdgcn_mfma_f32_32x32x16_bf16(pa1,PK(1),o[d0],0,0,0);
    o[d0]=__builtin_amdgcn_mfma_f32_32x32x16_bf16(pa2,PK(2),o[d0],0,0,0);
    o[d0]=__builtin_amdgcn_mfma_f32_32x32x16_bf16(pa3,PK(3),o[d0],0,0,0);
    #undef PK
  }
}
__device__ __forceinline__ void namask(f32x16&p0,f32x16&p1,int kr,int qr,unsigned wlo,unsigned whi,lds_fptr brow0,float mh){
  const float BIG=1e30f;
  int r0=qr-4; r0=r0<0?0:(r0>56?56:r0);
  if(kr<r0||kr>=r0+8){
    #pragma unroll
    for(int r=0;r<16;++r){p0[r]=-BIG;p1[r]=-BIG;}
    return; }
  const lds_fptr brow=brow0+(kr-qr+7)*128;
  asm volatile("":"+v"(wlo),"+v"(whi));
  #pragma unroll
  for(int r=0;r<16;++r){
    const int pos=(r&3)+8*(r>>2);
    const float b0=brow[pos]-mh, b1=brow[pos+32]-mh;
    const float f0=(float)((wlo>>pos)&1u), f1=(float)((whi>>pos)&1u);
    p0[r]=(p0[r]+b0)+__builtin_fmaf(f0,BIG,-BIG); p1[r]=(p1[r]+b1)+__builtin_fmaf(f1,BIG,-BIG);
    if((r&3)==3) __builtin_amdgcn_sched_barrier(0); }
}
struct AttnArgs { const AGAS bf16* Q; const AGAS bf16* K; const AGAS bf16* V; AGAS bf16* O; int kr0, kr1, tsw, NT; int qrow0, rb0; const AGAS float* rpb; };
#define ATTN_STORE16(p,v) (*(AGAS u32x4*)(p)=(v))
template<int THRL,bool MASKED> __device__ __forceinline__ void attn_unit(const AttnArgs&a,char*shm,int tid){
  const int lane=tid&63,r32=lane&31,hi=lane>>5; const int wid=__builtin_amdgcn_readfirstlane(tid>>6);
  const AGAS bf16*Qw=a.Q+(long)(wid*QBLK)*QP;
  const AGAS bf16*Kh=a.K,*Vh=a.V;
  const unsigned lds0=(unsigned)(uintptr_t)shm;
  float*wsf=(float*)(shm+LDS_WS)+wid*64;
  const AGAS bf16*ksrc=Kh+(long)lane*KP+wid*8;
  const AGAS bf16*vsrc=Vh+(long)(16*(wid&3)+(lane>>2))*VP+(wid>>2)*32+(lane&3)*8;
  const unsigned kdst=lds0+LDS_K+wid*1024, vdst=lds0+LDS_V+wid*1024;
  const int kr0=a.kr0,kr1=a.kr1,tsw=a.tsw;
  #define KROW(t) ((t)<tsw?kr0+64*(t):kr1+64*((t)-tsw))
  #define DMA_K(t,slot) glds16(ksrc+(long)KROW(t)*KP,(unsigned)__builtin_amdgcn_readfirstlane(kdst+(slot)))
  #define DMA_V(t,slot) glds16(vsrc+(long)KROW(t)*VP,(unsigned)__builtin_amdgcn_readfirstlane(vdst+(slot)))
  const int vb0=(int)(lds0+LDS_V)+((lane>>4)&1)*32+(lane&3)*8+(4*hi+((lane&15)>>2))*64;
  const char*Kbase=shm+LDS_K; bf16x8 kf[8];
  const lds_cptr shm3=(lds_cptr)shm; const lds_cptr kp0=shm3+LDS_K+hi*1024+r32*16; const lds_cptr vp0=shm3+LDS_V+((lane>>4)&1)*32+(lane&3)*8+(4*hi+((lane&15)>>2))*64;
  const lds_fptr biasl=(lds_fptr)(shm3+LDS_BIAS);
  const int NT=a.NT;
  if constexpr(MASKED){ __attribute__((address_space(3))) float* bt=(__attribute__((address_space(3))) float*)(shm3+LDS_BIAS);
    for(int i_=tid;i_<15*128;i_+=512){ const int ri=i_>>7, dc=(i_&127)-48; bt[i_]=(dc>=0&&dc<31)?a.rpb[ri*31+dc]*1.4426950408889634f:0.f; } }
  const int qgr=a.qrow0+(wid>>1), qgc=(wid&1)*32+r32, rb0=a.rb0;
  unsigned wlo=0u,whi=0u; lds_fptr brow0=biasl;
  if constexpr(MASKED){ int cs=qgc-8; cs=cs<0?0:(cs>48?48:cs); const unsigned long long cm=(0xFFFFull<<cs)>>(4*hi); wlo=(unsigned)cm; whi=(unsigned)(cm>>32); brow0=biasl+(4*hi-qgc+63); }
  DMA_K(0,0);DMA_V(0,0);DMA_K(1,SLOTB);
  bf16x8 qr[4];
  #pragma unroll
  for(int d0=0;d0<4;++d0)qr[d0]=*(const AGAS bf16x8*)(&Qw[(long)r32*QP+d0*16+hi*8]);
  float zf_=0.f; asm volatile("":"+v"(zf_)); float mhat=zf_,l_reg=zf_;f32x16 o[2],negm; _Pragma("unroll") for(int r=0;r<16;++r){o[0][r]=zf_;o[1][r]=zf_;negm[r]=zf_;} if constexpr(!MASKED){asm volatile("":"+v"(negm));} const f32x16 zc=f32x16{};
  #define CMASK(P0,P1,t) do{ if constexpr(MASKED){ if((t)>=4) namask(P0,P1,rb0+(t)-4,qgr,wlo,whi,brow0,mhat); else { _Pragma("unroll") for(int r_=0;r_<16;++r_){P0[r_]-=mhat;P1[r_]-=mhat;} } } }while(0)
  bool resc=false;
  #define START(P0,P1) do{ const float rm=rowmax(P0,P1); resc=false; \
    { const float dl=rm; mhat=fadd_s(mhat,dl); \
      _Pragma("unroll") for(int r=0;r<16;++r){P0[r]=fsub_s(P0[r],dl);P1[r]=fsub_s(P1[r],dl);} \
      if constexpr(!MASKED){ _Pragma("unroll") for(int r=0;r<16;++r)negm[r]=-mhat; asm volatile("":"+v"(negm)); } } \
    _Pragma("unroll") for(int r=0;r<16;++r)P0[r]=__builtin_amdgcn_exp2f(P0[r]); }while(0)
  #define RESC() do{ if(resc){ asm volatile("s_waitcnt lgkmcnt(0)":::"memory"); \
      _Pragma("unroll") for(int d_=0;d_<2;++d_) _Pragma("unroll") for(int r=0;r<16;++r)o[d_][r]*=wsf[crow(r,hi)]; } }while(0)
  f32x16 pA0,pA1,pB0,pB1;
  int sl_prev=0,sl_cur=0,sl_next=SLOTB;
  #define ROT() do{sl_prev=sl_cur;sl_cur=sl_next;sl_next=(sl_next==(NSLOT-1)*SLOTB)?0:sl_next+SLOTB;}while(0)
  DMA_K(2,2*SLOTB);
  WAIT_BAR(3);
  qkt(pA0,pA1,Kbase,qr,zc,r32,hi);asm volatile("s_nop 15\n\ts_nop 7":"+v"(pA0),"+v"(pA1));
  START(pA0,pA1);
  _Pragma("unroll") for(int r=0;r<16;++r)pA1[r]=__builtin_amdgcn_exp2f(pA1[r]);
  WAIT_BAR(0);
  DMA_K(3,0);DMA_V(1,SLOTB);
  ROT();
  kload8(kf,kp0+sl_cur);
  WAIT_BAR(2);
  s16x4 vlo[8],vhi[8]; u32x4 pw0,pw1,pw2,pw3;
  #define PKW(P,B) cvtpk_s(P[B],P[B+1])
  #define PAF(k) __builtin_bit_cast(bf16x8,pw##k)
  #define VFR(i) (bf16x8){vlo[i][0],vlo[i][1],vlo[i][2],vlo[i][3],vhi[i][0],vhi[i][1],vhi[i][2],vhi[i][3]}
  #define PIN(x) asm volatile("":"+v"(x))
  #define MX3(a,b,c) __builtin_fmaxf(__builtin_fmaxf((a),(b)),(c))
  #define GAPA(MF,A0,A1,A2,A3,W0,W1,PW) do{ MF; sacc+=A0; sacc+=A1; sacc+=A2; sacc+=A3; PIN(sacc); W0; W1; PIN(PW); SBAR(); }while(0)
  #define EX(v) __builtin_amdgcn_exp2f(v)
  #define GAPB(MF,X,B) do{ MF; X[B]=EX(X[B]); X[B+1]=EX(X[B+1]); X[B+2]=EX(X[B+2]); X[B+3]=EX(X[B+3]); PIN(X); SBAR(); }while(0)
  #define VRD(i) do{ vlo[i]=vtr(vp_+(((i)>>2)*4096+((i)&3)*1024)); vhi[i]=vtr(vp_+(((i)>>2)*4096+((i)&3)*1024+512)); }while(0)
  #define KRD(G,j) do{ if(G){ kload2(kf,kp0+sl_next,j); SBAR(); } }while(0)
  #define STEP(C0,C1,P0,P1,t,GK,GV,GL) do{ SBAR(); \
    const lds_cptr vp_=vp0+sl_prev; \
    VRD(0); SBAR(); float sacc=(P0[0]+P0[1]); \
    GAPA(C0=__builtin_amdgcn_mfma_f32_32x32x16_bf16(kf[0],qr[0],(MASKED?zc:negm),0,0,0), P0[2],P0[3],P0[4],P0[5],     pw0[0]=PKW(P0,0), pw0[1]=PKW(P0,2), pw0); \
    VRD(4); SBAR(); GAPA(C1=__builtin_amdgcn_mfma_f32_32x32x16_bf16(kf[1],qr[0],(MASKED?zc:negm),0,0,0), P0[6],P0[7],P0[8],P0[9],     pw0[2]=PKW(P0,4), pw0[3]=PKW(P0,6), pw0); \
    VRD(1); SBAR(); GAPA(C0=__builtin_amdgcn_mfma_f32_32x32x16_bf16(kf[2],qr[1],C0,0,0,0),   P0[10],P0[11],P0[12],P0[13], pw1[0]=PKW(P0,8), pw1[1]=PKW(P0,10), pw1); \
    VRD(5); SBAR(); GAPA(C1=__builtin_amdgcn_mfma_f32_32x32x16_bf16(kf[3],qr[1],C1,0,0,0),   P0[14],P0[15],P1[0],P1[1],   pw1[2]=PKW(P0,12),pw1[3]=PKW(P0,14), pw1); \
    VRD(2); SBAR(); GAPA(C0=__builtin_amdgcn_mfma_f32_32x32x16_bf16(kf[4],qr[2],C0,0,0,0),   P1[2],P1[3],P1[4],P1[5],     pw2[0]=PKW(P1,0), pw2[1]=PKW(P1,2), pw2); \
    VRD(6); SBAR(); GAPA(C1=__builtin_amdgcn_mfma_f32_32x32x16_bf16(kf[5],qr[2],C1,0,0,0),   P1[6],P1[7],P1[8],P1[9],     pw2[2]=PKW(P1,4), pw2[3]=PKW(P1,6), pw2); \
    VRD(3); SBAR(); GAPA(C0=__builtin_amdgcn_mfma_f32_32x32x16_bf16(kf[6],qr[3],C0,0,0,0),   P1[10],P1[11],P1[12],P1[13], pw3[0]=PKW(P1,8), pw3[1]=PKW(P1,10), pw3); \
    VRD(7); SBAR(); GAPA(C1=__builtin_amdgcn_mfma_f32_32x32x16_bf16(kf[7],qr[3],C1,0,0,0),   P1[14],P1[15],0.f,0.f,       pw3[2]=PKW(P1,12),pw3[3]=PKW(P1,14), pw3); \
    l_reg+=sacc; \
    if(GK){DMA_K((t)+3,sl_cur);} if(GV){DMA_V((t)+1,sl_next);} \
    CMASK(C0,C1,t); \
    { float a_=MX3(C0[0],C0[1],C1[0]),b_=MX3(C0[2],C0[3],C1[1]); a_=MX3(a_,C1[2],C1[3]); \
      _Pragma("unroll") for(int r=4;r<16;r+=4){a_=MX3(a_,C0[r],C0[r+1]);b_=MX3(b_,C0[r+2],C0[r+3]);a_=MX3(a_,C1[r],C1[r+1]);b_=MX3(b_,C1[r+2],C1[r+3]);} \
      float rm=__builtin_fmaxf(a_,b_); { auto rr=__builtin_amdgcn_permlane32_swap(__float_as_uint(rm),__float_as_uint(rm),false,false); rm=__builtin_fmaxf(__uint_as_float(rr[0]),__uint_as_float(rr[1])); } \
      resc=false; \
      if(__builtin_expect(__any(rm>(float)THRL),0)){ const float dl=__builtin_fmaxf(rm,0.f); mhat+=dl; \
        _Pragma("unroll") for(int r=0;r<16;++r){C0[r]-=dl;C1[r]-=dl;} \
        if constexpr(!MASKED){ _Pragma("unroll") for(int r=0;r<16;++r)negm[r]=-mhat; asm volatile("":"+v"(negm)); } \
        const float f=__builtin_amdgcn_exp2f(-dl); l_reg*=f; if(hi==0)wsf[r32]=f; resc=true; } } \
    SBAR(); \
    GAPB(o[0]=__builtin_amdgcn_mfma_f32_32x32x16_bf16(PAF(0),VFR(0),o[0],0,0,0), C0,0); \
    GAPB(o[1]=__builtin_amdgcn_mfma_f32_32x32x16_bf16(PAF(0),VFR(4),o[1],0,0,0), C0,4); \
    KRD(GL,0); GAPB(o[0]=__builtin_amdgcn_mfma_f32_32x32x16_bf16(PAF(1),VFR(1),o[0],0,0,0), C0,8); \
    KRD(GL,1); GAPB(o[1]=__builtin_amdgcn_mfma_f32_32x32x16_bf16(PAF(1),VFR(5),o[1],0,0,0), C0,12); \
    KRD(GL,2); GAPB(o[0]=__builtin_amdgcn_mfma_f32_32x32x16_bf16(PAF(2),VFR(2),o[0],0,0,0), C1,0); \
    KRD(GL,3); GAPB(o[1]=__builtin_amdgcn_mfma_f32_32x32x16_bf16(PAF(2),VFR(6),o[1],0,0,0), C1,4); \
    GAPB(o[0]=__builtin_amdgcn_mfma_f32_32x32x16_bf16(PAF(3),VFR(3),o[0],0,0,0), C1,8); \
    GAPB(o[1]=__builtin_amdgcn_mfma_f32_32x32x16_bf16(PAF(3),VFR(7),o[1],0,0,0), C1,12); \
    }while(0)
  int t=1;
  for(;t+5<NT;t+=2){
    STEP(pB0,pB1,pA0,pA1,t,true,true,true);     WAIT_BAR(2); RESC(); ROT();
    STEP(pA0,pA1,pB0,pB1,t+1,true,true,true);   WAIT_BAR(2); RESC(); ROT();
  }
  #define ENDW(tt) do{ if((tt)+3<NT){WAIT_BAR(2);} else if((tt)+2<NT){WAIT_BAR(1);} else {WAIT_BAR(0);} }while(0)
  for(;t+1<NT;t+=2){
    STEP(pB0,pB1,pA0,pA1,t,(t+3<NT),(t+1<NT),(t+1<NT));       ENDW(t);   RESC(); ROT();
    STEP(pA0,pA1,pB0,pB1,t+1,(t+4<NT),(t+2<NT),(t+2<NT));     ENDW(t+1); RESC(); ROT();
  }
  STEP(pB0,pB1,pA0,pA1,NT-1,false,false,false); RESC();
  { float sacc=pB0[0]+pB0[1]; _Pragma("unroll") for(int r=2;r<16;++r)sacc+=pB0[r]; _Pragma("unroll") for(int r=0;r<16;++r)sacc+=pB1[r]; l_reg+=sacc;
    pw0=(u32x4){PKW(pB0,0),PKW(pB0,2),PKW(pB0,4),PKW(pB0,6)};pw1=(u32x4){PKW(pB0,8),PKW(pB0,10),PKW(pB0,12),PKW(pB0,14)};pw2=(u32x4){PKW(pB1,0),PKW(pB1,2),PKW(pB1,4),PKW(pB1,6)};pw3=(u32x4){PKW(pB1,8),PKW(pB1,10),PKW(pB1,12),PKW(pB1,14)};
    SBAR(); pv(o,vb0+sl_cur,PAF(0),PAF(1),PAF(2),PAF(3)); }
  #undef PKW
  #undef PAF
  #undef VFR
  #undef PIN
  #undef MX3
  #undef GAPA
  #undef GAPB
  #undef EX
  #undef VRD
  #undef KRD
  #undef STEP
  #undef ENDW
  {auto rr=__builtin_amdgcn_permlane32_swap(__float_as_uint(l_reg),__float_as_uint(l_reg),false,false);l_reg=__uint_as_float(rr[0])+__uint_as_float(rr[1]);}
  if(hi==0)wsf[32+r32]=l_reg;asm volatile("s_waitcnt lgkmcnt(0)":::"memory");
  float rli[16];
  #pragma unroll
  for(int r=0;r<16;++r)rli[r]=__builtin_amdgcn_rcpf(wsf[32+crow(r,hi)]);
  AGAS bf16*Ow=a.O+(long)(wid*QBLK)*OP;
  { bf16*stg=(bf16*)(shm+LDS_OST)+wid*2048;
    #pragma unroll
    for(int r=0;r<16;++r){const int orow=crow(r,hi);
      #pragma unroll
      for(int d0=0;d0<2;++d0)stg[orow*64+d0*32+r32]=__float2bfloat16(o[d0][r]*rli[r]);}
    asm volatile("s_waitcnt lgkmcnt(0)":::"memory");
    #pragma unroll
    for(int i=0;i<4;++i){const int row=i*8+(lane>>3),ch=lane&7; const u32x4 v=*(const u32x4*)(stg+row*64+ch*8); ATTN_STORE16(Ow+(long)row*OP+ch*8,v);} }
  asm volatile("s_waitcnt lgkmcnt(0)\n\ts_barrier":::"memory");
  #undef KROW
  #undef DMA_K
  #undef DMA_V
  #undef CMASK
  #undef START
  #undef RESC
  #undef ROT
}
#undef SBAR
#undef WAIT_BAR
}
constexpr int NWAVES = 8, NTHR = 512;
constexpr int DM = 1024, NBATCH = 4, SEQ = 4096, CTXL = 256, RPB = SEQ + CTXL  , MROWS = NBATCH * RPB  , NLAYER = 2;
constexpr int PW = 4352;
constexpr int C_GQ = 0, C_GK = 512, C_GV = 640, C_NQ = 768, C_NK = 1280, C_NV = 1792, C_F = 2304, C_CA = 3328, C_CB = 3840, C_G = 4352;
constexpr int YW = 2048;
constexpr int INW = 7936;
constexpr int NEXP = 16, EFF = 512, MOE_ROWS = 38912  ;
constexpr float EPS = 1e-6f, LOG2E = 1.4426950408889634f;
constexpr float QSCALE = 0.125f * LOG2E;
constexpr size_t MiB = 1u << 20;
constexpr size_t WS_CTL = 0, CTL_ZERO_BYTES = 1 * MiB;
constexpr size_t WS_MODV = 1 * MiB;
constexpr size_t WS_ROPE = 1 * MiB + 384 * 1024;
constexpr size_t WS_TOKE = 2 * MiB, WS_TOKW = WS_TOKE + 160 * 1024, WS_TOKR = WS_TOKW + 160 * 1024, WS_TOKS = WS_TOKR + 160 * 1024;
constexpr size_t WS_XC = 4 * MiB;
constexpr size_t WS_WIN = 8 * MiB;
constexpr size_t WS_WB = 25 * MiB;
constexpr size_t WS_WO = 29 * MiB;
constexpr size_t WS_WGU = 32 * MiB;
constexpr size_t WS_WD = 64 * MiB;
constexpr size_t WS_H = 80 * MiB;
constexpr size_t WS_Y = 114 * MiB;
constexpr size_t WS_TP = WS_H;
constexpr size_t WS_WGU2 = 182 * MiB, WS_WD2 = 495 * MiB;
constexpr size_t WS_P = 214 * MiB;
constexpr size_t WS_GN = WS_P + 145 * MiB;
constexpr size_t WS_AM = WS_P, WS_HM = WS_P + 76 * MiB, WS_OM = WS_P + 114 * MiB;
constexpr size_t WS_END = 511 * MiB;
static_assert(WS_WIN + (size_t)PW * DM * 2 <= WS_WB && WS_P + (size_t)MROWS * PW * 2 <= WS_GN && WS_GN + (size_t)68 * 16 * 65536 * 2 <= WS_WD2 && WS_OM + (size_t)MOE_ROWS * DM * 2 <= WS_END, "ws map");
constexpr int CW_BAR = 4096;
constexpr int CW_CNT = 16384;
constexpr int RING_OFF = 0, RING_BYTES = 131072;
constexpr int LDSCTL_OFF = RING_BYTES, MISC_OFF = LDSCTL_OFF + 320;
constexpr int LDS_BYTES = 147456;

#define GAS __attribute__((address_space(1)))
#define LAS __attribute__((address_space(3)))
typedef unsigned short bf16;
typedef unsigned v4u __attribute__((ext_vector_type(4)));
typedef unsigned v2u __attribute__((ext_vector_type(2)));
typedef float f32x4 __attribute__((ext_vector_type(4)));
typedef GAS unsigned gu32;
#define RLX_AGENT __ATOMIC_RELAXED, __HIP_MEMORY_SCOPE_AGENT
#define LDS_WAIT() asm volatile("s_waitcnt lgkmcnt(0)" ::: "memory")
__device__ __forceinline__ unsigned f2bf(float f) { unsigned u = __builtin_bit_cast(unsigned, f); return (u + 0x7fffu + ((u >> 16) & 1u)) >> 16; }
__device__ __forceinline__ unsigned pk2(float lo, float hi) { return f2bf(lo) | (f2bf(hi) << 16); }
__device__ __forceinline__ float bf_lo(unsigned w) { return __uint_as_float(w << 16); }
__device__ __forceinline__ float bf_hi(unsigned w) { return __uint_as_float(w & 0xffff0000u); }
__device__ __forceinline__ float bf1(bf16 v) { return __uint_as_float(((unsigned)v) << 16); }
__device__ __forceinline__ float sigm(float x) { return 1.0f / (1.0f + __expf(-x)); }

#define XB_TMO      128
#define XB_XCNT(j)  (256  + 64 * (j))
#define XB_XSUB(j)  (1280 + 64 * (j))
#define XB_XGEN(j)  (2304 + 64 * (j))
#define XB_TOP      3328
#define XB_TOPGEN   3392
#define XCD_BAR_WORDS 3456
#define XB_SPIN_CAP (1u << 18)
__device__ __forceinline__ unsigned xb_ld(unsigned* p)              { return __hip_atomic_load(p, __ATOMIC_RELAXED, __HIP_MEMORY_SCOPE_AGENT); }
__device__ __forceinline__ unsigned xb_add(unsigned* p, unsigned v) { return __hip_atomic_fetch_add(p, v, __ATOMIC_RELAXED, __HIP_MEMORY_SCOPE_AGENT); }
__device__ __forceinline__ unsigned xb_xcc_id() { return (unsigned)__builtin_amdgcn_s_getreg((3 << 11) | 20) & 0xFu; }
#define XB_SPIN(cond, bar) do { unsigned _sp = 0; while (cond) { __builtin_amdgcn_s_sleep(1); \
    if ((++_sp & 255u) == 0u) { if (xb_ld(&(bar)[XB_TMO])) break; if (_sp > XB_SPIN_CAP) { atomicAdd(&(bar)[XB_TMO], 1u); break; } } } } while (0)
struct XcdBarrier { unsigned* bar; unsigned x; volatile LAS unsigned* st; };
__device__ __forceinline__ XcdBarrier xcd_barrier_post(unsigned* bar, volatile LAS unsigned* st) {
    XcdBarrier b; b.bar = bar; b.x = xb_xcc_id(); b.st = st;
    if (threadIdx.x == 0) (void)xb_add(&bar[XB_XCNT(b.x)], 1u);
    return b;
}
__device__ __forceinline__ void xcd_barrier_complete(unsigned* bar, unsigned x, unsigned& nloc, unsigned& nx) {
    const unsigned G = gridDim.x * gridDim.y * gridDim.z;
    unsigned sum, cnt, mine, sp = 0u;
    for (;;) {
        sum = 0u; cnt = 0u; mine = 0u;
#pragma unroll
        for (unsigned j = 0; j < 16; ++j) { const unsigned c = xb_ld(&bar[XB_XCNT(j)]); sum += c; cnt += (c > 0u) ? 1u : 0u; mine = (j == x) ? c : mine; }
        if (sum == G) break;
        __builtin_amdgcn_s_sleep(1);
        if ((++sp & 255u) == 0u) { if (xb_ld(&bar[XB_TMO])) break; if (sp > XB_SPIN_CAP) { atomicAdd(&bar[XB_TMO], 1u); break; } }
    }
    nloc = mine > 0u ? mine : 1u; nx = cnt > 0u ? cnt : 1u;
}
__device__ __forceinline__ void xcd_barrier(const XcdBarrier& b) {
    asm volatile("s_waitcnt vmcnt(0)" ::: "memory");
    __syncthreads();
    if (threadIdx.x == 0) {
        unsigned* bar = b.bar;
        __builtin_amdgcn_s_waitcnt(0);
        unsigned nloc = b.st[0], nx = b.st[1];
        if (nloc == 0u) { xcd_barrier_complete(bar, b.x, nloc, nx); b.st[0] = nloc; b.st[1] = nx; }
        const unsigned old = xb_add(&bar[XB_XSUB(b.x)], 1u);
        const unsigned gen = old / nloc;
        if (old + 1u == (gen + 1u) * nloc) {
            __builtin_amdgcn_fence(__ATOMIC_RELEASE, "agent");
            asm volatile("s_waitcnt vmcnt(0)" ::: "memory");
            const unsigned og = xb_add(&bar[XB_TOP], 1u);
            const unsigned tg = og / nx;
            if (og + 1u == (tg + 1u) * nx) xb_add(&bar[XB_TOPGEN], 1u);
            else XB_SPIN(xb_ld(&bar[XB_TOPGEN]) == tg, bar);
            __builtin_amdgcn_fence(__ATOMIC_ACQUIRE, "agent");
            xb_add(&bar[XB_XGEN(b.x)], 1u);
            asm volatile("s_waitcnt vmcnt(0)" ::: "memory");
        } else {
            XB_SPIN(xb_ld(&bar[XB_XGEN(b.x)]) == gen, bar);
            __builtin_amdgcn_fence(__ATOMIC_ACQUIRE, "agent");
            asm volatile("s_waitcnt vmcnt(0)" ::: "memory");
        }
    }
    __syncthreads();
}

struct Frame {
    LAS unsigned char* lds; volatile LAS unsigned* MISC; LAS unsigned* LCTL;
    gu32* ctl; unsigned char* ws; GAS float* out; int tid, lane, wave, vcu, G;
};
constexpr int PTR_OFF = LDSCTL_OFF + 96;
__device__ __forceinline__ const GAS float* INP(const Frame& F, int i) {
    const LAS unsigned* t = (const LAS unsigned*)(F.lds + PTR_OFF) + 2 * i;
    const unsigned lo = __builtin_amdgcn_readfirstlane(t[0]), hi = __builtin_amdgcn_readfirstlane(t[1]);
    return (const GAS float*)(((unsigned long long)hi << 32) | lo);
}
__device__ __forceinline__ float shx(float v, int m, int lane) { return __builtin_bit_cast(float, __builtin_amdgcn_ds_bpermute((lane ^ m) << 2, __builtin_bit_cast(int, v))); }
__device__ __forceinline__ float wave_sum(float v, int lane) {
#pragma unroll
    for (int o = 1; o < 64; o <<= 1) v += shx(v, o, lane);
    return v;
}
__device__ __forceinline__ const GAS float* xrow_in(const Frame& F, int row) { const int b = row / RPB, t = row % RPB; return t < SEQ ? INP(F, 0) + ((size_t)b * SEQ + t) * DM : INP(F, 2) + ((size_t)b * CTXL + (t - SEQ)) * DM; }
__device__ __forceinline__ GAS float* xrow_ws(const Frame& F, int row) { const int b = row / RPB, t = row % RPB; return t < SEQ ? F.out + ((size_t)b * SEQ + t) * DM : ((GAS float*)(F.ws + WS_XC)) + ((size_t)b * CTXL + (t - SEQ)) * DM; }
__device__ __forceinline__ int modidx(int row) { const int b = row / RPB, t = row % RPB; return t < SEQ ? b : 4; }

__device__ __forceinline__ void tr_item(const GAS float* W, int ldw, int k0, int n0, GAS bf16* WT, int ldt, int drow0, int dcol0, LAS float* scr, int lane) {
    f32x4 t[8];
#pragma unroll
    for (int i = 0; i < 8; ++i) t[i] = *(const GAS f32x4*)(W + (size_t)(k0 + 8 * i + (lane >> 3)) * ldw + n0 + 4 * (lane & 7));
#pragma unroll
    for (int i = 0; i < 8; ++i) { LAS float* d = scr + (8 * i + (lane >> 3)) * 33 + 4 * (lane & 7); d[0] = t[i].x; d[1] = t[i].y; d[2] = t[i].z; d[3] = t[i].w; }
    LDS_WAIT(); asm volatile("" ::: "memory");
    const int c = lane & 7;
#pragma unroll
    for (int j = 0; j < 4; ++j) { const int n = (lane >> 3) + 8 * j; const LAS float* s = scr + (8 * c) * 33 + n;
        v4u o; o.x = pk2(s[0 * 33], s[1 * 33]); o.y = pk2(s[2 * 33], s[3 * 33]); o.z = pk2(s[4 * 33], s[5 * 33]); o.w = pk2(s[6 * 33], s[7 * 33]);
        *(GAS v4u*)(WT + (size_t)(drow0 + n) * ldt + dcol0 + 8 * c) = o; }
    LDS_WAIT(); asm volatile("" ::: "memory");
}
constexpr int CV_IN = 1, CV_BR = 2, CV_OUT = 4, CV_GU = 8, CV_DN = 16, CV_ALL = 31;
__device__ __forceinline__ void convert_weights(Frame& F, int l, int parts, int rank, int nranks) {
    if (rank < 0) return;
    LAS float* scr = (LAS float*)(F.lds + RING_OFF + F.wave * 16384);
    const int gw = rank * NWAVES + F.wave, NGW = nranks * NWAVES;
    constexpr int I_IN = 16 * (INW / 32), I_BR = 4 * 8 * 32, I_O = 16 * 32, I_GU = 16 * 16 * 32, I_D = 16 * 8 * 32;
    GAS bf16* WGUd = (GAS bf16*)(F.ws + ((l & 1) ? WS_WGU2 : WS_WGU)); GAS bf16* WDd = (GAS bf16*)(F.ws + ((l & 1) ? WS_WD2 : WS_WD));
    const int n_in = (parts & CV_IN) ? I_IN : 0, n_br = (parts & CV_BR) ? I_BR : 0, n_o = (parts & CV_OUT) ? I_O : 0, n_gu = (parts & CV_GU) ? I_GU : 0, n_d = (parts & CV_DN) ? I_D : 0;
    const int nitems = n_in + n_br + n_o + n_gu + n_d;
    for (int it = gw; it < nitems; it += NGW) {
        int r = it;
        if (r < n_in) { const int nblk = INW / 32, kb = r / nblk, nb = r % nblk, n0 = 32 * nb;
            if (n0 >= 2304 && n0 < 2816) continue;
            const int drow = n0 < 2304 ? n0 : n0 + 512;
            tr_item(INP(F, 8) + (size_t)l * DM * INW, INW, 64 * kb, n0, ((GAS bf16*)(F.ws + WS_WIN)), DM, drow, 64 * kb, scr, F.lane); continue; } r -= n_in;
        if (r < n_br) { const int nbr = r / 256, q = r % 256, kb = q / 32, nb = q % 32;
            tr_item(INP(F, 15) + ((size_t)l * 4 + nbr) * 512 * DM, DM, 64 * kb, 32 * nb, ((GAS bf16*)(F.ws + WS_WB)), 2048, 32 * nb, nbr * 512 + 64 * kb, scr, F.lane); continue; } r -= n_br;
        if (r < n_o) { const int kb = r / 32, nb = r % 32;
            tr_item(INP(F, 16) + (size_t)l * DM * DM, DM, 64 * kb, 32 * nb, ((GAS bf16*)(F.ws + WS_WO)), DM, 32 * nb, 64 * kb, scr, F.lane); continue; } r -= n_o;
        if (r < n_gu) { const int e = r / 512, q = r % 512, kb = q / 32, nb = q % 32, n0 = 32 * nb;
            const int drow = n0 < 512 ? (n0 / 128) * 256 + (n0 % 128) : ((n0 - 512) / 128) * 256 + 128 + ((n0 - 512) % 128);
            tr_item(INP(F, 19) + ((size_t)l * NEXP + e) * DM * DM, DM, 64 * kb, n0, WGUd + (size_t)e * DM * DM, DM, drow, 64 * kb, scr, F.lane); continue; } r -= n_gu;
        { const int e = r / 256, q = r % 256, kb = q / 32, nb = q % 32;
            tr_item(INP(F, 20) + ((size_t)l * NEXP + e) * EFF * DM, DM, 64 * kb, 32 * nb, WDd + (size_t)e * DM * EFF, EFF, 32 * nb, 64 * kb, scr, F.lane); }
    }
    if (!(parts & CV_IN)) return;
    __syncthreads();
    LAS float* wt = (LAS float*)(F.lds + RING_OFF);
    LAS float* tab = (LAS float*)(F.lds + RING_OFF + 32768);
    if (F.tid < 128) { float s, c; sincospif((float)F.tid * (1.0f / 64.0f), &s, &c); tab[2 * F.tid] = c; tab[2 * F.tid + 1] = s; }
    for (int u = rank; u < 64; u += nranks) {
        const int kt = u >> 2, g = u & 3;
        __syncthreads();
#pragma unroll
        for (int i = 0; i < 16; ++i) { const int idx = i * 512 + F.tid, kk = idx >> 7, c = idx & 127; wt[idx] = INP(F, 8)[(size_t)l * DM * INW + (size_t)(kt * 64 + kk) * INW + 2304 + g * 128 + c]; }
        __syncthreads();
        const int kc = F.tid & 127, kq = F.tid >> 7;
        float aA[16], aB[16];
#pragma unroll
        for (int i = 0; i < 16; ++i) { aA[i] = 0.f; aB[i] = 0.f; }
        for (int c = 0; c < 128; ++c) { const int ti = (c * kc) & 127; const float cs = tab[2 * ti], sn = tab[2 * ti + 1];
#pragma unroll
            for (int i = 0; i < 16; ++i) { const float w = wt[(kq * 16 + i) * 128 + c]; aA[i] += w * cs; aB[i] += w * sn; } }
        GAS bf16* ra = ((GAS bf16*)(F.ws + WS_WIN)) + (size_t)(2304 + g * 128 + kc) * DM + kt * 64 + kq * 16; GAS bf16* rb = ra + (size_t)512 * DM;
        v4u o; o.x = pk2(aA[0], aA[1]); o.y = pk2(aA[2], aA[3]); o.z = pk2(aA[4], aA[5]); o.w = pk2(aA[6], aA[7]); *(GAS v4u*)ra = o;
        o.x = pk2(aA[8], aA[9]); o.y = pk2(aA[10], aA[11]); o.z = pk2(aA[12], aA[13]); o.w = pk2(aA[14], aA[15]); *(GAS v4u*)(ra + 8) = o;
        o.x = pk2(aB[0], aB[1]); o.y = pk2(aB[2], aB[3]); o.z = pk2(aB[4], aB[5]); o.w = pk2(aB[6], aB[7]); *(GAS v4u*)rb = o;
        o.x = pk2(aB[8], aB[9]); o.y = pk2(aB[10], aB[11]); o.z = pk2(aB[12], aB[13]); o.w = pk2(aB[14], aB[15]); *(GAS v4u*)(rb + 8) = o;
    }
    __syncthreads();
}
__device__ __forceinline__ void mod_vectors(Frame& F) {
    LAS float* sc = (LAS float*)(F.lds + RING_OFF);
    LAS float* part = (LAS float*)(F.lds + RING_OFF + 32768);
    if (F.vcu == 0) for (int i = F.tid; i < 1024; i += NTHR) { const float invf = exp2f(-(float)(i & 15) * (13.287712379549449f / 16.0f)); float sn, cs; sincosf((float)(i >> 4) * invf, &sn, &cs);
        ((GAS float*)(F.ws + WS_ROPE))[2 * i] = cs; ((GAS float*)(F.ws + WS_ROPE))[2 * i + 1] = sn; }
    for (int i = F.tid; i < 5 * DM; i += NTHR) { const float v = i < 4 * DM ? INP(F, 1)[i] : INP(F, 3)[i - 4 * DM]; sc[i] = v * sigm(v); }
    __syncthreads();
    for (int u = F.vcu; u < 2 * 96; u += F.G) {
        const int l = u / 96, j = (u % 96) * 64 + F.lane;
        const GAS float* wp = INP(F, 4) + (size_t)l * DM * 6144 + (size_t)(F.wave * 128) * 6144 + j;
        float a0 = 0.f, a1 = 0.f, a2 = 0.f, a3 = 0.f, a4 = 0.f;
#pragma unroll 8
        for (int kk = 0; kk < 128; ++kk) { const float w = wp[(size_t)kk * 6144]; const int k = F.wave * 128 + kk;
            a0 += sc[k] * w; a1 += sc[DM + k] * w; a2 += sc[2 * DM + k] * w; a3 += sc[3 * DM + k] * w; a4 += sc[4 * DM + k] * w; }
        part[(F.wave * 5 + 0) * 64 + F.lane] = a0; part[(F.wave * 5 + 1) * 64 + F.lane] = a1; part[(F.wave * 5 + 2) * 64 + F.lane] = a2; part[(F.wave * 5 + 3) * 64 + F.lane] = a3; part[(F.wave * 5 + 4) * 64 + F.lane] = a4;
        __syncthreads();
        if (F.tid < 320) { const int bp = F.tid >> 6, ln = F.tid & 63; float s = 0.f;
#pragma unroll
            for (int w = 0; w < 8; ++w) s += part[(w * 5 + bp) * 64 + ln];
            const int jj = (u % 96) * 64 + ln; ((GAS float*)(F.ws + WS_MODV))[((size_t)l * 5 + bp) * 6144 + jj] = s + INP(F, 5)[(size_t)l * 6144 + jj]; }
        __syncthreads();
    }
}
__device__ __forceinline__ void norm_mod(f32x4 (&v)[4], const GAS float* g, const GAS float* sc, const GAS float* sh, int lane) {
    float ss = 0.f;
#pragma unroll
    for (int j = 0; j < 4; ++j) ss += (v[j].x * v[j].x + v[j].y * v[j].y) + (v[j].z * v[j].z + v[j].w * v[j].w);
    const float rstd = 1.0f / sqrtf(wave_sum(ss, lane) * (1.0f / DM) + EPS);
#pragma unroll
    for (int j = 0; j < 4; ++j) { const int c = 4 * lane + 256 * j; const f32x4 gg = *(const f32x4*)(g + c), s1 = *(const f32x4*)(sc + c), s0 = *(const f32x4*)(sh + c);
        v[j] = v[j] * rstd * gg * (s1 + 1.0f) + s0; }
}
__device__ __forceinline__ void store_bf16_row(GAS bf16* orow, const f32x4 (&v)[4], int lane) {
#pragma unroll
    for (int j = 0; j < 4; ++j) { v2u w; w.x = pk2(v[j].x, v[j].y); w.y = pk2(v[j].z, v[j].w); *(GAS v2u*)(orow + 4 * lane + 256 * j) = w; }
}
__device__ __forceinline__ void load_row(f32x4 (&v)[4], const GAS float* xr, int lane) {
#pragma unroll
    for (int j = 0; j < 4; ++j) v[j] = *(const GAS f32x4*)(xr + 4 * lane + 256 * j);
}
__device__ __forceinline__ void phase_norm1_first(Frame& F) {
    const int gw = F.vcu * NWAVES + F.wave, NGW = F.G * NWAVES; const GAS float* mv = ((GAS float*)(F.ws + WS_MODV)); const GAS float* g1 = INP(F, 6);
    for (int row = gw; row < MROWS; row += 2 * NGW) { const int row2 = row + NGW; const bool has2 = row2 < MROWS;
        f32x4 v[4], v2[4]; load_row(v, xrow_in(F, row), F.lane); if (has2) load_row(v2, xrow_in(F, row2), F.lane);
        { const GAS float* m = mv + (size_t)modidx(row) * 6144; norm_mod(v, g1, m + 1024, m, F.lane); store_bf16_row(((GAS bf16*)(F.ws + WS_H)) + (size_t)row * DM, v, F.lane); }
        if (has2) { const GAS float* m = mv + (size_t)modidx(row2) * 6144; norm_mod(v2, g1, m + 1024, m, F.lane); store_bf16_row(((GAS bf16*)(F.ws + WS_H)) + (size_t)row2 * DM, v2, F.lane); } }
}
__device__ __forceinline__ void phase_qkrope(Frame& F, int l) {
    const int gw = F.vcu * NWAVES + F.wave, NGW = F.G * NWAVES; const int lane = F.lane, i = lane & 31;
    const GAS float* rope = (const GAS float*)(F.ws + WS_ROPE) + 2 * (i & 15);
    const float qg0 = INP(F, 9)[l * 64 + 2 * i], qg1 = INP(F, 9)[l * 64 + 2 * i + 1], kg0 = INP(F, 10)[l * 64 + 2 * i], kg1 = INP(F, 10)[l * 64 + 2 * i + 1];
    for (int row = gw; row < MROWS; row += NGW) {
        const int t = row % RPB; const bool lat = t < SEQ; GAS bf16* pr = ((GAS bf16*)(F.ws + WS_P)) + (size_t)row * PW;
        float cs = 1.f, sn = 0.f;
        if (lat) { const int pos = (i < 16) ? (t >> 6) : (t & 63); cs = rope[pos * 32]; sn = rope[pos * 32 + 1]; }
#pragma unroll
        for (int it = 0; it < 5; ++it) { const int hh = 2 * it + (lane >> 5); const int col = (hh < 8 ? hh * 64 : C_GK + (hh - 8) * 64) + 2 * i;
            const unsigned w = *(const GAS unsigned*)(pr + col); float x1 = bf_lo(w), x2 = bf_hi(w);
            float ss = x1 * x1 + x2 * x2;
            ss += shx(ss, 1, lane); ss += shx(ss, 2, lane); ss += shx(ss, 4, lane); ss += shx(ss, 8, lane); ss += shx(ss, 16, lane);
            const float rstd = __builtin_amdgcn_rsqf(ss * (1.0f / 64.0f) + EPS);
            x1 = x1 * rstd * (hh < 8 ? qg0 : kg0); x2 = x2 * rstd * (hh < 8 ? qg1 : kg1);
            float y1 = x1 * cs - x2 * sn, y2 = x1 * sn + x2 * cs;
            if (hh < 8) { y1 *= QSCALE; y2 *= QSCALE; }
            *(GAS unsigned*)(pr + col) = pk2(y1, y2); }
        { const v4u w = *(const GAS v4u*)(pr + C_NQ + 8 * lane); v4u o;
          o.x = pk2(bf_lo(w.x) * QSCALE, bf_hi(w.x) * QSCALE); o.y = pk2(bf_lo(w.y) * QSCALE, bf_hi(w.y) * QSCALE); o.z = pk2(bf_lo(w.z) * QSCALE, bf_hi(w.z) * QSCALE); o.w = pk2(bf_lo(w.w) * QSCALE, bf_hi(w.w) * QSCALE);
          *(GAS v4u*)(pr + C_NQ + 8 * lane) = o; }
    }
}
__device__ __forceinline__ void phase_conv(Frame& F, int l) {
    LAS float* zl = (LAS float*)(F.lds + RING_OFF);
    LAS float* red = (LAS float*)(F.lds + RING_OFF + 62 * 512 * 4);
    const int ch = F.tid; const int nchunk = (l == 0) ? 136 : 128;
    float w[31];
#pragma unroll
    for (int j = 0; j < 31; ++j) w[j] = INP(F, 12)[((size_t)l * 31 + j) * 512 + ch];
    const float cb = INP(F, 13)[l * 512 + ch], cg = INP(F, 14)[l * 512 + ch];
    const GAS bf16* P = ((GAS bf16*)(F.ws + WS_P)); GAS bf16* Y = ((GAS bf16*)(F.ws + WS_Y));
    for (int u = F.vcu; u < NBATCH * nchunk; u += F.G) {
        const int b = u / nchunk, c = u % nchunk; const bool lat = c < 128;
        const int seq0 = b * RPB + (lat ? 0 : SEQ), slen = lat ? SEQ : CTXL, t0 = 32 * (lat ? c : c - 128);
        __syncthreads();
#pragma unroll
        for (int it = 0; it < 8; ++it) { const int item = it * 512 + F.tid;
            if (item < 62 * 64) { const int i = item >> 6, cgp = item & 63; const int t = t0 - 15 + i; f32x4 z0 = {0.f, 0.f, 0.f, 0.f}, z1 = {0.f, 0.f, 0.f, 0.f};
                if (t >= 0 && t < slen) { const GAS bf16* pr = P + (size_t)(seq0 + t) * PW; const v4u a = *(const GAS v4u*)(pr + C_CA + 8 * cgp), g = *(const GAS v4u*)(pr + C_CB + 8 * cgp);
                    z0.x = bf_lo(a.x) * sigm(bf_lo(g.x)); z0.y = bf_hi(a.x) * sigm(bf_hi(g.x)); z0.z = bf_lo(a.y) * sigm(bf_lo(g.y)); z0.w = bf_hi(a.y) * sigm(bf_hi(g.y));
                    z1.x = bf_lo(a.z) * sigm(bf_lo(g.z)); z1.y = bf_hi(a.z) * sigm(bf_hi(g.z)); z1.z = bf_lo(a.w) * sigm(bf_lo(g.w)); z1.w = bf_hi(a.w) * sigm(bf_hi(g.w)); }
                *(LAS f32x4*)(zl + i * 512 + 8 * cgp) = z0; *(LAS f32x4*)(zl + i * 512 + 8 * cgp + 4) = z1; } }
        __syncthreads();
        float z[62];
#pragma unroll
        for (int i = 0; i < 62; ++i) z[i] = zl[i * 512 + ch];
        float o[32];
#pragma unroll
        for (int q = 0; q < 32; ++q) { float s = cb;
#pragma unroll
            for (int j = 0; j < 31; ++j) s += z[q + j] * w[j];
            o[q] = s; }
#pragma unroll
        for (int q = 0; q < 32; ++q) { const float s = wave_sum(o[q] * o[q], F.lane); if (F.lane == 0) red[F.wave * 32 + q] = s; }
        __syncthreads();
#pragma unroll
        for (int q = 0; q < 32; ++q) { float s = 0.f;
#pragma unroll
            for (int wv = 0; wv < 8; ++wv) s += red[wv * 32 + q];
            const float y = o[q] * (1.0f / sqrtf(s * (1.0f / 512.0f) + EPS)) * cg;
            Y[(size_t)(seq0 + t0 + q) * YW + 1536 + ch] = (bf16)f2bf(y * sigm(y)); }
    }
    __syncthreads();
}
typedef short fbf16x8 __attribute__((ext_vector_type(8)));
typedef short fs16x4 __attribute__((ext_vector_type(4)));
typedef float ff32x16 __attribute__((ext_vector_type(16)));
typedef __attribute__((address_space(3))) const char* flds_cptr;
__device__ __forceinline__ fs16x4 f_vtr(flds_cptr p) { return __builtin_bit_cast(fs16x4, __builtin_amdgcn_ds_read_tr16_b64_v4i16((__attribute__((address_space(3))) attn_body::v4i16_t*)p)); }
__device__ __forceinline__ void fourier_frags(Frame& F, fbf16x8 (&fr)[4][4]) {
    LAS float* tab = (LAS float*)(F.lds + RING_OFF);
    __syncthreads();
    if (F.tid < 64) { float s, c; sincospif((float)F.tid * (1.0f / 32.0f), &s, &c); tab[2 * F.tid] = c; tab[2 * F.tid + 1] = s; }
    __syncthreads();
    const int m = F.lane & 31, hi = F.lane >> 5;
#pragma unroll
    for (int mt = 0; mt < 4; ++mt)
#pragma unroll
        for (int g = 0; g < 4; ++g) { unsigned wv[4];
#pragma unroll
            for (int jp = 0; jp < 4; ++jp) { float v[2];
#pragma unroll
                for (int q = 0; q < 2; ++q) { const int j = 2 * jp + q; const int n = 16 * g + (j & 3) + 8 * (j >> 2) + 4 * hi; const int k = 32 * (mt & 1) + m; const int ix = (k * n) & 63; v[q] = tab[2 * ix + (mt >> 1)]; }
                wv[jp] = pk2(v[0], v[1]); }
            v4u t; t.x = wv[0]; t.y = wv[1]; t.z = wv[2]; t.w = wv[3]; fr[mt][g] = __builtin_bit_cast(fbf16x8, t); __builtin_amdgcn_sched_barrier(0); }
    __syncthreads();
}
#define F_BFRAG(dst, vp, dh) do { _Pragma("unroll") for (int g_ = 0; g_ < 4; ++g_) { const fs16x4 lo_ = f_vtr((vp) + (dh) * 4096 + g_ * 1024), hi_ = f_vtr((vp) + (dh) * 4096 + g_ * 1024 + 512); \
        dst[g_] = (fbf16x8){lo_[0], lo_[1], lo_[2], lo_[3], hi_[0], hi_[1], hi_[2], hi_[3]}; } } while (0)
__device__ __forceinline__ void glds16_so(const GAS void* sbase, unsigned voff, unsigned lds_dst) { unsigned keep;
    asm volatile("s_mov_b32 %0, m0\n\ts_mov_b32 m0, %3\n\ts_nop 0\n\tglobal_load_lds_dwordx4 %1, %2\n\ts_mov_b32 m0, %0" : "=&s"(keep) : "v"(voff), "s"(sbase), "s"(lds_dst) : "memory"); }
__device__ __forceinline__ fbf16x8 f_neg(fbf16x8 v) { v4u t = __builtin_bit_cast(v4u, v); t.x ^= 0x80008000u; t.y ^= 0x80008000u; t.z ^= 0x80008000u; t.w ^= 0x80008000u; return __builtin_bit_cast(fbf16x8, t); }
__device__ __forceinline__ void phase_fourier1(Frame& F) {
    fbf16x8 fr[4][4]; fourier_frags(F, fr);
    const int lane = F.lane, w = F.wave, r32 = lane & 31, hi = lane >> 5;
    const unsigned lds0 = (unsigned)(uintptr_t)(F.lds + RING_OFF);
    const flds_cptr vbase = (flds_cptr)(F.lds + RING_OFF) + ((lane >> 4) & 1) * 32 + (lane & 3) * 8 + (4 * hi + ((lane & 15) >> 2)) * 64;
    const GAS bf16* P = ((GAS bf16*)(F.ws + WS_P)); GAS bf16* TPb = (GAS bf16*)(F.ws + WS_TP);
    const unsigned voff0 = (unsigned)((64 * (lane >> 2)) * PW + (lane & 3) * 8) * 2u;
    for (int u = F.vcu; u < NBATCH * 64; u += F.G) {
        const int b = u >> 6, n2 = u & 63;
        const GAS bf16* base = P + (size_t)(b * RPB + n2) * PW + C_F + 64 * w;
        asm volatile("s_waitcnt lgkmcnt(0)" ::: "memory");
#pragma unroll
        for (int rg = 0; rg < 4; ++rg) { const unsigned vo = voff0 + (unsigned)rg * (unsigned)(64 * 16 * PW * 2);
            const unsigned dA = (unsigned)__builtin_amdgcn_readfirstlane(lds0 + w * 8192 + rg * 1024), dB = dA + 8 * 8192;
            glds16_so(base, vo, dA); glds16_so(base + 32, vo, dA + 4096); glds16_so(base + 512, vo, dB); glds16_so(base + 544, vo, dB + 4096); }
        asm volatile("s_waitcnt vmcnt(0)" ::: "memory");
#pragma unroll 1
        for (int dh = 0; dh < 2; ++dh) {
            fbf16x8 bA[4], nA[4], nB[4];
            F_BFRAG(bA, vbase + w * 8192, dh); F_BFRAG(nB, vbase + (8 + w) * 8192, dh);
#pragma unroll
            for (int g = 0; g < 4; ++g) { nA[g] = f_neg(bA[g]); nB[g] = f_neg(nB[g]); }
#pragma unroll
            for (int kb = 0; kb < 2; ++kb) {
                ff32x16 tr = {}, ti = {};
#pragma unroll
                for (int g = 0; g < 4; ++g) { tr = __builtin_amdgcn_mfma_f32_32x32x16_bf16(fr[kb][g], bA[g], tr, 0, 0, 0); ti = __builtin_amdgcn_mfma_f32_32x32x16_bf16(fr[kb][g], nB[g], ti, 0, 0, 0);
                    tr = __builtin_amdgcn_mfma_f32_32x32x16_bf16(fr[2 + kb][g], nB[g], tr, 0, 0, 0); ti = __builtin_amdgcn_mfma_f32_32x32x16_bf16(fr[2 + kb][g], nA[g], ti, 0, 0, 0); }
                const unsigned o0 = (unsigned)(((b * 64 + 32 * kb + 4 * hi) * 2) * 64 + n2) * 512u + 64 * w + 32 * dh + r32;
#pragma unroll
                for (int r = 0; r < 16; ++r) { const int kk = (r & 3) + 8 * (r >> 2); const int k1 = 32 * kb + kk + 4 * hi;
                    const float rev = (float)(n2 * k1) * (1.0f / 4096.0f); const float c = __builtin_amdgcn_cosf(rev), s = __builtin_amdgcn_sinf(rev);
                    const unsigned oi = o0 + (unsigned)kk * (2u * 64u * 512u);
                    TPb[oi] = (bf16)f2bf(tr[r] * c + ti[r] * s); TPb[oi + 64u * 512u] = (bf16)f2bf(ti[r] * c - tr[r] * s);
                    if ((r & 3) == 3) __builtin_amdgcn_sched_barrier(0); }
                __builtin_amdgcn_sched_barrier(0);
            }
        }
    }
}
__device__ __forceinline__ void phase_fourier2(Frame& F) {
    fbf16x8 fr[4][4]; fourier_frags(F, fr);
    const int lane = F.lane, w = F.wave, r32 = lane & 31, hi = lane >> 5;
    const unsigned lds0 = (unsigned)(uintptr_t)(F.lds + RING_OFF);
    const flds_cptr vbase = (flds_cptr)(F.lds + RING_OFF) + ((lane >> 4) & 1) * 32 + (lane & 3) * 8 + (4 * hi + ((lane & 15) >> 2)) * 64;
    const GAS bf16* TPb = (const GAS bf16*)(F.ws + WS_TP); GAS bf16* Y = ((GAS bf16*)(F.ws + WS_Y));
    const float scale = 1.0f / sqrtf(4096.0f * 128.0f);
    const unsigned voff0 = (unsigned)((lane >> 2) * 512 + (lane & 3) * 8) * 2u;
    for (int u = F.vcu; u < NBATCH * 64; u += F.G) {
        const int b = u >> 6, k1 = u & 63;
        const GAS bf16* base0 = TPb + (size_t)((b * 64 + k1) * 2) * 64 * 512 + 64 * w; const GAS bf16* base1 = base0 + 64 * 512;
        asm volatile("s_waitcnt lgkmcnt(0)" ::: "memory");
#pragma unroll
        for (int rg = 0; rg < 4; ++rg) { const unsigned vo = voff0 + (unsigned)rg * (unsigned)(16 * 512 * 2);
            const unsigned d0 = (unsigned)__builtin_amdgcn_readfirstlane(lds0 + w * 8192 + rg * 1024), d1 = d0 + 8 * 8192;
            glds16_so(base0, vo, d0); glds16_so(base0 + 32, vo, d0 + 4096); glds16_so(base1, vo, d1); glds16_so(base1 + 32, vo, d1 + 4096); }
        asm volatile("s_waitcnt vmcnt(0)" ::: "memory");
#pragma unroll
        for (int dh = 0; dh < 2; ++dh) {
            fbf16x8 b0[4], b1[4];
            F_BFRAG(b0, vbase + w * 8192, dh); F_BFRAG(b1, vbase + (8 + w) * 8192, dh);
#pragma unroll
            for (int mt = 0; mt < 2; ++mt) {
                ff32x16 acc = {};
#pragma unroll
                for (int g = 0; g < 4; ++g) { acc = __builtin_amdgcn_mfma_f32_32x32x16_bf16(fr[mt][g], b0[g], acc, 0, 0, 0); acc = __builtin_amdgcn_mfma_f32_32x32x16_bf16(fr[2 + mt][g], b1[g], acc, 0, 0, 0); }
                const unsigned y0 = (unsigned)(b * RPB + k1 + 64 * (32 * mt + 4 * hi)) * (unsigned)YW + 1024u + 64 * w + 32 * dh + r32;
#pragma unroll
                for (int r = 0; r < 16; ++r) { const int kk = (r & 3) + 8 * (r >> 2);
                    Y[y0 + (unsigned)kk * (64u * (unsigned)YW)] = (bf16)f2bf(acc[r] * scale); }
                __builtin_amdgcn_sched_barrier(0);
            }
        }
    }
}
typedef float fc_f32x2 __attribute__((ext_vector_type(2)));
__device__ __forceinline__ void phase_fourier_ctx(Frame& F) {
    LAS float* tab = (LAS float*)(F.lds + RING_OFF + 8192);
    __syncthreads();
    if (F.tid < 256) { float s, c; sincospif((float)F.tid * (1.0f / 128.0f), &s, &c); tab[2 * F.tid] = c; tab[2 * F.tid + 1] = s; }
    __syncthreads();
    const float scale = 1.0f / sqrtf(256.0f * 128.0f);
#define FC_LOAD(A_, B_, n0_) do { _Pragma("unroll") for (int i_ = 0; i_ < 16; ++i_) { A_[i_] = pcol[(size_t)((n0_) + i_) * PW]; B_[i_] = pcol[(size_t)((n0_) + i_) * PW + 512]; } } while (0)
#define FC_COMP(A_, B_, n0_) do { _Pragma("unroll") for (int i_ = 0; i_ < 16; ++i_) { const float a_ = bf1(A_[i_]), b_ = bf1(B_[i_]); _Pragma("unroll") for (int k_ = 0; k_ < 4; ++k_) { \
        const int ix_ = (((n0_) + i_) * (kb + k_)) & 255; const fc_f32x2 cs_ = *(const LAS fc_f32x2*)(tab + 2 * ix_); acc[k_] += a_ * cs_.x - b_ * cs_.y; } } } while (0)
    for (int u = F.vcu; u < NBATCH * 64; u += F.G) {
        const int b = u >> 6, kb = (u & 63) * 4;
        float acc[4] = {0.f, 0.f, 0.f, 0.f};
        const GAS bf16* pcol = ((GAS bf16*)(F.ws + WS_P)) + (size_t)(b * RPB + SEQ) * PW + C_F + F.tid;
        bf16 A0[16], B0[16], A1[16], B1[16];
        FC_LOAD(A0, B0, 0);
        for (int n0 = 0; n0 < 256; n0 += 32) {
            FC_LOAD(A1, B1, n0 + 16);
            FC_COMP(A0, B0, n0);
            if (n0 + 32 < 256) FC_LOAD(A0, B0, n0 + 32);
            FC_COMP(A1, B1, n0 + 16);
        }
        GAS bf16* yo = ((GAS bf16*)(F.ws + WS_Y)) + (size_t)(b * RPB + SEQ + kb) * YW + 1024 + F.tid;
#pragma unroll
        for (int k = 0; k < 4; ++k) yo[(size_t)k * YW] = (bf16)f2bf(acc[k] * scale);
    }
#undef FC_LOAD
#undef FC_COMP
}
#ifndef PROBE
#define PROBE 0
#endif
#define GSTAMP(i) do { if (PROBE && l == 0 && blockIdx.x == 0 && threadIdx.x == 0) ((GAS unsigned long long*)(F.ws + WS_CTL + 512 * 1024))[i] = __builtin_amdgcn_s_memrealtime(); } while (0)
struct GVecs { int cmi; f32x4 G1[4], GS[4], SH[4]; };
struct GRow { f32x4 v[4]; v2u y[4]; };
__device__ __forceinline__ void g_load(Frame& F, int l, int row, GRow& R) {
    load_row(R.v, (l == 0) ? xrow_in(F, row) : (const GAS float*)xrow_ws(F, row), F.lane);
#pragma unroll
    for (int j = 0; j < 4; ++j) R.y[j] = *(const GAS v2u*)(((const GAS bf16*)(F.ws + WS_Y)) + (size_t)row * DM + 4 * F.lane + 256 * j);
}
__device__ __forceinline__ void g_front(Frame& F, int l, int row, GRow& R, GVecs& V) {
    const int mi = modidx(row);
    if (mi != V.cmi) { V.cmi = mi; const GAS float* m = ((GAS float*)(F.ws + WS_MODV)) + (size_t)l * 5 * 6144 + (size_t)mi * 6144; const GAS float* g2 = INP(F, 7) + l * DM;
#pragma unroll
        for (int j = 0; j < 4; ++j) { const int c = 4 * F.lane + 256 * j; V.G1[j] = *(const GAS f32x4*)(m + 2 * 1024 + c); V.SH[j] = *(const GAS f32x4*)(m + 3 * 1024 + c);
            V.GS[j] = *(const GAS f32x4*)(g2 + c) * (*(const GAS f32x4*)(m + 4 * 1024 + c) + 1.0f); } }
    float ss = 0.f;
#pragma unroll
    for (int j = 0; j < 4; ++j) { f32x4 y; y.x = bf_lo(R.y[j].x); y.y = bf_hi(R.y[j].x); y.z = bf_lo(R.y[j].y); y.w = bf_hi(R.y[j].y); R.v[j] = R.v[j] + V.G1[j] * y;
        ss += (R.v[j].x * R.v[j].x + R.v[j].y * R.v[j].y) + (R.v[j].z * R.v[j].z + R.v[j].w * R.v[j].w); }
    { GAS float* xo = xrow_ws(F, row);
#pragma unroll
      for (int j = 0; j < 4; ++j) *(GAS f32x4*)(xo + 4 * F.lane + 256 * j) = R.v[j]; }
    const float rstd = 1.0f / sqrtf(wave_sum(ss, F.lane) * (1.0f / DM) + EPS);
#pragma unroll
    for (int j = 0; j < 4; ++j) R.v[j] = R.v[j] * rstd * V.GS[j] + V.SH[j];
    store_bf16_row(((GAS bf16*)(F.ws + WS_H)) + (size_t)row * DM, R.v, F.lane);
}
__device__ __forceinline__ float g_reduce16(const float (&lg)[16], int lane) {
    float r8[8], r4[4], r2[2], r1;
    { const bool up = (lane & 32) != 0;
#pragma unroll
      for (int q = 0; q < 8; ++q) { const float snd = up ? lg[q] : lg[8 + q], kp = up ? lg[8 + q] : lg[q]; r8[q] = kp + shx(snd, 32, lane); } }
    { const bool up = (lane & 16) != 0;
#pragma unroll
      for (int q = 0; q < 4; ++q) { const float snd = up ? r8[q] : r8[4 + q], kp = up ? r8[4 + q] : r8[q]; r4[q] = kp + shx(snd, 16, lane); } }
    { const bool up = (lane & 8) != 0;
#pragma unroll
      for (int q = 0; q < 2; ++q) { const float snd = up ? r4[q] : r4[2 + q], kp = up ? r4[2 + q] : r4[q]; r2[q] = kp + shx(snd, 8, lane); } }
    { const bool up = (lane & 4) != 0; const float snd = up ? r2[0] : r2[1], kp = up ? r2[1] : r2[0]; r1 = kp + shx(snd, 4, lane); }
    r1 += shx(r1, 1, lane); r1 += shx(r1, 2, lane);
    return r1;
}
typedef float g_f32x2 __attribute__((ext_vector_type(2)));
__device__ __forceinline__ void g_select(const float (&lgt)[16], const float (&rb)[16], int& bi1, int& bi2, float& w1, float& w2) {
    float sc[16], sl[16];
#pragma unroll
    for (int e = 0; e < 16; ++e) { sc[e] = __builtin_amdgcn_rcpf(1.0f + __builtin_amdgcn_exp2f(-LOG2E * lgt[e])); sl[e] = sc[e] + rb[e]; }
    float best = -INFINITY; bi1 = 0; bi2 = 1; float bs1 = 0.f, bs2 = 0.f;
#pragma unroll
    for (int g = 0; g < 4; ++g) {
        int i1 = 4 * g; float m1 = sl[4 * g];
#pragma unroll
        for (int q = 1; q < 4; ++q) if (sl[4 * g + q] > m1) { m1 = sl[4 * g + q]; i1 = 4 * g + q; }
        int i2 = -1; float m2 = -INFINITY;
#pragma unroll
        for (int q = 0; q < 4; ++q) if (4 * g + q != i1 && sl[4 * g + q] > m2) { m2 = sl[4 * g + q]; i2 = 4 * g + q; }
        float s1 = 0.f, s2 = 0.f;
#pragma unroll
        for (int q = 0; q < 4; ++q) { if (4 * g + q == i1) s1 = sc[4 * g + q]; if (4 * g + q == i2) s2 = sc[4 * g + q]; }
        const float gs = m1 + m2;
        if (gs > best) { best = gs; bi1 = i1; bi2 = i2; bs1 = s1; bs2 = s2; }
    }
    const float inv = 1.0f / (bs1 + bs2); w1 = bs1 * inv; w2 = bs2 * inv;
}
__device__ __forceinline__ void phase_norm2_router(Frame& F, int l) {
    LAS float* wr = (LAS float*)(F.lds + RING_OFF);
    LAS int* sel = (LAS int*)(F.lds + RING_OFF + 65536);
    LAS unsigned* basel = (LAS unsigned*)(F.lds + RING_OFF + 65536 + 16384);
    LAS float* lgl = (LAS float*)(F.lds + RING_OFF + 65536 + 32768);
    const int nact = (l == 0) ? MROWS : NBATCH * SEQ; const int chunk = (nact + F.G - 1) / F.G; const int a0 = F.vcu * chunk, a1 = (a0 + chunk < nact) ? a0 + chunk : nact;
    __syncthreads();
    for (int i = F.tid; i < DM * 16 / 4; i += NTHR) { const f32x4 t = ((const GAS f32x4*)INP(F, 17))[i]; const int c = i >> 2, e0 = (i & 3) * 4;
        wr[(e0 + 0) * DM + c] = t.x; wr[(e0 + 1) * DM + c] = t.y; wr[(e0 + 2) * DM + c] = t.z; wr[(e0 + 3) * DM + c] = t.w; }
    __syncthreads();
    GSTAMP(31);
    GVecs V; V.cmi = -1;
#define G_ROW(a_) ((l == 0) ? (a_) : ((a_) / SEQ) * RPB + ((a_) % SEQ))
    for (int a = a0 + F.wave; a < a1; a += 2 * NWAVES) {
        const int ab = a + NWAVES; const bool has2 = ab < a1;
        const int row = G_ROW(a), row2 = has2 ? G_ROW(ab) : row;
        GRow R0, R1; g_load(F, l, row, R0); if (has2) g_load(F, l, row2, R1); else R1 = R0;
        g_front(F, l, row, R0, V); if (has2) g_front(F, l, row2, R1, V);
        float lg0[16], lg1[16];
#pragma unroll
        for (int e = 0; e < 16; ++e) { g_f32x2 p0 = {0.f, 0.f}, p1 = {0.f, 0.f};
#pragma unroll
            for (int j = 0; j < 4; ++j) { const f32x4 ww = *(const LAS f32x4*)(wr + e * DM + 4 * F.lane + 256 * j); const g_f32x2 wl = {ww.x, ww.y}, wh = {ww.z, ww.w};
                p0 += (g_f32x2){R0.v[j].x, R0.v[j].y} * wl; p0 += (g_f32x2){R0.v[j].z, R0.v[j].w} * wh;
                p1 += (g_f32x2){R1.v[j].x, R1.v[j].y} * wl; p1 += (g_f32x2){R1.v[j].z, R1.v[j].w} * wh; }
            lg0[e] = p0.x + p0.y; lg1[e] = p1.x + p1.y; }
        const float q0 = g_reduce16(lg0, F.lane), q1 = g_reduce16(lg1, F.lane);
        if ((F.lane & 3) == 0) { lgl[(a - a0) * 16 + (F.lane >> 2)] = q0; if (has2) lgl[(ab - a0) * 16 + (F.lane >> 2)] = q1; }
    }
    __syncthreads(); GSTAMP(32);
    const int nr = a1 - a0, ns = 2 * nr;
    { float rb[16];
#pragma unroll
      for (int e = 0; e < 16; ++e) rb[e] = INP(F, 18)[e];
      for (int i = F.tid; i < nr; i += NTHR) { float lgt[16];
#pragma unroll
        for (int e4 = 0; e4 < 4; ++e4) { const f32x4 t = *(const LAS f32x4*)(lgl + i * 16 + 4 * e4); lgt[4 * e4] = t.x; lgt[4 * e4 + 1] = t.y; lgt[4 * e4 + 2] = t.z; lgt[4 * e4 + 3] = t.w; }
        int b1, b2; float w1, w2; g_select(lgt, rb, b1, b2, w1, w2); const int row = G_ROW(a0 + i);
        ((GAS int*)(F.ws + WS_TOKE))[2 * row] = b1; ((GAS int*)(F.ws + WS_TOKE))[2 * row + 1] = b2; ((GAS float*)(F.ws + WS_TOKW))[2 * row] = w1; ((GAS float*)(F.ws + WS_TOKW))[2 * row + 1] = w2;
        sel[2 * i] = b1; sel[2 * i + 1] = b2; } }
    __syncthreads();
    if (F.tid < 16) { const int e = F.tid; int n = 0;
        for (int i = 0; i < ns; ++i) n += (sel[i] == e) ? 1 : 0;
        unsigned base = 0u; if (n > 0) base = __hip_atomic_fetch_add((unsigned*)(F.ctl + CW_CNT + (l * 16 + e) * 64), (unsigned)n, RLX_AGENT);
        basel[e] = base; }
    __syncthreads();
    for (int i = F.tid; i < ns; i += NTHR) { const int e = sel[i]; int rank = 0;
        for (int j = 0; j < i; ++j) rank += (sel[j] == e) ? 1 : 0;
        const int a = a0 + (i >> 1); ((GAS int*)(F.ws + WS_TOKR))[2 * G_ROW(a) + (i & 1)] = (int)basel[e] + rank; }
#undef G_ROW
    __syncthreads();
}
__device__ __forceinline__ void moe_offsets(Frame& F, int l) {
    __syncthreads();
    if (F.tid == 0) { unsigned off = 0u;
        for (int e = 0; e < 16; ++e) { F.LCTL[e] = off; const unsigned c = __hip_atomic_load((unsigned*)(F.ctl + CW_CNT + (l * 16 + e) * 64), RLX_AGENT); off += (c + 255u) & ~255u; }
        F.LCTL[16] = off; F.LCTL[17] = off >> 8; }
    __syncthreads();
}
__device__ __forceinline__ void phase_scatter(Frame& F, int l) {
    moe_offsets(F, l);
    const int nact = (l == 0) ? MROWS : NBATCH * SEQ; const int chunk = (nact + F.G - 1) / F.G; const int a0 = F.vcu * chunk, a1 = (a0 + chunk < nact) ? a0 + chunk : nact;
    for (int a = a0 + F.wave; a < a1; a += NWAVES) {
        const int row = (l == 0) ? a : (a / SEQ) * RPB + (a % SEQ);
        const int e1 = ((GAS int*)(F.ws + WS_TOKE))[2 * row], e2 = ((GAS int*)(F.ws + WS_TOKE))[2 * row + 1];
        const int s1 = (int)F.LCTL[e1] + ((GAS int*)(F.ws + WS_TOKR))[2 * row], s2 = (int)F.LCTL[e2] + ((GAS int*)(F.ws + WS_TOKR))[2 * row + 1];
        if (F.lane == 0) { ((GAS int*)(F.ws + WS_TOKS))[2 * row] = s1; ((GAS int*)(F.ws + WS_TOKS))[2 * row + 1] = s2; }
        const GAS v4u* src = (const GAS v4u*)(((GAS bf16*)(F.ws + WS_H)) + (size_t)row * DM) + F.lane; const v4u x0 = src[0], x1 = src[64];
        GAS v4u* d1 = (GAS v4u*)(((GAS bf16*)(F.ws + WS_AM)) + (size_t)s1 * DM) + F.lane; GAS v4u* d2 = (GAS v4u*)(((GAS bf16*)(F.ws + WS_AM)) + (size_t)s2 * DM) + F.lane;
        d1[0] = x0; d1[64] = x1; d2[0] = x0; d2[64] = x1;
    }
}
struct CombRow { f32x4 v[4]; v2u p[4], q[4]; float w1, w2; };
__device__ __forceinline__ void comb_load(Frame& F, int row, CombRow& R, GAS float* xr) {
    load_row(R.v, xr, F.lane);
    const int s1 = ((GAS int*)(F.ws + WS_TOKS))[2 * row], s2 = ((GAS int*)(F.ws + WS_TOKS))[2 * row + 1]; R.w1 = ((GAS float*)(F.ws + WS_TOKW))[2 * row]; R.w2 = ((GAS float*)(F.ws + WS_TOKW))[2 * row + 1];
    const GAS bf16* o1 = ((GAS bf16*)(F.ws + WS_OM)) + (size_t)s1 * DM; const GAS bf16* o2 = ((GAS bf16*)(F.ws + WS_OM)) + (size_t)s2 * DM;
#pragma unroll
    for (int j = 0; j < 4; ++j) { const int c = 4 * F.lane + 256 * j; R.p[j] = *(const GAS v2u*)(o1 + c); R.q[j] = *(const GAS v2u*)(o2 + c); }
}
__device__ __forceinline__ void comb_finish(Frame& F, int l, int row, CombRow& R, GAS float* xr) {
    const GAS float* g2 = ((GAS float*)(F.ws + WS_MODV)) + (size_t)l * 5 * 6144 + (size_t)modidx(row) * 6144 + 5 * 1024;
#pragma unroll
    for (int j = 0; j < 4; ++j) { const int c = 4 * F.lane + 256 * j; const v2u p = R.p[j], q = R.q[j]; const f32x4 gg = *(const GAS f32x4*)(g2 + c); const float w1 = R.w1, w2 = R.w2;
        f32x4 z; z.x = w1 * bf_lo(p.x) + w2 * bf_lo(q.x); z.y = w1 * bf_hi(p.x) + w2 * bf_hi(q.x); z.z = w1 * bf_lo(p.y) + w2 * bf_lo(q.y); z.w = w1 * bf_hi(p.y) + w2 * bf_hi(q.y);
        R.v[j] = R.v[j] + gg * z; }
    if (l == 0) {
#pragma unroll
        for (int j = 0; j < 4; ++j) *(GAS f32x4*)(xr + 4 * F.lane + 256 * j) = R.v[j];
        const GAS float* m1 = ((GAS float*)(F.ws + WS_MODV)) + (size_t)5 * 6144 + (size_t)modidx(row) * 6144;
        norm_mod(R.v, INP(F, 6) + DM, m1 + 1024, m1, F.lane); store_bf16_row(((GAS bf16*)(F.ws + WS_H)) + (size_t)row * DM, R.v, F.lane);
    } else {
        float ss = 0.f;
#pragma unroll
        for (int j = 0; j < 4; ++j) ss += (R.v[j].x * R.v[j].x + R.v[j].y * R.v[j].y) + (R.v[j].z * R.v[j].z + R.v[j].w * R.v[j].w);
        const float rstd = 1.0f / sqrtf(wave_sum(ss, F.lane) * (1.0f / DM) + EPS);
#pragma unroll
        for (int j = 0; j < 4; ++j) { const int c = 4 * F.lane + 256 * j; *(GAS f32x4*)(xr + c) = R.v[j] * rstd * *(const GAS f32x4*)(INP(F, 21) + c); }
    }
}
__device__ __forceinline__ void phase_combine(Frame& F, int l) {
    const int gw = F.vcu * NWAVES + F.wave, NGW = F.G * NWAVES;
    const int nact = (l == 0) ? MROWS : NBATCH * SEQ;
    for (int a = gw; a < nact; a += 2 * NGW) { const int a2 = a + NGW; const bool has2 = a2 < nact;
        const int row = (l == 0) ? a : (a / SEQ) * RPB + (a % SEQ); const int row2 = has2 ? ((l == 0) ? a2 : (a2 / SEQ) * RPB + (a2 % SEQ)) : row;
        GAS float* xr = xrow_ws(F, row); GAS float* xr2 = xrow_ws(F, row2);
        CombRow R1, R2; comb_load(F, row, R1, xr); if (has2) comb_load(F, row2, R2, xr2);
        comb_finish(F, l, row, R1, xr); if (has2) comb_finish(F, l, row2, R2, xr2); }
}
struct SchedIn {
    int G, c;
    __device__ __forceinline__ bool next(int i, pg8::Unit& u) const { const long L = (long)i * G + c; if (L >= 68 * 33) return false; int pm, pn; pg8::tile_map((int)L, 68, 33, pm, pn);
        u.pm = pm; u.pn = pn; u.aux = 0; u.aoff = (size_t)pm * 256 * DM * 2; u.boff = (size_t)pn * 256 * DM * 2; return true; }
};
struct SchedBr {
    int G, c, nMt; bool skipctx;
    __device__ __forceinline__ bool next(int i, pg8::Unit& u) const { const long L = (long)(i >> 2) * G + c; if (L >= nMt * 4) return false; int pm, pn; pg8::tile_map((int)L, nMt, 4, pm, pn);
        if (skipctx) pm = (pm / 16) * 17 + (pm % 16);
        const int n = i & 3; u.pm = pm; u.pn = pn; u.aux = n; u.aoff = ((size_t)pm * 256 * YW + n * 512) * 2; u.boff = ((size_t)pn * 256 * 2048 + n * 512) * 2; return true; }
};
struct SchedOut {
    int G, c, nMt; bool skipctx;
    __device__ __forceinline__ bool next(int i, pg8::Unit& u) const { const long L = (long)i * G + c; if (L >= nMt * 4) return false; int pm, pn; pg8::tile_map((int)L, nMt, 4, pm, pn);
        if (skipctx) pm = (pm / 16) * 17 + (pm % 16);
        u.pm = pm; u.pn = pn; u.aux = 0; u.aoff = (size_t)pm * 256 * DM * 2; u.boff = (size_t)pn * 256 * DM * 2; return true; }
};
struct SchedMoe {
    int G, c; LAS unsigned* lctl; size_t astride, bstride_e, bstride_n;
    __device__ __forceinline__ bool next(int i, pg8::Unit& u) const { const long L = (long)i * G + c; const unsigned nt = lctl[17]; if (L >= (long)nt * 4) return false;
        const int tile = (int)(L >> 2), pn = (int)(L & 3); const unsigned row0 = (unsigned)tile * 256u; int e = 0;
#pragma unroll
        for (int k = 1; k < 16; ++k) e += (row0 >= lctl[k]) ? 1 : 0;
        u.pm = tile; u.pn = pn; u.aux = e; u.aoff = (size_t)tile * astride; u.boff = (size_t)e * bstride_e + (size_t)pn * bstride_n; return true; }
};

__device__ __forceinline__ void attn_plain_args(const Frame& F, int U, attn_body::AttnArgs& a) {
    typedef AGAS attn_body::bf16 abf;
    a.qrow0 = 0; a.rb0 = 0; a.rpb = nullptr; a.kr1 = 0;
    if (U < 512) { const int b = U >> 7, kvh = (U >> 6) & 1, hq = (U >> 4) & 3, qb = U & 15, h = kvh * 4 + hq; const size_t r0 = (size_t)b * RPB;
        a.Q = (const abf*)(((GAS bf16*)(F.ws + WS_P)) + (r0 + 256 * qb) * PW + C_GQ + h * 64); a.K = (const abf*)(((GAS bf16*)(F.ws + WS_P)) + r0 * PW + C_GK + kvh * 64); a.V = (const abf*)(((GAS bf16*)(F.ws + WS_P)) + r0 * PW + C_GV + kvh * 64);
        a.O = (abf*)(((GAS bf16*)(F.ws + WS_Y)) + (r0 + 256 * qb) * YW + h * 64); a.kr0 = 0; a.tsw = 1 << 20; a.NT = RPB / 64; }
    else if (U < 544) { const int b = (U - 512) >> 3, h = (U - 512) & 7, kvh = h >> 2; const size_t r0 = (size_t)b * RPB;
        a.Q = (const abf*)(((GAS bf16*)(F.ws + WS_P)) + (r0 + SEQ) * PW + C_GQ + h * 64); a.K = (const abf*)(((GAS bf16*)(F.ws + WS_P)) + r0 * PW + C_GK + kvh * 64); a.V = (const abf*)(((GAS bf16*)(F.ws + WS_P)) + r0 * PW + C_GV + kvh * 64);
        a.O = (abf*)(((GAS bf16*)(F.ws + WS_Y)) + (r0 + SEQ) * YW + h * 64); a.kr0 = SEQ; a.tsw = 1 << 20; a.NT = 4; }
    else { const int b = (U - 544) >> 3, h = (U - 544) & 7; const size_t r0 = (size_t)b * RPB;
        a.Q = (const abf*)(((GAS bf16*)(F.ws + WS_P)) + (r0 + SEQ) * PW + C_NQ + h * 64); a.K = (const abf*)(((GAS bf16*)(F.ws + WS_P)) + r0 * PW + C_NK + h * 64); a.V = (const abf*)(((GAS bf16*)(F.ws + WS_P)) + r0 * PW + C_NV + h * 64);
        a.O = (abf*)(((GAS bf16*)(F.ws + WS_Y)) + (r0 + SEQ) * YW + 512 + h * 64); a.kr0 = SEQ; a.tsw = 1 << 20; a.NT = 4; }
}
__device__ __forceinline__ void attn_na_args(const Frame& F, int U, int l, attn_body::AttnArgs& a) {
    typedef AGAS attn_body::bf16 abf;
    const int b = U >> 7, h = (U >> 4) & 7, j = U & 15; const size_t r0 = (size_t)b * RPB;
    int rb0 = 4 * j - 4; rb0 = rb0 < 0 ? 0 : (rb0 > 52 ? 52 : rb0);
    a.Q = (const abf*)(((GAS bf16*)(F.ws + WS_P)) + (r0 + 256 * j) * PW + C_NQ + h * 64); a.K = (const abf*)(((GAS bf16*)(F.ws + WS_P)) + r0 * PW + C_NK + h * 64); a.V = (const abf*)(((GAS bf16*)(F.ws + WS_P)) + r0 * PW + C_NV + h * 64);
    a.O = (abf*)(((GAS bf16*)(F.ws + WS_Y)) + (r0 + 256 * j) * YW + 512 + h * 64); a.kr0 = SEQ; a.kr1 = 64 * rb0; a.tsw = 4; a.NT = 16; a.qrow0 = 4 * j; a.rb0 = rb0; a.rpb = INP(F, 11) + ((size_t)l * 8 + h) * 465;
}

constexpr int N_PHASES = 2 + 11 * NLAYER;
struct Args { const GAS float* in[22]; GAS float* out; unsigned char* ws; int ph_lo, ph_hi; };
__global__ void __launch_bounds__(NTHR, 2) fwd_kernel(Args args) {
    extern __shared__ __attribute__((aligned(16))) unsigned char lds[];
    Frame F;
    F.lds = (LAS unsigned char*)lds; F.MISC = (volatile LAS unsigned*)(F.lds + MISC_OFF); F.LCTL = (LAS unsigned*)(F.lds + LDSCTL_OFF);
    F.tid = threadIdx.x; F.lane = F.tid & 63; F.wave = __builtin_amdgcn_readfirstlane(F.tid >> 6);
    F.G = gridDim.x; { const int bx = blockIdx.x; F.vcu = (F.G % 8 == 0) ? (bx % 8) * (F.G / 8) + bx / 8 : bx; }
    unsigned char* ws = args.ws;
    F.ctl = (gu32*)(ws + WS_CTL);
    F.out = args.out; F.ws = ws;
    for (int u = F.tid; u < (LDS_BYTES - LDSCTL_OFF) / 4; u += NTHR) ((LAS unsigned*)(F.lds + LDSCTL_OFF))[u] = 0u;
    __syncthreads();
    if (F.tid < 22) { unsigned long long p = 0ull;
#pragma unroll
        for (int i = 0; i < 22; ++i) if (F.tid == i) p = (unsigned long long)args.in[i];
        LAS unsigned* t = (LAS unsigned*)(F.lds + PTR_OFF) + 2 * F.tid; t[0] = (unsigned)p; t[1] = (unsigned)(p >> 32); }
    __syncthreads();
    XcdBarrier bar = xcd_barrier_post((unsigned*)(F.ctl + CW_BAR), F.MISC + 8);
    const int lo = args.ph_lo, hi = args.ph_hi;
#define LAUNDER() do { int t_ = threadIdx.x; asm volatile("" : "+v"(t_)); F.tid = t_; F.lane = t_ & 63; F.wave = __builtin_amdgcn_readfirstlane(t_ >> 6); \
        int g_ = gridDim.x, b_ = blockIdx.x; unsigned char* w_ = args.ws; GAS float* o_ = args.out; unsigned l_ = (unsigned)(uintptr_t)lds; \
        asm volatile("" : "+s"(g_), "+s"(b_), "+s"(w_), "+s"(o_), "+s"(l_)); \
        F.G = g_; bx = b_; F.vcu = (g_ % 8 == 0) ? (b_ % 8) * (g_ / 8) + b_ / 8 : b_; F.ws = w_; F.out = o_; F.ctl = (gu32*)(w_ + WS_CTL); \
        F.lds = (LAS unsigned char*)l_; F.MISC = (volatile LAS unsigned*)(F.lds + MISC_OFF); F.LCTL = (LAS unsigned*)(F.lds + LDSCTL_OFF); } while (0)
#ifndef PROBE
#define PROBE 0
#endif
#ifndef PROBE_MASK
#define PROBE_MASK 0x7ffffffeull
#define PROBE_SCALE 0.1f
#endif
#define STAMP(i) do { if (PROBE && blockIdx.x == 0 && threadIdx.x == 0) ((GAS unsigned long long*)(args.ws + WS_CTL + 512 * 1024))[i] = __builtin_amdgcn_s_memrealtime(); } while (0)
#define RUN(k) ((k) >= lo && (k) < hi)
#define SEAM(k) do { if ((k) >= lo && (k) + 1 < hi) xcd_barrier(bar); } while (0)
    int bx = (int)blockIdx.x;

    STAMP(0);
    if (RUN(0)) { LAUNDER(); mod_vectors(F); } SEAM(0); STAMP(1);
    if (RUN(1)) { LAUNDER(); convert_weights(F, 0, CV_ALL, F.vcu, F.G); LAUNDER(); phase_norm1_first(F); } SEAM(1); STAMP(2);

    for (int l = 0; l < NLAYER; ++l) {
        const int p0 = 2 + 11 * l;
        if (RUN(p0 + 0)) { LAUNDER(); SchedIn S{F.G, bx}; pg8::EpiP E{((GAS bf16*)(F.ws + WS_P)), PW, C_G / 256, (GAS bf16*)(F.ws + WS_GN)};
            pg8::gemm_phase<pg8::EpiP, SchedIn, true>(F.lds + RING_OFF, F.tid, ((GAS bf16*)(F.ws + WS_H)), ((GAS bf16*)(F.ws + WS_WIN)), DM, DM, DM, S, E); } SEAM(p0 + 0); STAMP(3 + 14 * l + 0);
        if (RUN(p0 + 1)) { LAUNDER(); phase_qkrope(F, l); } SEAM(p0 + 1); STAMP(3 + 14 * l + 1);
        if (RUN(p0 + 2)) { LAUNDER();
            phase_fourier1(F); __syncthreads(); LAUNDER(); STAMP(3 + 14 * l + 2);
            phase_conv(F, l); __syncthreads(); LAUNDER(); STAMP(3 + 14 * l + 3);
            const int nU = (l == 0) ? 576 : 512;
            for (int U = F.vcu; U < nU; U += F.G) { attn_body::AttnArgs a; attn_plain_args(F, U, a); int t_ = threadIdx.x; asm volatile("" : "+v"(t_)); attn_body::attn_unit<8, false>(a, (char*)F.lds + RING_OFF, t_); }
            __syncthreads();
        } SEAM(p0 + 2); STAMP(3 + 14 * l + 4);
        if (RUN(p0 + 3)) { LAUNDER();
            phase_fourier2(F); __syncthreads(); LAUNDER(); STAMP(3 + 14 * l + 5);
            for (int U = F.vcu; U < 512; U += F.G) { attn_body::AttnArgs a; attn_na_args(F, U, l, a); int t_ = threadIdx.x; asm volatile("" : "+v"(t_)); attn_body::attn_unit<8, true>(a, (char*)F.lds + RING_OFF, t_); }
            __syncthreads();
            if (l == 0) { LAUNDER(); phase_fourier_ctx(F); __syncthreads(); }
        } SEAM(p0 + 3); STAMP(3 + 14 * l + 6);
        if (RUN(p0 + 4)) { LAUNDER(); SchedBr S{F.G, bx, (l == 0) ? 68 : 64, l != 0}; pg8::EpiBranch E{(const GAS bf16*)(F.ws + WS_GN), ((GAS bf16*)(F.ws + WS_H)), DM};
            pg8::gemm_phase<pg8::EpiBranch, SchedBr, true>(F.lds + RING_OFF, F.tid, ((GAS bf16*)(F.ws + WS_Y)), ((GAS bf16*)(F.ws + WS_WB)), YW, 2048, 512, S, E);
            if (l == 0) { __syncthreads(); LAUNDER(); int nbusy = (272 > F.G) ? 272 - F.G : 0; if (nbusy >= F.G) nbusy = 0;
                convert_weights(F, 1, CV_IN | CV_GU | CV_DN, (bx < nbusy) ? -1 : bx - nbusy, F.G - nbusy); } } SEAM(p0 + 4); STAMP(3 + 14 * l + 7);
        if (RUN(p0 + 5)) { LAUNDER(); SchedOut S{F.G, bx, (l == 0) ? 68 : 64, l != 0}; pg8::EpiP E{((GAS bf16*)(F.ws + WS_Y)), DM, 1 << 20, nullptr};
            pg8::gemm_phase<pg8::EpiP, SchedOut, true>(F.lds + RING_OFF, F.tid, ((GAS bf16*)(F.ws + WS_H)), ((GAS bf16*)(F.ws + WS_WO)), DM, DM, DM, S, E); } SEAM(p0 + 5); STAMP(3 + 14 * l + 8);
        if (RUN(p0 + 6)) { LAUNDER(); phase_norm2_router(F, l); } SEAM(p0 + 6); STAMP(3 + 14 * l + 9);
        if (RUN(p0 + 7)) { LAUNDER(); phase_scatter(F, l); } SEAM(p0 + 7); STAMP(3 + 14 * l + 10);
        if (RUN(p0 + 8)) { LAUNDER(); moe_offsets(F, l); SchedMoe S{F.G, bx, F.LCTL, (size_t)256 * DM * 2, (size_t)DM * DM * 2, (size_t)256 * DM * 2}; pg8::EpiGU E{((GAS bf16*)(F.ws + WS_HM)), EFF};
            pg8::gemm_phase<pg8::EpiGU, SchedMoe, true>(F.lds + RING_OFF, F.tid, ((GAS bf16*)(F.ws + WS_AM)), ((GAS bf16*)(F.ws + ((l & 1) ? WS_WGU2 : WS_WGU))), DM, DM, DM, S, E); } SEAM(p0 + 8); STAMP(3 + 14 * l + 11);
        if (RUN(p0 + 9)) { LAUNDER(); moe_offsets(F, l); SchedMoe S{F.G, bx, F.LCTL, (size_t)256 * EFF * 2, (size_t)DM * EFF * 2, (size_t)256 * EFF * 2}; pg8::EpiP E{((GAS bf16*)(F.ws + WS_OM)), DM, 1 << 20, nullptr};
            pg8::gemm_phase<pg8::EpiP, SchedMoe, true>(F.lds + RING_OFF, F.tid, ((GAS bf16*)(F.ws + WS_HM)), ((GAS bf16*)(F.ws + ((l & 1) ? WS_WD2 : WS_WD))), EFF, EFF, EFF, S, E); } SEAM(p0 + 9); STAMP(3 + 14 * l + 12);
        if (RUN(p0 + 10)) { LAUNDER(); phase_combine(F, l); if (l + 1 < NLAYER) { __syncthreads(); LAUNDER(); convert_weights(F, l + 1, CV_BR | CV_OUT, F.vcu, F.G); } } SEAM(p0 + 10); STAMP(3 + 14 * l + 13);
    }
#if PROBE
    xcd_barrier(bar);
    { const GAS unsigned long long* st = (const GAS unsigned long long*)(args.ws + WS_CTL + 512 * 1024);
      float db = 0.f;
      for (int i = 1; i <= 30; ++i) if ((PROBE_MASK >> i) & 1ull) db += (float)(st[i] - st[i - 1]) * 0.01f;
      if ((PROBE_MASK >> 31) & 1ull) db += (float)(st[31] - st[11]) * 0.01f; if ((PROBE_MASK >> 32) & 1ull) db += (float)(st[32] - st[31]) * 0.01f; if ((PROBE_MASK >> 33) & 1ull) db += (float)(st[12] - st[32]) * 0.01f;
      db *= PROBE_SCALE;
      for (size_t i = (size_t)blockIdx.x * NTHR + threadIdx.x; i < (size_t)NBATCH * SEQ * DM; i += (size_t)gridDim.x * NTHR) args.out[i] = (i == 0) ? db : 8.0f; }
#endif
#undef RUN
#undef SEAM
}

#ifndef MK_PER_PHASE
#define MK_PER_PHASE 0
#endif
extern "C" void kernel_launch(void* const* d_in, const GAS int* in_sizes, int n_in, void* d_out, int out_size, void* d_ws, size_t ws_size, hipStream_t stream) {
    static int grid = 0;
    if (grid == 0) {
        if (n_in != 22 || out_size != NBATCH * SEQ * DM || ws_size < WS_END) { fprintf(stderr, "kernel_launch: unexpected shapes (n_in %d, out %d, ws %zu); nothing launched\n", n_in, out_size, ws_size); grid = -1; return; }
        int dev = 0, cus = 0, per_cu = 0;
        if (hipGetDevice(&dev) != hipSuccess || hipDeviceGetAttribute(&cus, hipDeviceAttributeMultiprocessorCount, dev) != hipSuccess) { grid = -1; return; }
        if (hipFuncSetAttribute((const void*)fwd_kernel, hipFuncAttributeMaxDynamicSharedMemorySize, LDS_BYTES) != hipSuccess) { fprintf(stderr, "kernel_launch: hipFuncSetAttribute failed\n"); grid = -1; return; }
        if (hipOccupancyMaxActiveBlocksPerMultiprocessor(&per_cu, (const void*)fwd_kernel, NTHR, LDS_BYTES) != hipSuccess || per_cu < 1) { fprintf(stderr, "kernel_launch: occupancy query reports %d\n", per_cu); (void)hipGetLastError(); grid = -1; return; }
        grid = cus;
    }
    if (grid < 0) return;
    (void)hipMemsetAsync((char*)d_ws + WS_CTL, 0, CTL_ZERO_BYTES, stream);
    Args a{};
    for (int i = 0; i < 22; ++i) a.in[i] = (const GAS float*)d_in[i];
    a.out = (GAS float*)d_out; a.ws = (unsigned char*)d_ws;
#if MK_PER_PHASE
    for (int p = 0; p < N_PHASES; ++p) { a.ph_lo = p; a.ph_hi = p + 1; hipLaunchKernelGGL(fwd_kernel, dim3(grid), dim3(NTHR), LDS_BYTES, stream, a); }
#else
    a.ph_lo = 0; a.ph_hi = N_PHASES;
    hipLaunchKernelGGL(fwd_kernel, dim3(grid), dim3(NTHR), LDS_BYTES, stream, a);
#endif
}
```

```cpp
#include <hip/hip_runtime.h>
#include <hip/hip_bf16.h>
#include <cstdio>
#include <cstdint>
#include <cmath>

namespace pg8 {
#define PG8_LAS __attribute__((address_space(3)))
#define PG8_GAS __attribute__((address_space(1)))
typedef unsigned short bf16_t;
typedef short bf16x8 __attribute__((ext_vector_type(8)));
typedef float f32x4 __attribute__((ext_vector_type(4)));
typedef unsigned u32x4 __attribute__((ext_vector_type(4)));
constexpr int BM = 256, BK = 64, HALF = 128, HTB = HALF * BK * 2, STAGE_BYTES = 8 * HTB, NXCD = 8, WGM = 8;

__host__ __device__ __forceinline__ int lds_byte(int r, int c) { const int st = (r >> 4) * 2 + (c >> 5), rr = r & 15, cc = c & 31, ob = rr * 64 + cc * 2; return st * 1024 + (ob ^ (((ob >> 9) & 1) << 5)); }
__host__ __device__ __forceinline__ void stage_rc(int b, int& R, int& C) { const int st = b / 1024, sb = b % 1024, swz = sb ^ (((sb >> 9) & 1) << 5); R = (st >> 1) * 16 + swz / 64; C = (st & 1) * 32 + (swz % 64) / 2; }
__host__ __device__ __forceinline__ int perm32(int rho) { const int n = rho >> 4, i = rho & 15; return 8 * (i >> 2) + 4 * n + (i & 3); }

struct Unit { int pm, pn, aux; size_t aoff, boff; };

__device__ __forceinline__ void tile_map(int L, int nM, int nN, int& pm, int& pn) {
    const int nwg = nM * nN; int wgid = L;
    { const int q = nwg / NXCD, r = nwg % NXCD, xcd = wgid % NXCD, off = wgid / NXCD; wgid = (xcd < r ? xcd * (q + 1) : r * (q + 1) + (xcd - r) * q) + off; }
    const int nig = WGM * nN, gid = wgid / nig, fm = gid * WGM, gsz = (nM - fm) < WGM ? (nM - fm) : WGM;
    pm = fm + ((wgid % nig) % gsz); pn = (wgid % nig) / gsz;
}

__device__ __forceinline__ unsigned cvt_pk_bf16(float lo, float hi) { unsigned r; asm volatile("v_cvt_pk_bf16_f32 %0, %1, %2" : "=v"(r) : "v"(lo), "v"(hi)); return r; }
__device__ __forceinline__ float fast_sigmoid(float x) { return __builtin_amdgcn_rcpf(1.0f + __builtin_amdgcn_exp2f(-1.4426950408889634f * x)); }
__device__ __forceinline__ float bflo(unsigned w) { return __uint_as_float(w << 16); }
__device__ __forceinline__ float bfhi(unsigned w) { return __uint_as_float(w & 0xffff0000u); }

struct EpiP {
    static constexpr bool PERM = true, KEEP = false;
    PG8_GAS bf16_t* O; int ldc; int sig_from; PG8_GAS bf16_t* GN;
    __device__ __forceinline__ void operator()(f32x4 (&acc)[2][2][4][2], const Unit& u, int wr, int wc, int fr, int fq) const {
        const int row0 = u.pm * BM + wr * 64 + fr, col0 = u.pn * BM + wc * 32 + 8 * fq; const bool sig = u.pn >= sig_from;
        PG8_GAS bf16_t* gt = GN + ((size_t)(u.pm * 16 + (u.pn - sig_from)) * 65536 + (size_t)((wr * 4 + wc) * 16 * 64 + fq * 16 + fr) * 8);
#pragma unroll
        for (int ai = 0; ai < 2; ++ai)
#pragma unroll
            for (int m = 0; m < 4; ++m) { PG8_GAS bf16_t* rowp = O + (size_t)(row0 + ai * HALF + m * 16) * ldc + col0;
#pragma unroll
                for (int bj = 0; bj < 2; ++bj) { f32x4 v0 = acc[ai][bj][m][0], v1 = acc[ai][bj][m][1];
                    if (sig) {
#pragma unroll
                        for (int k = 0; k < 4; ++k) { v0[k] = __builtin_fmaxf(fast_sigmoid(v0[k]), 1e-20f); v1[k] = __builtin_fmaxf(fast_sigmoid(v1[k]), 1e-20f); } }
                    u32x4 w; w.x = cvt_pk_bf16(v0[0], v0[1]); w.y = cvt_pk_bf16(v0[2], v0[3]); w.z = cvt_pk_bf16(v1[0], v1[1]); w.w = cvt_pk_bf16(v1[2], v1[3]);
                    if (sig) *(PG8_GAS u32x4*)(gt + (ai * 8 + m * 2 + bj) * 512) = w; else *(PG8_GAS u32x4*)(rowp + bj * HALF) = w; } }
    }
};
struct EpiIn {
    static constexpr bool PERM = true, KEEP = false;
    PG8_GAS bf16_t* O; int ldc; PG8_GAS bf16_t* GN; const PG8_GAS float* qg; const PG8_GAS float* kg; const PG8_GAS float* rope; float qscale;
    __device__ __forceinline__ void operator()(f32x4 (&acc)[2][2][4][2], const Unit& u, int wr, int wc, int fr, int fq) const {
        const int row0 = u.pm * BM + wr * 64 + fr;
        if (u.pn >= 17) {
            PG8_GAS bf16_t* gt = GN + ((size_t)(u.pm * 16 + (u.pn - 17)) * 65536 + (size_t)((wr * 4 + wc) * 16 * 64 + fq * 16 + fr) * 8);
#pragma unroll
            for (int ai = 0; ai < 2; ++ai)
#pragma unroll
                for (int m = 0; m < 4; ++m)
#pragma unroll
                    for (int bj = 0; bj < 2; ++bj) { f32x4 v0 = acc[ai][bj][m][0], v1 = acc[ai][bj][m][1];
#pragma unroll
                        for (int k = 0; k < 4; ++k) { v0[k] = __builtin_fmaxf(fast_sigmoid(v0[k]), 1e-20f); v1[k] = __builtin_fmaxf(fast_sigmoid(v1[k]), 1e-20f); }
                        u32x4 w; w.x = cvt_pk_bf16(v0[0], v0[1]); w.y = cvt_pk_bf16(v0[2], v0[3]); w.z = cvt_pk_bf16(v1[0], v1[1]); w.w = cvt_pk_bf16(v1[2], v1[3]);
                        *(PG8_GAS u32x4*)(gt + (ai * 8 + m * 2 + bj) * 512) = w; }
            return; }
        if (u.pn > 2) {
            const int col0 = u.pn * BM + wc * 32 + 8 * fq; const float sc = (u.pn == 3 || u.pn == 4) ? qscale : 1.0f;
#pragma unroll
            for (int ai = 0; ai < 2; ++ai)
#pragma unroll
                for (int m = 0; m < 4; ++m) { PG8_GAS bf16_t* rowp = O + (size_t)(row0 + ai * HALF + m * 16) * ldc + col0;
#pragma unroll
                    for (int bj = 0; bj < 2; ++bj) { const f32x4 v0 = acc[ai][bj][m][0] * sc, v1 = acc[ai][bj][m][1] * sc;
                        u32x4 w; w.x = cvt_pk_bf16(v0[0], v0[1]); w.y = cvt_pk_bf16(v0[2], v0[3]); w.z = cvt_pk_bf16(v1[0], v1[1]); w.w = cvt_pk_bf16(v1[2], v1[3]);
                        *(PG8_GAS u32x4*)(rowp + bj * HALF) = w; } }
            return; }
        const bool isv = (u.pn == 2) && (wc >= 2); const bool lat = (u.pm % 17) < 16; const int lane = fq * 16 + fr;
        const PG8_GAS float* gp = ((u.pn == 2) ? kg : qg) + 8 * fq; const float osc = (u.pn < 2) ? qscale : 1.0f;
        f32x4 g[2][2];
#pragma unroll
        for (int bj = 0; bj < 2; ++bj)
#pragma unroll
            for (int n = 0; n < 2; ++n) g[bj][n] = isv ? (f32x4){1.f, 1.f, 1.f, 1.f} : *(const PG8_GAS f32x4*)(gp + 32 * bj + 4 * n);
        const int lcol0 = u.pn * BM + 64 * wc + 8 * fq;
#pragma unroll
        for (int ai = 0; ai < 2; ++ai)
#pragma unroll
            for (int m = 0; m < 4; ++m) { const int row = row0 + ai * HALF + m * 16; PG8_GAS bf16_t* rowp = O + (size_t)row * ldc + lcol0;
                f32x4 v[2][2];
#pragma unroll
                for (int bj = 0; bj < 2; ++bj)
#pragma unroll
                    for (int n = 0; n < 2; ++n) v[bj][n] = acc[ai][bj][m][n];
                if (!isv) {
                    float ss = 0.f;
#pragma unroll
                    for (int bj = 0; bj < 2; ++bj)
#pragma unroll
                        for (int n = 0; n < 2; ++n) ss += (v[bj][n][0] * v[bj][n][0] + v[bj][n][1] * v[bj][n][1]) + (v[bj][n][2] * v[bj][n][2] + v[bj][n][3] * v[bj][n][3]);
                    ss += __builtin_bit_cast(float, __builtin_amdgcn_ds_bpermute((lane ^ 16) << 2, __builtin_bit_cast(int, ss)));
                    ss += __builtin_bit_cast(float, __builtin_amdgcn_ds_bpermute((lane ^ 32) << 2, __builtin_bit_cast(int, ss)));
                    const float rstd = __builtin_amdgcn_rsqf(ss * (1.0f / 64.0f) + 1e-6f);
                    const int t = row % 4352;
#pragma unroll
                    for (int bj = 0; bj < 2; ++bj)
#pragma unroll
                        for (int n = 0; n < 2; ++n) { f32x4 x = v[bj][n] * rstd * g[bj][n];
                            if (lat) { const int pos = (bj == 0) ? (t >> 6) : (t & 63); const f32x4 cs = *(const PG8_GAS f32x4*)(rope + pos * 32 + 8 * fq + 4 * n);
                                const float a0 = x[0] * cs[0] - x[1] * cs[1], a1 = x[0] * cs[1] + x[1] * cs[0], a2 = x[2] * cs[2] - x[3] * cs[3], a3 = x[2] * cs[3] + x[3] * cs[2];
                                x = (f32x4){a0, a1, a2, a3}; }
                            v[bj][n] = x * osc; }
                }
#pragma unroll
                for (int bj = 0; bj < 2; ++bj) { u32x4 w; w.x = cvt_pk_bf16(v[bj][0][0], v[bj][0][1]); w.y = cvt_pk_bf16(v[bj][0][2], v[bj][0][3]); w.z = cvt_pk_bf16(v[bj][1][0], v[bj][1][1]); w.w = cvt_pk_bf16(v[bj][1][2], v[bj][1][3]);
                    *(PG8_GAS u32x4*)(rowp + 32 * bj) = w; } }
    }
};
struct EpiBranch {
    static constexpr bool PERM = true, KEEP = true;
    const PG8_GAS bf16_t* GN; PG8_GAS bf16_t* O; int ldc;
    __device__ __forceinline__ void operator()(f32x4 (&acc)[2][2][4][2], const Unit& u, int wr, int wc, int fr, int fq) const {
        const int row0 = u.pm * BM + wr * 64 + fr, col0 = u.pn * BM + wc * 32 + 8 * fq; const int nb = u.aux;
        const PG8_GAS bf16_t* gt = GN + ((size_t)(u.pm * 16 + nb * 4 + u.pn) * 65536 + (size_t)((wr * 4 + wc) * 16 * 64 + fq * 16 + fr) * 8);
#pragma unroll
        for (int ai = 0; ai < 2; ++ai) {
            u32x4 g0[4][2], g1[4][2];
#pragma unroll
            for (int m = 0; m < 4; ++m)
#pragma unroll
                for (int bj = 0; bj < 2; ++bj) { const PG8_GAS bf16_t* gp = gt + (ai * 8 + m * 2 + bj) * 512;
                    g0[m][bj] = *(const PG8_GAS u32x4*)gp; g1[m][bj] = (nb < 3) ? *(const PG8_GAS u32x4*)(gp + 4 * 65536) : g0[m][bj]; }
#pragma unroll
            for (int m = 0; m < 4; ++m)
#pragma unroll
                for (int bj = 0; bj < 2; ++bj) { const size_t row = (size_t)(row0 + ai * HALF + m * 16); const int col = col0 + bj * HALF;
                    const u32x4 a = g0[m][bj], b = g1[m][bj];
                    float f[8] = {bflo(a.x), bfhi(a.x), bflo(a.y), bfhi(a.y), bflo(a.z), bfhi(a.z), bflo(a.w), bfhi(a.w)};
                    if (nb < 3) {
                        f[0] *= __builtin_amdgcn_rcpf(bflo(b.x)); f[1] *= __builtin_amdgcn_rcpf(bfhi(b.x)); f[2] *= __builtin_amdgcn_rcpf(bflo(b.y)); f[3] *= __builtin_amdgcn_rcpf(bfhi(b.y));
                        f[4] *= __builtin_amdgcn_rcpf(bflo(b.z)); f[5] *= __builtin_amdgcn_rcpf(bfhi(b.z)); f[6] *= __builtin_amdgcn_rcpf(bflo(b.w)); f[7] *= __builtin_amdgcn_rcpf(bfhi(b.w)); }
                    f32x4 v0 = acc[ai][bj][m][0], v1 = acc[ai][bj][m][1];
                    v0[0] *= f[0]; v0[1] *= f[1]; v0[2] *= f[2]; v0[3] *= f[3]; v1[0] *= f[4]; v1[1] *= f[5]; v1[2] *= f[6]; v1[3] *= f[7];
                    if (nb < 3) { acc[ai][bj][m][0] = v0; acc[ai][bj][m][1] = v1; }
                    else { u32x4 w; w.x = cvt_pk_bf16(v0[0], v0[1]); w.y = cvt_pk_bf16(v0[2], v0[3]); w.z = cvt_pk_bf16(v1[0], v1[1]); w.w = cvt_pk_bf16(v1[2], v1[3]);
                        *(PG8_GAS u32x4*)(O + row * ldc + col) = w; acc[ai][bj][m][0] = (f32x4){0.f, 0.f, 0.f, 0.f}; acc[ai][bj][m][1] = (f32x4){0.f, 0.f, 0.f, 0.f}; } }
        }
    }
};
struct EpiRes {
    static constexpr bool PERM = false, KEEP = false;
    const PG8_GAS float* base_lat; const PG8_GAS float* base_ctx; PG8_GAS float* out_lat; PG8_GAS float* out_ctx; const PG8_GAS float* gmod;
    __device__ __forceinline__ void operator()(f32x4 (&acc)[2][2][4][2], const Unit& u, int wr, int wc, int fr, int fq) const {
        const int b = u.pm / 17, j = u.pm % 17;
        const size_t ro = (j < 16) ? ((size_t)b * 4096 + (size_t)j * 256) * 1024 : (size_t)b * 256 * 1024;
        const PG8_GAS float* bp = ((j < 16) ? base_lat : base_ctx) + ro; PG8_GAS float* op = ((j < 16) ? out_lat : out_ctx) + ro; const PG8_GAS float* gv = gmod + ((j < 16) ? b : 4) * 6144;
        const int col0 = u.pn * BM + wc * 32 + 4 * fq;
#pragma unroll
        for (int bj = 0; bj < 2; ++bj)
#pragma unroll
            for (int n = 0; n < 2; ++n) { const int col = col0 + bj * HALF + n * 16; const f32x4 g = *(const PG8_GAS f32x4*)(gv + col);
                f32x4 bs[2][4];
#pragma unroll
                for (int ai = 0; ai < 2; ++ai)
#pragma unroll
                    for (int m = 0; m < 4; ++m) bs[ai][m] = *(const PG8_GAS f32x4*)(bp + (size_t)(ai * HALF + wr * 64 + m * 16 + fr) * 1024 + col);
#pragma unroll
                for (int ai = 0; ai < 2; ++ai)
#pragma unroll
                    for (int m = 0; m < 4; ++m) *(PG8_GAS f32x4*)(op + (size_t)(ai * HALF + wr * 64 + m * 16 + fr) * 1024 + col) = bs[ai][m] + g * acc[ai][bj][m][n]; }
    }
};
struct EpiGU {
    static constexpr bool PERM = true, KEEP = false;
    PG8_GAS bf16_t* O; int ldc;
    __device__ __forceinline__ void operator()(f32x4 (&acc)[2][2][4][2], const Unit& u, int wr, int wc, int fr, int fq) const {
        const int row0 = u.pm * BM + wr * 64 + fr, col0 = u.pn * HALF + wc * 32 + 8 * fq;
#pragma unroll
        for (int ai = 0; ai < 2; ++ai)
#pragma unroll
            for (int m = 0; m < 4; ++m) { float o[8];
#pragma unroll
                for (int n = 0; n < 2; ++n)
#pragma unroll
                    for (int k = 0; k < 4; ++k) { const float a = acc[ai][0][m][n][k], b = acc[ai][1][m][n][k]; o[n * 4 + k] = a * fast_sigmoid(a) * b; }
                u32x4 w; w.x = cvt_pk_bf16(o[0], o[1]); w.y = cvt_pk_bf16(o[2], o[3]); w.z = cvt_pk_bf16(o[4], o[5]); w.w = cvt_pk_bf16(o[6], o[7]);
                *(PG8_GAS u32x4*)(O + (size_t)(row0 + ai * HALF + m * 16) * ldc + col0) = w; }
    }
};

template <class Epi, class Sched, bool ALIGN_EPI>
__device__ __forceinline__ void gemm_phase(PG8_LAS unsigned char* lds, int tid, const PG8_GAS bf16_t* A, const PG8_GAS bf16_t* Bt, int lda, int ldb, int K, const Sched& S, const Epi& E) {
    const int wid = __builtin_amdgcn_readfirstlane(tid >> 6), lane = tid & 63, wr = wid >> 2, wc = wid & 3, fr = lane & 15, fq = lane >> 4;
    const int nt = K / BK;
    unsigned voffA[2], voffB[2];
#pragma unroll
    for (int i = 0; i < 2; ++i) { int R, C; stage_rc(tid * 16 + i * 8192, R, C); const int Rb = Epi::PERM ? ((R & ~31) + perm32(R & 31)) : R;
        voffA[i] = (unsigned)(R * lda + C) * 2u; voffB[i] = (unsigned)(Rb * ldb + C) * 2u; }
    const size_t kstep = (size_t)(BK * 2);
    const size_t hstepA = (size_t)HALF * lda * 2, hstepB = (size_t)HALF * ldb * 2;
    const unsigned ldsw = (unsigned)wid * 1024u;
    const int aoff = lds_byte(wr * 64 + fr, fq * 8), boff = lds_byte(wc * 32 + fr, fq * 8);
#define PG8_SA(b, h) (((b) * 2 + (h)) * HTB)
#define PG8_SB(b, h) ((4 + (b) * 2 + (h)) * HTB)
#define PG8_STAGE(bufoff, gbase, voff) do { _Pragma("unroll") for (int _i = 0; _i < 2; ++_i) \
        __builtin_amdgcn_global_load_lds((const PG8_GAS unsigned*)((const PG8_GAS char*)(gbase) + (voff)[_i]), (PG8_LAS unsigned*)(lds + (bufoff) + ldsw + _i * 8192), 16, 0, 0); } while (0)
#define PG8_LDA(dst, b, h) do { _Pragma("unroll") for (int m = 0; m < 4; ++m) _Pragma("unroll") for (int k = 0; k < 2; ++k) dst[m][k] = *(const PG8_LAS bf16x8*)(lds + PG8_SA(b, h) + aoff + m * 2048 + k * 1024); } while (0)
#define PG8_LDB(dst, b, h) do { _Pragma("unroll") for (int n = 0; n < 2; ++n) _Pragma("unroll") for (int k = 0; k < 2; ++k) dst[n][k] = *(const PG8_LAS bf16x8*)(lds + PG8_SB(b, h) + boff + n * 2048 + k * 1024); } while (0)
#define PG8_MMA(ai, bj, At, Bt_) do { __builtin_amdgcn_s_setprio(1); _Pragma("unroll") for (int m = 0; m < 4; ++m) _Pragma("unroll") for (int n = 0; n < 2; ++n) _Pragma("unroll") for (int k = 0; k < 2; ++k) \
        acc[ai][bj][m][n] = __builtin_amdgcn_mfma_f32_16x16x32_bf16(Bt_[n][k], At[m][k], acc[ai][bj][m][n], 0, 0, 0); __builtin_amdgcn_s_setprio(0); } while (0)
#define PG8_WAIT_V(n) asm volatile("s_waitcnt vmcnt(" #n ")" ::: "memory")
#define PG8_WAIT_L(n) asm volatile("s_waitcnt lgkmcnt(" #n ")" ::: "memory")
#define PG8_BAR __builtin_amdgcn_s_barrier()
#define PG8_SCHED __builtin_amdgcn_sched_barrier(0)
    Unit cur, nxt; int ui = 0;
    if (!S.next(0, cur)) return;
    f32x4 acc[2][2][4][2];
#pragma unroll
    for (int a = 0; a < 2; ++a)
#pragma unroll
        for (int b = 0; b < 2; ++b)
#pragma unroll
            for (int m = 0; m < 4; ++m)
#pragma unroll
                for (int n = 0; n < 2; ++n) acc[a][b][m][n] = (f32x4){0.f, 0.f, 0.f, 0.f};
    bf16x8 At[4][2], B0[2][2], B1[2][2];
    const PG8_GAS char* cA = (const PG8_GAS char*)A + cur.aoff; const PG8_GAS char* cB = (const PG8_GAS char*)Bt + cur.boff;
    PG8_STAGE(PG8_SB(0, 0), cB, voffB); PG8_STAGE(PG8_SB(0, 1), cB + hstepB, voffB); PG8_STAGE(PG8_SA(0, 0), cA, voffA); PG8_STAGE(PG8_SA(0, 1), cA + hstepA, voffA);
    if (wr == 1) PG8_BAR;
    PG8_WAIT_V(2); PG8_BAR;
    PG8_STAGE(PG8_SB(1, 0), cB + kstep, voffB); PG8_STAGE(PG8_SA(1, 0), cA + kstep, voffA); PG8_STAGE(PG8_SB(1, 1), cB + hstepB + kstep, voffB);
    PG8_WAIT_V(6); PG8_BAR;
    for (;;) {
        const bool has_next = S.next(ui + 1, nxt);
        const PG8_GAS char* nA = has_next ? (const PG8_GAS char*)A + nxt.aoff : cA; const PG8_GAS char* nB = has_next ? (const PG8_GAS char*)Bt + nxt.boff : cB;
        for (int t = 0; t < nt; t += 2) {
            const bool last = (t == nt - 2);
            const PG8_GAS char* a1 = cA + (size_t)(t + 1) * kstep;
            const PG8_GAS char* a2 = last ? nA : cA + (size_t)(t + 2) * kstep; const PG8_GAS char* b2 = last ? nB : cB + (size_t)(t + 2) * kstep;
            const PG8_GAS char* a3 = a2 + kstep; const PG8_GAS char* b3 = b2 + kstep;
            PG8_LDB(B0, 0, 0); PG8_LDB(B1, 0, 1); PG8_SCHED; PG8_LDA(At, 0, 0); PG8_STAGE(PG8_SA(1, 1), a1 + hstepA, voffA);
            PG8_WAIT_V(8); PG8_WAIT_L(0); PG8_BAR; PG8_MMA(0, 0, At, B0); PG8_MMA(0, 1, At, B1); PG8_BAR; PG8_SCHED;
            PG8_LDA(At, 0, 1); PG8_STAGE(PG8_SB(0, 0), b2, voffB); PG8_STAGE(PG8_SB(0, 1), b2 + hstepB, voffB); PG8_STAGE(PG8_SA(0, 0), a2, voffA);
            PG8_WAIT_V(8); PG8_WAIT_L(0); PG8_BAR; PG8_MMA(1, 0, At, B0); PG8_MMA(1, 1, At, B1); PG8_BAR; PG8_SCHED;
            PG8_LDB(B0, 1, 0); PG8_LDB(B1, 1, 1); PG8_SCHED; PG8_LDA(At, 1, 0); PG8_STAGE(PG8_SA(0, 1), a2 + hstepA, voffA);
            PG8_WAIT_V(8); PG8_WAIT_L(0); PG8_BAR; PG8_MMA(0, 0, At, B0); PG8_MMA(0, 1, At, B1); PG8_BAR; PG8_SCHED;
            PG8_LDA(At, 1, 1); PG8_STAGE(PG8_SB(1, 0), b3, voffB); PG8_STAGE(PG8_SB(1, 1), b3 + hstepB, voffB); PG8_STAGE(PG8_SA(1, 0), a3, voffA);
            PG8_WAIT_V(8); PG8_WAIT_L(0); PG8_BAR; PG8_MMA(1, 0, At, B0); PG8_MMA(1, 1, At, B1); PG8_BAR; PG8_SCHED;
        }
        if constexpr (ALIGN_EPI) { if (wr == 0) PG8_BAR; }
        E(acc, cur, wr, wc, fr, fq);
        if (!has_next) break;
        if constexpr (!Epi::KEEP) {
#pragma unroll
            for (int a = 0; a < 2; ++a)
#pragma unroll
                for (int b = 0; b < 2; ++b)
#pragma unroll
                    for (int m = 0; m < 4; ++m)
#pragma unroll
                        for (int n = 0; n < 2; ++n) acc[a][b][m][n] = (f32x4){0.f, 0.f, 0.f, 0.f};
        }
        cur = nxt; cA = nA; cB = nB; ++ui;
        if constexpr (ALIGN_EPI) { if (wr == 1) PG8_BAR; }
    }
    PG8_WAIT_V(0);
    if constexpr (!ALIGN_EPI) { if (wr == 0) PG8_BAR; }
    PG8_BAR;
#undef PG8_SA
#undef PG8_SB
#undef PG8_STAGE
#undef PG8_LDA
#undef PG8_LDB
#undef PG8_MMA
#undef PG8_WAIT_V
#undef PG8_WAIT_L
#undef PG8_BAR
#undef PG8_SCHED
}
}
namespace attn_body {
using bf16=__hip_bfloat16;
using bf16x8=__attribute__((ext_vector_type(8)))short;
using s16x4=__attribute__((ext_vector_type(4)))short;
using f32x16=__attribute__((ext_vector_type(16)))float;
using u32x4=__attribute__((ext_vector_type(4)))unsigned;
constexpr int D=64;
constexpr int QP=4352,KP=4352,VP=4352,OP=2048;
constexpr int NW=8,QBLK=32,QB=QBLK*NW,KVBLK=64;
__device__ __forceinline__ int crow(int r,int hi){return (r&3)+8*(r>>2)+4*hi;}
#define SBAR() __builtin_amdgcn_sched_barrier(0)
#define AGAS __attribute__((address_space(1)))
constexpr int NSLOT=3, SLOTB=8192;
constexpr int LDS_K=0, LDS_V=NSLOT*SLOTB, LDS_WS=2*NSLOT*SLOTB, LDS_OST=LDS_WS+NW*64*4, LDS_BIAS=LDS_OST+NW*4096, LDS_BYTES=LDS_BIAS+8192;
constexpr float C2=0.125f*1.4426950408889634f;
__device__ __forceinline__ void glds16(const AGAS void*gsrc,unsigned lds_dst){unsigned keep;
  asm volatile("s_mov_b32 %0, m0\n\ts_mov_b32 m0, %2\n\ts_nop 0\n\tglobal_load_lds_dwordx4 %1, off\n\ts_mov_b32 m0, %0":"=&s"(keep):"v"(gsrc),"s"(lds_dst):"memory");}
__device__ __forceinline__ float max3f(float a,float b,float c){float r;asm("v_max3_f32 %0, %1, %2, %3":"=v"(r):"v"(a),"v"(b),"v"(c));return r;}
__device__ __forceinline__ float max2f(float a,float b){float r;asm("v_max_f32_e32 %0, %1, %2":"=v"(r):"v"(a),"v"(b));return r;}
__device__ __forceinline__ float fadd_s(float a,float b){float r;asm("v_add_f32_e32 %0, %1, %2":"=v"(r):"v"(a),"v"(b));return r;}
__device__ __forceinline__ float fsub_s(float a,float b){float r;asm("v_sub_f32_e32 %0, %1, %2":"=v"(r):"v"(a),"v"(b));return r;}
typedef float f32x2_t __attribute__((ext_vector_type(2))); typedef __bf16 bf16x2_t __attribute__((ext_vector_type(2)));
__device__ __forceinline__ unsigned cvtpk_s(float lo,float hi){f32x2_t v={lo,hi};bf16x2_t b=__builtin_convertvector(v,bf16x2_t);return __builtin_bit_cast(unsigned,b);}
#define WAIT_BAR(N) asm volatile("s_waitcnt vmcnt(" #N ") lgkmcnt(0)\n\ts_barrier":::"memory")

__device__ __forceinline__ void qkt(f32x16&p0,f32x16&p1,const char*Kslot,const bf16x8*qr,const f32x16&negm,int r32,int hi){
  const char*kb=Kslot+hi*1024+r32*16;
  #pragma unroll
  for(int d0=0;d0<4;++d0){
    const bf16x8 b0=*reinterpret_cast<const bf16x8*>(kb+d0*2048);
    const bf16x8 b1=*reinterpret_cast<const bf16x8*>(kb+d0*2048+512);
    if(d0==0){p0=__builtin_amdgcn_mfma_f32_32x32x16_bf16(b0,qr[0],negm,0,0,0);p1=__builtin_amdgcn_mfma_f32_32x32x16_bf16(b1,qr[0],negm,0,0,0);}
    else{p0=__builtin_amdgcn_mfma_f32_32x32x16_bf16(b0,qr[d0],p0,0,0,0);p1=__builtin_amdgcn_mfma_f32_32x32x16_bf16(b1,qr[d0],p1,0,0,0);}}
}
typedef __attribute__((address_space(3))) const char* lds_cptr;
typedef __attribute__((address_space(3))) const float* lds_fptr;
typedef short v4i16_t __attribute__((ext_vector_type(4)));
__device__ __forceinline__ void kload8(bf16x8*kf,lds_cptr kp){
  kf[0]=*(const __attribute__((address_space(3))) bf16x8*)(kp);      kf[1]=*(const __attribute__((address_space(3))) bf16x8*)(kp+512);
  kf[2]=*(const __attribute__((address_space(3))) bf16x8*)(kp+2048); kf[3]=*(const __attribute__((address_space(3))) bf16x8*)(kp+2560);
  kf[4]=*(const __attribute__((address_space(3))) bf16x8*)(kp+4096); kf[5]=*(const __attribute__((address_space(3))) bf16x8*)(kp+4608);
  kf[6]=*(const __attribute__((address_space(3))) bf16x8*)(kp+6144); kf[7]=*(const __attribute__((address_space(3))) bf16x8*)(kp+6656);
}
__device__ __forceinline__ void kload2(bf16x8*kf,lds_cptr kp,int j){ kf[2*j]=*(const __attribute__((address_space(3))) bf16x8*)(kp+j*2048); kf[2*j+1]=*(const __attribute__((address_space(3))) bf16x8*)(kp+j*2048+512); }
__device__ __forceinline__ s16x4 vtr(lds_cptr p){ return __builtin_bit_cast(s16x4,__builtin_amdgcn_ds_read_tr16_b64_v4i16((__attribute__((address_space(3))) v4i16_t*)p)); }
__device__ __forceinline__ float rowmax(const f32x16&p0,const f32x16&p1){
  float a=max3f(p0[0],p0[1],p1[0]),b=max3f(p0[2],p0[3],p1[1]);a=max3f(a,p1[2],p1[3]);
  #pragma unroll
  for(int r=4;r<16;r+=4){a=max3f(a,p0[r],p0[r+1]);b=max3f(b,p0[r+2],p0[r+3]);a=max3f(a,p1[r],p1[r+1]);b=max3f(b,p1[r+2],p1[r+3]);}
  const float m=max2f(a,b);
  auto rr=__builtin_amdgcn_permlane32_swap(__float_as_uint(m),__float_as_uint(m),false,false);
  return max2f(__uint_as_float(rr[0]),__uint_as_float(rr[1]));
}
__device__ __forceinline__ void pv(f32x16*o,int vb,bf16x8 pa0,bf16x8 pa1,bf16x8 pa2,bf16x8 pa3){
  #pragma unroll
  for(int d0=0;d0<2;++d0){s16x4 lo[4],hi[4];
    #pragma unroll
    for(int ks=0;ks<4;++ks){
      asm volatile("ds_read_b64_tr_b16 %0,%1 offset:%c2":"=&v"(lo[ks]):"v"(vb),"i"(d0*4096+ks*1024):"memory");
      asm volatile("ds_read_b64_tr_b16 %0,%1 offset:%c2":"=&v"(hi[ks]):"v"(vb),"i"(d0*4096+ks*1024+512):"memory");}
    asm volatile("s_waitcnt lgkmcnt(0)":::"memory");SBAR();
    #define PK(k) (bf16x8){lo[k][0],lo[k][1],lo[k][2],lo[k][3],hi[k][0],hi[k][1],hi[k][2],hi[k][3]}
    o[d0]=__builtin_amdgcn_mfma_f32_32x32x16_bf16(pa0,PK(0),o[d0],0,0,0);
    o[d0]=__builtin_amdgcn_mfma_f32_32x32x16_bf16(pa1,PK(1),o[d0],0,0,0);
    o[d0]=__builtin_amdgcn_mfma_f32_32x32x16_bf16(pa2,PK(2),o[d0],0,0,0);
    o[d0]=__builtin_amdgcn_mfma_f32_32x32x16_bf16(pa3,PK(3),o[d0],0,0,0);
    #undef PK
  }
}
__device__ __forceinline__ void namask(f32x16&p0,f32x16&p1,int kr,int qr,unsigned wlo,unsigned whi,lds_fptr brow0,float mh){
  const float BIG=1e30f;
  int r0=qr-4; r0=r0<0?0:(r0>56?56:r0);
  if(kr<r0||kr>=r0+8){
    #pragma unroll
    for(int r=0;r<16;++r){p0[r]=-BIG;p1[r]=-BIG;}
    return; }
  const lds_fptr brow=brow0+(kr-qr+7)*128;
  asm volatile("":"+v"(wlo),"+v"(whi));
  #pragma unroll
  for(int r=0;r<16;++r){
    const int pos=(r&3)+8*(r>>2);
    const float b0=brow[pos]-mh, b1=brow[pos+32]-mh;
    const float f0=(float)((wlo>>pos)&1u), f1=(float)((whi>>pos)&1u);
    p0[r]=(p0[r]+b0)+__builtin_fmaf(f0,BIG,-BIG); p1[r]=(p1[r]+b1)+__builtin_fmaf(f1,BIG,-BIG);
    if((r&3)==3) __builtin_amdgcn_sched_barrier(0); }
}
struct AttnArgs { const AGAS bf16* Q; const AGAS bf16* K; const AGAS bf16* V; AGAS bf16* O; int kr0, kr1, tsw, NT; int qrow0, rb0; const AGAS float* rpb; };
#define ATTN_STORE16(p,v) (*(AGAS u32x4*)(p)=(v))
template<int THRL,bool MASKED> __device__ __forceinline__ void attn_unit(const AttnArgs&a,char*shm,int tid){
  const int lane=tid&63,r32=lane&31,hi=lane>>5; const int wid=__builtin_amdgcn_readfirstlane(tid>>6);
  const AGAS bf16*Qw=a.Q+(long)(wid*QBLK)*QP;
  const AGAS bf16*Kh=a.K,*Vh=a.V;
  const unsigned lds0=(unsigned)(uintptr_t)shm;
  float*wsf=(float*)(shm+LDS_WS)+wid*64;
  const AGAS bf16*ksrc=Kh+(long)lane*KP+wid*8;
  const AGAS bf16*vsrc=Vh+(long)(16*(wid&3)+(lane>>2))*VP+(wid>>2)*32+(lane&3)*8;
  const unsigned kdst=lds0+LDS_K+wid*1024, vdst=lds0+LDS_V+wid*1024;
  const int kr0=a.kr0,kr1=a.kr1,tsw=a.tsw;
  #define KROW(t) ((t)<tsw?kr0+64*(t):kr1+64*((t)-tsw))
  #define DMA_K(t,slot) glds16(ksrc+(long)KROW(t)*KP,(unsigned)__builtin_amdgcn_readfirstlane(kdst+(slot)))
  #define DMA_V(t,slot) glds16(vsrc+(long)KROW(t)*VP,(unsigned)__builtin_amdgcn_readfirstlane(vdst+(slot)))
  const int vb0=(int)(lds0+LDS_V)+((lane>>4)&1)*32+(lane&3)*8+(4*hi+((lane&15)>>2))*64;
  const char*Kbase=shm+LDS_K; bf16x8 kf[8];
  const lds_cptr shm3=(lds_cptr)shm; const lds_cptr kp0=shm3+LDS_K+hi*1024+r32*16; const lds_cptr vp0=shm3+LDS_V+((lane>>4)&1)*32+(lane&3)*8+(4*hi+((lane&15)>>2))*64;
  const lds_fptr biasl=(lds_fptr)(shm3+LDS_BIAS);
  const int NT=a.NT;
  if constexpr(MASKED){ __attribute__((address_space(3))) float* bt=(__attribute__((address_space(3))) float*)(shm3+LDS_BIAS);
    for(int i_=tid;i_<15*128;i_+=512){ const int ri=i_>>7, dc=(i_&127)-48; bt[i_]=(dc>=0&&dc<31)?a.rpb[ri*31+dc]*1.4426950408889634f:0.f; } }
  const int qgr=a.qrow0+(wid>>1), qgc=(wid&1)*32+r32, rb0=a.rb0;
  unsigned wlo=0u,whi=0u; lds_fptr brow0=biasl;
  if constexpr(MASKED){ int cs=qgc-8; cs=cs<0?0:(cs>48?48:cs); const unsigned long long cm=(0xFFFFull<<cs)>>(4*hi); wlo=(unsigned)cm; whi=(unsigned)(cm>>32); brow0=biasl+(4*hi-qgc+63); }
  DMA_K(0,0);DMA_V(0,0);DMA_K(1,SLOTB);
  bf16x8 qr[4];
  #pragma unroll
  for(int d0=0;d0<4;++d0)qr[d0]=*(const AGAS bf16x8*)(&Qw[(long)r32*QP+d0*16+hi*8]);
  float zf_=0.f; asm volatile("":"+v"(zf_)); float mhat=zf_,l_reg=zf_;f32x16 o[2],negm; _Pragma("unroll") for(int r=0;r<16;++r){o[0][r]=zf_;o[1][r]=zf_;negm[r]=zf_;} if constexpr(!MASKED){asm volatile("":"+v"(negm));} const f32x16 zc=f32x16{};
  #define CMASK(P0,P1,t) do{ if constexpr(MASKED){ if((t)>=4) namask(P0,P1,rb0+(t)-4,qgr,wlo,whi,brow0,mhat); else { _Pragma("unroll") for(int r_=0;r_<16;++r_){P0[r_]-=mhat;P1[r_]-=mhat;} } } }while(0)
  bool resc=false;
  #define START(P0,P1) do{ const float rm=rowmax(P0,P1); resc=false; \
    { const float dl=rm; mhat=fadd_s(mhat,dl); \
      _Pragma("unroll") for(int r=0;r<16;++r){P0[r]=fsub_s(P0[r],dl);P1[r]=fsub_s(P1[r],dl);} \
      if constexpr(!MASKED){ _Pragma("unroll") for(int r=0;r<16;++r)negm[r]=-mhat; asm volatile("":"+v"(negm)); } } \
    _Pragma("unroll") for(int r=0;r<16;++r)P0[r]=__builtin_amdgcn_exp2f(P0[r]); }while(0)
  #define RESC() do{ if(resc){ asm volatile("s_waitcnt lgkmcnt(0)":::"memory"); \
      _Pragma("unroll") for(int d_=0;d_<2;++d_) _Pragma("unroll") for(int r=0;r<16;++r)o[d_][r]*=wsf[crow(r,hi)]; } }while(0)
  f32x16 pA0,pA1,pB0,pB1;
  int sl_prev=0,sl_cur=0,sl_next=SLOTB;
  #define ROT() do{sl_prev=sl_cur;sl_cur=sl_next;sl_next=(sl_next==(NSLOT-1)*SLOTB)?0:sl_next+SLOTB;}while(0)
  DMA_K(2,2*SLOTB);
  WAIT_BAR(3);
  qkt(pA0,pA1,Kbase,qr,zc,r32,hi);asm volatile("s_nop 15\n\ts_nop 7":"+v"(pA0),"+v"(pA1));
  START(pA0,pA1);
  _Pragma("unroll") for(int r=0;r<16;++r)pA1[r]=__builtin_amdgcn_exp2f(pA1[r]);
  WAIT_BAR(0);
  DMA_K(3,0);DMA_V(1,SLOTB);
  ROT();
  kload8(kf,kp0+sl_cur);
  WAIT_BAR(2);
  s16x4 vlo[8],vhi[8]; u32x4 pw0,pw1,pw2,pw3;
  #define PKW(P,B) cvtpk_s(P[B],P[B+1])
  #define PAF(k) __builtin_bit_cast(bf16x8,pw##k)
  #define VFR(i) (bf16x8){vlo[i][0],vlo[i][1],vlo[i][2],vlo[i][3],vhi[i][0],vhi[i][1],vhi[i][2],vhi[i][3]}
  #define PIN(x) asm volatile("":"+v"(x))
  #define MX3(a,b,c) __builtin_fmaxf(__builtin_fmaxf((a),(b)),(c))
  #define GAPA(MF,A0,A1,A2,A3,W0,W1,PW) do{ MF; sacc+=A0; sacc+=A1; sacc+=A2; sacc+=A3; PIN(sacc); W0; W1; PIN(PW); SBAR(); }while(0)
  #define EX(v) __builtin_amdgcn_exp2f(v)
  #define GAPB(MF,X,B) do{ MF; X[B]=EX(X[B]); X[B+1]=EX(X[B+1]); X[B+2]=EX(X[B+2]); X[B+3]=EX(X[B+3]); PIN(X); SBAR(); }while(0)
  #define VRD(i) do{ vlo[i]=vtr(vp_+(((i)>>2)*4096+((i)&3)*1024)); vhi[i]=vtr(vp_+(((i)>>2)*4096+((i)&3)*1024+512)); }while(0)
  #define KRD(G,j) do{ if(G){ kload2(kf,kp0+sl_next,j); SBAR(); } }while(0)
  #define STEP(C0,C1,P0,P1,t,GK,GV,GL) do{ SBAR(); \
    const lds_cptr vp_=vp0+sl_prev; \
    VRD(0); SBAR(); float sacc=(P0[0]+P0[1]); \
    GAPA(C0=__builtin_amdgcn_mfma_f32_32x32x16_bf16(kf[0],qr[0],(MASKED?zc:negm),0,0,0), P0[2],P0[3],P0[4],P0[5],     pw0[0]=PKW(P0,0), pw0[1]=PKW(P0,2), pw0); \
    VRD(4); SBAR(); GAPA(C1=__builtin_amdgcn_mfma_f32_32x32x16_bf16(kf[1],qr[0],(MASKED?zc:negm),0,0,0), P0[6],P0[7],P0[8],P0[9],     pw0[2]=PKW(P0,4), pw0[3]=PKW(P0,6), pw0); \
    VRD(1); SBAR(); GAPA(C0=__builtin_amdgcn_mfma_f32_32x32x16_bf16(kf[2],qr[1],C0,0,0,0),   P0[10],P0[11],P0[12],P0[13], pw1[0]=PKW(P0,8), pw1[1]=PKW(P0,10), pw1); \
    VRD(5); SBAR(); GAPA(C1=__builtin_amdgcn_mfma_f32_32x32x16_bf16(kf[3],qr[1],C1,0,0,0),   P0[14],P0[15],P1[0],P1[1],   pw1[2]=PKW(P0,12),pw1[3]=PKW(P0,14), pw1); \
    VRD(2); SBAR(); GAPA(C0=__builtin_amdgcn_mfma_f32_32x32x16_bf16(kf[4],qr[2],C0,0,0,0),   P1[2],P1[3],P1[4],P1[5],     pw2[0]=PKW(P1,0), pw2[1]=PKW(P1,2), pw2); \
    VRD(6); SBAR(); GAPA(C1=__builtin_amdgcn_mfma_f32_32x32x16_bf16(kf[5],qr[2],C1,0,0,0),   P1[6],P1[7],P1[8],P1[9],     pw2[2]=PKW(P1,4), pw2[3]=PKW(P1,6), pw2); \
    VRD(3); SBAR(); GAPA(C0=__builtin_amdgcn_mfma_f32_32x32x16_bf16(kf[6],qr[3],C0,0,0,0),   P1[10],P1[11],P1[12],P1[13], pw3[0]=PKW(P1,8), pw3[1]=PKW(P1,10), pw3); \
    VRD(7); SBAR(); GAPA(C1=__builtin_amdgcn_mfma_f32_32x32x16_bf16(kf[7],qr[3],C1,0,0,0),   P1[14],P1[15],0.f,0.f,       pw3[2]=PKW(P1,12),pw3[3]=PKW(P1,14), pw3); \
    l_reg+=sacc; \
    if(GK){DMA_K((t)+3,sl_cur);} if(GV){DMA_V((t)+1,sl_next);} \
    CMASK(C0,C1,t); \
    { float a_=MX3(C0[0],C0[1],C1[0]),b_=MX3(C0[2],C0[3],C1[1]); a_=MX3(a_,C1[2],C1[3]); \
      _Pragma("unroll") for(int r=4;r<16;r+=4){a_=MX3(a_,C0[r],C0[r+1]);b_=MX3(b_,C0[r+2],C0[r+3]);a_=MX3(a_,C1[r],C1[r+1]);b_=MX3(b_,C1[r+2],C1[r+3]);} \
      float rm=__builtin_fmaxf(a_,b_); { auto rr=__builtin_amdgcn_permlane32_swap(__float_as_uint(rm),__float_as_uint(rm),false,false); rm=__builtin_fmaxf(__uint_as_float(rr[0]),__uint_as_float(rr[1])); } \
      resc=false; \
      if(__builtin_expect(__any(rm>(float)THRL),0)){ const float dl=__builtin_fmaxf(rm,0.f); mhat+=dl; \
        _Pragma("unroll") for(int r=0;r<16;++r){C0[r]-=dl;C1[r]-=dl;} \
        if constexpr(!MASKED){ _Pragma("unroll") for(int r=0;r<16;++r)negm[r]=-mhat; asm volatile("":"+v"(negm)); } \
        const float f=__builtin_amdgcn_exp2f(-dl); l_reg*=f; if(hi==0)wsf[r32]=f; resc=true; } } \
    SBAR(); \
    GAPB(o[0]=__builtin_amdgcn_mfma_f32_32x32x16_bf16(PAF(0),VFR(0),o[0],0,0,0), C0,0); \
    GAPB(o[1]=__builtin_amdgcn_mfma_f32_32x32x16_bf16(PAF(0),VFR(4),o[1],0,0,0), C0,4); \
    KRD(GL,0); GAPB(o[0]=__builtin_amdgcn_mfma_f32_32x32x16_bf16(PAF(1),VFR(1),o[0],0,0,0), C0,8); \
    KRD(GL,1); GAPB(o[1]=__builtin_amdgcn_mfma_f32_32x32x16_bf16(PAF(1),VFR(5),o[1],0,0,0), C0,12); \
    KRD(GL,2); GAPB(o[0]=__builtin_amdgcn_mfma_f32_32x32x16_bf16(PAF(2),VFR(2),o[0],0,0,0), C1,0); \
    KRD(GL,3); GAPB(o[1]=__builtin_amdgcn_mfma_f32_32x32x16_bf16(PAF(2),VFR(6),o[1],0,0,0), C1,4); \
    GAPB(o[0]=__builtin_amdgcn_mfma_f32_32x32x16_bf16(PAF(3),VFR(3),o[0],0,0,0), C1,8); \
    GAPB(o[1]=__builtin_amdgcn_mfma_f32_32x32x16_bf16(PAF(3),VFR(7),o[1],0,0,0), C1,12); \
    }while(0)
  int t=1;
  for(;t+5<NT;t+=2){
    STEP(pB0,pB1,pA0,pA1,t,true,true,true);     WAIT_BAR(2); RESC(); ROT();
    STEP(pA0,pA1,pB0,pB1,t+1,true,true,true);   WAIT_BAR(2); RESC(); ROT();
  }
  #define ENDW(tt) do{ if((tt)+3<NT){WAIT_BAR(2);} else if((tt)+2<NT){WAIT_BAR(1);} else {WAIT_BAR(0);} }while(0)
  for(;t+1<NT;t+=2){
    STEP(pB0,pB1,pA0,pA1,t,(t+3<NT),(t+1<NT),(t+1<NT));       ENDW(t);   RESC(); ROT();
    STEP(pA0,pA1,pB0,pB1,t+1,(t+4<NT),(t+2<NT),(t+2<NT));     ENDW(t+1); RESC(); ROT();
  }
  STEP(pB0,pB1,pA0,pA1,NT-1,false,false,false); RESC();
  { float sacc=pB0[0]+pB0[1]; _Pragma("unroll") for(int r=2;r<16;++r)sacc+=pB0[r]; _Pragma("unroll") for(int r=0;r<16;++r)sacc+=pB1[r]; l_reg+=sacc;
    pw0=(u32x4){PKW(pB0,0),PKW(pB0,2),PKW(pB0,4),PKW(pB0,6)};pw1=(u32x4){PKW(pB0,8),PKW(pB0,10),PKW(pB0,12),PKW(pB0,14)};pw2=(u32x4){PKW(pB1,0),PKW(pB1,2),PKW(pB1,4),PKW(pB1,6)};pw3=(u32x4){PKW(pB1,8),PKW(pB1,10),PKW(pB1,12),PKW(pB1,14)};
    SBAR(); pv(o,vb0+sl_cur,PAF(0),PAF(1),PAF(2),PAF(3)); }
  #undef PKW
  #undef PAF
  #undef VFR
  #undef PIN
  #undef MX3
  #undef GAPA
  #undef GAPB
  #undef EX
  #undef VRD
  #undef KRD
  #undef STEP
  #undef ENDW
  {auto rr=__builtin_amdgcn_permlane32_swap(__float_as_uint(l_reg),__float_as_uint(l_reg),false,false);l_reg=__uint_as_float(rr[0])+__uint_as_float(rr[1]);}
  if(hi==0)wsf[32+r32]=l_reg;asm volatile("s_waitcnt lgkmcnt(0)":::"memory");
  float rli[16];
  #pragma unroll
  for(int r=0;r<16;++r)rli[r]=__builtin_amdgcn_rcpf(wsf[32+crow(r,hi)]);
  AGAS bf16*Ow=a.O+(long)(wid*QBLK)*OP;
  { bf16*stg=(bf16*)(shm+LDS_OST)+wid*2048;
    #pragma unroll
    for(int r=0;r<16;++r){const int orow=crow(r,hi);
      #pragma unroll
      for(int d0=0;d0<2;++d0)stg[orow*64+d0*32+r32]=__float2bfloat16(o[d0][r]*rli[r]);}
    asm volatile("s_waitcnt lgkmcnt(0)":::"memory");
    #pragma unroll
    for(int i=0;i<4;++i){const int row=i*8+(lane>>3),ch=lane&7; const u32x4 v=*(const u32x4*)(stg+row*64+ch*8); ATTN_STORE16(Ow+(long)row*OP+ch*8,v);} }
  asm volatile("s_waitcnt lgkmcnt(0)\n\ts_barrier":::"memory");
  #undef KROW
  #undef DMA_K
  #undef DMA_V
  #undef CMASK
  #undef START
  #undef RESC
  #undef ROT
}
#undef SBAR
#undef WAIT_BAR
}
constexpr int NWAVES = 8, NTHR = 512;
constexpr int DM = 1024, NBATCH = 4, SEQ = 4096, CTXL = 256, RPB = SEQ + CTXL  , MROWS = NBATCH * RPB  , NLAYER = 2;
constexpr int PW = 4352;
constexpr int C_GQ = 0, C_GK = 512, C_GV = 640, C_NQ = 768, C_NK = 1280, C_NV = 1792, C_F = 2304, C_CA = 3328, C_CB = 3840, C_G = 4352;
constexpr int YW = 2048;
constexpr int INW = 7936;
constexpr int NEXP = 16, EFF = 512, MOE_ROWS = 38912  ;
constexpr float EPS = 1e-6f, LOG2E = 1.4426950408889634f;
constexpr float QSCALE = 0.125f * LOG2E;
constexpr size_t MiB = 1u << 20;
constexpr size_t WS_CTL = 0, CTL_ZERO_BYTES = 1 * MiB;
constexpr size_t WS_MODV = 1 * MiB;
constexpr size_t WS_ROPE = 1 * MiB + 384 * 1024;
constexpr size_t WS_TOKE = 2 * MiB, WS_TOKW = WS_TOKE + 160 * 1024, WS_TOKR = WS_TOKW + 160 * 1024, WS_TOKS = WS_TOKR + 160 * 1024;
constexpr size_t WS_XC = 4 * MiB;
constexpr size_t WS_WIN = 8 * MiB;
constexpr size_t WS_WB = 25 * MiB;
constexpr size_t WS_WO = 29 * MiB;
constexpr size_t WS_WGU = 32 * MiB;
constexpr size_t WS_WD = 64 * MiB;
constexpr size_t WS_H = 80 * MiB;
constexpr size_t WS_Y = 114 * MiB;
constexpr size_t WS_TP = WS_H;
constexpr size_t WS_WGU2 = 182 * MiB, WS_WD2 = 495 * MiB;
constexpr size_t WS_P = 214 * MiB;
constexpr size_t WS_GN = WS_P + 145 * MiB;
constexpr size_t WS_AM = WS_P, WS_HM = WS_P + 76 * MiB, WS_OM = WS_P + 114 * MiB;
constexpr size_t WS_END = 511 * MiB;
static_assert(WS_WIN + (size_t)PW * DM * 2 <= WS_WB && WS_P + (size_t)MROWS * PW * 2 <= WS_GN && WS_GN + (size_t)68 * 16 * 65536 * 2 <= WS_WD2 && WS_OM + (size_t)MOE_ROWS * DM * 2 <= WS_END, "ws map");
constexpr int CW_BAR = 4096;
constexpr int CW_CNT = 16384;
constexpr int RING_OFF = 0, RING_BYTES = 131072;
constexpr int LDSCTL_OFF = RING_BYTES, MISC_OFF = LDSCTL_OFF + 320;
constexpr int LDS_BYTES = 147456;

#define GAS __attribute__((address_space(1)))
#define LAS __attribute__((address_space(3)))
typedef unsigned short bf16;
typedef unsigned v4u __attribute__((ext_vector_type(4)));
typedef unsigned v2u __attribute__((ext_vector_type(2)));
typedef float f32x4 __attribute__((ext_vector_type(4)));
typedef GAS unsigned gu32;
#define RLX_AGENT __ATOMIC_RELAXED, __HIP_MEMORY_SCOPE_AGENT
#define LDS_WAIT() asm volatile("s_waitcnt lgkmcnt(0)" ::: "memory")
__device__ __forceinline__ unsigned f2bf(float f) { unsigned u = __builtin_bit_cast(unsigned, f); return (u + 0x7fffu + ((u >> 16) & 1u)) >> 16; }
__device__ __forceinline__ unsigned pk2(float lo, float hi) { return f2bf(lo) | (f2bf(hi) << 16); }
__device__ __forceinline__ float bf_lo(unsigned w) { return __uint_as_float(w << 16); }
__device__ __forceinline__ float bf_hi(unsigned w) { return __uint_as_float(w & 0xffff0000u); }
__device__ __forceinline__ float bf1(bf16 v) { return __uint_as_float(((unsigned)v) << 16); }
__device__ __forceinline__ float sigm(float x) { return 1.0f / (1.0f + __expf(-x)); }

#define XB_TMO      128
#define XB_XCNT(j)  (256  + 64 * (j))
#define XB_XSUB(j)  (1280 + 64 * (j))
#define XB_XGEN(j)  (2304 + 64 * (j))
#define XB_TOP      3328
#define XB_TOPGEN   3392
#define XCD_BAR_WORDS 3456
#define XB_SPIN_CAP (1u << 18)
__device__ __forceinline__ unsigned xb_ld(unsigned* p)              { return __hip_atomic_load(p, __ATOMIC_RELAXED, __HIP_MEMORY_SCOPE_AGENT); }
__device__ __forceinline__ unsigned xb_add(unsigned* p, unsigned v) { return __hip_atomic_fetch_add(p, v, __ATOMIC_RELAXED, __HIP_MEMORY_SCOPE_AGENT); }
__device__ __forceinline__ unsigned xb_xcc_id() { return (unsigned)__builtin_amdgcn_s_getreg((3 << 11) | 20) & 0xFu; }
#define XB_SPIN(cond, bar) do { unsigned _sp = 0; while (cond) { __builtin_amdgcn_s_sleep(1); \
    if ((++_sp & 255u) == 0u) { if (xb_ld(&(bar)[XB_TMO])) break; if (_sp > XB_SPIN_CAP) { atomicAdd(&(bar)[XB_TMO], 1u); break; } } } } while (0)
struct XcdBarrier { unsigned* bar; unsigned x; volatile LAS unsigned* st; };
__device__ __forceinline__ XcdBarrier xcd_barrier_post(unsigned* bar, volatile LAS unsigned* st) {
    XcdBarrier b; b.bar = bar; b.x = xb_xcc_id(); b.st = st;
    if (threadIdx.x == 0) (void)xb_add(&bar[XB_XCNT(b.x)], 1u);
    return b;
}
__device__ __forceinline__ void xcd_barrier_complete(unsigned* bar, unsigned x, unsigned& nloc, unsigned& nx) {
    const unsigned G = gridDim.x * gridDim.y * gridDim.z;
    unsigned sum, cnt, mine, sp = 0u;
    for (;;) {
        sum = 0u; cnt = 0u; mine = 0u;
#pragma unroll
        for (unsigned j = 0; j < 16; ++j) { const unsigned c = xb_ld(&bar[XB_XCNT(j)]); sum += c; cnt += (c > 0u) ? 1u : 0u; mine = (j == x) ? c : mine; }
        if (sum == G) break;
        __builtin_amdgcn_s_sleep(1);
        if ((++sp & 255u) == 0u) { if (xb_ld(&bar[XB_TMO])) break; if (sp > XB_SPIN_CAP) { atomicAdd(&bar[XB_TMO], 1u); break; } }
    }
    nloc = mine > 0u ? mine : 1u; nx = cnt > 0u ? cnt : 1u;
}
__device__ __forceinline__ void xcd_barrier(const XcdBarrier& b) {
    asm volatile("s_waitcnt vmcnt(0)" ::: "memory");
    __syncthreads();
    if (threadIdx.x == 0) {
        unsigned* bar = b.bar;
        __builtin_amdgcn_s_waitcnt(0);
        unsigned nloc = b.st[0], nx = b.st[1];
        if (nloc == 0u) { xcd_barrier_complete(bar, b.x, nloc, nx); b.st[0] = nloc; b.st[1] = nx; }
        const unsigned old = xb_add(&bar[XB_XSUB(b.x)], 1u);
        const unsigned gen = old / nloc;
        if (old + 1u == (gen + 1u) * nloc) {
            __builtin_amdgcn_fence(__ATOMIC_RELEASE, "agent");
            asm volatile("s_waitcnt vmcnt(0)" ::: "memory");
            const unsigned og = xb_add(&bar[XB_TOP], 1u);
            const unsigned tg = og / nx;
            if (og + 1u == (tg + 1u) * nx) xb_add(&bar[XB_TOPGEN], 1u);
            else XB_SPIN(xb_ld(&bar[XB_TOPGEN]) == tg, bar);
            __builtin_amdgcn_fence(__ATOMIC_ACQUIRE, "agent");
            xb_add(&bar[XB_XGEN(b.x)], 1u);
            asm volatile("s_waitcnt vmcnt(0)" ::: "memory");
        } else {
            XB_SPIN(xb_ld(&bar[XB_XGEN(b.x)]) == gen, bar);
            __builtin_amdgcn_fence(__ATOMIC_ACQUIRE, "agent");
            asm volatile("s_waitcnt vmcnt(0)" ::: "memory");
        }
    }
    __syncthreads();
}

struct Frame {
    LAS unsigned char* lds; volatile LAS unsigned* MISC; LAS unsigned* LCTL;
    gu32* ctl; unsigned char* ws; GAS float* out; int tid, lane, wave, vcu, G;
};
constexpr int PTR_OFF = LDSCTL_OFF + 96;
__device__ __forceinline__ const GAS float* INP(const Frame& F, int i) {
    const LAS unsigned* t = (const LAS unsigned*)(F.lds + PTR_OFF) + 2 * i;
    const unsigned lo = __builtin_amdgcn_readfirstlane(t[0]), hi = __builtin_amdgcn_readfirstlane(t[1]);
    return (const GAS float*)(((unsigned long long)hi << 32) | lo);
}
__device__ __forceinline__ float shx(float v, int m, int lane) { return __builtin_bit_cast(float, __builtin_amdgcn_ds_bpermute((lane ^ m) << 2, __builtin_bit_cast(int, v))); }
__device__ __forceinline__ float wave_sum(float v, int lane) {
#pragma unroll
    for (int o = 1; o < 64; o <<= 1) v += shx(v, o, lane);
    return v;
}
__device__ __forceinline__ const GAS float* xrow_in(const Frame& F, int row) { const int b = row / RPB, t = row % RPB; return t < SEQ ? INP(F, 0) + ((size_t)b * SEQ + t) * DM : INP(F, 2) + ((size_t)b * CTXL + (t - SEQ)) * DM; }
__device__ __forceinline__ GAS float* xrow_ws(const Frame& F, int row) { const int b = row / RPB, t = row % RPB; return t < SEQ ? F.out + ((size_t)b * SEQ + t) * DM : ((GAS float*)(F.ws + WS_XC)) + ((size_t)b * CTXL + (t - SEQ)) * DM; }
__device__ __forceinline__ int modidx(int row) { const int b = row / RPB, t = row % RPB; return t < SEQ ? b : 4; }

struct CvItem { const GAS float* src; GAS bf16* dst; int ldw, ldt; bool valid; };
__device__ __forceinline__ unsigned cvpk(float lo, float hi) { unsigned r; asm volatile("v_cvt_pk_bf16_f32 %0, %1, %2" : "=v"(r) : "v"(lo), "v"(hi)); return r; }
__device__ __forceinline__ void cv_load(const CvItem& c, f32x4 (&t)[8], int lane) {
#pragma unroll
    for (int i = 0; i < 8; ++i) t[i] = *(const GAS f32x4*)(c.src + (size_t)(8 * i + (lane >> 3)) * c.ldw + 4 * (lane & 7));
}
__device__ __forceinline__ void cv_store(const CvItem& c, const f32x4 (&t)[8], LAS float* scr, int lane) {
#pragma unroll
    for (int i = 0; i < 8; ++i) { LAS float* d = scr + (8 * i + (lane >> 3)) * 33 + 4 * (lane & 7); d[0] = t[i].x; d[1] = t[i].y; d[2] = t[i].z; d[3] = t[i].w; }
    LDS_WAIT(); asm volatile("" ::: "memory");
    const int cc = lane & 7;
#pragma unroll
    for (int j = 0; j < 4; ++j) { const int n = (lane >> 3) + 8 * j; const LAS float* s = scr + (8 * cc) * 33 + n;
        v4u o; o.x = cvpk(s[0 * 33], s[1 * 33]); o.y = cvpk(s[2 * 33], s[3 * 33]); o.z = cvpk(s[4 * 33], s[5 * 33]); o.w = cvpk(s[6 * 33], s[7 * 33]);
        *(GAS v4u*)(c.dst + (size_t)n * c.ldt + 8 * cc) = o; }
    LDS_WAIT(); asm volatile("" ::: "memory");
}
constexpr int CV_IN = 1, CV_BR = 2, CV_OUT = 4, CV_GU = 8, CV_DN = 16, CV_ALL = 31;
__device__ __forceinline__ CvItem cv_decode(const Frame& F, int l, int r, int n_in, int n_br, int n_o, int n_gu, int nitems) {
    CvItem c; c.valid = r < nitems; c.src = nullptr; c.dst = nullptr; c.ldw = 0; c.ldt = 0;
    if (!c.valid) return c;
    if (r < n_in) { const int nblk = INW / 32, kb = r / nblk, nb = r % nblk, n0 = 32 * nb;
        if (n0 >= 2304 && n0 < 2816) { c.valid = false; return c; }
        int drow = n0 < 2304 ? n0 : n0 + 512;
        if (n0 < 768) { const int Lb = (n0 & 255) >> 5; drow = (n0 & ~255) + 128 * (Lb & 1) + 32 * (Lb >> 1); }
        c.src = INP(F, 8) + (size_t)l * DM * INW + (size_t)(64 * kb) * INW + n0; c.ldw = INW; c.dst = ((GAS bf16*)(F.ws + WS_WIN)) + (size_t)drow * DM + 64 * kb; c.ldt = DM; return c; } r -= n_in;
    if (r < n_br) { const int nbr = r / 256, q = r % 256, kb = q / 32, nb = q % 32;
        c.src = INP(F, 15) + ((size_t)l * 4 + nbr) * 512 * DM + (size_t)(64 * kb) * DM + 32 * nb; c.ldw = DM; c.dst = ((GAS bf16*)(F.ws + WS_WB)) + (size_t)(32 * nb) * 2048 + nbr * 512 + 64 * kb; c.ldt = 2048; return c; } r -= n_br;
    if (r < n_o) { const int kb = r / 32, nb = r % 32;
        c.src = INP(F, 16) + (size_t)l * DM * DM + (size_t)(64 * kb) * DM + 32 * nb; c.ldw = DM; c.dst = ((GAS bf16*)(F.ws + WS_WO)) + (size_t)(32 * nb) * DM + 64 * kb; c.ldt = DM; return c; } r -= n_o;
    if (r < n_gu) { const int e = r / 512, q = r % 512, kb = q / 32, nb = q % 32, n0 = 32 * nb;
        const int drow = n0 < 512 ? (n0 / 128) * 256 + (n0 % 128) : ((n0 - 512) / 128) * 256 + 128 + ((n0 - 512) % 128);
        c.src = INP(F, 19) + ((size_t)l * NEXP + e) * DM * DM + (size_t)(64 * kb) * DM + n0; c.ldw = DM;
        c.dst = (GAS bf16*)(F.ws + ((l & 1) ? WS_WGU2 : WS_WGU)) + (size_t)e * DM * DM + (size_t)drow * DM + 64 * kb; c.ldt = DM; return c; } r -= n_gu;
    { const int e = r / 256, q = r % 256, kb = q / 32, nb = q % 32;
        c.src = INP(F, 20) + ((size_t)l * NEXP + e) * EFF * DM + (size_t)(64 * kb) * DM + 32 * nb; c.ldw = DM;
        c.dst = (GAS bf16*)(F.ws + ((l & 1) ? WS_WD2 : WS_WD)) + (size_t)e * DM * EFF + (size_t)(32 * nb) * EFF + 64 * kb; c.ldt = EFF; return c; }
}
__device__ __forceinline__ void convert_weights(Frame& F, int l, int parts, int rank, int nranks) {
    if (rank < 0) return;
    LAS float* scr = (LAS float*)(F.lds + RING_OFF + F.wave * 16384);
    const int gw = rank * NWAVES + F.wave, NGW = nranks * NWAVES;
    constexpr int I_IN = 16 * (INW / 32), I_BR = 4 * 8 * 32, I_O = 16 * 32, I_GU = 16 * 16 * 32, I_D = 16 * 8 * 32;
    const int n_in = (parts & CV_IN) ? I_IN : 0, n_br = (parts & CV_BR) ? I_BR : 0, n_o = (parts & CV_OUT) ? I_O : 0, n_gu = (parts & CV_GU) ? I_GU : 0, n_d = (parts & CV_DN) ? I_D : 0;
    const int nitems = n_in + n_br + n_o + n_gu + n_d;
    f32x4 t[8], tn[8];
    CvItem cur = cv_decode(F, l, gw, n_in, n_br, n_o, n_gu, nitems);
    if (cur.valid) cv_load(cur, t, F.lane);
    for (int it = gw; it < nitems; it += NGW) {
        const CvItem nxt = cv_decode(F, l, it + NGW, n_in, n_br, n_o, n_gu, nitems);
        if (nxt.valid) cv_load(nxt, tn, F.lane);
        if (cur.valid) cv_store(cur, t, scr, F.lane);
        cur = nxt;
#pragma unroll
        for (int i = 0; i < 8; ++i) t[i] = tn[i];
    }
    if (!(parts & CV_IN)) return;
    __syncthreads();
    LAS float* wt = (LAS float*)(F.lds + RING_OFF);
    LAS float* tab = (LAS float*)(F.lds + RING_OFF + 32768);
    if (F.tid < 128) { float s, c; sincospif((float)F.tid * (1.0f / 64.0f), &s, &c); tab[2 * F.tid] = c; tab[2 * F.tid + 1] = s; }
    for (int u = rank; u < 64; u += nranks) {
        const int kt = u >> 2, g = u & 3;
        __syncthreads();
#pragma unroll
        for (int i = 0; i < 16; ++i) { const int idx = i * 512 + F.tid, kk = idx >> 7, c = idx & 127; wt[idx] = INP(F, 8)[(size_t)l * DM * INW + (size_t)(kt * 64 + kk) * INW + 2304 + g * 128 + c]; }
        __syncthreads();
        const int kc = F.tid & 127, kq = F.tid >> 7;
        float aA[16], aB[16];
#pragma unroll
        for (int i = 0; i < 16; ++i) { aA[i] = 0.f; aB[i] = 0.f; }
        for (int c = 0; c < 128; ++c) { const int ti = (c * kc) & 127; const float cs = tab[2 * ti], sn = tab[2 * ti + 1];
#pragma unroll
            for (int i = 0; i < 16; ++i) { const float w = wt[(kq * 16 + i) * 128 + c]; aA[i] += w * cs; aB[i] += w * sn; } }
        GAS bf16* ra = ((GAS bf16*)(F.ws + WS_WIN)) + (size_t)(2304 + g * 128 + kc) * DM + kt * 64 + kq * 16; GAS bf16* rb = ra + (size_t)512 * DM;
        v4u o; o.x = pk2(aA[0], aA[1]); o.y = pk2(aA[2], aA[3]); o.z = pk2(aA[4], aA[5]); o.w = pk2(aA[6], aA[7]); *(GAS v4u*)ra = o;
        o.x = pk2(aA[8], aA[9]); o.y = pk2(aA[10], aA[11]); o.z = pk2(aA[12], aA[13]); o.w = pk2(aA[14], aA[15]); *(GAS v4u*)(ra + 8) = o;
        o.x = pk2(aB[0], aB[1]); o.y = pk2(aB[2], aB[3]); o.z = pk2(aB[4], aB[5]); o.w = pk2(aB[6], aB[7]); *(GAS v4u*)rb = o;
        o.x = pk2(aB[8], aB[9]); o.y = pk2(aB[10], aB[11]); o.z = pk2(aB[12], aB[13]); o.w = pk2(aB[14], aB[15]); *(GAS v4u*)(rb + 8) = o;
    }
    __syncthreads();
}
__device__ __forceinline__ void mod_vectors(Frame& F) {
    LAS float* sc = (LAS float*)(F.lds + RING_OFF);
    LAS float* part = (LAS float*)(F.lds + RING_OFF + 32768);
    if (F.vcu == 0) for (int i = F.tid; i < 1024; i += NTHR) { const float invf = exp2f(-(float)(i & 15) * (13.287712379549449f / 16.0f)); float sn, cs; sincosf((float)(i >> 4) * invf, &sn, &cs);
        ((GAS float*)(F.ws + WS_ROPE))[2 * i] = cs; ((GAS float*)(F.ws + WS_ROPE))[2 * i + 1] = sn; }
    for (int i = F.tid; i < 5 * DM; i += NTHR) { const float v = i < 4 * DM ? INP(F, 1)[i] : INP(F, 3)[i - 4 * DM]; sc[i] = v * sigm(v); }
    __syncthreads();
    for (int u = F.vcu; u < 2 * 96; u += F.G) {
        const int l = u / 96, j = (u % 96) * 64 + F.lane;
        const GAS float* wp = INP(F, 4) + (size_t)l * DM * 6144 + (size_t)(F.wave * 128) * 6144 + j;
        float a0 = 0.f, a1 = 0.f, a2 = 0.f, a3 = 0.f, a4 = 0.f;
#pragma unroll 8
        for (int kk = 0; kk < 128; ++kk) { const float w = wp[(size_t)kk * 6144]; const int k = F.wave * 128 + kk;
            a0 += sc[k] * w; a1 += sc[DM + k] * w; a2 += sc[2 * DM + k] * w; a3 += sc[3 * DM + k] * w; a4 += sc[4 * DM + k] * w; }
        part[(F.wave * 5 + 0) * 64 + F.lane] = a0; part[(F.wave * 5 + 1) * 64 + F.lane] = a1; part[(F.wave * 5 + 2) * 64 + F.lane] = a2; part[(F.wave * 5 + 3) * 64 + F.lane] = a3; part[(F.wave * 5 + 4) * 64 + F.lane] = a4;
        __syncthreads();
        if (F.tid < 320) { const int bp = F.tid >> 6, ln = F.tid & 63; float s = 0.f;
#pragma unroll
            for (int w = 0; w < 8; ++w) s += part[(w * 5 + bp) * 64 + ln];
            const int jj = (u % 96) * 64 + ln; ((GAS float*)(F.ws + WS_MODV))[((size_t)l * 5 + bp) * 6144 + jj] = s + INP(F, 5)[(size_t)l * 6144 + jj]; }
        __syncthreads();
    }
}
__device__ __forceinline__ void norm_mod(f32x4 (&v)[4], const GAS float* g, const GAS float* sc, const GAS float* sh, int lane) {
    float ss = 0.f;
#pragma unroll
    for (int j = 0; j < 4; ++j) ss += (v[j].x * v[j].x + v[j].y * v[j].y) + (v[j].z * v[j].z + v[j].w * v[j].w);
    const float rstd = 1.0f / sqrtf(wave_sum(ss, lane) * (1.0f / DM) + EPS);
#pragma unroll
    for (int j = 0; j < 4; ++j) { const int c = 4 * lane + 256 * j; const f32x4 gg = *(const f32x4*)(g + c), s1 = *(const f32x4*)(sc + c), s0 = *(const f32x4*)(sh + c);
        v[j] = v[j] * rstd * gg * (s1 + 1.0f) + s0; }
}
__device__ __forceinline__ void store_bf16_row(GAS bf16* orow, const f32x4 (&v)[4], int lane) {
#pragma unroll
    for (int j = 0; j < 4; ++j) { v2u w; w.x = pk2(v[j].x, v[j].y); w.y = pk2(v[j].z, v[j].w); *(GAS v2u*)(orow + 4 * lane + 256 * j) = w; }
}
__device__ __forceinline__ void load_row(f32x4 (&v)[4], const GAS float* xr, int lane) {
#pragma unroll
    for (int j = 0; j < 4; ++j) v[j] = *(const GAS f32x4*)(xr + 4 * lane + 256 * j);
}
__device__ __forceinline__ void phase_norm1_first(Frame& F) {
    const int gw = F.vcu * NWAVES + F.wave, NGW = F.G * NWAVES; const GAS float* mv = ((GAS float*)(F.ws + WS_MODV)); const GAS float* g1 = INP(F, 6);
    for (int row = gw; row < MROWS; row += 2 * NGW) { const int row2 = row + NGW; const bool has2 = row2 < MROWS;
        f32x4 v[4], v2[4]; load_row(v, xrow_in(F, row), F.lane); if (has2) load_row(v2, xrow_in(F, row2), F.lane);
        { const GAS float* m = mv + (size_t)modidx(row) * 6144; norm_mod(v, g1, m + 1024, m, F.lane); store_bf16_row(((GAS bf16*)(F.ws + WS_H)) + (size_t)row * DM, v, F.lane); }
        if (has2) { const GAS float* m = mv + (size_t)modidx(row2) * 6144; norm_mod(v2, g1, m + 1024, m, F.lane); store_bf16_row(((GAS bf16*)(F.ws + WS_H)) + (size_t)row2 * DM, v2, F.lane); } }
}
__device__ __forceinline__ void phase_qkrope(Frame& F, int l) {
    const int gw = F.vcu * NWAVES + F.wave, NGW = F.G * NWAVES; const int lane = F.lane, i = lane & 31;
    const GAS float* rope = (const GAS float*)(F.ws + WS_ROPE) + 2 * (i & 15);
    const float qg0 = INP(F, 9)[l * 64 + 2 * i], qg1 = INP(F, 9)[l * 64 + 2 * i + 1], kg0 = INP(F, 10)[l * 64 + 2 * i], kg1 = INP(F, 10)[l * 64 + 2 * i + 1];
    for (int row = gw; row < MROWS; row += NGW) {
        const int t = row % RPB; const bool lat = t < SEQ; GAS bf16* pr = ((GAS bf16*)(F.ws + WS_P)) + (size_t)row * PW;
        float cs = 1.f, sn = 0.f;
        if (lat) { const int pos = (i < 16) ? (t >> 6) : (t & 63); cs = rope[pos * 32]; sn = rope[pos * 32 + 1]; }
#pragma unroll
        for (int it = 0; it < 5; ++it) { const int hh = 2 * it + (lane >> 5); const int col = (hh < 8 ? hh * 64 : C_GK + (hh - 8) * 64) + 2 * i;
            const unsigned w = *(const GAS unsigned*)(pr + col); float x1 = bf_lo(w), x2 = bf_hi(w);
            float ss = x1 * x1 + x2 * x2;
            ss += shx(ss, 1, lane); ss += shx(ss, 2, lane); ss += shx(ss, 4, lane); ss += shx(ss, 8, lane); ss += shx(ss, 16, lane);
            const float rstd = __builtin_amdgcn_rsqf(ss * (1.0f / 64.0f) + EPS);
            x1 = x1 * rstd * (hh < 8 ? qg0 : kg0); x2 = x2 * rstd * (hh < 8 ? qg1 : kg1);
            float y1 = x1 * cs - x2 * sn, y2 = x1 * sn + x2 * cs;
            if (hh < 8) { y1 *= QSCALE; y2 *= QSCALE; }
            *(GAS unsigned*)(pr + col) = pk2(y1, y2); }
        { const v4u w = *(const GAS v4u*)(pr + C_NQ + 8 * lane); v4u o;
          o.x = pk2(bf_lo(w.x) * QSCALE, bf_hi(w.x) * QSCALE); o.y = pk2(bf_lo(w.y) * QSCALE, bf_hi(w.y) * QSCALE); o.z = pk2(bf_lo(w.z) * QSCALE, bf_hi(w.z) * QSCALE); o.w = pk2(bf_lo(w.w) * QSCALE, bf_hi(w.w) * QSCALE);
          *(GAS v4u*)(pr + C_NQ + 8 * lane) = o; }
    }
}
__device__ __forceinline__ void phase_conv(Frame& F, int l) {
    LAS float* zl = (LAS float*)(F.lds + RING_OFF);
    LAS float* red = (LAS float*)(F.lds + RING_OFF + 62 * 512 * 4);
    const int ch = F.tid; const int nchunk = (l == 0) ? 136 : 128;
    float w[31];
#pragma unroll
    for (int j = 0; j < 31; ++j) w[j] = INP(F, 12)[((size_t)l * 31 + j) * 512 + ch];
    const float cb = INP(F, 13)[l * 512 + ch], cg = INP(F, 14)[l * 512 + ch];
    const GAS bf16* P = ((GAS bf16*)(F.ws + WS_P)); GAS bf16* Y = ((GAS bf16*)(F.ws + WS_Y));
    for (int u = F.vcu; u < NBATCH * nchunk; u += F.G) {
        const int b = u / nchunk, c = u % nchunk; const bool lat = c < 128;
        const int seq0 = b * RPB + (lat ? 0 : SEQ), slen = lat ? SEQ : CTXL, t0 = 32 * (lat ? c : c - 128);
        __syncthreads();
#pragma unroll
        for (int it = 0; it < 8; ++it) { const int item = it * 512 + F.tid;
            if (item < 62 * 64) { const int i = item >> 6, cgp = item & 63; const int t = t0 - 15 + i; f32x4 z0 = {0.f, 0.f, 0.f, 0.f}, z1 = {0.f, 0.f, 0.f, 0.f};
                if (t >= 0 && t < slen) { const GAS bf16* pr = P + (size_t)(seq0 + t) * PW; const v4u a = *(const GAS v4u*)(pr + C_CA + 8 * cgp), g = *(const GAS v4u*)(pr + C_CB + 8 * cgp);
                    z0.x = bf_lo(a.x) * sigm(bf_lo(g.x)); z0.y = bf_hi(a.x) * sigm(bf_hi(g.x)); z0.z = bf_lo(a.y) * sigm(bf_lo(g.y)); z0.w = bf_hi(a.y) * sigm(bf_hi(g.y));
                    z1.x = bf_lo(a.z) * sigm(bf_lo(g.z)); z1.y = bf_hi(a.z) * sigm(bf_hi(g.z)); z1.z = bf_lo(a.w) * sigm(bf_lo(g.w)); z1.w = bf_hi(a.w) * sigm(bf_hi(g.w)); }
                *(LAS f32x4*)(zl + i * 512 + 8 * cgp) = z0; *(LAS f32x4*)(zl + i * 512 + 8 * cgp + 4) = z1; } }
        __syncthreads();
        float z[62];
#pragma unroll
        for (int i = 0; i < 62; ++i) z[i] = zl[i * 512 + ch];
        float o[32];
#pragma unroll
        for (int q = 0; q < 32; ++q) { float s = cb;
#pragma unroll
            for (int j = 0; j < 31; ++j) s += z[q + j] * w[j];
            o[q] = s; }
#pragma unroll
        for (int q = 0; q < 32; ++q) { const float s = wave_sum(o[q] * o[q], F.lane); if (F.lane == 0) red[F.wave * 32 + q] = s; }
        __syncthreads();
#pragma unroll
        for (int q = 0; q < 32; ++q) { float s = 0.f;
#pragma unroll
            for (int wv = 0; wv < 8; ++wv) s += red[wv * 32 + q];
            const float y = o[q] * (1.0f / sqrtf(s * (1.0f / 512.0f) + EPS)) * cg;
            Y[(size_t)(seq0 + t0 + q) * YW + 1536 + ch] = (bf16)f2bf(y * sigm(y)); }
    }
    __syncthreads();
}
typedef short fbf16x8 __attribute__((ext_vector_type(8)));
typedef short fs16x4 __attribute__((ext_vector_type(4)));
typedef float ff32x16 __attribute__((ext_vector_type(16)));
typedef __attribute__((address_space(3))) const char* flds_cptr;
__device__ __forceinline__ fs16x4 f_vtr(flds_cptr p) { return __builtin_bit_cast(fs16x4, __builtin_amdgcn_ds_read_tr16_b64_v4i16((__attribute__((address_space(3))) attn_body::v4i16_t*)p)); }
__device__ __forceinline__ void fourier_frags(Frame& F, fbf16x8 (&fr)[4][4]) {
    LAS float* tab = (LAS float*)(F.lds + RING_OFF);
    __syncthreads();
    if (F.tid < 64) { float s, c; sincospif((float)F.tid * (1.0f / 32.0f), &s, &c); tab[2 * F.tid] = c; tab[2 * F.tid + 1] = s; }
    __syncthreads();
    const int m = F.lane & 31, hi = F.lane >> 5;
#pragma unroll
    for (int mt = 0; mt < 4; ++mt)
#pragma unroll
        for (int g = 0; g < 4; ++g) { unsigned wv[4];
#pragma unroll
            for (int jp = 0; jp < 4; ++jp) { float v[2];
#pragma unroll
                for (int q = 0; q < 2; ++q) { const int j = 2 * jp + q; const int n = 16 * g + (j & 3) + 8 * (j >> 2) + 4 * hi; const int k = 32 * (mt & 1) + m; const int ix = (k * n) & 63; v[q] = tab[2 * ix + (mt >> 1)]; }
                wv[jp] = pk2(v[0], v[1]); }
            v4u t; t.x = wv[0]; t.y = wv[1]; t.z = wv[2]; t.w = wv[3]; fr[mt][g] = __builtin_bit_cast(fbf16x8, t); __builtin_amdgcn_sched_barrier(0); }
    __syncthreads();
}
#define F_BFRAG(dst, vp, dh) do { _Pragma("unroll") for (int g_ = 0; g_ < 4; ++g_) { const fs16x4 lo_ = f_vtr((vp) + (dh) * 4096 + g_ * 1024), hi_ = f_vtr((vp) + (dh) * 4096 + g_ * 1024 + 512); \
        dst[g_] = (fbf16x8){lo_[0], lo_[1], lo_[2], lo_[3], hi_[0], hi_[1], hi_[2], hi_[3]}; } } while (0)
__device__ __forceinline__ void glds16_so(const GAS void* sbase, unsigned voff, unsigned lds_dst) { unsigned keep;
    asm volatile("s_mov_b32 %0, m0\n\ts_mov_b32 m0, %3\n\ts_nop 0\n\tglobal_load_lds_dwordx4 %1, %2\n\ts_mov_b32 m0, %0" : "=&s"(keep) : "v"(voff), "s"(sbase), "s"(lds_dst) : "memory"); }
__device__ __forceinline__ fbf16x8 f_neg(fbf16x8 v) { v4u t = __builtin_bit_cast(v4u, v); t.x ^= 0x80008000u; t.y ^= 0x80008000u; t.z ^= 0x80008000u; t.w ^= 0x80008000u; return __builtin_bit_cast(fbf16x8, t); }
__device__ __forceinline__ void phase_fourier1(Frame& F) {
    fbf16x8 fr[4][4]; fourier_frags(F, fr);
    const int lane = F.lane, w = F.wave, r32 = lane & 31, hi = lane >> 5;
    const unsigned lds0 = (unsigned)(uintptr_t)(F.lds + RING_OFF);
    const flds_cptr vbase = (flds_cptr)(F.lds + RING_OFF) + ((lane >> 4) & 1) * 32 + (lane & 3) * 8 + (4 * hi + ((lane & 15) >> 2)) * 64;
    const GAS bf16* P = ((GAS bf16*)(F.ws + WS_P)); GAS bf16* TPb = (GAS bf16*)(F.ws + WS_TP);
    const unsigned voff0 = (unsigned)((64 * (lane >> 2)) * PW + (lane & 3) * 8) * 2u;
    for (int u = F.vcu; u < NBATCH * 64; u += F.G) {
        const int b = u >> 6, n2 = u & 63;
        const GAS bf16* base = P + (size_t)(b * RPB + n2) * PW + C_F + 64 * w;
        asm volatile("s_waitcnt lgkmcnt(0)" ::: "memory");
#pragma unroll
        for (int rg = 0; rg < 4; ++rg) { const unsigned vo = voff0 + (unsigned)rg * (unsigned)(64 * 16 * PW * 2);
            const unsigned dA = (unsigned)__builtin_amdgcn_readfirstlane(lds0 + w * 8192 + rg * 1024), dB = dA + 8 * 8192;
            glds16_so(base, vo, dA); glds16_so(base + 32, vo, dA + 4096); glds16_so(base + 512, vo, dB); glds16_so(base + 544, vo, dB + 4096); }
        asm volatile("s_waitcnt vmcnt(0)" ::: "memory");
#pragma unroll 1
        for (int dh = 0; dh < 2; ++dh) {
            fbf16x8 bA[4], nA[4], nB[4];
            F_BFRAG(bA, vbase + w * 8192, dh); F_BFRAG(nB, vbase + (8 + w) * 8192, dh);
#pragma unroll
            for (int g = 0; g < 4; ++g) { nA[g] = f_neg(bA[g]); nB[g] = f_neg(nB[g]); }
#pragma unroll
            for (int kb = 0; kb < 2; ++kb) {
                ff32x16 tr = {}, ti = {};
#pragma unroll
                for (int g = 0; g < 4; ++g) { tr = __builtin_amdgcn_mfma_f32_32x32x16_bf16(fr[kb][g], bA[g], tr, 0, 0, 0); ti = __builtin_amdgcn_mfma_f32_32x32x16_bf16(fr[kb][g], nB[g], ti, 0, 0, 0);
                    tr = __builtin_amdgcn_mfma_f32_32x32x16_bf16(fr[2 + kb][g], nB[g], tr, 0, 0, 0); ti = __builtin_amdgcn_mfma_f32_32x32x16_bf16(fr[2 + kb][g], nA[g], ti, 0, 0, 0); }
                const unsigned o0 = (unsigned)(((b * 64 + 32 * kb + 4 * hi) * 2) * 64 + n2) * 512u + 64 * w + 32 * dh + r32;
#pragma unroll
                for (int r = 0; r < 16; ++r) { const int kk = (r & 3) + 8 * (r >> 2); const int k1 = 32 * kb + kk + 4 * hi;
                    const float rev = (float)(n2 * k1) * (1.0f / 4096.0f); const float c = __builtin_amdgcn_cosf(rev), s = __builtin_amdgcn_sinf(rev);
                    const unsigned oi = o0 + (unsigned)kk * (2u * 64u * 512u);
                    TPb[oi] = (bf16)f2bf(tr[r] * c + ti[r] * s); TPb[oi + 64u * 512u] = (bf16)f2bf(ti[r] * c - tr[r] * s);
                    if ((r & 3) == 3) __builtin_amdgcn_sched_barrier(0); }
                __builtin_amdgcn_sched_barrier(0);
            }
        }
    }
}
__device__ __forceinline__ void phase_fourier2(Frame& F) {
    fbf16x8 fr[4][4]; fourier_frags(F, fr);
    const int lane = F.lane, w = F.wave, r32 = lane & 31, hi = lane >> 5;
    const unsigned lds0 = (unsigned)(uintptr_t)(F.lds + RING_OFF);
    const flds_cptr vbase = (flds_cptr)(F.lds + RING_OFF) + ((lane >> 4) & 1) * 32 + (lane & 3) * 8 + (4 * hi + ((lane & 15) >> 2)) * 64;
    const GAS bf16* TPb = (const GAS bf16*)(F.ws + WS_TP); GAS bf16* Y = ((GAS bf16*)(F.ws + WS_Y));
    const float scale = 1.0f / sqrtf(4096.0f * 128.0f);
    const unsigned voff0 = (unsigned)((lane >> 2) * 512 + (lane & 3) * 8) * 2u;
    for (int u = F.vcu; u < NBATCH * 64; u += F.G) {
        const int b = u >> 6, k1 = u & 63;
        const GAS bf16* base0 = TPb + (size_t)((b * 64 + k1) * 2) * 64 * 512 + 64 * w; const GAS bf16* base1 = base0 + 64 * 512;
        asm volatile("s_waitcnt lgkmcnt(0)" ::: "memory");
#pragma unroll
        for (int rg = 0; rg < 4; ++rg) { const unsigned vo = voff0 + (unsigned)rg * (unsigned)(16 * 512 * 2);
            const unsigned d0 = (unsigned)__builtin_amdgcn_readfirstlane(lds0 + w * 8192 + rg * 1024), d1 = d0 + 8 * 8192;
            glds16_so(base0, vo, d0); glds16_so(base0 + 32, vo, d0 + 4096); glds16_so(base1, vo, d1); glds16_so(base1 + 32, vo, d1 + 4096); }
        asm volatile("s_waitcnt vmcnt(0)" ::: "memory");
#pragma unroll
        for (int dh = 0; dh < 2; ++dh) {
            fbf16x8 b0[4], b1[4];
            F_BFRAG(b0, vbase + w * 8192, dh); F_BFRAG(b1, vbase + (8 + w) * 8192, dh);
#pragma unroll
            for (int mt = 0; mt < 2; ++mt) {
                ff32x16 acc = {};
#pragma unroll
                for (int g = 0; g < 4; ++g) { acc = __builtin_amdgcn_mfma_f32_32x32x16_bf16(fr[mt][g], b0[g], acc, 0, 0, 0); acc = __builtin_amdgcn_mfma_f32_32x32x16_bf16(fr[2 + mt][g], b1[g], acc, 0, 0, 0); }
                const unsigned y0 = (unsigned)(b * RPB + k1 + 64 * (32 * mt + 4 * hi)) * (unsigned)YW + 1024u + 64 * w + 32 * dh + r32;
#pragma unroll
                for (int r = 0; r < 16; ++r) { const int kk = (r & 3) + 8 * (r >> 2);
                    Y[y0 + (unsigned)kk * (64u * (unsigned)YW)] = (bf16)f2bf(acc[r] * scale); }
                __builtin_amdgcn_sched_barrier(0);
            }
        }
    }
}
typedef float fc_f32x2 __attribute__((ext_vector_type(2)));
__device__ __forceinline__ void phase_fourier_ctx(Frame& F) {
    LAS float* tab = (LAS float*)(F.lds + RING_OFF + 8192);
    __syncthreads();
    if (F.tid < 256) { float s, c; sincospif((float)F.tid * (1.0f / 128.0f), &s, &c); tab[2 * F.tid] = c; tab[2 * F.tid + 1] = s; }
    __syncthreads();
    const float scale = 1.0f / sqrtf(256.0f * 128.0f);
#define FC_LOAD(A_, B_, n0_) do { _Pragma("unroll") for (int i_ = 0; i_ < 16; ++i_) { A_[i_] = pcol[(size_t)((n0_) + i_) * PW]; B_[i_] = pcol[(size_t)((n0_) + i_) * PW + 512]; } } while (0)
#define FC_COMP(A_, B_, n0_) do { _Pragma("unroll") for (int i_ = 0; i_ < 16; ++i_) { const float a_ = bf1(A_[i_]), b_ = bf1(B_[i_]); _Pragma("unroll") for (int k_ = 0; k_ < 4; ++k_) { \
        const int ix_ = (((n0_) + i_) * (kb + k_)) & 255; const fc_f32x2 cs_ = *(const LAS fc_f32x2*)(tab + 2 * ix_); acc[k_] += a_ * cs_.x - b_ * cs_.y; } } } while (0)
    for (int u = F.vcu; u < NBATCH * 64; u += F.G) {
        const int b = u >> 6, kb = (u & 63) * 4;
        float acc[4] = {0.f, 0.f, 0.f, 0.f};
        const GAS bf16* pcol = ((GAS bf16*)(F.ws + WS_P)) + (size_t)(b * RPB + SEQ) * PW + C_F + F.tid;
        bf16 A0[16], B0[16], A1[16], B1[16];
        FC_LOAD(A0, B0, 0);
        for (int n0 = 0; n0 < 256; n0 += 32) {
            FC_LOAD(A1, B1, n0 + 16);
            FC_COMP(A0, B0, n0);
            if (n0 + 32 < 256) FC_LOAD(A0, B0, n0 + 32);
            FC_COMP(A1, B1, n0 + 16);
        }
        GAS bf16* yo = ((GAS bf16*)(F.ws + WS_Y)) + (size_t)(b * RPB + SEQ + kb) * YW + 1024 + F.tid;
#pragma unroll
        for (int k = 0; k < 4; ++k) yo[(size_t)k * YW] = (bf16)f2bf(acc[k] * scale);
    }
#undef FC_LOAD
#undef FC_COMP
}
#ifndef PROBE
#define PROBE 0
#endif
#define GSTAMP(i) do { if (PROBE && l == 0 && blockIdx.x == 0 && threadIdx.x == 0) ((GAS unsigned long long*)(F.ws + WS_CTL + 512 * 1024))[i] = __builtin_amdgcn_s_memrealtime(); } while (0)
struct GVecs { int cmi; f32x4 G1[4], GS[4], SH[4]; };
struct GRow { f32x4 v[4]; v2u y[4]; };
__device__ __forceinline__ void g_load(Frame& F, int l, int row, GRow& R) {
    load_row(R.v, (l == 0) ? xrow_in(F, row) : (const GAS float*)xrow_ws(F, row), F.lane);
#pragma unroll
    for (int j = 0; j < 4; ++j) R.y[j] = *(const GAS v2u*)(((const GAS bf16*)(F.ws + WS_Y)) + (size_t)row * DM + 4 * F.lane + 256 * j);
}
__device__ __forceinline__ void g_front(Frame& F, int l, int row, GRow& R, GVecs& V) {
    const int mi = modidx(row);
    if (mi != V.cmi) { V.cmi = mi; const GAS float* m = ((GAS float*)(F.ws + WS_MODV)) + (size_t)l * 5 * 6144 + (size_t)mi * 6144; const GAS float* g2 = INP(F, 7) + l * DM;
#pragma unroll
        for (int j = 0; j < 4; ++j) { const int c = 4 * F.lane + 256 * j; V.G1[j] = *(const GAS f32x4*)(m + 2 * 1024 + c); V.SH[j] = *(const GAS f32x4*)(m + 3 * 1024 + c);
            V.GS[j] = *(const GAS f32x4*)(g2 + c) * (*(const GAS f32x4*)(m + 4 * 1024 + c) + 1.0f); } }
    float ss = 0.f;
#pragma unroll
    for (int j = 0; j < 4; ++j) { f32x4 y; y.x = bf_lo(R.y[j].x); y.y = bf_hi(R.y[j].x); y.z = bf_lo(R.y[j].y); y.w = bf_hi(R.y[j].y); R.v[j] = R.v[j] + V.G1[j] * y;
        ss += (R.v[j].x * R.v[j].x + R.v[j].y * R.v[j].y) + (R.v[j].z * R.v[j].z + R.v[j].w * R.v[j].w); }
    { GAS float* xo = xrow_ws(F, row);
#pragma unroll
      for (int j = 0; j < 4; ++j) *(GAS f32x4*)(xo + 4 * F.lane + 256 * j) = R.v[j]; }
    const float rstd = 1.0f / sqrtf(wave_sum(ss, F.lane) * (1.0f / DM) + EPS);
#pragma unroll
    for (int j = 0; j < 4; ++j) R.v[j] = R.v[j] * rstd * V.GS[j] + V.SH[j];
    store_bf16_row(((GAS bf16*)(F.ws + WS_H)) + (size_t)row * DM, R.v, F.lane);
}
__device__ __forceinline__ float g_reduce16(const float (&lg)[16], int lane) {
    float r8[8], r4[4], r2[2], r1;
    { const bool up = (lane & 32) != 0;
#pragma unroll
      for (int q = 0; q < 8; ++q) { const float snd = up ? lg[q] : lg[8 + q], kp = up ? lg[8 + q] : lg[q]; r8[q] = kp + shx(snd, 32, lane); } }
    { const bool up = (lane & 16) != 0;
#pragma unroll
      for (int q = 0; q < 4; ++q) { const float snd = up ? r8[q] : r8[4 + q], kp = up ? r8[4 + q] : r8[q]; r4[q] = kp + shx(snd, 16, lane); } }
    { const bool up = (lane & 8) != 0;
#pragma unroll
      for (int q = 0; q < 2; ++q) { const float snd = up ? r4[q] : r4[2 + q], kp = up ? r4[2 + q] : r4[q]; r2[q] = kp + shx(snd, 8, lane); } }
    { const bool up = (lane & 4) != 0; const float snd = up ? r2[0] : r2[1], kp = up ? r2[1] : r2[0]; r1 = kp + shx(snd, 4, lane); }
    r1 += shx(r1, 1, lane); r1 += shx(r1, 2, lane);
    return r1;
}
typedef float g_f32x2 __attribute__((ext_vector_type(2)));
__device__ __forceinline__ void g_select(const float (&lgt)[16], const float (&rb)[16], int& bi1, int& bi2, float& w1, float& w2) {
    float sc[16], sl[16];
#pragma unroll
    for (int e = 0; e < 16; ++e) { sc[e] = __builtin_amdgcn_rcpf(1.0f + __builtin_amdgcn_exp2f(-LOG2E * lgt[e])); sl[e] = sc[e] + rb[e]; }
    float best = -INFINITY; bi1 = 0; bi2 = 1; float bs1 = 0.f, bs2 = 0.f;
#pragma unroll
    for (int g = 0; g < 4; ++g) {
        int i1 = 4 * g; float m1 = sl[4 * g];
#pragma unroll
        for (int q = 1; q < 4; ++q) if (sl[4 * g + q] > m1) { m1 = sl[4 * g + q]; i1 = 4 * g + q; }
        int i2 = -1; float m2 = -INFINITY;
#pragma unroll
        for (int q = 0; q < 4; ++q) if (4 * g + q != i1 && sl[4 * g + q] > m2) { m2 = sl[4 * g + q]; i2 = 4 * g + q; }
        float s1 = 0.f, s2 = 0.f;
#pragma unroll
        for (int q = 0; q < 4; ++q) { if (4 * g + q == i1) s1 = sc[4 * g + q]; if (4 * g + q == i2) s2 = sc[4 * g + q]; }
        const float gs = m1 + m2;
        if (gs > best) { best = gs; bi1 = i1; bi2 = i2; bs1 = s1; bs2 = s2; }
    }
    const float inv = 1.0f / (bs1 + bs2); w1 = bs1 * inv; w2 = bs2 * inv;
}
__device__ __forceinline__ void phase_norm2_router(Frame& F, int l) {
    LAS float* wr = (LAS float*)(F.lds + RING_OFF);
    LAS int* sel = (LAS int*)(F.lds + RING_OFF + 65536);
    LAS unsigned* basel = (LAS unsigned*)(F.lds + RING_OFF + 65536 + 16384);
    LAS float* lgl = (LAS float*)(F.lds + RING_OFF + 65536 + 32768);
    const int nact = (l == 0) ? MROWS : NBATCH * SEQ; const int chunk = (nact + F.G - 1) / F.G; const int a0 = F.vcu * chunk, a1 = (a0 + chunk < nact) ? a0 + chunk : nact;
    __syncthreads();
    for (int i = F.tid; i < DM * 16 / 4; i += NTHR) { const f32x4 t = ((const GAS f32x4*)INP(F, 17))[i]; const int c = i >> 2, e0 = (i & 3) * 4;
        wr[(e0 + 0) * DM + c] = t.x; wr[(e0 + 1) * DM + c] = t.y; wr[(e0 + 2) * DM + c] = t.z; wr[(e0 + 3) * DM + c] = t.w; }
    __syncthreads();
    GSTAMP(31);
    GVecs V; V.cmi = -1;
#define G_ROW(a_) ((l == 0) ? (a_) : ((a_) / SEQ) * RPB + ((a_) % SEQ))
    for (int a = a0 + F.wave; a < a1; a += 2 * NWAVES) {
        const int ab = a + NWAVES; const bool has2 = ab < a1;
        const int row = G_ROW(a), row2 = has2 ? G_ROW(ab) : row;
        GRow R0, R1; g_load(F, l, row, R0); if (has2) g_load(F, l, row2, R1); else R1 = R0;
        g_front(F, l, row, R0, V); if (has2) g_front(F, l, row2, R1, V);
        float lg0[16], lg1[16];
#pragma unroll
        for (int e = 0; e < 16; ++e) { g_f32x2 p0 = {0.f, 0.f}, p1 = {0.f, 0.f};
#pragma unroll
            for (int j = 0; j < 4; ++j) { const f32x4 ww = *(const LAS f32x4*)(wr + e * DM + 4 * F.lane + 256 * j); const g_f32x2 wl = {ww.x, ww.y}, wh = {ww.z, ww.w};
                p0 += (g_f32x2){R0.v[j].x, R0.v[j].y} * wl; p0 += (g_f32x2){R0.v[j].z, R0.v[j].w} * wh;
                p1 += (g_f32x2){R1.v[j].x, R1.v[j].y} * wl; p1 += (g_f32x2){R1.v[j].z, R1.v[j].w} * wh; }
            lg0[e] = p0.x + p0.y; lg1[e] = p1.x + p1.y; }
        const float q0 = g_reduce16(lg0, F.lane), q1 = g_reduce16(lg1, F.lane);
        if ((F.lane & 3) == 0) { lgl[(a - a0) * 16 + (F.lane >> 2)] = q0; if (has2) lgl[(ab - a0) * 16 + (F.lane >> 2)] = q1; }
    }
    __syncthreads(); GSTAMP(32);
    const int nr = a1 - a0, ns = 2 * nr;
    { float rb[16];
#pragma unroll
      for (int e = 0; e < 16; ++e) rb[e] = INP(F, 18)[e];
      for (int i = F.tid; i < nr; i += NTHR) { float lgt[16];
#pragma unroll
        for (int e4 = 0; e4 < 4; ++e4) { const f32x4 t = *(const LAS f32x4*)(lgl + i * 16 + 4 * e4); lgt[4 * e4] = t.x; lgt[4 * e4 + 1] = t.y; lgt[4 * e4 + 2] = t.z; lgt[4 * e4 + 3] = t.w; }
        int b1, b2; float w1, w2; g_select(lgt, rb, b1, b2, w1, w2); const int row = G_ROW(a0 + i);
        ((GAS int*)(F.ws + WS_TOKE))[2 * row] = b1; ((GAS int*)(F.ws + WS_TOKE))[2 * row + 1] = b2; ((GAS float*)(F.ws + WS_TOKW))[2 * row] = w1; ((GAS float*)(F.ws + WS_TOKW))[2 * row + 1] = w2;
        sel[2 * i] = b1; sel[2 * i + 1] = b2; } }
    __syncthreads();
    if (F.tid < 16) { const int e = F.tid; int n = 0;
        for (int i = 0; i < ns; ++i) n += (sel[i] == e) ? 1 : 0;
        unsigned base = 0u; if (n > 0) base = __hip_atomic_fetch_add((unsigned*)(F.ctl + CW_CNT + (l * 16 + e) * 64), (unsigned)n, RLX_AGENT);
        basel[e] = base; }
    __syncthreads();
    for (int i = F.tid; i < ns; i += NTHR) { const int e = sel[i]; int rank = 0;
        for (int j = 0; j < i; ++j) rank += (sel[j] == e) ? 1 : 0;
        const int a = a0 + (i >> 1); ((GAS int*)(F.ws + WS_TOKR))[2 * G_ROW(a) + (i & 1)] = (int)basel[e] + rank; }
#undef G_ROW
    __syncthreads();
}
__device__ __forceinline__ void moe_offsets(Frame& F, int l) {
    __syncthreads();
    if (F.tid == 0) { unsigned off = 0u;
        for (int e = 0; e < 16; ++e) { F.LCTL[e] = off; const unsigned c = __hip_atomic_load((unsigned*)(F.ctl + CW_CNT + (l * 16 + e) * 64), RLX_AGENT); off += (c + 255u) & ~255u; }
        F.LCTL[16] = off; F.LCTL[17] = off >> 8; }
    __syncthreads();
}
__device__ __forceinline__ void phase_scatter(Frame& F, int l) {
    moe_offsets(F, l);
    const int nact = (l == 0) ? MROWS : NBATCH * SEQ; const int chunk = (nact + F.G - 1) / F.G; const int a0 = F.vcu * chunk, a1 = (a0 + chunk < nact) ? a0 + chunk : nact;
    for (int a = a0 + F.wave; a < a1; a += NWAVES) {
        const int row = (l == 0) ? a : (a / SEQ) * RPB + (a % SEQ);
        const int e1 = ((GAS int*)(F.ws + WS_TOKE))[2 * row], e2 = ((GAS int*)(F.ws + WS_TOKE))[2 * row + 1];
        const int s1 = (int)F.LCTL[e1] + ((GAS int*)(F.ws + WS_TOKR))[2 * row], s2 = (int)F.LCTL[e2] + ((GAS int*)(F.ws + WS_TOKR))[2 * row + 1];
        if (F.lane == 0) { ((GAS int*)(F.ws + WS_TOKS))[2 * row] = s1; ((GAS int*)(F.ws + WS_TOKS))[2 * row + 1] = s2; }
        const GAS v4u* src = (const GAS v4u*)(((GAS bf16*)(F.ws + WS_H)) + (size_t)row * DM) + F.lane; const v4u x0 = src[0], x1 = src[64];
        GAS v4u* d1 = (GAS v4u*)(((GAS bf16*)(F.ws + WS_AM)) + (size_t)s1 * DM) + F.lane; GAS v4u* d2 = (GAS v4u*)(((GAS bf16*)(F.ws + WS_AM)) + (size_t)s2 * DM) + F.lane;
        d1[0] = x0; d1[64] = x1; d2[0] = x0; d2[64] = x1;
    }
}
struct CombRow { f32x4 v[4]; v2u p[4], q[4]; float w1, w2; };
__device__ __forceinline__ void comb_load(Frame& F, int row, CombRow& R, GAS float* xr) {
    load_row(R.v, xr, F.lane);
    const int s1 = ((GAS int*)(F.ws + WS_TOKS))[2 * row], s2 = ((GAS int*)(F.ws + WS_TOKS))[2 * row + 1]; R.w1 = ((GAS float*)(F.ws + WS_TOKW))[2 * row]; R.w2 = ((GAS float*)(F.ws + WS_TOKW))[2 * row + 1];
    const GAS bf16* o1 = ((GAS bf16*)(F.ws + WS_OM)) + (size_t)s1 * DM; const GAS bf16* o2 = ((GAS bf16*)(F.ws + WS_OM)) + (size_t)s2 * DM;
#pragma unroll
    for (int j = 0; j < 4; ++j) { const int c = 4 * F.lane + 256 * j; R.p[j] = *(const GAS v2u*)(o1 + c); R.q[j] = *(const GAS v2u*)(o2 + c); }
}
__device__ __forceinline__ void comb_finish(Frame& F, int l, int row, CombRow& R, GAS float* xr) {
    const GAS float* g2 = ((GAS float*)(F.ws + WS_MODV)) + (size_t)l * 5 * 6144 + (size_t)modidx(row) * 6144 + 5 * 1024;
#pragma unroll
    for (int j = 0; j < 4; ++j) { const int c = 4 * F.lane + 256 * j; const v2u p = R.p[j], q = R.q[j]; const f32x4 gg = *(const GAS f32x4*)(g2 + c); const float w1 = R.w1, w2 = R.w2;
        f32x4 z; z.x = w1 * bf_lo(p.x) + w2 * bf_lo(q.x); z.y = w1 * bf_hi(p.x) + w2 * bf_hi(q.x); z.z = w1 * bf_lo(p.y) + w2 * bf_lo(q.y); z.w = w1 * bf_hi(p.y) + w2 * bf_hi(q.y);
        R.v[j] = R.v[j] + gg * z; }
    if (l == 0) {
#pragma unroll
        for (int j = 0; j < 4; ++j) *(GAS f32x4*)(xr + 4 * F.lane + 256 * j) = R.v[j];
        const GAS float* m1 = ((GAS float*)(F.ws + WS_MODV)) + (size_t)5 * 6144 + (size_t)modidx(row) * 6144;
        norm_mod(R.v, INP(F, 6) + DM, m1 + 1024, m1, F.lane); store_bf16_row(((GAS bf16*)(F.ws + WS_H)) + (size_t)row * DM, R.v, F.lane);
    } else {
        float ss = 0.f;
#pragma unroll
        for (int j = 0; j < 4; ++j) ss += (R.v[j].x * R.v[j].x + R.v[j].y * R.v[j].y) + (R.v[j].z * R.v[j].z + R.v[j].w * R.v[j].w);
        const float rstd = 1.0f / sqrtf(wave_sum(ss, F.lane) * (1.0f / DM) + EPS);
#pragma unroll
        for (int j = 0; j < 4; ++j) { const int c = 4 * F.lane + 256 * j; *(GAS f32x4*)(xr + c) = R.v[j] * rstd * *(const GAS f32x4*)(INP(F, 21) + c); }
    }
}
__device__ __forceinline__ void phase_combine(Frame& F, int l) {
    const int gw = F.vcu * NWAVES + F.wave, NGW = F.G * NWAVES;
    const int nact = (l == 0) ? MROWS : NBATCH * SEQ;
    for (int a = gw; a < nact; a += 2 * NGW) { const int a2 = a + NGW; const bool has2 = a2 < nact;
        const int row = (l == 0) ? a : (a / SEQ) * RPB + (a % SEQ); const int row2 = has2 ? ((l == 0) ? a2 : (a2 / SEQ) * RPB + (a2 % SEQ)) : row;
        GAS float* xr = xrow_ws(F, row); GAS float* xr2 = xrow_ws(F, row2);
        CombRow R1, R2; comb_load(F, row, R1, xr); if (has2) comb_load(F, row2, R2, xr2);
        comb_finish(F, l, row, R1, xr); if (has2) comb_finish(F, l, row2, R2, xr2); }
}
struct SchedIn {
    int G, c;
    __device__ __forceinline__ bool next(int i, pg8::Unit& u) const { const long L = (long)i * G + c; if (L >= 68 * 33) return false; int pm, pn; pg8::tile_map((int)L, 68, 33, pm, pn);
        u.pm = pm; u.pn = pn; u.aux = 0; u.aoff = (size_t)pm * 256 * DM * 2; u.boff = (size_t)pn * 256 * DM * 2; return true; }
};
struct SchedBr {
    int G, c, nMt; bool skipctx;
    __device__ __forceinline__ bool next(int i, pg8::Unit& u) const { const long L = (long)(i >> 2) * G + c; if (L >= nMt * 4) return false; int pm, pn; pg8::tile_map((int)L, nMt, 4, pm, pn);
        if (skipctx) pm = (pm / 16) * 17 + (pm % 16);
        const int n = i & 3; u.pm = pm; u.pn = pn; u.aux = n; u.aoff = ((size_t)pm * 256 * YW + n * 512) * 2; u.boff = ((size_t)pn * 256 * 2048 + n * 512) * 2; return true; }
};
struct SchedOut {
    int G, c, nMt; bool skipctx;
    __device__ __forceinline__ bool next(int i, pg8::Unit& u) const { const long L = (long)i * G + c; if (L >= nMt * 4) return false; int pm, pn; pg8::tile_map((int)L, nMt, 4, pm, pn);
        if (skipctx) pm = (pm / 16) * 17 + (pm % 16);
        u.pm = pm; u.pn = pn; u.aux = 0; u.aoff = (size_t)pm * 256 * DM * 2; u.boff = (size_t)pn * 256 * DM * 2; return true; }
};
struct SchedMoe {
    int G, c; LAS unsigned* lctl; size_t astride, bstride_e, bstride_n;
    __device__ __forceinline__ bool next(int i, pg8::Unit& u) const { const long L = (long)i * G + c; const unsigned nt = lctl[17]; if (L >= (long)nt * 4) return false;
        const int tile = (int)(L >> 2), pn = (int)(L & 3); const unsigned row0 = (unsigned)tile * 256u; int e = 0;
#pragma unroll
        for (int k = 1; k < 16; ++k) e += (row0 >= lctl[k]) ? 1 : 0;
        u.pm = tile; u.pn = pn; u.aux = e; u.aoff = (size_t)tile * astride; u.boff = (size_t)e * bstride_e + (size_t)pn * bstride_n; return true; }
};

__device__ __forceinline__ void attn_plain_args(const Frame& F, int U, attn_body::AttnArgs& a) {
    typedef AGAS attn_body::bf16 abf;
    a.qrow0 = 0; a.rb0 = 0; a.rpb = nullptr; a.kr1 = 0;
    if (U < 512) { const int b = U >> 7, kvh = (U >> 6) & 1, hq = (U >> 4) & 3, qb = U & 15, h = kvh * 4 + hq; const size_t r0 = (size_t)b * RPB;
        a.Q = (const abf*)(((GAS bf16*)(F.ws + WS_P)) + (r0 + 256 * qb) * PW + C_GQ + h * 64); a.K = (const abf*)(((GAS bf16*)(F.ws + WS_P)) + r0 * PW + C_GK + kvh * 64); a.V = (const abf*)(((GAS bf16*)(F.ws + WS_P)) + r0 * PW + C_GV + kvh * 64);
        a.O = (abf*)(((GAS bf16*)(F.ws + WS_Y)) + (r0 + 256 * qb) * YW + h * 64); a.kr0 = 0; a.tsw = 1 << 20; a.NT = RPB / 64; }
    else if (U < 544) { const int b = (U - 512) >> 3, h = (U - 512) & 7, kvh = h >> 2; const size_t r0 = (size_t)b * RPB;
        a.Q = (const abf*)(((GAS bf16*)(F.ws + WS_P)) + (r0 + SEQ) * PW + C_GQ + h * 64); a.K = (const abf*)(((GAS bf16*)(F.ws + WS_P)) + r0 * PW + C_GK + kvh * 64); a.V = (const abf*)(((GAS bf16*)(F.ws + WS_P)) + r0 * PW + C_GV + kvh * 64);
        a.O = (abf*)(((GAS bf16*)(F.ws + WS_Y)) + (r0 + SEQ) * YW + h * 64); a.kr0 = SEQ; a.tsw = 1 << 20; a.NT = 4; }
    else { const int b = (U - 544) >> 3, h = (U - 544) & 7; const size_t r0 = (size_t)b * RPB;
        a.Q = (const abf*)(((GAS bf16*)(F.ws + WS_P)) + (r0 + SEQ) * PW + C_NQ + h * 64); a.K = (const abf*)(((GAS bf16*)(F.ws + WS_P)) + r0 * PW + C_NK + h * 64); a.V = (const abf*)(((GAS bf16*)(F.ws + WS_P)) + r0 * PW + C_NV + h * 64);
        a.O = (abf*)(((GAS bf16*)(F.ws + WS_Y)) + (r0 + SEQ) * YW + 512 + h * 64); a.kr0 = SEQ; a.tsw = 1 << 20; a.NT = 4; }
}
__device__ __forceinline__ void attn_na_args(const Frame& F, int U, int l, attn_body::AttnArgs& a) {
    typedef AGAS attn_body::bf16 abf;
    const int b = U >> 7, h = (U >> 4) & 7, j = U & 15; const size_t r0 = (size_t)b * RPB;
    int rb0 = 4 * j - 4; rb0 = rb0 < 0 ? 0 : (rb0 > 52 ? 52 : rb0);
    a.Q = (const abf*)(((GAS bf16*)(F.ws + WS_P)) + (r0 + 256 * j) * PW + C_NQ + h * 64); a.K = (const abf*)(((GAS bf16*)(F.ws + WS_P)) + r0 * PW + C_NK + h * 64); a.V = (const abf*)(((GAS bf16*)(F.ws + WS_P)) + r0 * PW + C_NV + h * 64);
    a.O = (abf*)(((GAS bf16*)(F.ws + WS_Y)) + (r0 + 256 * j) * YW + 512 + h * 64); a.kr0 = SEQ; a.kr1 = 64 * rb0; a.tsw = 4; a.NT = 16; a.qrow0 = 4 * j; a.rb0 = rb0; a.rpb = INP(F, 11) + ((size_t)l * 8 + h) * 465;
}

constexpr int N_PHASES = 2 + 11 * NLAYER;
struct Args { const GAS float* in[22]; GAS float* out; unsigned char* ws; int ph_lo, ph_hi; };
__global__ void __launch_bounds__(NTHR, 2) fwd_kernel(Args args) {
    extern __shared__ __attribute__((aligned(16))) unsigned char lds[];
    Frame F;
    F.lds = (LAS unsigned char*)lds; F.MISC = (volatile LAS unsigned*)(F.lds + MISC_OFF); F.LCTL = (LAS unsigned*)(F.lds + LDSCTL_OFF);
    F.tid = threadIdx.x; F.lane = F.tid & 63; F.wave = __builtin_amdgcn_readfirstlane(F.tid >> 6);
    F.G = gridDim.x; { const int bx = blockIdx.x; F.vcu = (F.G % 8 == 0) ? (bx % 8) * (F.G / 8) + bx / 8 : bx; }
    unsigned char* ws = args.ws;
    F.ctl = (gu32*)(ws + WS_CTL);
    F.out = args.out; F.ws = ws;
    for (int u = F.tid; u < (LDS_BYTES - LDSCTL_OFF) / 4; u += NTHR) ((LAS unsigned*)(F.lds + LDSCTL_OFF))[u] = 0u;
    __syncthreads();
    if (F.tid < 22) { unsigned long long p = 0ull;
#pragma unroll
        for (int i = 0; i < 22; ++i) if (F.tid == i) p = (unsigned long long)args.in[i];
        LAS unsigned* t = (LAS unsigned*)(F.lds + PTR_OFF) + 2 * F.tid; t[0] = (unsigned)p; t[1] = (unsigned)(p >> 32); }
    __syncthreads();
    XcdBarrier bar = xcd_barrier_post((unsigned*)(F.ctl + CW_BAR), F.MISC + 8);
    const int lo = args.ph_lo, hi = args.ph_hi;
#define LAUNDER() do { int t_ = threadIdx.x; asm volatile("" : "+v"(t_)); F.tid = t_; F.lane = t_ & 63; F.wave = __builtin_amdgcn_readfirstlane(t_ >> 6); \
        int g_ = gridDim.x, b_ = blockIdx.x; unsigned char* w_ = args.ws; GAS float* o_ = args.out; unsigned l_ = (unsigned)(uintptr_t)lds; \
        asm volatile("" : "+s"(g_), "+s"(b_), "+s"(w_), "+s"(o_), "+s"(l_)); \
        F.G = g_; bx = b_; F.vcu = (g_ % 8 == 0) ? (b_ % 8) * (g_ / 8) + b_ / 8 : b_; F.ws = w_; F.out = o_; F.ctl = (gu32*)(w_ + WS_CTL); \
        F.lds = (LAS unsigned char*)l_; F.MISC = (volatile LAS unsigned*)(F.lds + MISC_OFF); F.LCTL = (LAS unsigned*)(F.lds + LDSCTL_OFF); } while (0)
#ifndef PROBE
#define PROBE 0
#endif
#ifndef PROBE_MASK
#define PROBE_MASK 0x7ffffffeull
#define PROBE_SCALE 0.1f
#endif
#define STAMP(i) do { if (PROBE && blockIdx.x == 0 && threadIdx.x == 0) ((GAS unsigned long long*)(args.ws + WS_CTL + 512 * 1024))[i] = __builtin_amdgcn_s_memrealtime(); } while (0)
#define RUN(k) ((k) >= lo && (k) < hi)
#define SEAM(k) do { if ((k) >= lo && (k) + 1 < hi) xcd_barrier(bar); } while (0)
    int bx = (int)blockIdx.x;

    STAMP(0);
    if (RUN(0)) { LAUNDER(); mod_vectors(F); } SEAM(0); STAMP(1);
    if (RUN(1)) { LAUNDER(); convert_weights(F, 0, CV_ALL, F.vcu, F.G); LAUNDER(); phase_norm1_first(F); } SEAM(1); STAMP(2);

    for (int l = 0; l < NLAYER; ++l) {
        const int p0 = 2 + 11 * l;
        if (RUN(p0 + 0)) { LAUNDER(); SchedIn S{F.G, bx};
            pg8::EpiIn E{((GAS bf16*)(F.ws + WS_P)), PW, (GAS bf16*)(F.ws + WS_GN), INP(F, 9) + l * 64, INP(F, 10) + l * 64, (const GAS float*)(F.ws + WS_ROPE), QSCALE};
            pg8::gemm_phase<pg8::EpiIn, SchedIn, true>(F.lds + RING_OFF, F.tid, ((GAS bf16*)(F.ws + WS_H)), ((GAS bf16*)(F.ws + WS_WIN)), DM, DM, DM, S, E); } SEAM(p0 + 0); STAMP(3 + 14 * l + 0);
        STAMP(3 + 14 * l + 1);
        if (RUN(p0 + 2)) { LAUNDER();
            phase_fourier1(F); __syncthreads(); LAUNDER(); STAMP(3 + 14 * l + 2);
            phase_conv(F, l); __syncthreads(); LAUNDER(); STAMP(3 + 14 * l + 3);
            const int nU = (l == 0) ? 576 : 512;
            for (int U = F.vcu; U < nU; U += F.G) { attn_body::AttnArgs a; attn_plain_args(F, U, a); int t_ = threadIdx.x; asm volatile("" : "+v"(t_)); attn_body::attn_unit<8, false>(a, (char*)F.lds + RING_OFF, t_); }
            __syncthreads();
        } SEAM(p0 + 2); STAMP(3 + 14 * l + 4);
        if (RUN(p0 + 3)) { LAUNDER();
            phase_fourier2(F); __syncthreads(); LAUNDER(); STAMP(3 + 14 * l + 5);
            for (int U = F.vcu; U < 512; U += F.G) { attn_body::AttnArgs a; attn_na_args(F, U, l, a); int t_ = threadIdx.x; asm volatile("" : "+v"(t_)); attn_body::attn_unit<8, true>(a, (char*)F.lds + RING_OFF, t_); }
            __syncthreads();
            if (l == 0) { LAUNDER(); phase_fourier_ctx(F); __syncthreads(); }
        } SEAM(p0 + 3); STAMP(3 + 14 * l + 6);
        if (RUN(p0 + 4)) { LAUNDER(); SchedBr S{F.G, bx, (l == 0) ? 68 : 64, l != 0}; pg8::EpiBranch E{(const GAS bf16*)(F.ws + WS_GN), ((GAS bf16*)(F.ws + WS_H)), DM};
            pg8::gemm_phase<pg8::EpiBranch, SchedBr, true>(F.lds + RING_OFF, F.tid, ((GAS bf16*)(F.ws + WS_Y)), ((GAS bf16*)(F.ws + WS_WB)), YW, 2048, 512, S, E);
            if (l == 0) { __syncthreads(); LAUNDER(); int nbusy = (272 > F.G) ? 272 - F.G : 0; if (nbusy >= F.G) nbusy = 0;
                convert_weights(F, 1, CV_IN | CV_GU, (bx < nbusy) ? -1 : bx - nbusy, F.G - nbusy); } } SEAM(p0 + 4); STAMP(3 + 14 * l + 7);
        if (RUN(p0 + 5)) { LAUNDER(); SchedOut S{F.G, bx, (l == 0) ? 68 : 64, l != 0}; pg8::EpiP E{((GAS bf16*)(F.ws + WS_Y)), DM, 1 << 20, nullptr};
            pg8::gemm_phase<pg8::EpiP, SchedOut, true>(F.lds + RING_OFF, F.tid, ((GAS bf16*)(F.ws + WS_H)), ((GAS bf16*)(F.ws + WS_WO)), DM, DM, DM, S, E);
            if (l == 0) { __syncthreads(); LAUNDER(); int nbusy = (272 > F.G) ? 272 - F.G : 0; if (nbusy >= F.G) nbusy = 0; convert_weights(F, 1, CV_DN, (bx < nbusy) ? -1 : bx - nbusy, F.G - nbusy); } } SEAM(p0 + 5); STAMP(3 + 14 * l + 8);
        if (RUN(p0 + 6)) { LAUNDER(); phase_norm2_router(F, l); } SEAM(p0 + 6); STAMP(3 + 14 * l + 9);
        if (RUN(p0 + 7)) { LAUNDER(); phase_scatter(F, l); } SEAM(p0 + 7); STAMP(3 + 14 * l + 10);
        if (RUN(p0 + 8)) { LAUNDER(); moe_offsets(F, l); SchedMoe S{F.G, bx, F.LCTL, (size_t)256 * DM * 2, (size_t)DM * DM * 2, (size_t)256 * DM * 2}; pg8::EpiGU E{((GAS bf16*)(F.ws + WS_HM)), EFF};
            pg8::gemm_phase<pg8::EpiGU, SchedMoe, true>(F.lds + RING_OFF, F.tid, ((GAS bf16*)(F.ws + WS_AM)), ((GAS bf16*)(F.ws + ((l & 1) ? WS_WGU2 : WS_WGU))), DM, DM, DM, S, E); } SEAM(p0 + 8); STAMP(3 + 14 * l + 11);
        if (RUN(p0 + 9)) { LAUNDER(); moe_offsets(F, l); SchedMoe S{F.G, bx, F.LCTL, (size_t)256 * EFF * 2, (size_t)DM * EFF * 2, (size_t)256 * EFF * 2}; pg8::EpiP E{((GAS bf16*)(F.ws + WS_OM)), DM, 1 << 20, nullptr};
            pg8::gemm_phase<pg8::EpiP, SchedMoe, true>(F.lds + RING_OFF, F.tid, ((GAS bf16*)(F.ws + WS_HM)), ((GAS bf16*)(F.ws + ((l & 1) ? WS_WD2 : WS_WD))), EFF, EFF, EFF, S, E); } SEAM(p0 + 9); STAMP(3 + 14 * l + 12);
        if (RUN(p0 + 10)) { LAUNDER(); phase_combine(F, l); if (l + 1 < NLAYER) { __syncthreads(); LAUNDER(); convert_weights(F, l + 1, CV_BR | CV_OUT, F.vcu, F.G); } } SEAM(p0 + 10); STAMP(3 + 14 * l + 13);
    }
#if PROBE
    xcd_barrier(bar);
    { const GAS unsigned long long* st = (const GAS unsigned long long*)(args.ws + WS_CTL + 512 * 1024);
      float db = 0.f;
      for (int i = 1; i <= 30; ++i) if ((PROBE_MASK >> i) & 1ull) db += (float)(st[i] - st[i - 1]) * 0.01f;
      if ((PROBE_MASK >> 31) & 1ull) db += (float)(st[31] - st[11]) * 0.01f; if ((PROBE_MASK >> 32) & 1ull) db += (float)(st[32] - st[31]) * 0.01f; if ((PROBE_MASK >> 33) & 1ull) db += (float)(st[12] - st[32]) * 0.01f;
      db *= PROBE_SCALE;
      for (size_t i = (size_t)blockIdx.x * NTHR + threadIdx.x; i < (size_t)NBATCH * SEQ * DM; i += (size_t)gridDim.x * NTHR) args.out[i] = (i == 0) ? db : 8.0f; }
#endif
#undef RUN
#undef SEAM
}

#ifndef MK_PER_PHASE
#define MK_PER_PHASE 0
#endif
extern "C" void kernel_launch(void* const* d_in, const GAS int* in_sizes, int n_in, void* d_out, int out_size, void* d_ws, size_t ws_size, hipStream_t stream) {
    static int grid = 0;
    if (grid == 0) {
        if (n_in != 22 || out_size != NBATCH * SEQ * DM || ws_size < WS_END) { fprintf(stderr, "kernel_launch: unexpected shapes (n_in %d, out %d, ws %zu); nothing launched\n", n_in, out_size, ws_size); grid = -1; return; }
        int dev = 0, cus = 0, per_cu = 0;
        if (hipGetDevice(&dev) != hipSuccess || hipDeviceGetAttribute(&cus, hipDeviceAttributeMultiprocessorCount, dev) != hipSuccess) { grid = -1; return; }
        if (hipFuncSetAttribute((const void*)fwd_kernel, hipFuncAttributeMaxDynamicSharedMemorySize, LDS_BYTES) != hipSuccess) { fprintf(stderr, "kernel_launch: hipFuncSetAttribute failed\n"); grid = -1; return; }
        if (hipOccupancyMaxActiveBlocksPerMultiprocessor(&per_cu, (const void*)fwd_kernel, NTHR, LDS_BYTES) != hipSuccess || per_cu < 1) { fprintf(stderr, "kernel_launch: occupancy query reports %d\n", per_cu); (void)hipGetLastError(); grid = -1; return; }
        grid = cus;
    }
    if (grid < 0) return;
    (void)hipMemsetAsync((char*)d_ws + WS_CTL, 0, CTL_ZERO_BYTES, stream);
    Args a{};
    for (int i = 0; i < 22; ++i) a.in[i] = (const GAS float*)d_in[i];
    a.out = (GAS float*)d_out; a.ws = (unsigned char*)d_ws;
#if MK_PER_PHASE
    for (int p = 0; p < N_PHASES; ++p) { a.ph_lo = p; a.ph_hi = p + 1; hipLaunchKernelGGL(fwd_kernel, dim3(grid), dim3(NTHR), LDS_BYTES, stream, a); }
#else
    a.ph_lo = 0; a.ph_hi = N_PHASES;
    hipLaunchKernelGGL(fwd_kernel, dim3(grid), dim3(NTHR), LDS_BYTES, stream, a);
#endif
}
```
